# Optimizing an MI355X kernel written in HIP

```python
import jax, jax.numpy as jnp
from jax import lax
import numpy as np

D_MODEL = 1024
BATCH = 4
SEQ = 4096
DEPTH = 2

N_META = 16
BLK = 128
PAD = BLK - N_META
ROPE_THETA = 10000.0
EPS = 1e-6
NEG = -1e30

FOX_HEADS = 8
FOX_DH = 64

MLA_HEADS = 8
MLA_NOPE = 64
MLA_ROPE = 32
MLA_V = 64
MLA_QLORA = 384
MLA_KVLORA = 256

SWA_HEADS = 8
SWA_KV_HEADS = 2
SWA_DH = 64
WINDOW = 128

BRANCH_W = 512
N_BRANCH = 3

SPLIT_SIZES = (
    FOX_HEADS * FOX_DH, FOX_HEADS * FOX_DH, FOX_HEADS * FOX_DH, FOX_HEADS, BRANCH_W,
    MLA_QLORA, MLA_KVLORA, MLA_ROPE, BRANCH_W,
    SWA_HEADS * SWA_DH, SWA_KV_HEADS * SWA_DH, SWA_KV_HEADS * SWA_DH, BRANCH_W,
    N_BRANCH * D_MODEL,
)
N_IN = sum(SPLIT_SIZES)

kernel_name = "hybrid_fox_mla_swa_gated_branches"


def rmsnorm(x, g):
    xf = x.astype(jnp.float32)
    y = xf * lax.rsqrt(jnp.mean(xf * xf, axis=-1, keepdims=True) + EPS)
    return (y * g.astype(jnp.float32)).astype(x.dtype)


def rope(x, pos):
    half = x.shape[-1] // 2
    inv = ROPE_THETA ** (-jnp.arange(half, dtype=jnp.float32) / half)
    ang = pos.astype(jnp.float32)[:, None] * inv[None, :]
    cos = jnp.cos(ang)[None, :, None, :]
    sin = jnp.sin(ang)[None, :, None, :]
    xf = x.astype(jnp.float32)
    x1, x2 = xf[..., :half], xf[..., half:]
    return jnp.concatenate([x1 * cos - x2 * sin, x2 * cos + x1 * sin], axis=-1).astype(x.dtype)


def causal_block_attention(q, k, v, scale, log_cum=None):
    B, L, H, _ = q.shape
    nb = L // BLK
    kpos = jnp.arange(L)
    key_ok = kpos >= PAD
    qb = jnp.moveaxis(q.reshape(B, nb, BLK, H, q.shape[-1]), 1, 0)
    if log_cum is None:
        xs = (jnp.arange(nb), qb)
        ck = None
    else:
        cb = jnp.moveaxis(log_cum.reshape(B, nb, BLK, H), 1, 0)
        xs = (jnp.arange(nb), qb, cb)
        ck = jnp.swapaxes(log_cum, 1, 2)

    def block(args):
        i, qi = args[0], args[1]
        s = jnp.einsum('bqhd,bkhd->bhqk', qi, k).astype(jnp.float32) * scale
        if log_cum is not None:
            ci = jnp.swapaxes(args[2], 1, 2)
            s = s + (ci[..., :, None] - ck[..., None, :])
        qpos = i * BLK + jnp.arange(BLK)
        mask = (kpos[None, :] <= qpos[:, None]) & key_ok[None, :]
        s = jnp.where(mask, s, NEG)
        p = jax.nn.softmax(s, axis=-1)
        return jnp.einsum('bhqk,bkhd->bqhd', p.astype(v.dtype), v)

    o = lax.map(block, xs)
    return jnp.moveaxis(o, 0, 1).reshape(B, L, H, v.shape[-1])


def sliding_window_sink_attention(q, k, v, sinks):
    B, L, H, D = q.shape
    Hkv = k.shape[2]
    G = H // Hkv
    nb = L // BLK
    qb = q.reshape(B, nb, BLK, Hkv, G, D)

    def with_prev(t):
        prev = jnp.concatenate([jnp.zeros_like(t[:, :1]), t[:, :-1]], axis=1)
        return jnp.concatenate([prev, t], axis=2)

    kx = with_prev(k.reshape(B, nb, BLK, Hkv, D))
    vx = with_prev(v.reshape(B, nb, BLK, Hkv, D))
    s = jnp.einsum('bnqhgd,bnkhd->bnhgqk', qb, kx).astype(jnp.float32) * (D ** -0.5)
    blocks = jnp.arange(nb)[:, None]
    qpos = blocks * BLK + jnp.arange(BLK)[None, :]
    kpos = (blocks - 1) * BLK + jnp.arange(2 * BLK)[None, :]
    rel = qpos[:, :, None] - kpos[:, None, :]
    mask = (rel >= 0) & (rel < WINDOW) & (kpos >= PAD)[:, None, :]
    s = jnp.where(mask[None, :, None, None], s, NEG)
    sink = jnp.broadcast_to(sinks.astype(jnp.float32).reshape(1, 1, Hkv, G, 1, 1), s.shape[:-1] + (1,))
    p = jax.nn.softmax(jnp.concatenate([s, sink], axis=-1), axis=-1)[..., :-1]
    o = jnp.einsum('bnhgqk,bnkhd->bnqhgd', p.astype(v.dtype), vx)
    return o.reshape(B, L, H, D)


def hybrid_layer(x, pos, norm_g, w_in, b_f, g_cq, g_ckv, w_uq, w_ukv, sinks, w_branch, w_out):
    B, L, _ = x.shape
    h = rmsnorm(x, norm_g)
    proj = h @ w_in
    (a_q, a_k, a_v, a_f, a_z,
     b_cq, b_ckv, b_kr, b_z,
     c_q, c_k, c_v, c_z, gates) = jnp.split(proj, np.cumsum(SPLIT_SIZES)[:-1], axis=-1)

    log_f = jax.nn.log_sigmoid((a_f + b_f).astype(jnp.float32))
    log_cum = jnp.cumsum(log_f, axis=1)
    y_a = causal_block_attention(a_q.reshape(B, L, FOX_HEADS, FOX_DH),
                                 a_k.reshape(B, L, FOX_HEADS, FOX_DH),
                                 a_v.reshape(B, L, FOX_HEADS, FOX_DH),
                                 FOX_DH ** -0.5, log_cum)

    cq = rmsnorm(b_cq, g_cq)
    ckv = rmsnorm(b_ckv, g_ckv)
    qB = (cq @ w_uq).reshape(B, L, MLA_HEADS, MLA_NOPE + MLA_ROPE)
    q_b = jnp.concatenate([qB[..., :MLA_NOPE], rope(qB[..., MLA_NOPE:], pos)], axis=-1)
    kvB = (ckv @ w_ukv).reshape(B, L, MLA_HEADS, MLA_NOPE + MLA_V)
    k_rope = rope(b_kr.reshape(B, L, 1, MLA_ROPE), pos)
    k_b = jnp.concatenate([kvB[..., :MLA_NOPE],
                           jnp.broadcast_to(k_rope, (B, L, MLA_HEADS, MLA_ROPE))], axis=-1)
    v_b = kvB[..., MLA_NOPE:]
    y_b = causal_block_attention(q_b, k_b, v_b, (MLA_NOPE + MLA_ROPE) ** -0.5)

    qc = rope(c_q.reshape(B, L, SWA_HEADS, SWA_DH), pos)
    kc = rope(c_k.reshape(B, L, SWA_KV_HEADS, SWA_DH), pos)
    vc = c_v.reshape(B, L, SWA_KV_HEADS, SWA_DH)
    y_c = sliding_window_sink_attention(qc, kc, vc, sinks)

    branches = jnp.stack([y_a.reshape(B, L, BRANCH_W) * jax.nn.silu(a_z),
                          y_b.reshape(B, L, BRANCH_W) * jax.nn.silu(b_z),
                          y_c.reshape(B, L, BRANCH_W) * jax.nn.silu(c_z)], axis=2)
    proj_br = jnp.einsum('blnw,nwd->blnd', branches, w_branch)
    g = jax.nn.sigmoid(gates.reshape(B, L, N_BRANCH, D_MODEL))
    merged = jnp.sum(g * proj_br, axis=2)
    return x + merged @ w_out


def setup_inputs(seed: int = 0) -> dict:
    key = jax.random.key(seed)
    ks = jax.random.split(key, 14)
    f32 = jnp.float32
    nrm = lambda k, shape, scale: jax.random.normal(k, shape, f32) * scale
    return {
        "x": nrm(ks[0], (BATCH, SEQ, D_MODEL), 1.0),
        "meta_tokens": nrm(ks[1], (N_META, D_MODEL), 1.0),
        "norm_g": 1.0 + nrm(ks[2], (DEPTH, D_MODEL), 0.02),
        "w_in": nrm(ks[3], (DEPTH, D_MODEL, N_IN), D_MODEL ** -0.5),
        "b_f": jax.random.uniform(ks[4], (DEPTH, FOX_HEADS), f32, 1.0, 4.0),
        "g_cq": 1.0 + nrm(ks[5], (DEPTH, MLA_QLORA), 0.02),
        "g_ckv": 1.0 + nrm(ks[6], (DEPTH, MLA_KVLORA), 0.02),
        "w_uq": nrm(ks[7], (DEPTH, MLA_QLORA, MLA_HEADS * (MLA_NOPE + MLA_ROPE)), MLA_QLORA ** -0.5),
        "w_ukv": nrm(ks[8], (DEPTH, MLA_KVLORA, MLA_HEADS * (MLA_NOPE + MLA_V)), MLA_KVLORA ** -0.5),
        "sinks": nrm(ks[9], (DEPTH, SWA_HEADS), 0.5),
        "w_branch": nrm(ks[10], (DEPTH, N_BRANCH, BRANCH_W, D_MODEL), BRANCH_W ** -0.5),
        "w_out": nrm(ks[11], (DEPTH, D_MODEL, D_MODEL), D_MODEL ** -0.5),
        "final_g": 1.0 + nrm(ks[12], (D_MODEL,), 0.02),
    }


def reference(x, meta_tokens, norm_g, w_in, b_f, g_cq, g_ckv, w_uq, w_ukv, sinks, w_branch, w_out, final_g):
    B = x.shape[0]
    pad = jnp.zeros((B, PAD, D_MODEL), x.dtype)
    meta = jnp.broadcast_to(meta_tokens.astype(x.dtype)[None], (B, N_META, D_MODEL))
    h = jnp.concatenate([pad, meta, x], axis=1)
    pos = jnp.arange(h.shape[1]) - PAD
    for l in range(DEPTH):
        h = hybrid_layer(h, pos, norm_g[l], w_in[l], b_f[l], g_cq[l], g_ckv[l],
                         w_uq[l], w_ukv[l], sinks[l], w_branch[l], w_out[l])
    h = rmsnorm(h, final_g)
    return h[:, BLK:]
```

```cpp
#include <hip/hip_runtime.h>
#include <cstdio>
#include <cstdint>

#ifndef MK_SINGLE
#define MK_SINGLE 0
#endif

#define GAS __attribute__((address_space(1)))
#define LAS __attribute__((address_space(3)))
typedef unsigned short bf16;
typedef short bf16x8 __attribute__((ext_vector_type(8)));
typedef float f32x4 __attribute__((ext_vector_type(4)));
typedef unsigned u32x4 __attribute__((ext_vector_type(4)));
typedef unsigned u32x2 __attribute__((ext_vector_type(2)));
typedef float f32x2_t __attribute__((ext_vector_type(2)));
typedef __bf16 bf16x2_t __attribute__((ext_vector_type(2)));
typedef GAS unsigned gu32;
#define RLX_AGENT __ATOMIC_RELAXED, __HIP_MEMORY_SCOPE_AGENT

constexpr int DM = 1024, NBATCH = 4, SEQ = 4096, M = NBATCH * SEQ, NMETA = 16, FR = 64, MOFF = 48, NPOS = SEQ + NMETA;
constexpr int NIN = 7592, NWAVES = 8, NTHREADS = NWAVES * 64;
constexpr float EPS = 1e-6f, LOG2E = 1.4426950408889634f, LN2 = 0.6931471805599453f;
constexpr float C2A = 0.125f * LOG2E, C2B = 0.10206207261596575f * LOG2E, C2C = 0.125f * LOG2E;
constexpr int LC_AQ = 0, LC_AK = 512, LC_AV = 1024, LC_AF = 1536, LC_AZ = 1544, LC_BCQ = 2056, LC_BCKV = 2440, LC_BKR = 2696, LC_BZ = 2728,
              LC_CQ = 3240, LC_CK = 3752, LC_CV = 3880, LC_CZ = 4008, LC_G = 4520;
constexpr int NE = 3072, NL = 4608, NUQ = 768, NUKV = 1024;
constexpr int PQA = 512, PKA = 640, PVA = 512, PQB = 768, PKB = 768, PVB = 512, PQC = 512, PKC = 128, PVC = 128, PCQ = 384, PCKV = 256, PY = 512, PG = 3072;

constexpr size_t MiB = 1u << 20;
constexpr size_t al(size_t x) { return (x + 255) & ~(size_t)255; }
constexpr size_t WS_CTL = 0, CTL_BYTES = 1 * MiB;
constexpr size_t WS_COS64 = CTL_BYTES, WS_SIN64 = WS_COS64 + al((size_t)NPOS * 32 * 4), WS_COS32 = WS_SIN64 + al((size_t)NPOS * 32 * 4), WS_SIN32 = WS_COS32 + al((size_t)NPOS * 16 * 4);
constexpr size_t WS_LF = WS_SIN32 + al((size_t)NPOS * 16 * 4), WS_RQ = WS_LF + al((size_t)M * 8 * 4), WS_RKV = WS_RQ + al((size_t)M * 4);
constexpr size_t WS_HM = WS_RKV + al((size_t)M * 4);
constexpr size_t WS_HNM = WS_HM + al(16 * 1024 * 4);
constexpr size_t WS_RAWE = WS_HNM + al(16 * 1024 * 2);
constexpr size_t WS_RAWU = WS_RAWE + al(16 * NE * 4);
constexpr size_t WS_RAWL = WS_RAWU + al(16 * (NUQ + NUKV) * 4);
constexpr size_t WS_RAWB = WS_RAWL + al(16 * NL * 4);
constexpr size_t WS_RAWO = WS_RAWB + al(3 * 16 * 1024 * 4);
constexpr size_t WS_YM = WS_RAWO + al(16 * 1024 * 4);
constexpr size_t WS_CM = WS_YM + al(16 * 1536 * 2);
constexpr size_t WS_RQM = WS_CM + al(16 * 640 * 2);
constexpr size_t WS_LFM = WS_RQM + al(32 * 4);
constexpr size_t WS_QAM = WS_LFM + al(16 * 8 * 4);
constexpr size_t WS_QBM = WS_QAM + al(16 * 512 * 2);
constexpr size_t WS_QCM = WS_QBM + al(16 * 768 * 2);
constexpr size_t WS_SMALL_END = WS_QCM + al(16 * 512 * 2);
constexpr size_t WL_EARLY = 0, WL_LATE = WL_EARLY + (size_t)NE * DM * 2, WL_UQ = WL_LATE + (size_t)NL * DM * 2, WL_UKV = WL_UQ + (size_t)NUQ * 384 * 2,
                 WL_BR = WL_UKV + (size_t)NUKV * 256 * 2, WL_OUT = WL_BR + (size_t)3 * DM * 512 * 2, WL_BYTES = WL_OUT + (size_t)DM * DM * 2;
constexpr size_t WS_W = 6 * MiB;
static_assert(WS_SMALL_END <= WS_W, "small region");
constexpr size_t WS_HN = WS_W + al(2 * WL_BYTES);
constexpr size_t WS_QA = WS_HN + (size_t)M * DM * 2;
constexpr size_t WS_QC = WS_QA + (size_t)M * PQA * 2;
constexpr size_t WS_CQ = WS_QC + (size_t)M * PQC * 2;
constexpr size_t WS_CKV = WS_CQ + (size_t)M * PCQ * 2;
constexpr size_t WS_YB = WS_CQ;
constexpr size_t WS_QB = WS_CKV + (size_t)M * PCKV * 2;
constexpr size_t WS_KB = WS_QB + (size_t)M * PQB * 2;
constexpr size_t WS_VB = WS_KB + (size_t)(FR + M) * PKB * 2;
constexpr size_t WS_KA = WS_VB + (size_t)(FR + M) * PVB * 2;
constexpr size_t WS_VA = WS_KA + (size_t)(FR + M) * PKA * 2;
constexpr size_t WS_KC = WS_VA + (size_t)(FR + M) * PVA * 2;
constexpr size_t WS_VC = WS_KC + (size_t)(FR + M) * PKC * 2;
constexpr size_t WS_END = WS_VC + (size_t)(FR + M) * PVC * 2;
constexpr size_t WS_G = WS_QB;
static_assert(WS_G + (size_t)M * PG * 2 <= WS_KC, "G overlay");
static_assert((size_t)M * PY * 2 <= (size_t)M * (PCQ + PCKV) * 2, "YB overlay");
static_assert(WS_END <= 256 * MiB, "workspace");

__device__ __forceinline__ unsigned cvtpk(float lo, float hi) { f32x2_t v = {lo, hi}; bf16x2_t b = __builtin_convertvector(v, bf16x2_t); return __builtin_bit_cast(unsigned, b); }
__device__ __forceinline__ bf16 f2bf(float f) { return (bf16)(cvtpk(f, 0.f) & 0xffffu); }
__device__ __forceinline__ float bf2f(bf16 v) { return __uint_as_float((unsigned)v << 16); }
__device__ __forceinline__ float bflo(unsigned w) { return __uint_as_float(w << 16); }
__device__ __forceinline__ float bfhi(unsigned w) { return __uint_as_float(w & 0xffff0000u); }
__device__ __forceinline__ float fexp2(float x) { return __builtin_amdgcn_exp2f(x); }
__device__ __forceinline__ float frcp(float x) { return __builtin_amdgcn_rcpf(x); }
__device__ __forceinline__ float sigmoidf_(float x) { return frcp(1.f + fexp2(-x * LOG2E)); }
__device__ __forceinline__ float siluf_(float x) { return x * sigmoidf_(x); }
__device__ __forceinline__ float logsigf_(float x) { return fminf(x, 0.f) - __builtin_amdgcn_logf(1.f + fexp2(-fabsf(x) * LOG2E)) * LN2; }
__device__ __forceinline__ float wave_sum(float v) {
#pragma unroll
    for (int o = 1; o < 64; o <<= 1) v += __shfl_xor(v, o);
    return v;
}
__device__ __forceinline__ u32x4 pack8(f32x4 a, f32x4 b) { u32x4 w; w.x = cvtpk(a[0], a[1]); w.y = cvtpk(a[2], a[3]); w.z = cvtpk(b[0], b[1]); w.w = cvtpk(b[2], b[3]); return w; }
__device__ __forceinline__ void st8(bf16* p, f32x4 a, f32x4 b) { *(u32x4*)p = pack8(a, b); }
__device__ __forceinline__ void ld8(const bf16* p, f32x4& a, f32x4& b) { const u32x4 w = *(const u32x4*)p; a = (f32x4){bflo(w.x), bfhi(w.x), bflo(w.y), bfhi(w.y)}; b = (f32x4){bflo(w.z), bfhi(w.z), bflo(w.w), bfhi(w.w)}; }
__device__ __forceinline__ void split3(float b, bf16& h, bf16& m, bf16& l) { h = f2bf(b); const float r1 = b - bf2f(h); m = f2bf(r1); const float r2 = r1 - bf2f(m); l = f2bf(r2); }

enum { MAP_EARLY = 0, MAP_LATE = 1, MAP_UQ = 2, MAP_ID = 3 };
__device__ __forceinline__ int map_col(int kind, int p) {
    const int t = p >> 8, c = p & 255, half = c >> 7, c7 = c & 127;
    if (kind == MAP_EARLY) {
        if (t < 2) return LC_AQ + p;
        if (t < 4) return LC_AK + (p - 512);
        if (t < 6) return LC_AV + (p - 1024);
        if (t < 8) return LC_CQ + 256 * (t - 6) + 64 * (c7 >> 5) + 32 * half + (c7 & 31);
        if (t == 8) { if (c7 < 64) return LC_CK + 64 * (c7 >> 5) + 32 * half + (c7 & 31); return LC_CV + 64 * half + (c7 - 64); }
        if (t == 9) return LC_BCQ + c;
        if (t == 10) { if (c7 < 64) return LC_BCQ + 256 + 64 * half + c7; if (c7 < 80) return LC_BKR + 16 * half + (c7 - 64); if (c7 < 88 && half == 0) return LC_AF + (c7 - 80); return -1; }
        return LC_BCKV + c;
    }
    if (kind == MAP_LATE) {
        if (t < 2) return LC_AZ + p;
        if (t < 4) return LC_BZ + (p - 512);
        if (t < 6) return LC_CZ + (p - 1024);
        return LC_G + (p - 1536);
    }
    if (kind == MAP_UQ) {
        if (t < 2) return (4 * t + (c >> 6)) * 96 + (c & 63);
        return (c7 >> 4) * 96 + 64 + 16 * half + (c7 & 15);
    }
    return p;
}

struct Ctx {
    const float *x, *meta, *norm_g, *w_in, *b_f, *g_cq, *g_ckv, *w_uq, *w_ukv, *sinks, *w_branch, *w_out, *final_g;
    float* out; unsigned char* ws;
    LAS unsigned char* lds;
    int tid, lane, wave, G, bid;
};
#define WSP(T, off) ((T*)(c.ws + (off)))
__device__ __forceinline__ bf16* wl(const Ctx& c, int layer, size_t off) { return (bf16*)(c.ws + WS_W + (size_t)layer * WL_BYTES + off); }

__device__ __forceinline__ void conv_item(const float* W, int N, const float* gv, bf16* Bt, int K, int kind, int nblk, int item, LAS float* scr, int lane) {
    const int kb = item / nblk, nb = item % nblk, k0 = 64 * kb, n0 = 32 * nb;
    const int lc = map_col(kind, n0 + (lane & 31));
#pragma unroll 8
    for (int i = 0; i < 32; ++i) { const int kk = 2 * i + (lane >> 5); float v = 0.f; if (lc >= 0) { v = W[(size_t)(k0 + kk) * N + lc]; if (gv) v *= gv[k0 + kk]; } scr[kk * 33 + (lane & 31)] = v; }
    asm volatile("s_waitcnt lgkmcnt(0)" ::: "memory");
    const int ch = lane & 7;
#pragma unroll
    for (int j = 0; j < 4; ++j) { const int n = (lane >> 3) + 8 * j; const LAS float* s = scr + (8 * ch) * 33 + n;
        u32x4 o; o.x = cvtpk(s[0 * 33], s[1 * 33]); o.y = cvtpk(s[2 * 33], s[3 * 33]); o.z = cvtpk(s[4 * 33], s[5 * 33]); o.w = cvtpk(s[6 * 33], s[7 * 33]);
        *(u32x4*)(Bt + (size_t)(n0 + n) * K + k0 + 8 * ch) = o; }
    asm volatile("s_waitcnt lgkmcnt(0)" ::: "memory");
}
__device__ __forceinline__ void zero_fronts(const Ctx& c) {
    const int g = c.bid * NTHREADS + c.tid, NG = c.G * NTHREADS;
    const u32x4 z = {0u, 0u, 0u, 0u};
    for (int e = g; e < MOFF * PKB / 8; e += NG) WSP(u32x4, WS_KB)[e] = z;
    for (int e = g; e < MOFF * PVB / 8; e += NG) WSP(u32x4, WS_VB)[e] = z;
    for (int e = g; e < MOFF * PKA / 8; e += NG) WSP(u32x4, WS_KA)[e] = z;
    for (int e = g; e < MOFF * PVA / 8; e += NG) WSP(u32x4, WS_VA)[e] = z;
    for (int e = g; e < MOFF * PKC / 8; e += NG) WSP(u32x4, WS_KC)[e] = z;
    for (int e = g; e < MOFF * PVC / 8; e += NG) WSP(u32x4, WS_VC)[e] = z;
}
__device__ __forceinline__ void sincos_d(float ang, float& s, float& co) {
    const double x = (double)ang, TWO_PI = 6.283185307179586476925, INV = 0.15915494309189533577;
    const double n = __builtin_rint(x * INV), r = __builtin_fma(-n, TWO_PI, x), y = 0.5 * r, y2 = y * y;
    double sp, cp;
    double ts = 1.0, tc = 1.0; sp = 1.0; cp = 1.0;
#pragma unroll
    for (int j = 1; j <= 12; ++j) { tc = -tc * y2 / (double)((2 * j - 1) * (2 * j)); ts = -ts * y2 / (double)((2 * j) * (2 * j + 1)); cp += tc; sp += ts; }
    const double sy = y * sp, cy = cp;
    s = (float)(2.0 * sy * cy); co = (float)(1.0 - 2.0 * sy * sy);
}
__device__ __forceinline__ void rope_tables(const Ctx& c) {
    const int g = c.bid * NTHREADS + c.tid, NG = c.G * NTHREADS;
    for (int e = g; e < NPOS * 48; e += NG) {
        const int pos = e / 48, i = e % 48;
        float inv; if (i < 32) inv = fexp2(-(float)i * (13.287712379549449f / 32.f)); else inv = fexp2(-(float)(i - 32) * (13.287712379549449f / 16.f));
        const float ang = (float)pos * inv; float s, co; sincos_d(ang, s, co);
        if (i < 32) { WSP(float, WS_COS64)[pos * 32 + i] = co; WSP(float, WS_SIN64)[pos * 32 + i] = s; }
        else { WSP(float, WS_COS32)[pos * 16 + i - 32] = co; WSP(float, WS_SIN32)[pos * 16 + i - 32] = s; }
    }
}
__device__ __forceinline__ void rms_row_to_bf16(const float* xrow, bf16* orow, float* copy, int lane) {
    const f32x4* xr = (const f32x4*)xrow + lane;
    f32x4 v[4]; float s = 0.f;
#pragma unroll
    for (int j = 0; j < 4; ++j) { v[j] = xr[64 * j]; s += (v[j][0] * v[j][0] + v[j][1] * v[j][1]) + (v[j][2] * v[j][2] + v[j][3] * v[j][3]); }
    const float rstd = 1.f / sqrtf(wave_sum(s) * (1.f / DM) + EPS);
    u32x2* o8 = (u32x2*)orow + lane;
#pragma unroll
    for (int j = 0; j < 4; ++j) { u32x2 w; w.x = cvtpk(v[j][0] * rstd, v[j][1] * rstd); w.y = cvtpk(v[j][2] * rstd, v[j][3] * rstd); o8[64 * j] = w; if (copy) ((f32x4*)copy + lane)[64 * j] = v[j]; }
}
__device__ __forceinline__ void slot0(const Ctx& c) {
    LAS float* scr = (LAS float*)(c.lds + c.wave * 16384);
    const int gw = c.bid * NWAVES + c.wave, NGW = c.G * NWAVES;
    for (int layer = 0; layer < 2; ++layer) {
        const float* w_in = c.w_in + (size_t)layer * DM * NIN;
        const int I_E = 16 * (NE / 32), I_L = 16 * (NL / 32), I_UQ = 6 * (NUQ / 32), I_UKV = 4 * (NUKV / 32), I_BR = 8 * (DM / 32), I_O = 16 * (DM / 32);
        const int tot = I_E + I_L + I_UQ + I_UKV + 3 * I_BR + I_O;
        for (int it = gw; it < tot; it += NGW) {
            int r = it;
            if (r < I_E) { conv_item(w_in, NIN, c.norm_g + layer * DM, wl(c, layer, WL_EARLY), DM, MAP_EARLY, NE / 32, r, scr, c.lane); continue; } r -= I_E;
            if (r < I_L) { conv_item(w_in, NIN, c.norm_g + layer * DM, wl(c, layer, WL_LATE), DM, MAP_LATE, NL / 32, r, scr, c.lane); continue; } r -= I_L;
            if (r < I_UQ) { conv_item(c.w_uq + (size_t)layer * 384 * 768, 768, c.g_cq + layer * 384, wl(c, layer, WL_UQ), 384, MAP_UQ, NUQ / 32, r, scr, c.lane); continue; } r -= I_UQ;
            if (r < I_UKV) { conv_item(c.w_ukv + (size_t)layer * 256 * 1024, 1024, c.g_ckv + layer * 256, wl(c, layer, WL_UKV), 256, MAP_ID, NUKV / 32, r, scr, c.lane); continue; } r -= I_UKV;
            if (r < 3 * I_BR) { const int n = r / I_BR; conv_item(c.w_branch + ((size_t)layer * 3 + n) * 512 * DM, DM, nullptr, wl(c, layer, WL_BR) + (size_t)n * DM * 512, 512, MAP_ID, DM / 32, r % I_BR, scr, c.lane); continue; } r -= 3 * I_BR;
            conv_item(c.w_out + (size_t)layer * DM * DM, DM, nullptr, wl(c, layer, WL_OUT), DM, MAP_ID, DM / 32, r, scr, c.lane);
        }
    }
    rope_tables(c);
    if (gw < 16) rms_row_to_bf16(c.meta + (size_t)gw * DM, WSP(bf16, WS_HNM) + (size_t)gw * DM, WSP(float, WS_HM) + (size_t)gw * DM, c.lane);
}

__device__ __forceinline__ void norm_main(const Ctx& c, const float* src) {
    const int gw = c.bid * NWAVES + c.wave, NGW = c.G * NWAVES;
    for (int m = gw; m < M; m += NGW) rms_row_to_bf16(src + (size_t)m * DM, WSP(bf16, WS_HN) + (size_t)m * DM, nullptr, c.lane);
}

template <class AF>
__device__ __forceinline__ void meta_block(const AF& af, const bf16* Bt, int K, int col0, float* raw, int ldraw, int rcol0, int lane) {
    f32x4 acc = {0.f, 0.f, 0.f, 0.f};
    const int r = lane & 15, kq = 8 * (lane >> 4);
    for (int k0 = 0; k0 < K; k0 += 32) {
        const bf16x8 a = af(r, k0 + kq);
        const bf16x8 b = *(const bf16x8*)(Bt + (size_t)(col0 + r) * K + k0 + kq);
        acc = __builtin_amdgcn_mfma_f32_16x16x32_bf16(a, b, acc, 0, 0, 0);
    }
#pragma unroll
    for (int x = 0; x < 4; ++x) raw[(size_t)(4 * (lane >> 4) + x) * ldraw + rcol0 + r] = acc[x];
}
struct AfPlain { const bf16* A; int lda; __device__ __forceinline__ bf16x8 operator()(int r, int k) const { return *(const bf16x8*)(A + (size_t)r * lda + k); } };
struct AfBranch {
    const bf16* ym; const float* rawl; int n;
    __device__ __forceinline__ bf16x8 operator()(int r, int k) const {
        f32x4 y0, y1; ld8(ym + (size_t)r * 1536 + n * 512 + k, y0, y1);
        const f32x4 z0 = *(const f32x4*)(rawl + (size_t)r * NL + 512 * n + k), z1 = *(const f32x4*)(rawl + (size_t)r * NL + 512 * n + k + 4);
#pragma unroll
        for (int j = 0; j < 4; ++j) { y0[j] *= siluf_(z0[j]); y1[j] *= siluf_(z1[j]); }
        return __builtin_bit_cast(bf16x8, pack8(y0, y1));
    }
};
struct AfMerged {
    const float* rawl; const float* rawb;
    __device__ __forceinline__ bf16x8 operator()(int r, int k) const {
        f32x4 s0 = {0.f, 0.f, 0.f, 0.f}, s1 = s0;
#pragma unroll
        for (int n = 0; n < 3; ++n) {
            const float* g = rawl + (size_t)r * NL + 1536 + n * 1024 + k; const float* p = rawb + ((size_t)n * 16 + r) * 1024 + k;
#pragma unroll
            for (int j = 0; j < 4; ++j) { s0[j] += sigmoidf_(g[j]) * p[j]; s1[j] += sigmoidf_(g[4 + j]) * p[4 + j]; }
        }
        return __builtin_bit_cast(bf16x8, pack8(s0, s1));
    }
};
template <class AF>
__device__ __forceinline__ void meta_blocks(const Ctx& c, const AF& af, const bf16* Bt, int K, int nblocks, float* raw, int ldraw, int rcol0) {
    const int gw = c.bid * NWAVES + c.wave, NGW = c.G * NWAVES;
    for (int b = gw; b < nblocks; b += NGW) meta_block(af, Bt, K, 16 * b, raw, ldraw, rcol0 + 16 * b, c.lane);
}

__device__ __forceinline__ void post_early(const Ctx& c, int layer) {
    const float* raw = WSP(float, WS_RAWE);
    bf16 *QAm = WSP(bf16, WS_QAM), *QCm = WSP(bf16, WS_QCM), *cm = WSP(bf16, WS_CM);
    bf16 *KAf = WSP(bf16, WS_KA), *VAf = WSP(bf16, WS_VA), *KBf = WSP(bf16, WS_KB), *KCf = WSP(bf16, WS_KC), *VCf = WSP(bf16, WS_VC);
    float* LFm = WSP(float, WS_LFM);
    const float *cos64 = WSP(float, WS_COS64), *sin64 = WSP(float, WS_SIN64), *cos32 = WSP(float, WS_COS32), *sin32 = WSP(float, WS_SIN32);
    for (int e = c.tid; e < 16 * NE; e += NTHREADS) {
        const int r = e / NE, p = e % NE, t = p >> 8, cc = p & 255, half = cc >> 7, c7 = cc & 127; const float v = raw[e];
        if (t < 2) QAm[r * PQA + p] = f2bf(v * C2A);
        else if (t < 4) { const int L = p - 512; KAf[(size_t)(MOFF + r) * PKA + (L >> 6) * 80 + (L & 63)] = f2bf(v); }
        else if (t < 6) VAf[(size_t)(MOFF + r) * PVA + (p - 1024)] = f2bf(v);
        else if (t < 8) { if (half == 0) { const int hh = c7 >> 5, d = c7 & 31, head = 4 * (t - 6) + hh; const float x1 = v, x2 = raw[e + 128], cs = cos64[r * 32 + d], sn = sin64[r * 32 + d];
                QCm[r * PQC + head * 64 + d] = f2bf((x1 * cs - x2 * sn) * C2C); QCm[r * PQC + head * 64 + 32 + d] = f2bf((x2 * cs + x1 * sn) * C2C); } }
        else if (t == 8) { if (c7 < 64) { if (half == 0) { const int hh = c7 >> 5, d = c7 & 31; const float x1 = v, x2 = raw[e + 128], cs = cos64[r * 32 + d], sn = sin64[r * 32 + d];
                    KCf[(size_t)(MOFF + r) * PKC + hh * 64 + d] = f2bf(x1 * cs - x2 * sn); KCf[(size_t)(MOFF + r) * PKC + hh * 64 + 32 + d] = f2bf(x2 * cs + x1 * sn); } }
            else VCf[(size_t)(MOFF + r) * PVC + 64 * half + (c7 - 64)] = f2bf(v); }
        else if (t == 9) cm[r * 640 + cc] = f2bf(v);
        else if (t == 10) { if (c7 < 64) cm[r * 640 + 256 + 64 * half + c7] = f2bf(v);
            else if (c7 < 80) { if (half == 0) { const int d = c7 - 64; const float x1 = v, x2 = raw[e + 128], cs = cos32[r * 16 + d], sn = sin32[r * 16 + d]; const bf16 o1 = f2bf(x1 * cs - x2 * sn), o2 = f2bf(x2 * cs + x1 * sn);
                    for (int h = 0; h < 8; ++h) { KBf[(size_t)(MOFF + r) * PKB + h * 96 + 64 + d] = o1; KBf[(size_t)(MOFF + r) * PKB + h * 96 + 80 + d] = o2; } } }
            else if (c7 < 88 && half == 0) LFm[r * 8 + (c7 - 80)] = logsigf_(v + c.b_f[layer * 8 + (c7 - 80)]); }
        else cm[r * 640 + 384 + cc] = f2bf(v);
    }
    __syncthreads();
    float* rqm = WSP(float, WS_RQM);
    if (c.tid < 16) { float s = 0.f; for (int k = 0; k < 384; ++k) { const float v = bf2f(cm[c.tid * 640 + k]); s += v * v; } rqm[c.tid] = 1.f / sqrtf(s * (1.f / 384.f) + EPS); }
    else if (c.tid < 32) { const int r = c.tid - 16; float s = 0.f; for (int k = 0; k < 256; ++k) { const float v = bf2f(cm[r * 640 + 384 + k]); s += v * v; } rqm[16 + r] = 1.f / sqrtf(s * (1.f / 256.f) + EPS); }
    else if (c.tid < 40) { const int h = c.tid - 32; float suf = 0.f;
        for (int r = 15; r >= 0; --r) { bf16 bh, bm, bl; split3(suf * LOG2E, bh, bm, bl); bf16* kp = KAf + (size_t)(MOFF + r) * PKA + h * 80 + 64; kp[0] = bh; kp[1] = bm; kp[2] = bl; for (int j = 3; j < 16; ++j) kp[j] = 0; suf += LFm[r * 8 + h]; } }
}
__device__ __forceinline__ void post_up(const Ctx& c) {
    const float* raw = WSP(float, WS_RAWU); const float* rqm = WSP(float, WS_RQM);
    bf16 *QBm = WSP(bf16, WS_QBM), *KBf = WSP(bf16, WS_KB), *VBf = WSP(bf16, WS_VB);
    const float *cos32 = WSP(float, WS_COS32), *sin32 = WSP(float, WS_SIN32);
    for (int e = c.tid; e < 16 * (NUQ + NUKV); e += NTHREADS) {
        const int r = e / (NUQ + NUKV), p = e % (NUQ + NUKV); const float v = raw[e];
        if (p < 512) { const int h = p >> 6, d = p & 63; QBm[r * PQB + h * 96 + d] = f2bf(v * rqm[r] * C2B); }
        else if (p < 768) { const int cc = p - 512, half = cc >> 7, c7 = cc & 127; if (half == 0) { const int h = c7 >> 4, d = c7 & 15; const float sc = rqm[r] * C2B, x1 = v * sc, x2 = raw[e + 128] * sc, cs = cos32[r * 16 + d], sn = sin32[r * 16 + d];
                QBm[r * PQB + h * 96 + 64 + d] = f2bf(x1 * cs - x2 * sn); QBm[r * PQB + h * 96 + 80 + d] = f2bf(x2 * cs + x1 * sn); } }
        else { const int q = p - 768, h = q >> 7, d = q & 127; const float w = v * rqm[16 + r];
            if (d < 64) KBf[(size_t)(MOFF + r) * PKB + h * 96 + d] = f2bf(w); else VBf[(size_t)(MOFF + r) * PVB + h * 64 + (d - 64)] = f2bf(w); }
    }
}
__device__ __forceinline__ void post_resid(const Ctx& c) {
    for (int r = c.wave; r < 16; r += NWAVES) {
        float* hm = WSP(float, WS_HM) + (size_t)r * DM; const float* ro = WSP(float, WS_RAWO) + (size_t)r * DM;
        f32x4 v[4]; float s = 0.f;
#pragma unroll
        for (int j = 0; j < 4; ++j) { v[j] = ((const f32x4*)hm + c.lane)[64 * j] + ((const f32x4*)ro + c.lane)[64 * j]; s += (v[j][0] * v[j][0] + v[j][1] * v[j][1]) + (v[j][2] * v[j][2] + v[j][3] * v[j][3]); }
        const float rstd = 1.f / sqrtf(wave_sum(s) * (1.f / DM) + EPS);
        u32x2* o8 = (u32x2*)(WSP(bf16, WS_HNM) + (size_t)r * DM) + c.lane;
#pragma unroll
        for (int j = 0; j < 4; ++j) { u32x2 w; w.x = cvtpk(v[j][0] * rstd, v[j][1] * rstd); w.y = cvtpk(v[j][2] * rstd, v[j][3] * rstd); o8[64 * j] = w; ((f32x4*)hm + c.lane)[64 * j] = v[j]; }
    }
}

template <int DK, int MODE>
__device__ __forceinline__ void attn_row(const bf16* qrow, const bf16* Kf, const bf16* Km, int kpitch, int koff, const bf16* Vf, const bf16* Vm, int vpitch, int voff, int t, float sink2, bf16* orow) {
    float q[DK];
#pragma unroll
    for (int d = 0; d < DK; d += 8) { f32x4 a, b; ld8(qrow + d, a, b);
#pragma unroll
        for (int j = 0; j < 4; ++j) { q[d + j] = a[j]; q[d + 4 + j] = b[j]; } }
    float o[64];
#pragma unroll
    for (int d = 0; d < 64; ++d) o[d] = 0.f;
    float m = -1e30f, l = 0.f; if (MODE == 2) { m = sink2; l = 1.f; }
    const int s0 = (MODE == 2) ? (t - 127 > 0 ? t - 127 : 0) : 0;
    for (int s = s0; s <= t; ++s) {
        const bf16* kp = (s < NMETA) ? Kf + (size_t)(MOFF + s) * kpitch + koff : Km + (size_t)(s - NMETA) * kpitch + koff;
        const bf16* vp = (s < NMETA) ? Vf + (size_t)(MOFF + s) * vpitch + voff : Vm + (size_t)(s - NMETA) * vpitch + voff;
        float x = 0.f;
#pragma unroll
        for (int d = 0; d < DK; d += 8) { f32x4 a, b; ld8(kp + d, a, b);
#pragma unroll
            for (int j = 0; j < 4; ++j) { x += q[d + j] * a[j]; x += q[d + 4 + j] * b[j]; } }
        if (MODE == 0) x += bf2f(kp[64]) + bf2f(kp[65]) + bf2f(kp[66]);
        if (x > m) { const float f = fexp2(m - x); l *= f;
#pragma unroll
            for (int d = 0; d < 64; ++d) o[d] *= f;
            m = x; }
        const float p = fexp2(x - m); l += p;
#pragma unroll
        for (int d = 0; d < 64; d += 8) { f32x4 a, b; ld8(vp + d, a, b);
#pragma unroll
            for (int j = 0; j < 4; ++j) { o[d + j] += p * a[j]; o[d + 4 + j] += p * b[j]; } }
    }
    const float il = 1.f / l;
#pragma unroll
    for (int d = 0; d < 64; d += 8) { f32x4 a = {o[d] * il, o[d + 1] * il, o[d + 2] * il, o[d + 3] * il}, b = {o[d + 4] * il, o[d + 5] * il, o[d + 6] * il, o[d + 7] * il}; st8(orow + d, a, b); }
}
__device__ __forceinline__ void attn_main_naive(const Ctx& c, int layer) {
    const int g = c.bid * NTHREADS + c.tid, NG = c.G * NTHREADS;
    for (int e = g; e < M * 8; e += NG) {
        const int i = e % SEQ, bh = e / SEQ, b = bh >> 3, h = bh & 7; const size_t row = (size_t)b * SEQ + i; const int t = NMETA + i;
        attn_row<64, 0>(WSP(bf16, WS_QA) + row * PQA + h * 64, WSP(bf16, WS_KA), WSP(bf16, WS_KA) + (size_t)(FR + b * SEQ) * PKA, PKA, h * 80,
                        WSP(bf16, WS_VA), WSP(bf16, WS_VA) + (size_t)(FR + b * SEQ) * PVA, PVA, h * 64, t, 0.f, WSP(bf16, WS_QA) + row * PQA + h * 64);
    }
    for (int e = g; e < M * 8; e += NG) {
        const int i = e % SEQ, bh = e / SEQ, b = bh >> 3, h = bh & 7; const size_t row = (size_t)b * SEQ + i; const int t = NMETA + i;
        attn_row<96, 1>(WSP(bf16, WS_QB) + row * PQB + h * 96, WSP(bf16, WS_KB), WSP(bf16, WS_KB) + (size_t)(FR + b * SEQ) * PKB, PKB, h * 96,
                        WSP(bf16, WS_VB), WSP(bf16, WS_VB) + (size_t)(FR + b * SEQ) * PVB, PVB, h * 64, t, 0.f, WSP(bf16, WS_YB) + row * PY + h * 64);
    }
    for (int e = g; e < M * 8; e += NG) {
        const int i = e % SEQ, bh = e / SEQ, b = bh >> 3, h = bh & 7; const size_t row = (size_t)b * SEQ + i; const int t = NMETA + i;
        attn_row<64, 2>(WSP(bf16, WS_QC) + row * PQC + h * 64, WSP(bf16, WS_KC), WSP(bf16, WS_KC) + (size_t)(FR + b * SEQ) * PKC, PKC, (h >> 2) * 64,
                        WSP(bf16, WS_VC), WSP(bf16, WS_VC) + (size_t)(FR + b * SEQ) * PVC, PVC, (h >> 2) * 64, t, c.sinks[layer * 8 + h] * LOG2E, WSP(bf16, WS_QC) + row * PQC + h * 64);
    }
}
__device__ __forceinline__ void attn_meta(const Ctx& c) {
    if (c.tid >= 384) return;
    const int br = c.tid / 128, h = (c.tid >> 4) & 7, r = c.tid & 15; bf16* ym = WSP(bf16, WS_YM) + (size_t)r * 1536 + br * 512 + h * 64;
    if (br == 0) attn_row<64, 0>(WSP(bf16, WS_QAM) + r * PQA + h * 64, WSP(bf16, WS_KA), WSP(bf16, WS_KA), PKA, h * 80, WSP(bf16, WS_VA), WSP(bf16, WS_VA), PVA, h * 64, r, 0.f, ym);
    else if (br == 1) attn_row<96, 1>(WSP(bf16, WS_QBM) + r * PQB + h * 96, WSP(bf16, WS_KB), WSP(bf16, WS_KB), PKB, h * 96, WSP(bf16, WS_VB), WSP(bf16, WS_VB), PVB, h * 64, r, 0.f, ym);
    else attn_row<64, 2>(WSP(bf16, WS_QCM) + r * PQC + h * 64, WSP(bf16, WS_KC), WSP(bf16, WS_KC), PKC, (h >> 2) * 64, WSP(bf16, WS_VC), WSP(bf16, WS_VC), PVC, (h >> 2) * 64, r, c.sinks[h] * LOG2E, ym);
}

struct Unit { int pm, pn, z; };
__device__ __forceinline__ int perm32(int rho) { const int n = rho >> 4, i = rho & 15; return 8 * (i >> 2) + 4 * n + (i & 3); }
template <class Prob, class Epi>
__device__ __forceinline__ void gemm_naive(const Ctx& c, const Prob& P, const Epi& E) {
    const int wr = c.wave >> 2, wc = c.wave & 3, fr = c.lane & 15, fq = c.lane >> 4;
    const int nunits = P.nunits();
    for (int ui = c.bid; ui < nunits; ui += c.G) {
        Unit u; P.unit(ui, u);
        const bf16* A; const bf16* Bt; P.operands(u, A, Bt);
        const int K = P.K, lda = P.lda;
        f32x4 acc[2][2][4][2];
#pragma unroll
        for (int a = 0; a < 2; ++a)
#pragma unroll
            for (int b = 0; b < 2; ++b)
#pragma unroll
                for (int m = 0; m < 4; ++m)
#pragma unroll
                    for (int n = 0; n < 2; ++n) acc[a][b][m][n] = (f32x4){0.f, 0.f, 0.f, 0.f};
        for (int k0 = 0; k0 < K; k0 += 64) {
#pragma unroll
            for (int ai = 0; ai < 2; ++ai) {
#pragma unroll
                for (int bj = 0; bj < 2; ++bj) {
                    bf16x8 Bf[2][2];
#pragma unroll
                    for (int n = 0; n < 2; ++n)
#pragma unroll
                        for (int k = 0; k < 2; ++k) Bf[n][k] = *(const bf16x8*)(Bt + (size_t)(256 * u.pn + 128 * bj + 32 * wc + perm32(16 * n + fr)) * K + k0 + 32 * k + 8 * fq);
#pragma unroll
                    for (int m = 0; m < 4; ++m) {
                        bf16x8 At[2];
#pragma unroll
                        for (int k = 0; k < 2; ++k) At[k] = *(const bf16x8*)(A + (size_t)(256 * u.pm + 128 * ai + 64 * wr + 16 * m + fr) * lda + k0 + 32 * k + 8 * fq);
#pragma unroll
                        for (int n = 0; n < 2; ++n)
#pragma unroll
                            for (int k = 0; k < 2; ++k) acc[ai][bj][m][n] = __builtin_amdgcn_mfma_f32_16x16x32_bf16(Bf[n][k], At[k], acc[ai][bj][m][n], 0, 0, 0);
                    }
                }
            }
        }
        asm volatile("" ::: "memory");
        E(acc, u, wr, wc, fr, fq);
    }
}
struct ProbSimple { const bf16* A; const bf16* Bt; int lda, K, nM, nN, pn0;
    __device__ __forceinline__ int nunits() const { return nM * nN; }
    __device__ __forceinline__ void unit(int i, Unit& u) const { u.pm = i / nN; u.pn = pn0 + i % nN; u.z = 0; }
    __device__ __forceinline__ void operands(const Unit&, const bf16*& a, const bf16*& b) const { a = A; b = Bt; } };
struct ProbBranch { const bf16 *A0, *A1, *A2; const bf16* Bt; int lda, K, z;
    __device__ __forceinline__ int nunits() const { return 64 * 4; }
    __device__ __forceinline__ void unit(int i, Unit& u) const { u.pm = i >> 2; u.pn = i & 3; u.z = z; }
    __device__ __forceinline__ void operands(const Unit& u, const bf16*& a, const bf16*& b) const { a = (u.z == 0) ? A0 : (u.z == 1) ? A1 : A2; b = Bt + (size_t)u.z * DM * 512; } };

#define EPI_ROWS_BEGIN _Pragma("unroll") for (int ai = 0; ai < 2; ++ai) _Pragma("unroll") for (int m = 0; m < 4; ++m) { const int row = 256 * u.pm + 128 * ai + 64 * wr + 16 * m + fr; \
    const f32x4 l0 = acc[ai][0][m][0], l1 = acc[ai][0][m][1], h0 = acc[ai][1][m][0], h1 = acc[ai][1][m][1]; (void)l0; (void)l1; (void)h0; (void)h1;
#define EPI_ROWS_END asm volatile("" ::: "memory"); }
typedef f32x4 Acc_t[2][2][4][2];

__device__ __forceinline__ void rope8(const float* cs, const float* sn, f32x4 x1a, f32x4 x1b, f32x4 x2a, f32x4 x2b, float sc, f32x4& o1a, f32x4& o1b, f32x4& o2a, f32x4& o2b) {
    const f32x4 ca = *(const f32x4*)cs, cb = *(const f32x4*)(cs + 4), sa = *(const f32x4*)sn, sb = *(const f32x4*)(sn + 4);
    o1a = (x1a * ca - x2a * sa) * sc; o1b = (x1b * cb - x2b * sb) * sc; o2a = (x2a * ca + x1a * sa) * sc; o2b = (x2b * cb + x1b * sb) * sc;
}
struct EpiEarly {
    const Ctx& c; int layer;
    __device__ __forceinline__ void operator()(const Acc_t& acc, const Unit& u, int wr, int wc, int fr, int fq) const {
        const int c8 = 32 * wc + 8 * fq, t = u.pn;
        bf16 *QA = WSP(bf16, WS_QA), *KA = WSP(bf16, WS_KA) + (size_t)FR * PKA, *VA = WSP(bf16, WS_VA) + (size_t)FR * PVA, *QC = WSP(bf16, WS_QC), *KC = WSP(bf16, WS_KC) + (size_t)FR * PKC,
             *VC = WSP(bf16, WS_VC) + (size_t)FR * PVC, *CQ = WSP(bf16, WS_CQ), *CKV = WSP(bf16, WS_CKV), *KB = WSP(bf16, WS_KB) + (size_t)FR * PKB;
        const float *cos64 = WSP(float, WS_COS64), *sin64 = WSP(float, WS_SIN64), *cos32 = WSP(float, WS_COS32), *sin32 = WSP(float, WS_SIN32);
        if (t < 2) { EPI_ROWS_BEGIN st8(QA + (size_t)row * PQA + 256 * t + c8, l0 * C2A, l1 * C2A); st8(QA + (size_t)row * PQA + 256 * t + 128 + c8, h0 * C2A, h1 * C2A); EPI_ROWS_END }
        else if (t < 4) { const int L0 = 256 * (t - 2) + c8, L1 = L0 + 128;
            EPI_ROWS_BEGIN st8(KA + (size_t)row * PKA + (L0 >> 6) * 80 + (L0 & 63), l0, l1); st8(KA + (size_t)row * PKA + (L1 >> 6) * 80 + (L1 & 63), h0, h1); EPI_ROWS_END }
        else if (t < 6) { EPI_ROWS_BEGIN st8(VA + (size_t)row * PVA + 256 * (t - 4) + c8, l0, l1); st8(VA + (size_t)row * PVA + 256 * (t - 4) + 128 + c8, h0, h1); EPI_ROWS_END }
        else if (t < 8) { const int head = 4 * (t - 6) + wc, d = 8 * fq;
            EPI_ROWS_BEGIN const int pos = NMETA + (row & (SEQ - 1)); f32x4 o1a, o1b, o2a, o2b; rope8(cos64 + pos * 32 + d, sin64 + pos * 32 + d, l0, l1, h0, h1, C2C, o1a, o1b, o2a, o2b);
                st8(QC + (size_t)row * PQC + head * 64 + d, o1a, o1b); st8(QC + (size_t)row * PQC + head * 64 + 32 + d, o2a, o2b); EPI_ROWS_END }
        else if (t == 8) {
            if (wc < 2) { const int d = 8 * fq;
                EPI_ROWS_BEGIN const int pos = NMETA + (row & (SEQ - 1)); f32x4 o1a, o1b, o2a, o2b; rope8(cos64 + pos * 32 + d, sin64 + pos * 32 + d, l0, l1, h0, h1, 1.f, o1a, o1b, o2a, o2b);
                    st8(KC + (size_t)row * PKC + wc * 64 + d, o1a, o1b); st8(KC + (size_t)row * PKC + wc * 64 + 32 + d, o2a, o2b); EPI_ROWS_END }
            else { const int j = 32 * (wc - 2) + 8 * fq;
                EPI_ROWS_BEGIN st8(VC + (size_t)row * PVC + j, l0, l1); st8(VC + (size_t)row * PVC + 64 + j, h0, h1); EPI_ROWS_END } }
        else if (t == 9) { EPI_ROWS_BEGIN st8(CQ + (size_t)row * PCQ + c8, l0, l1); st8(CQ + (size_t)row * PCQ + 128 + c8, h0, h1); EPI_ROWS_END }
        else if (t == 10) {
            if (wc < 2) { EPI_ROWS_BEGIN st8(CQ + (size_t)row * PCQ + 256 + c8, l0, l1); st8(CQ + (size_t)row * PCQ + 256 + 64 + c8, h0, h1); EPI_ROWS_END }
            else if (wc == 2) {
                if (fq < 2) { const int d = 8 * fq;
                    EPI_ROWS_BEGIN const int pos = NMETA + (row & (SEQ - 1)); f32x4 o1a, o1b, o2a, o2b; rope8(cos32 + pos * 16 + d, sin32 + pos * 16 + d, l0, l1, h0, h1, 1.f, o1a, o1b, o2a, o2b);
                        const u32x4 w1 = pack8(o1a, o1b), w2 = pack8(o2a, o2b);
#pragma unroll
                        for (int h = 0; h < 8; ++h) { *(u32x4*)(KB + (size_t)row * PKB + h * 96 + 64 + d) = w1; *(u32x4*)(KB + (size_t)row * PKB + h * 96 + 80 + d) = w2; } EPI_ROWS_END }
                else if (fq == 2) { float* LF = WSP(float, WS_LF); const f32x4 b0 = *(const f32x4*)(c.b_f + layer * 8), b1 = *(const f32x4*)(c.b_f + layer * 8 + 4);
                    EPI_ROWS_BEGIN f32x4 a = l0 + b0, b = l1 + b1;
#pragma unroll
                        for (int j = 0; j < 4; ++j) { a[j] = logsigf_(a[j]); b[j] = logsigf_(b[j]); }
                        *(f32x4*)(LF + (size_t)row * 8) = a; *(f32x4*)(LF + (size_t)row * 8 + 4) = b; EPI_ROWS_END } } }
        else { EPI_ROWS_BEGIN st8(CKV + (size_t)row * PCKV + c8, l0, l1); st8(CKV + (size_t)row * PCKV + 128 + c8, h0, h1); EPI_ROWS_END }
    }
};
struct EpiUq {
    const Ctx& c;
    __device__ __forceinline__ void operator()(const Acc_t& acc, const Unit& u, int wr, int wc, int fr, int fq) const {
        bf16* QB = WSP(bf16, WS_QB); const float* RQ = WSP(float, WS_RQ); const float *cos32 = WSP(float, WS_COS32), *sin32 = WSP(float, WS_SIN32);
        const int c8 = 32 * wc + 8 * fq;
        if (u.pn < 2) { const int ha = 4 * u.pn + (c8 >> 6), hb = ha + 2, e = c8 & 63;
            EPI_ROWS_BEGIN const float sc = RQ[row] * C2B; st8(QB + (size_t)row * PQB + ha * 96 + e, l0 * sc, l1 * sc); st8(QB + (size_t)row * PQB + hb * 96 + e, h0 * sc, h1 * sc); EPI_ROWS_END }
        else { const int h = c8 >> 4, d = c8 & 15;
            EPI_ROWS_BEGIN const float sc = RQ[row] * C2B; const int pos = NMETA + (row & (SEQ - 1)); f32x4 o1a, o1b, o2a, o2b; rope8(cos32 + pos * 16 + d, sin32 + pos * 16 + d, l0, l1, h0, h1, sc, o1a, o1b, o2a, o2b);
                st8(QB + (size_t)row * PQB + h * 96 + 64 + d, o1a, o1b); st8(QB + (size_t)row * PQB + h * 96 + 80 + d, o2a, o2b); EPI_ROWS_END }
    }
};
struct EpiUkv {
    const Ctx& c;
    __device__ __forceinline__ void operator()(const Acc_t& acc, const Unit& u, int wr, int wc, int fr, int fq) const {
        bf16 *KB = WSP(bf16, WS_KB) + (size_t)FR * PKB, *VB = WSP(bf16, WS_VB) + (size_t)FR * PVB; const float* RKV = WSP(float, WS_RKV);
        const int c8 = 32 * wc + 8 * fq, ha = 2 * u.pn, hb = ha + 1;
        if (wc < 2) { EPI_ROWS_BEGIN const float sc = RKV[row]; st8(KB + (size_t)row * PKB + ha * 96 + c8, l0 * sc, l1 * sc); st8(KB + (size_t)row * PKB + hb * 96 + c8, h0 * sc, h1 * sc); EPI_ROWS_END }
        else { EPI_ROWS_BEGIN const float sc = RKV[row]; st8(VB + (size_t)row * PVB + ha * 64 + c8 - 64, l0 * sc, l1 * sc); st8(VB + (size_t)row * PVB + hb * 64 + c8 - 64, h0 * sc, h1 * sc); EPI_ROWS_END }
    }
};
struct EpiLateZ {
    const Ctx& c;
    __device__ __forceinline__ void operator()(const Acc_t& acc, const Unit& u, int wr, int wc, int fr, int fq) const {
        const int c8 = 32 * wc + 8 * fq, t = u.pn;
        bf16* Y = (t < 2) ? WSP(bf16, WS_QA) : (t < 4) ? WSP(bf16, WS_YB) : WSP(bf16, WS_QC); const int col = 256 * (t & 1) + c8;
        EPI_ROWS_BEGIN
            { bf16* p = Y + (size_t)row * PY + col; f32x4 ya, yb; ld8(p, ya, yb);
#pragma unroll
              for (int j = 0; j < 4; ++j) { ya[j] *= siluf_(l0[j]); yb[j] *= siluf_(l1[j]); }
              st8(p, ya, yb); }
            { bf16* p = Y + (size_t)row * PY + col + 128; f32x4 ya, yb; ld8(p, ya, yb);
#pragma unroll
              for (int j = 0; j < 4; ++j) { ya[j] *= siluf_(h0[j]); yb[j] *= siluf_(h1[j]); }
              st8(p, ya, yb); }
        EPI_ROWS_END
    }
};
struct EpiLateG {
    const Ctx& c;
    __device__ __forceinline__ void operator()(const Acc_t& acc, const Unit& u, int wr, int wc, int fr, int fq) const {
        bf16* Gp = WSP(bf16, WS_G); const int col = 256 * (u.pn - 6) + 32 * wc + 8 * fq;
        EPI_ROWS_BEGIN f32x4 a = l0, b = l1, cc = h0, d = h1;
#pragma unroll
            for (int j = 0; j < 4; ++j) { a[j] = sigmoidf_(a[j]); b[j] = sigmoidf_(b[j]); cc[j] = sigmoidf_(cc[j]); d[j] = sigmoidf_(d[j]); }
            st8(Gp + (size_t)row * PG + col, a, b); st8(Gp + (size_t)row * PG + col + 128, cc, d); EPI_ROWS_END
    }
};
struct EpiBranch {
    const Ctx& c;
    __device__ __forceinline__ void operator()(const Acc_t& acc, const Unit& u, int wr, int wc, int fr, int fq) const {
        const bf16* Gp = WSP(bf16, WS_G); bf16* MG = WSP(bf16, WS_HN); const int col = 256 * u.pn + 32 * wc + 8 * fq;
        EPI_ROWS_BEGIN
#pragma unroll
            for (int bj = 0; bj < 2; ++bj) { f32x4 ga, gb; ld8(Gp + (size_t)row * PG + u.z * DM + col + 128 * bj, ga, gb); f32x4 va = (bj ? h0 : l0) * ga, vb = (bj ? h1 : l1) * gb;
                bf16* p = MG + (size_t)row * DM + col + 128 * bj; if (u.z > 0) { f32x4 pa, pb; ld8(p, pa, pb); va += pa; vb += pb; } st8(p, va, vb); } EPI_ROWS_END
    }
};
struct EpiOut {
    const float* resid; float* out;
    __device__ __forceinline__ void operator()(const Acc_t& acc, const Unit& u, int wr, int wc, int fr, int fq) const {
        const int col = 256 * u.pn + 32 * wc + 8 * fq;
        EPI_ROWS_BEGIN const size_t off = (size_t)row * DM + col;
            const f32x4 r0 = *(const f32x4*)(resid + off), r1 = *(const f32x4*)(resid + off + 4), r2 = *(const f32x4*)(resid + off + 128), r3 = *(const f32x4*)(resid + off + 132);
            *(f32x4*)(out + off) = r0 + l0; *(f32x4*)(out + off + 4) = r1 + l1; *(f32x4*)(out + off + 128) = r2 + h0; *(f32x4*)(out + off + 132) = r3 + h1; EPI_ROWS_END
    }
};

__device__ __forceinline__ void stats_cumsum(const Ctx& c) {
    const int gw = c.bid * NWAVES + c.wave, NGW = c.G * NWAVES;
    for (int m = gw; m < M; m += NGW) {
        float sq = 0.f, sk = 0.f;
        if (c.lane < 48) { f32x4 a, b; ld8(WSP(bf16, WS_CQ) + (size_t)m * PCQ + 8 * c.lane, a, b); sq = (a[0] * a[0] + a[1] * a[1]) + (a[2] * a[2] + a[3] * a[3]) + (b[0] * b[0] + b[1] * b[1]) + (b[2] * b[2] + b[3] * b[3]); }
        if (c.lane < 32) { f32x4 a, b; ld8(WSP(bf16, WS_CKV) + (size_t)m * PCKV + 8 * c.lane, a, b); sk = (a[0] * a[0] + a[1] * a[1]) + (a[2] * a[2] + a[3] * a[3]) + (b[0] * b[0] + b[1] * b[1]) + (b[2] * b[2] + b[3] * b[3]); }
        sq = wave_sum(sq); sk = wave_sum(sk);
        if (c.lane == 0) { WSP(float, WS_RQ)[m] = 1.f / sqrtf(sq * (1.f / 384.f) + EPS); WSP(float, WS_RKV)[m] = 1.f / sqrtf(sk * (1.f / 256.f) + EPS); }
    }
    LAS double* wsum = (LAS double*)(c.lds);
    for (int task = c.bid; task < NBATCH * 8; task += c.G) {
        const int b = task >> 3, h = task & 7; const float* LF = WSP(float, WS_LF) + (size_t)b * SEQ * 8 + h;
        double v[8]; double s = 0.0;
#pragma unroll
        for (int j = 0; j < 8; ++j) { s += (double)LF[(size_t)(8 * c.tid + j) * 8]; v[j] = s; }
        double inc = s;
#pragma unroll
        for (int o = 1; o < 64; o <<= 1) { const double n = __shfl_up(inc, o); if (c.lane >= o) inc += n; }
        __syncthreads();
        if (c.lane == 63) wsum[c.wave] = inc;
        __syncthreads();
        double base = inc - s;
        for (int w = 0; w < c.wave; ++w) base += wsum[w];
        bf16* KA = WSP(bf16, WS_KA) + (size_t)(FR + b * SEQ) * PKA + h * 80 + 64;
#pragma unroll
        for (int j = 0; j < 8; ++j) { const float bias = (float)(-(base + v[j]) * 1.4426950408889634); bf16 bh, bm, bl; split3(bias, bh, bm, bl);
            u32x4 w0 = {(unsigned)bh | ((unsigned)bm << 16), (unsigned)bl, 0u, 0u}, w1 = {0u, 0u, 0u, 0u}; bf16* kp = KA + (size_t)(8 * c.tid + j) * PKA; *(u32x4*)kp = w0; *(u32x4*)(kp + 8) = w1; }
    }
}
__device__ __forceinline__ void final_norm(const Ctx& c) {
    const int gw = c.bid * NWAVES + c.wave, NGW = c.G * NWAVES;
    for (int m = gw; m < M; m += NGW) {
        f32x4* xr = (f32x4*)(c.out + (size_t)m * DM) + c.lane; f32x4 v[4]; float s = 0.f;
#pragma unroll
        for (int j = 0; j < 4; ++j) { v[j] = xr[64 * j]; s += (v[j][0] * v[j][0] + v[j][1] * v[j][1]) + (v[j][2] * v[j][2] + v[j][3] * v[j][3]); }
        const float rstd = 1.f / sqrtf(wave_sum(s) * (1.f / DM) + EPS);
#pragma unroll
        for (int j = 0; j < 4; ++j) { const f32x4 g = ((const f32x4*)c.final_g + c.lane)[64 * j]; xr[64 * j] = v[j] * rstd * g; }
    }
}

#define XB_TMO      128
#define XB_XCNT(j)  (256  + 64 * (j))
#define XB_XSUB(j)  (1280 + 64 * (j))
#define XB_XGEN(j)  (2304 + 64 * (j))
#define XB_TOP      3328
#define XB_TOPGEN   3392
#define XCD_BAR_WORDS 3456
#define XB_SPIN_CAP (1u << 18)
__device__ __forceinline__ unsigned xb_ld(unsigned* p)              { return __hip_atomic_load(p, __ATOMIC_RELAXED, __HIP_MEMORY_SCOPE_AGENT); }
__device__ __forceinline__ unsigned xb_add(unsigned* p, unsigned v) { return __hip_atomic_fetch_add(p, v, __ATOMIC_RELAXED, __HIP_MEMORY_SCOPE_AGENT); }
__device__ __forceinline__ unsigned xb_xcc_id() { return (unsigned)__builtin_amdgcn_s_getreg((3 << 11) | 20) & 0xFu; }
#define XB_SPIN(cond, bar) do { unsigned _sp = 0; while (cond) { __builtin_amdgcn_s_sleep(1); \
    if ((++_sp & 255u) == 0u) { if (xb_ld(&(bar)[XB_TMO])) break; if (_sp > XB_SPIN_CAP) { atomicAdd(&(bar)[XB_TMO], 1u); break; } } } } while (0)
struct XcdBarrier { unsigned* bar; unsigned x; volatile LAS unsigned* st; };
__device__ __forceinline__ XcdBarrier xcd_barrier_post(unsigned* bar, volatile LAS unsigned* st) {
    XcdBarrier b; b.bar = bar; b.x = xb_xcc_id(); b.st = st;
    if (threadIdx.x == 0) (void)xb_add(&bar[XB_XCNT(b.x)], 1u);
    return b;
}
__device__ __forceinline__ void xcd_barrier_complete(unsigned* bar, unsigned x, unsigned& nloc, unsigned& nx) {
    const unsigned G = gridDim.x * gridDim.y * gridDim.z;
    unsigned sum, cnt, mine, sp = 0u;
    for (;;) {
        sum = 0u; cnt = 0u; mine = 0u;
#pragma unroll
        for (unsigned j = 0; j < 16; ++j) { const unsigned cc = xb_ld(&bar[XB_XCNT(j)]); sum += cc; cnt += (cc > 0u) ? 1u : 0u; mine = (j == x) ? cc : mine; }
        if (sum == G) break;
        __builtin_amdgcn_s_sleep(1);
        if ((++sp & 255u) == 0u) { if (xb_ld(&bar[XB_TMO])) break; if (sp > XB_SPIN_CAP) { atomicAdd(&bar[XB_TMO], 1u); break; } }
    }
    nloc = mine > 0u ? mine : 1u; nx = cnt > 0u ? cnt : 1u;
}
__device__ __forceinline__ void xcd_barrier(const XcdBarrier& b) {
    asm volatile("s_waitcnt vmcnt(0)" ::: "memory");
    __syncthreads();
    if (threadIdx.x == 0) {
        unsigned* bar = b.bar;
        __builtin_amdgcn_s_waitcnt(0);
        unsigned nloc = b.st[0], nx = b.st[1];
        if (nloc == 0u) { xcd_barrier_complete(bar, b.x, nloc, nx); b.st[0] = nloc; b.st[1] = nx; }
        const unsigned old = xb_add(&bar[XB_XSUB(b.x)], 1u);
        const unsigned gen = old / nloc;
        if (old + 1u == (gen + 1u) * nloc) {
            __builtin_amdgcn_fence(__ATOMIC_RELEASE, "agent");
            asm volatile("s_waitcnt vmcnt(0)" ::: "memory");
            const unsigned og = xb_add(&bar[XB_TOP], 1u);
            const unsigned tg = og / nx;
            if (og + 1u == (tg + 1u) * nx) xb_add(&bar[XB_TOPGEN], 1u);
            else XB_SPIN(xb_ld(&bar[XB_TOPGEN]) == tg, bar);
            __builtin_amdgcn_fence(__ATOMIC_ACQUIRE, "agent");
            xb_add(&bar[XB_XGEN(b.x)], 1u);
            asm volatile("s_waitcnt vmcnt(0)" ::: "memory");
        } else {
            XB_SPIN(xb_ld(&bar[XB_XGEN(b.x)]) == gen, bar);
            __builtin_amdgcn_fence(__ATOMIC_ACQUIRE, "agent");
            asm volatile("s_waitcnt vmcnt(0)" ::: "memory");
        }
    }
    __syncthreads();
}

constexpr int LDS_BYTES = 147456, MISC_OFF = 131072 + 320;
constexpr int NSLOTS = 18;
constexpr int CW_BAR = 4096;

struct Args { const float* in[13]; float* out; unsigned char* ws; int ph_lo, ph_hi, pad0, pad1; };
#define CAS __attribute__((address_space(4)))
__device__ __forceinline__ Ctx make_ctx() {
    const CAS char* kp = (const CAS char*)__builtin_amdgcn_kernarg_segment_ptr();
    asm volatile("" : "+s"(kp));
    const CAS Args* a = (const CAS Args*)kp;
    Ctx c;
    c.x = a->in[0]; c.meta = a->in[1]; c.norm_g = a->in[2]; c.w_in = a->in[3]; c.b_f = a->in[4]; c.g_cq = a->in[5]; c.g_ckv = a->in[6];
    c.w_uq = a->in[7]; c.w_ukv = a->in[8]; c.sinks = a->in[9]; c.w_branch = a->in[10]; c.w_out = a->in[11]; c.final_g = a->in[12];
    c.out = a->out; c.ws = a->ws;
    extern __shared__ __attribute__((aligned(16))) unsigned char lds_raw[];
    c.lds = (LAS unsigned char*)lds_raw;
    c.tid = threadIdx.x; c.lane = c.tid & 63; c.wave = __builtin_amdgcn_readfirstlane(c.tid >> 6); c.G = gridDim.x; c.bid = blockIdx.x;
    return c;
}

template <int SLOT>
__device__ __forceinline__ void run_slot() {
    const Ctx c = make_ctx();
    constexpr int slot = SLOT;
    constexpr int layer = (slot >= 9) ? 1 : 0;
    constexpr int ls = (slot >= 9) ? slot - 8 : slot;
        if constexpr (slot == 0) slot0(c);
        else if constexpr (slot == 17) final_norm(c);
        else if constexpr (ls == 1) {
            zero_fronts(c);
            norm_main(c, layer == 0 ? c.x : c.out);
            meta_blocks(c, AfPlain{WSP(bf16, WS_HNM), DM}, wl(c, layer, WL_EARLY), DM, NE / 16, WSP(float, WS_RAWE), NE, 0);
        } else if constexpr (ls == 2) {
            if (c.bid == 0) post_early(c, layer);
            ProbSimple P{WSP(bf16, WS_HN), wl(c, layer, WL_EARLY), DM, DM, 64, NE / 256, 0};
            gemm_naive(c, P, EpiEarly{c, layer});
        } else if constexpr (ls == 3) {
            { const AfPlain af{WSP(bf16, WS_CM), 640}; meta_blocks(c, af, wl(c, layer, WL_UQ), 384, NUQ / 16, WSP(float, WS_RAWU), NUQ + NUKV, 0);
              const AfPlain af2{WSP(bf16, WS_CM) + 384, 640}; meta_blocks(c, af2, wl(c, layer, WL_UKV), 256, NUKV / 16, WSP(float, WS_RAWU), NUQ + NUKV, NUQ); }
            stats_cumsum(c);
        } else if constexpr (ls == 4) {
            if (c.bid == 0) post_up(c);
            { ProbSimple P{WSP(bf16, WS_CQ), wl(c, layer, WL_UQ), PCQ, 384, 64, NUQ / 256, 0}; gemm_naive(c, P, EpiUq{c}); }
            { ProbSimple P{WSP(bf16, WS_CKV), wl(c, layer, WL_UKV), PCKV, 256, 64, NUKV / 256, 0}; gemm_naive(c, P, EpiUkv{c}); }
        } else if constexpr (ls == 5) {
            if (layer == 0) {
#ifndef NO_ATTNM
                if (c.bid == 0) attn_meta(c);
#endif
 meta_blocks(c, AfPlain{WSP(bf16, WS_HNM), DM}, wl(c, 0, WL_LATE), DM, NL / 16, WSP(float, WS_RAWL), NL, 0); }
#ifndef NO_ATTN
            attn_main_naive(c, layer);
#endif
        } else if constexpr (ls == 6) {
#ifndef NO_S67
            if (layer == 0) { for (int n = 0; n < 3; ++n) { const AfBranch af{WSP(bf16, WS_YM), WSP(float, WS_RAWL), n}; meta_blocks(c, af, wl(c, 0, WL_BR) + (size_t)n * DM * 512, 512, DM / 16, WSP(float, WS_RAWB) + (size_t)n * 16 * 1024, 1024, 0); } }
#endif
            { ProbSimple P{WSP(bf16, WS_HN), wl(c, layer, WL_LATE), DM, DM, 64, 6, 0}; gemm_naive(c, P, EpiLateZ{c}); }
            { ProbSimple P{WSP(bf16, WS_HN), wl(c, layer, WL_LATE), DM, DM, 64, 12, 6}; gemm_naive(c, P, EpiLateG{c}); }
        } else if constexpr (ls == 7) {
            if (layer == 0) { const AfMerged af{WSP(float, WS_RAWL), WSP(float, WS_RAWB)}; meta_blocks(c, af, wl(c, 0, WL_OUT), DM, DM / 16, WSP(float, WS_RAWO), DM, 0); }
            for (int z = 0; z < 3; ++z) { ProbBranch P{WSP(bf16, WS_QA), WSP(bf16, WS_YB), WSP(bf16, WS_QC), wl(c, layer, WL_BR), PY, 512, z};
                gemm_naive(c, P, EpiBranch{c}); asm volatile("s_waitcnt vmcnt(0)" ::: "memory"); }
        } else if constexpr (ls == 8) {
            if (layer == 0 && c.bid == 0) post_resid(c);
            ProbSimple P{WSP(bf16, WS_HN), wl(c, layer, WL_OUT), DM, DM, 64, DM / 256, 0};
            gemm_naive(c, P, EpiOut{layer == 0 ? c.x : c.out, c.out});
        }
}

__global__ void __launch_bounds__(NTHREADS, 2) skel_fwd(Args args) {
    const Ctx c = make_ctx();
    volatile LAS unsigned* MISC = (volatile LAS unsigned*)(c.lds + MISC_OFF);
    for (int u = c.tid; u < (LDS_BYTES - 131072) / 4; u += NTHREADS) ((LAS unsigned*)(c.lds + 131072))[u] = 0u;
    __syncthreads();
    XcdBarrier bar; bar.bar = (unsigned*)(c.ws + WS_CTL) + CW_BAR; bar.x = 0; bar.st = nullptr;
    const int lo = args.ph_lo, hi = args.ph_hi;
    if (hi - lo > 1) bar = xcd_barrier_post((unsigned*)(c.ws + WS_CTL) + CW_BAR, MISC + 8);

#ifndef SLOT_ON
#define SLOT_ON(k) true
#endif
#define RUN_SLOT(k) if (SLOT_ON(k) && lo <= (k) && (k) < hi) { run_slot<k>(); if ((k) + 1 < hi) xcd_barrier(bar); }
    RUN_SLOT(0) RUN_SLOT(1) RUN_SLOT(2) RUN_SLOT(3) RUN_SLOT(4) RUN_SLOT(5) RUN_SLOT(6) RUN_SLOT(7) RUN_SLOT(8)
    RUN_SLOT(9) RUN_SLOT(10) RUN_SLOT(11) RUN_SLOT(12) RUN_SLOT(13) RUN_SLOT(14) RUN_SLOT(15) RUN_SLOT(16) RUN_SLOT(17)
#undef RUN_SLOT
}

extern "C" void kernel_launch(void* const* d_in, const int* in_sizes, int n_in, void* d_out, int out_size, void* d_ws, size_t ws_size, hipStream_t stream) {
    static int grid = 0;
    if (grid == 0) {
        if (n_in != 13 || out_size != M * DM || ws_size < WS_END) { fprintf(stderr, "kernel_launch: unexpected shapes (n_in %d out %d ws %zu need %zu)\n", n_in, out_size, ws_size, (size_t)WS_END); grid = -1; return; }
        int dev = 0, cus = 0, per_cu = 0;
        if (hipGetDevice(&dev) != hipSuccess || hipDeviceGetAttribute(&cus, hipDeviceAttributeMultiprocessorCount, dev) != hipSuccess) { grid = -1; return; }
        if (hipFuncSetAttribute((const void*)skel_fwd, hipFuncAttributeMaxDynamicSharedMemorySize, LDS_BYTES) != hipSuccess) { fprintf(stderr, "kernel_launch: hipFuncSetAttribute failed\n"); grid = -1; return; }
        if (hipOccupancyMaxActiveBlocksPerMultiprocessor(&per_cu, (const void*)skel_fwd, NTHREADS, LDS_BYTES) != hipSuccess || per_cu < 1) fprintf(stderr, "kernel_launch: occupancy query says %d\n", per_cu);
        (void)hipGetLastError();
        grid = cus;
    }
    if (grid < 0) return;
    (void)hipMemsetAsync((char*)d_ws + WS_CTL, 0, CTL_BYTES, stream);
    Args a{};
    for (int i = 0; i < 13; ++i) a.in[i] = (const float*)d_in[i];
    a.out = (float*)d_out; a.ws = (unsigned char*)d_ws;
#if MK_SINGLE
    a.ph_lo = 0; a.ph_hi = NSLOTS;
    hipLaunchKernelGGL(skel_fwd, dim3(grid), dim3(NTHREADS), LDS_BYTES, stream, a);
#else
    for (int s = 0; s < NSLOTS; ++s) { a.ph_lo = s; a.ph_hi = s + 1; hipLaunchKernelGGL(skel_fwd, dim3(grid), dim3(NTHREADS), LDS_BYTES, stream, a); }
#endif
}
```

```cpp
#include <hip/hip_runtime.h>
#include <cstdio>
#include <cstdint>

#ifndef MK_SINGLE
#define MK_SINGLE 1
#endif

#define GAS __attribute__((address_space(1)))
#define LAS __attribute__((address_space(3)))
typedef unsigned short bf16;
typedef short bf16x8 __attribute__((ext_vector_type(8)));
typedef float f32x4 __attribute__((ext_vector_type(4)));
typedef unsigned u32x4 __attribute__((ext_vector_type(4)));
typedef unsigned u32x2 __attribute__((ext_vector_type(2)));
typedef float f32x2_t __attribute__((ext_vector_type(2)));
typedef __bf16 bf16x2_t __attribute__((ext_vector_type(2)));
typedef GAS unsigned gu32;
#define RLX_AGENT __ATOMIC_RELAXED, __HIP_MEMORY_SCOPE_AGENT

constexpr int DM = 1024, NBATCH = 4, SEQ = 4096, M = NBATCH * SEQ, NMETA = 16, FR = 64, MOFF = 48, NPOS = SEQ + NMETA;
constexpr int NIN = 7592, NWAVES = 8, NTHREADS = NWAVES * 64;
constexpr float EPS = 1e-6f, LOG2E = 1.4426950408889634f, LN2 = 0.6931471805599453f;
constexpr float C2A = 0.125f * LOG2E, C2B = 0.10206207261596575f * LOG2E, C2C = 0.125f * LOG2E;
constexpr int LC_AQ = 0, LC_AK = 512, LC_AV = 1024, LC_AF = 1536, LC_AZ = 1544, LC_BCQ = 2056, LC_BCKV = 2440, LC_BKR = 2696, LC_BZ = 2728,
              LC_CQ = 3240, LC_CK = 3752, LC_CV = 3880, LC_CZ = 4008, LC_G = 4520;
constexpr int NE = 3072, NL = 4608, NUQ = 768, NUKV = 1024;
constexpr int PQA = 512, PKA = 640, PVA = 512, PQB = 768, PKB = 768, PVB = 512, PQC = 512, PKC = 128, PVC = 128, PCQ = 384, PCKV = 256, PY = 512, PG = 3072;

constexpr size_t MiB = 1u << 20;
constexpr size_t al(size_t x) { return (x + 255) & ~(size_t)255; }
constexpr size_t WS_CTL = 0, CTL_BYTES = 1 * MiB;
constexpr size_t WS_COS64 = CTL_BYTES, WS_SIN64 = WS_COS64 + al((size_t)NPOS * 32 * 4), WS_COS32 = WS_SIN64 + al((size_t)NPOS * 32 * 4), WS_SIN32 = WS_COS32 + al((size_t)NPOS * 16 * 4);
constexpr size_t WS_LF = WS_SIN32 + al((size_t)NPOS * 16 * 4), WS_RQ = WS_LF + al((size_t)M * 8 * 4), WS_RKV = WS_RQ + al((size_t)M * 4);
constexpr size_t WS_HM = WS_RKV + al((size_t)M * 4);
constexpr size_t WS_HNM = WS_HM + al(16 * 1024 * 4);
constexpr size_t WS_RAWE = WS_HNM + al(16 * 1024 * 2);
constexpr size_t WS_RAWU = WS_RAWE + al(16 * NE * 4);
constexpr size_t WS_RAWL = WS_RAWU + al(16 * (NUQ + NUKV) * 4);
constexpr size_t WS_RAWB = WS_RAWL + al(16 * NL * 4);
constexpr size_t WS_RAWO = WS_RAWB + al(3 * 16 * 1024 * 4);
constexpr size_t WS_YM = WS_RAWO + al(16 * 1024 * 4);
constexpr size_t WS_CM = WS_YM + al(16 * 1536 * 2);
constexpr size_t WS_RQM = WS_CM + al(16 * 640 * 2);
constexpr size_t WS_LFM = WS_RQM + al(32 * 4);
constexpr size_t WS_QAM = WS_LFM + al(16 * 8 * 4);
constexpr size_t WS_QBM = WS_QAM + al(16 * 512 * 2);
constexpr size_t WS_QCM = WS_QBM + al(16 * 768 * 2);
constexpr size_t WS_SMALL_END = WS_QCM + al(16 * 512 * 2);
constexpr size_t WL_EARLY = 0, WL_LATE = WL_EARLY + (size_t)NE * DM * 2, WL_UQ = WL_LATE + (size_t)NL * DM * 2, WL_UKV = WL_UQ + (size_t)NUQ * 384 * 2,
                 WL_BR = WL_UKV + (size_t)NUKV * 256 * 2, WL_OUT = WL_BR + (size_t)3 * DM * 512 * 2, WL_BYTES = WL_OUT + (size_t)DM * DM * 2;
constexpr size_t WS_W = 6 * MiB;
static_assert(WS_SMALL_END <= WS_W, "small region");
constexpr size_t WS_HN = WS_W + al(2 * WL_BYTES);
constexpr size_t WS_QA = WS_HN + (size_t)M * DM * 2;
constexpr size_t WS_QC = WS_QA + (size_t)M * PQA * 2;
constexpr size_t WS_CQ = WS_QC + (size_t)M * PQC * 2;
constexpr size_t WS_CKV = WS_CQ + (size_t)M * PCQ * 2;
constexpr size_t WS_YB = WS_CQ;
constexpr size_t WS_QB = WS_CKV + (size_t)M * PCKV * 2;
constexpr size_t WS_KB = WS_QB + (size_t)M * PQB * 2;
constexpr size_t WS_VB = WS_KB + (size_t)(FR + M) * PKB * 2;
constexpr size_t WS_KA = WS_VB + (size_t)(FR + M) * PVB * 2;
constexpr size_t WS_VA = WS_KA + (size_t)(FR + M) * PKA * 2;
constexpr size_t WS_KC = WS_VA + (size_t)(FR + M) * PVA * 2;
constexpr size_t WS_VC = WS_KC + (size_t)(FR + M) * PKC * 2;
constexpr size_t WS_END = WS_VC + (size_t)(FR + M) * PVC * 2;
constexpr size_t WS_G = WS_QB;
static_assert(WS_G + (size_t)M * PG * 2 <= WS_KC, "G overlay");
static_assert((size_t)M * PY * 2 <= (size_t)M * (PCQ + PCKV) * 2, "YB overlay");
static_assert(WS_END <= 256 * MiB, "workspace");

__device__ __forceinline__ unsigned cvtpk(float lo, float hi) { f32x2_t v = {lo, hi}; bf16x2_t b = __builtin_convertvector(v, bf16x2_t); return __builtin_bit_cast(unsigned, b); }
__device__ __forceinline__ bf16 f2bf(float f) { return (bf16)(cvtpk(f, 0.f) & 0xffffu); }
__device__ __forceinline__ float bf2f(bf16 v) { return __uint_as_float((unsigned)v << 16); }
__device__ __forceinline__ float bflo(unsigned w) { return __uint_as_float(w << 16); }
__device__ __forceinline__ float bfhi(unsigned w) { return __uint_as_float(w & 0xffff0000u); }
__device__ __forceinline__ float fexp2(float x) { return __builtin_amdgcn_exp2f(x); }
__device__ __forceinline__ float frcp(float x) { return __builtin_amdgcn_rcpf(x); }
__device__ __forceinline__ float sigmoidf_(float x) { return frcp(1.f + fexp2(-x * LOG2E)); }
__device__ __forceinline__ float siluf_(float x) { return x * sigmoidf_(x); }
__device__ __forceinline__ float logsigf_(float x) { return fminf(x, 0.f) - __builtin_amdgcn_logf(1.f + fexp2(-fabsf(x) * LOG2E)) * LN2; }
__device__ __forceinline__ float wave_sum(float v) {
#pragma unroll
    for (int o = 1; o < 64; o <<= 1) v += __shfl_xor(v, o);
    return v;
}
__device__ __forceinline__ u32x4 pack8(f32x4 a, f32x4 b) { u32x4 w; w.x = cvtpk(a[0], a[1]); w.y = cvtpk(a[2], a[3]); w.z = cvtpk(b[0], b[1]); w.w = cvtpk(b[2], b[3]); return w; }
__device__ __forceinline__ void st8(bf16* p, f32x4 a, f32x4 b) { *(u32x4*)p = pack8(a, b); }
__device__ __forceinline__ void ld8(const bf16* p, f32x4& a, f32x4& b) { const u32x4 w = *(const u32x4*)p; a = (f32x4){bflo(w.x), bfhi(w.x), bflo(w.y), bfhi(w.y)}; b = (f32x4){bflo(w.z), bfhi(w.z), bflo(w.w), bfhi(w.w)}; }
__device__ __forceinline__ void split3(float b, bf16& h, bf16& m, bf16& l) { h = f2bf(b); const float r1 = b - bf2f(h); m = f2bf(r1); const float r2 = r1 - bf2f(m); l = f2bf(r2); }

enum { MAP_EARLY = 0, MAP_LATE = 1, MAP_UQ = 2, MAP_ID = 3 };
__device__ __forceinline__ int map_col(int kind, int p) {
    const int t = p >> 8, c = p & 255, half = c >> 7, c7 = c & 127;
    if (kind == MAP_EARLY) {
        if (t < 2) return LC_AQ + p;
        if (t < 4) return LC_AK + (p - 512);
        if (t < 6) return LC_AV + (p - 1024);
        if (t < 8) return LC_CQ + 256 * (t - 6) + 64 * (c7 >> 5) + 32 * half + (c7 & 31);
        if (t == 8) { if (c7 < 64) return LC_CK + 64 * (c7 >> 5) + 32 * half + (c7 & 31); return LC_CV + 64 * half + (c7 - 64); }
        if (t == 9) return LC_BCQ + c;
        if (t == 10) { if (c7 < 64) return LC_BCQ + 256 + 64 * half + c7; if (c7 < 80) return LC_BKR + 16 * half + (c7 - 64); if (c7 < 88 && half == 0) return LC_AF + (c7 - 80); return -1; }
        return LC_BCKV + c;
    }
    if (kind == MAP_LATE) {
        if (t < 2) return LC_AZ + p;
        if (t < 4) return LC_BZ + (p - 512);
        if (t < 6) return LC_CZ + (p - 1024);
        return LC_G + (p - 1536);
    }
    if (kind == MAP_UQ) {
        if (t < 2) return (4 * t + (c >> 6)) * 96 + (c & 63);
        return (c7 >> 4) * 96 + 64 + 16 * half + (c7 & 15);
    }
    return p;
}

struct Ctx {
    const float *x, *meta, *norm_g, *w_in, *b_f, *g_cq, *g_ckv, *w_uq, *w_ukv, *sinks, *w_branch, *w_out, *final_g;
    float* out; unsigned char* ws;
    LAS unsigned char* lds;
    int tid, lane, wave, G, bid;
};
#define WSP(T, off) ((T*)(c.ws + (off)))
__device__ __forceinline__ bf16* wl(const Ctx& c, int layer, size_t off) { return (bf16*)(c.ws + WS_W + (size_t)layer * WL_BYTES + off); }

__device__ __forceinline__ void conv_item(const float* W, int N, const float* gv, bf16* Bt, int K, int kind, int nblk, int item, LAS float* scr, int lane) {
    const int kb = item / nblk, nb = item % nblk, k0 = 64 * kb, n0 = 32 * nb;
    const int lc = map_col(kind, n0 + (lane & 31));
#pragma unroll 8
    for (int i = 0; i < 32; ++i) { const int kk = 2 * i + (lane >> 5); float v = 0.f; if (lc >= 0) { v = W[(size_t)(k0 + kk) * N + lc]; if (gv) v *= gv[k0 + kk]; } scr[kk * 33 + (lane & 31)] = v; }
    asm volatile("s_waitcnt lgkmcnt(0)" ::: "memory");
    const int ch = lane & 7;
#pragma unroll
    for (int j = 0; j < 4; ++j) { const int n = (lane >> 3) + 8 * j; const LAS float* s = scr + (8 * ch) * 33 + n;
        u32x4 o; o.x = cvtpk(s[0 * 33], s[1 * 33]); o.y = cvtpk(s[2 * 33], s[3 * 33]); o.z = cvtpk(s[4 * 33], s[5 * 33]); o.w = cvtpk(s[6 * 33], s[7 * 33]);
        *(u32x4*)(Bt + (size_t)(n0 + n) * K + k0 + 8 * ch) = o; }
    asm volatile("s_waitcnt lgkmcnt(0)" ::: "memory");
}
__device__ __forceinline__ void zero_fronts(const Ctx& c) {
    const int g = c.bid * NTHREADS + c.tid, NG = c.G * NTHREADS;
    const u32x4 z = {0u, 0u, 0u, 0u};
    for (int e = g; e < MOFF * PKB / 8; e += NG) WSP(u32x4, WS_KB)[e] = z;
    for (int e = g; e < MOFF * PVB / 8; e += NG) WSP(u32x4, WS_VB)[e] = z;
    for (int e = g; e < MOFF * PKA / 8; e += NG) WSP(u32x4, WS_KA)[e] = z;
    for (int e = g; e < MOFF * PVA / 8; e += NG) WSP(u32x4, WS_VA)[e] = z;
    for (int e = g; e < MOFF * PKC / 8; e += NG) WSP(u32x4, WS_KC)[e] = z;
    for (int e = g; e < MOFF * PVC / 8; e += NG) WSP(u32x4, WS_VC)[e] = z;
}
__device__ __forceinline__ void sincos_d(float ang, float& s, float& co) {
    const double x = (double)ang, TWO_PI = 6.283185307179586476925, INV = 0.15915494309189533577;
    const double n = __builtin_rint(x * INV), r = __builtin_fma(-n, TWO_PI, x), y = 0.5 * r, y2 = y * y;
    double sp, cp;
    double ts = 1.0, tc = 1.0; sp = 1.0; cp = 1.0;
#pragma unroll
    for (int j = 1; j <= 12; ++j) { tc = -tc * y2 / (double)((2 * j - 1) * (2 * j)); ts = -ts * y2 / (double)((2 * j) * (2 * j + 1)); cp += tc; sp += ts; }
    const double sy = y * sp, cy = cp;
    s = (float)(2.0 * sy * cy); co = (float)(1.0 - 2.0 * sy * sy);
}
__device__ __forceinline__ void rope_tables(const Ctx& c) {
    const int g = c.bid * NTHREADS + c.tid, NG = c.G * NTHREADS;
    for (int e = g; e < NPOS * 48; e += NG) {
        const int pos = e / 48, i = e % 48;
        float inv; if (i < 32) inv = fexp2(-(float)i * (13.287712379549449f / 32.f)); else inv = fexp2(-(float)(i - 32) * (13.287712379549449f / 16.f));
        const float ang = (float)pos * inv; float s, co; sincos_d(ang, s, co);
        if (i < 32) { WSP(float, WS_COS64)[pos * 32 + i] = co; WSP(float, WS_SIN64)[pos * 32 + i] = s; }
        else { WSP(float, WS_COS32)[pos * 16 + i - 32] = co; WSP(float, WS_SIN32)[pos * 16 + i - 32] = s; }
    }
}
__device__ __forceinline__ void rms_row_to_bf16(const float* xrow, bf16* orow, float* copy, int lane) {
    const f32x4* xr = (const f32x4*)xrow + lane;
    f32x4 v[4]; float s = 0.f;
#pragma unroll
    for (int j = 0; j < 4; ++j) { v[j] = xr[64 * j]; s += (v[j][0] * v[j][0] + v[j][1] * v[j][1]) + (v[j][2] * v[j][2] + v[j][3] * v[j][3]); }
    const float rstd = 1.f / sqrtf(wave_sum(s) * (1.f / DM) + EPS);
    u32x2* o8 = (u32x2*)orow + lane;
#pragma unroll
    for (int j = 0; j < 4; ++j) { u32x2 w; w.x = cvtpk(v[j][0] * rstd, v[j][1] * rstd); w.y = cvtpk(v[j][2] * rstd, v[j][3] * rstd); o8[64 * j] = w; if (copy) ((f32x4*)copy + lane)[64 * j] = v[j]; }
}
__device__ __forceinline__ void slot0(const Ctx& c) {
    LAS float* scr = (LAS float*)(c.lds + c.wave * 16384);
    const int gw = c.bid * NWAVES + c.wave, NGW = c.G * NWAVES;
    for (int layer = 0; layer < 2; ++layer) {
        const float* w_in = c.w_in + (size_t)layer * DM * NIN;
        const int I_E = 16 * (NE / 32), I_L = 16 * (NL / 32), I_UQ = 6 * (NUQ / 32), I_UKV = 4 * (NUKV / 32), I_BR = 8 * (DM / 32), I_O = 16 * (DM / 32);
        const int tot = I_E + I_L + I_UQ + I_UKV + 3 * I_BR + I_O;
        for (int it = gw; it < tot; it += NGW) {
            int r = it;
            if (r < I_E) { conv_item(w_in, NIN, c.norm_g + layer * DM, wl(c, layer, WL_EARLY), DM, MAP_EARLY, NE / 32, r, scr, c.lane); continue; } r -= I_E;
            if (r < I_L) { conv_item(w_in, NIN, c.norm_g + layer * DM, wl(c, layer, WL_LATE), DM, MAP_LATE, NL / 32, r, scr, c.lane); continue; } r -= I_L;
            if (r < I_UQ) { conv_item(c.w_uq + (size_t)layer * 384 * 768, 768, c.g_cq + layer * 384, wl(c, layer, WL_UQ), 384, MAP_UQ, NUQ / 32, r, scr, c.lane); continue; } r -= I_UQ;
            if (r < I_UKV) { conv_item(c.w_ukv + (size_t)layer * 256 * 1024, 1024, c.g_ckv + layer * 256, wl(c, layer, WL_UKV), 256, MAP_ID, NUKV / 32, r, scr, c.lane); continue; } r -= I_UKV;
            if (r < 3 * I_BR) { const int n = r / I_BR; conv_item(c.w_branch + ((size_t)layer * 3 + n) * 512 * DM, DM, nullptr, wl(c, layer, WL_BR) + (size_t)n * DM * 512, 512, MAP_ID, DM / 32, r % I_BR, scr, c.lane); continue; } r -= 3 * I_BR;
            conv_item(c.w_out + (size_t)layer * DM * DM, DM, nullptr, wl(c, layer, WL_OUT), DM, MAP_ID, DM / 32, r, scr, c.lane);
        }
    }
    rope_tables(c);
    if (gw < 16) rms_row_to_bf16(c.meta + (size_t)gw * DM, WSP(bf16, WS_HNM) + (size_t)gw * DM, WSP(float, WS_HM) + (size_t)gw * DM, c.lane);
}

__device__ __forceinline__ void norm_main(const Ctx& c, const float* src) {
    const int gw = c.bid * NWAVES + c.wave, NGW = c.G * NWAVES;
    for (int m = gw; m < M; m += NGW) rms_row_to_bf16(src + (size_t)m * DM, WSP(bf16, WS_HN) + (size_t)m * DM, nullptr, c.lane);
}

template <class AF>
__device__ __forceinline__ void meta_block(const AF& af, const bf16* Bt, int K, int col0, float* raw, int ldraw, int rcol0, int lane) {
    f32x4 acc = {0.f, 0.f, 0.f, 0.f};
    const int r = lane & 15, kq = 8 * (lane >> 4);
    for (int k0 = 0; k0 < K; k0 += 32) {
        const bf16x8 a = af(r, k0 + kq);
        const bf16x8 b = *(const bf16x8*)(Bt + (size_t)(col0 + r) * K + k0 + kq);
        acc = __builtin_amdgcn_mfma_f32_16x16x32_bf16(a, b, acc, 0, 0, 0);
    }
#pragma unroll
    for (int x = 0; x < 4; ++x) raw[(size_t)(4 * (lane >> 4) + x) * ldraw + rcol0 + r] = acc[x];
}
struct AfPlain { const bf16* A; int lda; __device__ __forceinline__ bf16x8 operator()(int r, int k) const { return *(const bf16x8*)(A + (size_t)r * lda + k); } };
struct AfBranch {
    const bf16* ym; const float* rawl; int n;
    __device__ __forceinline__ bf16x8 operator()(int r, int k) const {
        f32x4 y0, y1; ld8(ym + (size_t)r * 1536 + n * 512 + k, y0, y1);
        const f32x4 z0 = *(const f32x4*)(rawl + (size_t)r * NL + 512 * n + k), z1 = *(const f32x4*)(rawl + (size_t)r * NL + 512 * n + k + 4);
#pragma unroll
        for (int j = 0; j < 4; ++j) { y0[j] *= siluf_(z0[j]); y1[j] *= siluf_(z1[j]); }
        return __builtin_bit_cast(bf16x8, pack8(y0, y1));
    }
};
struct AfMerged {
    const float* rawl; const float* rawb;
    __device__ __forceinline__ bf16x8 operator()(int r, int k) const {
        f32x4 s0 = {0.f, 0.f, 0.f, 0.f}, s1 = s0;
#pragma unroll
        for (int n = 0; n < 3; ++n) {
            const float* g = rawl + (size_t)r * NL + 1536 + n * 1024 + k; const float* p = rawb + ((size_t)n * 16 + r) * 1024 + k;
#pragma unroll
            for (int j = 0; j < 4; ++j) { s0[j] += sigmoidf_(g[j]) * p[j]; s1[j] += sigmoidf_(g[4 + j]) * p[4 + j]; }
        }
        return __builtin_bit_cast(bf16x8, pack8(s0, s1));
    }
};
template <class AF>
__device__ __forceinline__ void meta_blocks(const Ctx& c, const AF& af, const bf16* Bt, int K, int nblocks, float* raw, int ldraw, int rcol0) {
    const int gw = c.bid * NWAVES + c.wave, NGW = c.G * NWAVES;
    for (int b = gw; b < nblocks; b += NGW) meta_block(af, Bt, K, 16 * b, raw, ldraw, rcol0 + 16 * b, c.lane);
}

__device__ __forceinline__ void post_early(const Ctx& c, int layer) {
    const float* raw = WSP(float, WS_RAWE);
    bf16 *QAm = WSP(bf16, WS_QAM), *QCm = WSP(bf16, WS_QCM), *cm = WSP(bf16, WS_CM);
    bf16 *KAf = WSP(bf16, WS_KA), *VAf = WSP(bf16, WS_VA), *KBf = WSP(bf16, WS_KB), *KCf = WSP(bf16, WS_KC), *VCf = WSP(bf16, WS_VC);
    float* LFm = WSP(float, WS_LFM);
    const float *cos64 = WSP(float, WS_COS64), *sin64 = WSP(float, WS_SIN64), *cos32 = WSP(float, WS_COS32), *sin32 = WSP(float, WS_SIN32);
    for (int e = c.tid; e < 16 * NE; e += NTHREADS) {
        const int r = e / NE, p = e % NE, t = p >> 8, cc = p & 255, half = cc >> 7, c7 = cc & 127; const float v = raw[e];
        if (t < 2) QAm[r * PQA + p] = f2bf(v * C2A);
        else if (t < 4) { const int L = p - 512; KAf[(size_t)(MOFF + r) * PKA + (L >> 6) * 80 + (L & 63)] = f2bf(v); }
        else if (t < 6) VAf[(size_t)(MOFF + r) * PVA + (p - 1024)] = f2bf(v);
        else if (t < 8) { if (half == 0) { const int hh = c7 >> 5, d = c7 & 31, head = 4 * (t - 6) + hh; const float x1 = v, x2 = raw[e + 128], cs = cos64[r * 32 + d], sn = sin64[r * 32 + d];
                QCm[r * PQC + head * 64 + d] = f2bf((x1 * cs - x2 * sn) * C2C); QCm[r * PQC + head * 64 + 32 + d] = f2bf((x2 * cs + x1 * sn) * C2C); } }
        else if (t == 8) { if (c7 < 64) { if (half == 0) { const int hh = c7 >> 5, d = c7 & 31; const float x1 = v, x2 = raw[e + 128], cs = cos64[r * 32 + d], sn = sin64[r * 32 + d];
                    KCf[(size_t)(MOFF + r) * PKC + hh * 64 + d] = f2bf(x1 * cs - x2 * sn); KCf[(size_t)(MOFF + r) * PKC + hh * 64 + 32 + d] = f2bf(x2 * cs + x1 * sn); } }
            else VCf[(size_t)(MOFF + r) * PVC + 64 * half + (c7 - 64)] = f2bf(v); }
        else if (t == 9) cm[r * 640 + cc] = f2bf(v);
        else if (t == 10) { if (c7 < 64) cm[r * 640 + 256 + 64 * half + c7] = f2bf(v);
            else if (c7 < 80) { if (half == 0) { const int d = c7 - 64; const float x1 = v, x2 = raw[e + 128], cs = cos32[r * 16 + d], sn = sin32[r * 16 + d]; const bf16 o1 = f2bf(x1 * cs - x2 * sn), o2 = f2bf(x2 * cs + x1 * sn);
                    for (int h = 0; h < 8; ++h) { KBf[(size_t)(MOFF + r) * PKB + h * 96 + 64 + d] = o1; KBf[(size_t)(MOFF + r) * PKB + h * 96 + 80 + d] = o2; } } }
            else if (c7 < 88 && half == 0) LFm[r * 8 + (c7 - 80)] = logsigf_(v + c.b_f[layer * 8 + (c7 - 80)]); }
        else cm[r * 640 + 384 + cc] = f2bf(v);
    }
    __syncthreads();
    float* rqm = WSP(float, WS_RQM);
    if (c.tid < 16) { float s = 0.f; for (int k = 0; k < 384; ++k) { const float v = bf2f(cm[c.tid * 640 + k]); s += v * v; } rqm[c.tid] = 1.f / sqrtf(s * (1.f / 384.f) + EPS); }
    else if (c.tid < 32) { const int r = c.tid - 16; float s = 0.f; for (int k = 0; k < 256; ++k) { const float v = bf2f(cm[r * 640 + 384 + k]); s += v * v; } rqm[16 + r] = 1.f / sqrtf(s * (1.f / 256.f) + EPS); }
    else if (c.tid < 40) { const int h = c.tid - 32; float suf = 0.f;
        for (int r = 15; r >= 0; --r) { bf16 bh, bm, bl; split3(suf * LOG2E, bh, bm, bl); bf16* kp = KAf + (size_t)(MOFF + r) * PKA + h * 80 + 64; kp[0] = bh; kp[1] = bm; kp[2] = bl; for (int j = 3; j < 16; ++j) kp[j] = 0; suf += LFm[r * 8 + h]; } }
}
__device__ __forceinline__ void post_up(const Ctx& c) {
    const float* raw = WSP(float, WS_RAWU); const float* rqm = WSP(float, WS_RQM);
    bf16 *QBm = WSP(bf16, WS_QBM), *KBf = WSP(bf16, WS_KB), *VBf = WSP(bf16, WS_VB);
    const float *cos32 = WSP(float, WS_COS32), *sin32 = WSP(float, WS_SIN32);
    for (int e = c.tid; e < 16 * (NUQ + NUKV); e += NTHREADS) {
        const int r = e / (NUQ + NUKV), p = e % (NUQ + NUKV); const float v = raw[e];
        if (p < 512) { const int h = p >> 6, d = p & 63; QBm[r * PQB + h * 96 + d] = f2bf(v * rqm[r] * C2B); }
        else if (p < 768) { const int cc = p - 512, half = cc >> 7, c7 = cc & 127; if (half == 0) { const int h = c7 >> 4, d = c7 & 15; const float sc = rqm[r] * C2B, x1 = v * sc, x2 = raw[e + 128] * sc, cs = cos32[r * 16 + d], sn = sin32[r * 16 + d];
                QBm[r * PQB + h * 96 + 64 + d] = f2bf(x1 * cs - x2 * sn); QBm[r * PQB + h * 96 + 80 + d] = f2bf(x2 * cs + x1 * sn); } }
        else { const int q = p - 768, h = q >> 7, d = q & 127; const float w = v * rqm[16 + r];
            if (d < 64) KBf[(size_t)(MOFF + r) * PKB + h * 96 + d] = f2bf(w); else VBf[(size_t)(MOFF + r) * PVB + h * 64 + (d - 64)] = f2bf(w); }
    }
}
__device__ __forceinline__ void post_resid(const Ctx& c) {
    for (int r = c.wave; r < 16; r += NWAVES) {
        float* hm = WSP(float, WS_HM) + (size_t)r * DM; const float* ro = WSP(float, WS_RAWO) + (size_t)r * DM;
        f32x4 v[4]; float s = 0.f;
#pragma unroll
        for (int j = 0; j < 4; ++j) { v[j] = ((const f32x4*)hm + c.lane)[64 * j] + ((const f32x4*)ro + c.lane)[64 * j]; s += (v[j][0] * v[j][0] + v[j][1] * v[j][1]) + (v[j][2] * v[j][2] + v[j][3] * v[j][3]); }
        const float rstd = 1.f / sqrtf(wave_sum(s) * (1.f / DM) + EPS);
        u32x2* o8 = (u32x2*)(WSP(bf16, WS_HNM) + (size_t)r * DM) + c.lane;
#pragma unroll
        for (int j = 0; j < 4; ++j) { u32x2 w; w.x = cvtpk(v[j][0] * rstd, v[j][1] * rstd); w.y = cvtpk(v[j][2] * rstd, v[j][3] * rstd); o8[64 * j] = w; ((f32x4*)hm + c.lane)[64 * j] = v[j]; }
    }
}

template <int DK, int MODE>
__device__ __forceinline__ void attn_row(const bf16* qrow, const bf16* Kf, const bf16* Km, int kpitch, int koff, const bf16* Vf, const bf16* Vm, int vpitch, int voff, int t, float sink2, bf16* orow) {
    float q[DK];
#pragma unroll
    for (int d = 0; d < DK; d += 8) { f32x4 a, b; ld8(qrow + d, a, b);
#pragma unroll
        for (int j = 0; j < 4; ++j) { q[d + j] = a[j]; q[d + 4 + j] = b[j]; } }
    float o[64];
#pragma unroll
    for (int d = 0; d < 64; ++d) o[d] = 0.f;
    float m = -1e30f, l = 0.f; if (MODE == 2) { m = sink2; l = 1.f; }
    const int s0 = (MODE == 2) ? (t - 127 > 0 ? t - 127 : 0) : 0;
    for (int s = s0; s <= t; ++s) {
        const bf16* kp = (s < NMETA) ? Kf + (size_t)(MOFF + s) * kpitch + koff : Km + (size_t)(s - NMETA) * kpitch + koff;
        const bf16* vp = (s < NMETA) ? Vf + (size_t)(MOFF + s) * vpitch + voff : Vm + (size_t)(s - NMETA) * vpitch + voff;
        float x = 0.f;
#pragma unroll
        for (int d = 0; d < DK; d += 8) { f32x4 a, b; ld8(kp + d, a, b);
#pragma unroll
            for (int j = 0; j < 4; ++j) { x += q[d + j] * a[j]; x += q[d + 4 + j] * b[j]; } }
        if (MODE == 0) x += bf2f(kp[64]) + bf2f(kp[65]) + bf2f(kp[66]);
        if (x > m) { const float f = fexp2(m - x); l *= f;
#pragma unroll
            for (int d = 0; d < 64; ++d) o[d] *= f;
            m = x; }
        const float p = fexp2(x - m); l += p;
#pragma unroll
        for (int d = 0; d < 64; d += 8) { f32x4 a, b; ld8(vp + d, a, b);
#pragma unroll
            for (int j = 0; j < 4; ++j) { o[d + j] += p * a[j]; o[d + 4 + j] += p * b[j]; } }
    }
    const float il = 1.f / l;
#pragma unroll
    for (int d = 0; d < 64; d += 8) { f32x4 a = {o[d] * il, o[d + 1] * il, o[d + 2] * il, o[d + 3] * il}, b = {o[d + 4] * il, o[d + 5] * il, o[d + 6] * il, o[d + 7] * il}; st8(orow + d, a, b); }
}
__device__ __forceinline__ void attn_main_naive(const Ctx& c, int layer) {
    const int g = c.bid * NTHREADS + c.tid, NG = c.G * NTHREADS;
    for (int e = g; e < M * 8; e += NG) {
        const int i = e % SEQ, bh = e / SEQ, b = bh >> 3, h = bh & 7; const size_t row = (size_t)b * SEQ + i; const int t = NMETA + i;
        attn_row<64, 0>(WSP(bf16, WS_QA) + row * PQA + h * 64, WSP(bf16, WS_KA), WSP(bf16, WS_KA) + (size_t)(FR + b * SEQ) * PKA, PKA, h * 80,
                        WSP(bf16, WS_VA), WSP(bf16, WS_VA) + (size_t)(FR + b * SEQ) * PVA, PVA, h * 64, t, 0.f, WSP(bf16, WS_QA) + row * PQA + h * 64);
    }
    for (int e = g; e < M * 8; e += NG) {
        const int i = e % SEQ, bh = e / SEQ, b = bh >> 3, h = bh & 7; const size_t row = (size_t)b * SEQ + i; const int t = NMETA + i;
        attn_row<96, 1>(WSP(bf16, WS_QB) + row * PQB + h * 96, WSP(bf16, WS_KB), WSP(bf16, WS_KB) + (size_t)(FR + b * SEQ) * PKB, PKB, h * 96,
                        WSP(bf16, WS_VB), WSP(bf16, WS_VB) + (size_t)(FR + b * SEQ) * PVB, PVB, h * 64, t, 0.f, WSP(bf16, WS_YB) + row * PY + h * 64);
    }
    for (int e = g; e < M * 8; e += NG) {
        const int i = e % SEQ, bh = e / SEQ, b = bh >> 3, h = bh & 7; const size_t row = (size_t)b * SEQ + i; const int t = NMETA + i;
        attn_row<64, 2>(WSP(bf16, WS_QC) + row * PQC + h * 64, WSP(bf16, WS_KC), WSP(bf16, WS_KC) + (size_t)(FR + b * SEQ) * PKC, PKC, (h >> 2) * 64,
                        WSP(bf16, WS_VC), WSP(bf16, WS_VC) + (size_t)(FR + b * SEQ) * PVC, PVC, (h >> 2) * 64, t, c.sinks[layer * 8 + h] * LOG2E, WSP(bf16, WS_QC) + row * PQC + h * 64);
    }
}
__device__ __forceinline__ void attn_meta(const Ctx& c) {
    if (c.tid >= 384) return;
    const int br = c.tid / 128, h = (c.tid >> 4) & 7, r = c.tid & 15; bf16* ym = WSP(bf16, WS_YM) + (size_t)r * 1536 + br * 512 + h * 64;
    if (br == 0) attn_row<64, 0>(WSP(bf16, WS_QAM) + r * PQA + h * 64, WSP(bf16, WS_KA), WSP(bf16, WS_KA), PKA, h * 80, WSP(bf16, WS_VA), WSP(bf16, WS_VA), PVA, h * 64, r, 0.f, ym);
    else if (br == 1) attn_row<96, 1>(WSP(bf16, WS_QBM) + r * PQB + h * 96, WSP(bf16, WS_KB), WSP(bf16, WS_KB), PKB, h * 96, WSP(bf16, WS_VB), WSP(bf16, WS_VB), PVB, h * 64, r, 0.f, ym);
    else attn_row<64, 2>(WSP(bf16, WS_QCM) + r * PQC + h * 64, WSP(bf16, WS_KC), WSP(bf16, WS_KC), PKC, (h >> 2) * 64, WSP(bf16, WS_VC), WSP(bf16, WS_VC), PVC, (h >> 2) * 64, r, c.sinks[h] * LOG2E, ym);
}

struct Unit { int pm, pn, z; };
__device__ __forceinline__ int perm32(int rho) { const int n = rho >> 4, i = rho & 15; return 8 * (i >> 2) + 4 * n + (i & 3); }
template <class Prob, class Epi>
__device__ __forceinline__ void gemm_naive(const Ctx& c, const Prob& P, const Epi& E) {
    const int wr = c.wave >> 2, wc = c.wave & 3, fr = c.lane & 15, fq = c.lane >> 4;
    const int nunits = P.nunits();
    for (int ui = c.bid; ui < nunits; ui += c.G) {
        Unit u; P.unit(ui, u);
        const bf16* A; const bf16* Bt; P.operands(u, A, Bt);
        const int K = P.K, lda = P.lda;
        f32x4 acc[2][2][4][2];
#pragma unroll
        for (int a = 0; a < 2; ++a)
#pragma unroll
            for (int b = 0; b < 2; ++b)
#pragma unroll
                for (int m = 0; m < 4; ++m)
#pragma unroll
                    for (int n = 0; n < 2; ++n) acc[a][b][m][n] = (f32x4){0.f, 0.f, 0.f, 0.f};
        for (int k0 = 0; k0 < K; k0 += 64) {
#pragma unroll
            for (int ai = 0; ai < 2; ++ai) {
#pragma unroll
                for (int bj = 0; bj < 2; ++bj) {
                    bf16x8 Bf[2][2];
#pragma unroll
                    for (int n = 0; n < 2; ++n)
#pragma unroll
                        for (int k = 0; k < 2; ++k) Bf[n][k] = *(const bf16x8*)(Bt + (size_t)(256 * u.pn + 128 * bj + 32 * wc + perm32(16 * n + fr)) * K + k0 + 32 * k + 8 * fq);
#pragma unroll
                    for (int m = 0; m < 4; ++m) {
                        bf16x8 At[2];
#pragma unroll
                        for (int k = 0; k < 2; ++k) At[k] = *(const bf16x8*)(A + (size_t)(256 * u.pm + 128 * ai + 64 * wr + 16 * m + fr) * lda + k0 + 32 * k + 8 * fq);
#pragma unroll
                        for (int n = 0; n < 2; ++n)
#pragma unroll
                            for (int k = 0; k < 2; ++k) acc[ai][bj][m][n] = __builtin_amdgcn_mfma_f32_16x16x32_bf16(Bf[n][k], At[k], acc[ai][bj][m][n], 0, 0, 0);
                    }
                }
            }
        }
        asm volatile("" ::: "memory");
        E(acc, u, wr, wc, fr, fq);
    }
}
struct ProbSimple { const bf16* A; const bf16* Bt; int lda, K, nM, nN, pn0;
    __device__ __forceinline__ int nunits() const { return nM * nN; }
    __device__ __forceinline__ void unit(int i, Unit& u) const { u.pm = i / nN; u.pn = pn0 + i % nN; u.z = 0; }
    __device__ __forceinline__ void operands(const Unit&, const bf16*& a, const bf16*& b) const { a = A; b = Bt; } };
struct ProbBranch { const bf16 *A0, *A1, *A2; const bf16* Bt; int lda, K, z;
    __device__ __forceinline__ int nunits() const { return 64 * 4; }
    __device__ __forceinline__ void unit(int i, Unit& u) const { u.pm = i >> 2; u.pn = i & 3; u.z = z; }
    __device__ __forceinline__ void operands(const Unit& u, const bf16*& a, const bf16*& b) const { a = (u.z == 0) ? A0 : (u.z == 1) ? A1 : A2; b = Bt + (size_t)u.z * DM * 512; } };

#define EPI_ROWS_BEGIN _Pragma("unroll") for (int ai = 0; ai < 2; ++ai) _Pragma("unroll") for (int m = 0; m < 4; ++m) { const int row = 256 * u.pm + 128 * ai + 64 * wr + 16 * m + fr; \
    const f32x4 l0 = acc[ai][0][m][0], l1 = acc[ai][0][m][1], h0 = acc[ai][1][m][0], h1 = acc[ai][1][m][1]; (void)l0; (void)l1; (void)h0; (void)h1;
#define EPI_ROWS_END asm volatile("" ::: "memory"); }
typedef f32x4 Acc_t[2][2][4][2];

__device__ __forceinline__ void rope8(const float* cs, const float* sn, f32x4 x1a, f32x4 x1b, f32x4 x2a, f32x4 x2b, float sc, f32x4& o1a, f32x4& o1b, f32x4& o2a, f32x4& o2b) {
    const f32x4 ca = *(const f32x4*)cs, cb = *(const f32x4*)(cs + 4), sa = *(const f32x4*)sn, sb = *(const f32x4*)(sn + 4);
    o1a = (x1a * ca - x2a * sa) * sc; o1b = (x1b * cb - x2b * sb) * sc; o2a = (x2a * ca + x1a * sa) * sc; o2b = (x2b * cb + x1b * sb) * sc;
}
struct EpiEarly {
    const Ctx& c; int layer;
    __device__ __forceinline__ void operator()(const Acc_t& acc, const Unit& u, int wr, int wc, int fr, int fq) const {
        const int c8 = 32 * wc + 8 * fq, t = u.pn;
        bf16 *QA = WSP(bf16, WS_QA), *KA = WSP(bf16, WS_KA) + (size_t)FR * PKA, *VA = WSP(bf16, WS_VA) + (size_t)FR * PVA, *QC = WSP(bf16, WS_QC), *KC = WSP(bf16, WS_KC) + (size_t)FR * PKC,
             *VC = WSP(bf16, WS_VC) + (size_t)FR * PVC, *CQ = WSP(bf16, WS_CQ), *CKV = WSP(bf16, WS_CKV), *KB = WSP(bf16, WS_KB) + (size_t)FR * PKB;
        const float *cos64 = WSP(float, WS_COS64), *sin64 = WSP(float, WS_SIN64), *cos32 = WSP(float, WS_COS32), *sin32 = WSP(float, WS_SIN32);
        if (t < 2) { EPI_ROWS_BEGIN st8(QA + (size_t)row * PQA + 256 * t + c8, l0 * C2A, l1 * C2A); st8(QA + (size_t)row * PQA + 256 * t + 128 + c8, h0 * C2A, h1 * C2A); EPI_ROWS_END }
        else if (t < 4) { const int L0 = 256 * (t - 2) + c8, L1 = L0 + 128;
            EPI_ROWS_BEGIN st8(KA + (size_t)row * PKA + (L0 >> 6) * 80 + (L0 & 63), l0, l1); st8(KA + (size_t)row * PKA + (L1 >> 6) * 80 + (L1 & 63), h0, h1); EPI_ROWS_END }
        else if (t < 6) { EPI_ROWS_BEGIN st8(VA + (size_t)row * PVA + 256 * (t - 4) + c8, l0, l1); st8(VA + (size_t)row * PVA + 256 * (t - 4) + 128 + c8, h0, h1); EPI_ROWS_END }
        else if (t < 8) { const int head = 4 * (t - 6) + wc, d = 8 * fq;
            EPI_ROWS_BEGIN const int pos = NMETA + (row & (SEQ - 1)); f32x4 o1a, o1b, o2a, o2b; rope8(cos64 + pos * 32 + d, sin64 + pos * 32 + d, l0, l1, h0, h1, C2C, o1a, o1b, o2a, o2b);
                st8(QC + (size_t)row * PQC + head * 64 + d, o1a, o1b); st8(QC + (size_t)row * PQC + head * 64 + 32 + d, o2a, o2b); EPI_ROWS_END }
        else if (t == 8) {
            if (wc < 2) { const int d = 8 * fq;
                EPI_ROWS_BEGIN const int pos = NMETA + (row & (SEQ - 1)); f32x4 o1a, o1b, o2a, o2b; rope8(cos64 + pos * 32 + d, sin64 + pos * 32 + d, l0, l1, h0, h1, 1.f, o1a, o1b, o2a, o2b);
                    st8(KC + (size_t)row * PKC + wc * 64 + d, o1a, o1b); st8(KC + (size_t)row * PKC + wc * 64 + 32 + d, o2a, o2b); EPI_ROWS_END }
            else { const int j = 32 * (wc - 2) + 8 * fq;
                EPI_ROWS_BEGIN st8(VC + (size_t)row * PVC + j, l0, l1); st8(VC + (size_t)row * PVC + 64 + j, h0, h1); EPI_ROWS_END } }
        else if (t == 9) { EPI_ROWS_BEGIN st8(CQ + (size_t)row * PCQ + c8, l0, l1); st8(CQ + (size_t)row * PCQ + 128 + c8, h0, h1); EPI_ROWS_END }
        else if (t == 10) {
            if (wc < 2) { EPI_ROWS_BEGIN st8(CQ + (size_t)row * PCQ + 256 + c8, l0, l1); st8(CQ + (size_t)row * PCQ + 256 + 64 + c8, h0, h1); EPI_ROWS_END }
            else if (wc == 2) {
                if (fq < 2) { const int d = 8 * fq;
                    EPI_ROWS_BEGIN const int pos = NMETA + (row & (SEQ - 1)); f32x4 o1a, o1b, o2a, o2b; rope8(cos32 + pos * 16 + d, sin32 + pos * 16 + d, l0, l1, h0, h1, 1.f, o1a, o1b, o2a, o2b);
                        const u32x4 w1 = pack8(o1a, o1b), w2 = pack8(o2a, o2b);
#pragma unroll
                        for (int h = 0; h < 8; ++h) { *(u32x4*)(KB + (size_t)row * PKB + h * 96 + 64 + d) = w1; *(u32x4*)(KB + (size_t)row * PKB + h * 96 + 80 + d) = w2; } EPI_ROWS_END }
                else if (fq == 2) { float* LF = WSP(float, WS_LF); const f32x4 b0 = *(const f32x4*)(c.b_f + layer * 8), b1 = *(const f32x4*)(c.b_f + layer * 8 + 4);
                    EPI_ROWS_BEGIN f32x4 a = l0 + b0, b = l1 + b1;
#pragma unroll
                        for (int j = 0; j < 4; ++j) { a[j] = logsigf_(a[j]); b[j] = logsigf_(b[j]); }
                        *(f32x4*)(LF + (size_t)row * 8) = a; *(f32x4*)(LF + (size_t)row * 8 + 4) = b; EPI_ROWS_END } } }
        else { EPI_ROWS_BEGIN st8(CKV + (size_t)row * PCKV + c8, l0, l1); st8(CKV + (size_t)row * PCKV + 128 + c8, h0, h1); EPI_ROWS_END }
    }
};
struct EpiUq {
    const Ctx& c;
    __device__ __forceinline__ void operator()(const Acc_t& acc, const Unit& u, int wr, int wc, int fr, int fq) const {
        bf16* QB = WSP(bf16, WS_QB); const float* RQ = WSP(float, WS_RQ); const float *cos32 = WSP(float, WS_COS32), *sin32 = WSP(float, WS_SIN32);
        const int c8 = 32 * wc + 8 * fq;
        if (u.pn < 2) { const int ha = 4 * u.pn + (c8 >> 6), hb = ha + 2, e = c8 & 63;
            EPI_ROWS_BEGIN const float sc = RQ[row] * C2B; st8(QB + (size_t)row * PQB + ha * 96 + e, l0 * sc, l1 * sc); st8(QB + (size_t)row * PQB + hb * 96 + e, h0 * sc, h1 * sc); EPI_ROWS_END }
        else { const int h = c8 >> 4, d = c8 & 15;
            EPI_ROWS_BEGIN const float sc = RQ[row] * C2B; const int pos = NMETA + (row & (SEQ - 1)); f32x4 o1a, o1b, o2a, o2b; rope8(cos32 + pos * 16 + d, sin32 + pos * 16 + d, l0, l1, h0, h1, sc, o1a, o1b, o2a, o2b);
                st8(QB + (size_t)row * PQB + h * 96 + 64 + d, o1a, o1b); st8(QB + (size_t)row * PQB + h * 96 + 80 + d, o2a, o2b); EPI_ROWS_END }
    }
};
struct EpiUkv {
    const Ctx& c;
    __device__ __forceinline__ void operator()(const Acc_t& acc, const Unit& u, int wr, int wc, int fr, int fq) const {
        bf16 *KB = WSP(bf16, WS_KB) + (size_t)FR * PKB, *VB = WSP(bf16, WS_VB) + (size_t)FR * PVB; const float* RKV = WSP(float, WS_RKV);
        const int c8 = 32 * wc + 8 * fq, ha = 2 * u.pn, hb = ha + 1;
        if (wc < 2) { EPI_ROWS_BEGIN const float sc = RKV[row]; st8(KB + (size_t)row * PKB + ha * 96 + c8, l0 * sc, l1 * sc); st8(KB + (size_t)row * PKB + hb * 96 + c8, h0 * sc, h1 * sc); EPI_ROWS_END }
        else { EPI_ROWS_BEGIN const float sc = RKV[row]; st8(VB + (size_t)row * PVB + ha * 64 + c8 - 64, l0 * sc, l1 * sc); st8(VB + (size_t)row * PVB + hb * 64 + c8 - 64, h0 * sc, h1 * sc); EPI_ROWS_END }
    }
};
struct EpiLateZ {
    const Ctx& c;
    __device__ __forceinline__ void operator()(const Acc_t& acc, const Unit& u, int wr, int wc, int fr, int fq) const {
        const int c8 = 32 * wc + 8 * fq, t = u.pn;
        bf16* Y = (t < 2) ? WSP(bf16, WS_QA) : (t < 4) ? WSP(bf16, WS_YB) : WSP(bf16, WS_QC); const int col = 256 * (t & 1) + c8;
        EPI_ROWS_BEGIN
            { bf16* p = Y + (size_t)row * PY + col; f32x4 ya, yb; ld8(p, ya, yb);
#pragma unroll
              for (int j = 0; j < 4; ++j) { ya[j] *= siluf_(l0[j]); yb[j] *= siluf_(l1[j]); }
              st8(p, ya, yb); }
            { bf16* p = Y + (size_t)row * PY + col + 128; f32x4 ya, yb; ld8(p, ya, yb);
#pragma unroll
              for (int j = 0; j < 4; ++j) { ya[j] *= siluf_(h0[j]); yb[j] *= siluf_(h1[j]); }
              st8(p, ya, yb); }
        EPI_ROWS_END
    }
};
struct EpiLateG {
    const Ctx& c;
    __device__ __forceinline__ void operator()(const Acc_t& acc, const Unit& u, int wr, int wc, int fr, int fq) const {
        bf16* Gp = WSP(bf16, WS_G); const int col = 256 * (u.pn - 6) + 32 * wc + 8 * fq;
        EPI_ROWS_BEGIN f32x4 a = l0, b = l1, cc = h0, d = h1;
#pragma unroll
            for (int j = 0; j < 4; ++j) { a[j] = sigmoidf_(a[j]); b[j] = sigmoidf_(b[j]); cc[j] = sigmoidf_(cc[j]); d[j] = sigmoidf_(d[j]); }
            st8(Gp + (size_t)row * PG + col, a, b); st8(Gp + (size_t)row * PG + col + 128, cc, d); EPI_ROWS_END
    }
};
struct EpiBranch {
    const Ctx& c;
    __device__ __forceinline__ void operator()(const Acc_t& acc, const Unit& u, int wr, int wc, int fr, int fq) const {
        const bf16* Gp = WSP(bf16, WS_G); bf16* MG = WSP(bf16, WS_HN); const int col = 256 * u.pn + 32 * wc + 8 * fq;
        EPI_ROWS_BEGIN
#pragma unroll
            for (int bj = 0; bj < 2; ++bj) { f32x4 ga, gb; ld8(Gp + (size_t)row * PG + u.z * DM + col + 128 * bj, ga, gb); f32x4 va = (bj ? h0 : l0) * ga, vb = (bj ? h1 : l1) * gb;
                bf16* p = MG + (size_t)row * DM + col + 128 * bj; if (u.z > 0) { f32x4 pa, pb; ld8(p, pa, pb); va += pa; vb += pb; } st8(p, va, vb); } EPI_ROWS_END
    }
};
struct EpiOut {
    const float* resid; float* out;
    __device__ __forceinline__ void operator()(const Acc_t& acc, const Unit& u, int wr, int wc, int fr, int fq) const {
        const int col = 256 * u.pn + 32 * wc + 8 * fq;
        EPI_ROWS_BEGIN const size_t off = (size_t)row * DM + col;
            const f32x4 r0 = *(const f32x4*)(resid + off), r1 = *(const f32x4*)(resid + off + 4), r2 = *(const f32x4*)(resid + off + 128), r3 = *(const f32x4*)(resid + off + 132);
            *(f32x4*)(out + off) = r0 + l0; *(f32x4*)(out + off + 4) = r1 + l1; *(f32x4*)(out + off + 128) = r2 + h0; *(f32x4*)(out + off + 132) = r3 + h1; EPI_ROWS_END
    }
};

__device__ __forceinline__ void stats_cumsum(const Ctx& c) {
    const int gw = c.bid * NWAVES + c.wave, NGW = c.G * NWAVES;
    for (int m = gw; m < M; m += NGW) {
        float sq = 0.f, sk = 0.f;
        if (c.lane < 48) { f32x4 a, b; ld8(WSP(bf16, WS_CQ) + (size_t)m * PCQ + 8 * c.lane, a, b); sq = (a[0] * a[0] + a[1] * a[1]) + (a[2] * a[2] + a[3] * a[3]) + (b[0] * b[0] + b[1] * b[1]) + (b[2] * b[2] + b[3] * b[3]); }
        if (c.lane < 32) { f32x4 a, b; ld8(WSP(bf16, WS_CKV) + (size_t)m * PCKV + 8 * c.lane, a, b); sk = (a[0] * a[0] + a[1] * a[1]) + (a[2] * a[2] + a[3] * a[3]) + (b[0] * b[0] + b[1] * b[1]) + (b[2] * b[2] + b[3] * b[3]); }
        sq = wave_sum(sq); sk = wave_sum(sk);
        if (c.lane == 0) { WSP(float, WS_RQ)[m] = 1.f / sqrtf(sq * (1.f / 384.f) + EPS); WSP(float, WS_RKV)[m] = 1.f / sqrtf(sk * (1.f / 256.f) + EPS); }
    }
    LAS double* wsum = (LAS double*)(c.lds);
    for (int task = c.bid; task < NBATCH * 8; task += c.G) {
        const int b = task >> 3, h = task & 7; const float* LF = WSP(float, WS_LF) + (size_t)b * SEQ * 8 + h;
        double v[8]; double s = 0.0;
#pragma unroll
        for (int j = 0; j < 8; ++j) { s += (double)LF[(size_t)(8 * c.tid + j) * 8]; v[j] = s; }
        double inc = s;
#pragma unroll
        for (int o = 1; o < 64; o <<= 1) { const double n = __shfl_up(inc, o); if (c.lane >= o) inc += n; }
        __syncthreads();
        if (c.lane == 63) wsum[c.wave] = inc;
        __syncthreads();
        double base = inc - s;
        for (int w = 0; w < c.wave; ++w) base += wsum[w];
        bf16* KA = WSP(bf16, WS_KA) + (size_t)(FR + b * SEQ) * PKA + h * 80 + 64;
#pragma unroll
        for (int j = 0; j < 8; ++j) { const float bias = (float)(-(base + v[j]) * 1.4426950408889634); bf16 bh, bm, bl; split3(bias, bh, bm, bl);
            u32x4 w0 = {(unsigned)bh | ((unsigned)bm << 16), (unsigned)bl, 0u, 0u}, w1 = {0u, 0u, 0u, 0u}; bf16* kp = KA + (size_t)(8 * c.tid + j) * PKA; *(u32x4*)kp = w0; *(u32x4*)(kp + 8) = w1; }
    }
}
__device__ __forceinline__ void final_norm(const Ctx& c) {
    const int gw = c.bid * NWAVES + c.wave, NGW = c.G * NWAVES;
    for (int m = gw; m < M; m += NGW) {
        f32x4* xr = (f32x4*)(c.out + (size_t)m * DM) + c.lane; f32x4 v[4]; float s = 0.f;
#pragma unroll
        for (int j = 0; j < 4; ++j) { v[j] = xr[64 * j]; s += (v[j][0] * v[j][0] + v[j][1] * v[j][1]) + (v[j][2] * v[j][2] + v[j][3] * v[j][3]); }
        const float rstd = 1.f / sqrtf(wave_sum(s) * (1.f / DM) + EPS);
#pragma unroll
        for (int j = 0; j < 4; ++j) { const f32x4 g = ((const f32x4*)c.final_g + c.lane)[64 * j]; xr[64 * j] = v[j] * rstd * g; }
    }
}

#define XB_TMO      128
#define XB_XCNT(j)  (256  + 64 * (j))
#define XB_XSUB(j)  (1280 + 64 * (j))
#define XB_XGEN(j)  (2304 + 64 * (j))
#define XB_TOP      3328
#define XB_TOPGEN   3392
#define XCD_BAR_WORDS 3456
#define XB_SPIN_CAP (1u << 18)
__device__ __forceinline__ unsigned xb_ld(unsigned* p)              { return __hip_atomic_load(p, __ATOMIC_RELAXED, __HIP_MEMORY_SCOPE_AGENT); }
__device__ __forceinline__ unsigned xb_add(unsigned* p, unsigned v) { return __hip_atomic_fetch_add(p, v, __ATOMIC_RELAXED, __HIP_MEMORY_SCOPE_AGENT); }
__device__ __forceinline__ unsigned xb_xcc_id() { return (unsigned)__builtin_amdgcn_s_getreg((3 << 11) | 20) & 0xFu; }
#define XB_SPIN(cond, bar) do { unsigned _sp = 0; while (cond) { __builtin_amdgcn_s_sleep(1); \
    if ((++_sp & 255u) == 0u) { if (xb_ld(&(bar)[XB_TMO])) break; if (_sp > XB_SPIN_CAP) { atomicAdd(&(bar)[XB_TMO], 1u); break; } } } } while (0)
struct XcdBarrier { unsigned* bar; unsigned x; volatile LAS unsigned* st; };
__device__ __forceinline__ XcdBarrier xcd_barrier_post(unsigned* bar, volatile LAS unsigned* st) {
    XcdBarrier b; b.bar = bar; b.x = xb_xcc_id(); b.st = st;
    if (threadIdx.x == 0) (void)xb_add(&bar[XB_XCNT(b.x)], 1u);
    return b;
}
__device__ __forceinline__ void xcd_barrier_complete(unsigned* bar, unsigned x, unsigned& nloc, unsigned& nx) {
    const unsigned G = gridDim.x * gridDim.y * gridDim.z;
    unsigned sum, cnt, mine, sp = 0u;
    for (;;) {
        sum = 0u; cnt = 0u; mine = 0u;
#pragma unroll
        for (unsigned j = 0; j < 16; ++j) { const unsigned cc = xb_ld(&bar[XB_XCNT(j)]); sum += cc; cnt += (cc > 0u) ? 1u : 0u; mine = (j == x) ? cc : mine; }
        if (sum == G) break;
        __builtin_amdgcn_s_sleep(1);
        if ((++sp & 255u) == 0u) { if (xb_ld(&bar[XB_TMO])) break; if (sp > XB_SPIN_CAP) { atomicAdd(&bar[XB_TMO], 1u); break; } }
    }
    nloc = mine > 0u ? mine : 1u; nx = cnt > 0u ? cnt : 1u;
}
__device__ __forceinline__ void xcd_barrier(const XcdBarrier& b) {
    asm volatile("s_waitcnt vmcnt(0)" ::: "memory");
    __syncthreads();
    if (threadIdx.x == 0) {
        unsigned* bar = b.bar;
        __builtin_amdgcn_s_waitcnt(0);
        unsigned nloc = b.st[0], nx = b.st[1];
        if (nloc == 0u) { xcd_barrier_complete(bar, b.x, nloc, nx); b.st[0] = nloc; b.st[1] = nx; }
        const unsigned old = xb_add(&bar[XB_XSUB(b.x)], 1u);
        const unsigned gen = old / nloc;
        if (old + 1u == (gen + 1u) * nloc) {
            __builtin_amdgcn_fence(__ATOMIC_RELEASE, "agent");
            asm volatile("s_waitcnt vmcnt(0)" ::: "memory");
            const unsigned og = xb_add(&bar[XB_TOP], 1u);
            const unsigned tg = og / nx;
            if (og + 1u == (tg + 1u) * nx) xb_add(&bar[XB_TOPGEN], 1u);
            else XB_SPIN(xb_ld(&bar[XB_TOPGEN]) == tg, bar);
            __builtin_amdgcn_fence(__ATOMIC_ACQUIRE, "agent");
            xb_add(&bar[XB_XGEN(b.x)], 1u);
            asm volatile("s_waitcnt vmcnt(0)" ::: "memory");
        } else {
            XB_SPIN(xb_ld(&bar[XB_XGEN(b.x)]) == gen, bar);
            __builtin_amdgcn_fence(__ATOMIC_ACQUIRE, "agent");
            asm volatile("s_waitcnt vmcnt(0)" ::: "memory");
        }
    }
    __syncthreads();
}

constexpr int LDS_BYTES = 147456, MISC_OFF = 131072 + 320;
constexpr int NSLOTS = 18;
constexpr int CW_BAR = 4096;

struct Args { const float* in[13]; float* out; unsigned char* ws; int ph_lo, ph_hi, pad0, pad1; };
#define CAS __attribute__((address_space(4)))
__device__ __forceinline__ Ctx make_ctx() {
    const CAS char* kp = (const CAS char*)__builtin_amdgcn_kernarg_segment_ptr();
    asm volatile("" : "+s"(kp));
    const CAS Args* a = (const CAS Args*)kp;
    Ctx c;
    c.x = a->in[0]; c.meta = a->in[1]; c.norm_g = a->in[2]; c.w_in = a->in[3]; c.b_f = a->in[4]; c.g_cq = a->in[5]; c.g_ckv = a->in[6];
    c.w_uq = a->in[7]; c.w_ukv = a->in[8]; c.sinks = a->in[9]; c.w_branch = a->in[10]; c.w_out = a->in[11]; c.final_g = a->in[12];
    c.out = a->out; c.ws = a->ws;
    extern __shared__ __attribute__((aligned(16))) unsigned char lds_raw[];
    c.lds = (LAS unsigned char*)lds_raw;
    c.tid = threadIdx.x; c.lane = c.tid & 63; c.wave = __builtin_amdgcn_readfirstlane(c.tid >> 6); c.G = gridDim.x; c.bid = blockIdx.x;
    return c;
}

template <int SLOT>
__device__ __forceinline__ void run_slot() {
    const Ctx c = make_ctx();
    constexpr int slot = SLOT;
    constexpr int layer = (slot >= 9) ? 1 : 0;
    constexpr int ls = (slot >= 9) ? slot - 8 : slot;
        if constexpr (slot == 0) slot0(c);
        else if constexpr (slot == 17) final_norm(c);
        else if constexpr (ls == 1) {
            zero_fronts(c);
            norm_main(c, layer == 0 ? c.x : c.out);
            meta_blocks(c, AfPlain{WSP(bf16, WS_HNM), DM}, wl(c, layer, WL_EARLY), DM, NE / 16, WSP(float, WS_RAWE), NE, 0);
        } else if constexpr (ls == 2) {
            if (c.bid == 0) post_early(c, layer);
            ProbSimple P{WSP(bf16, WS_HN), wl(c, layer, WL_EARLY), DM, DM, 64, NE / 256, 0};
            gemm_naive(c, P, EpiEarly{c, layer});
        } else if constexpr (ls == 3) {
            { const AfPlain af{WSP(bf16, WS_CM), 640}; meta_blocks(c, af, wl(c, layer, WL_UQ), 384, NUQ / 16, WSP(float, WS_RAWU), NUQ + NUKV, 0);
              const AfPlain af2{WSP(bf16, WS_CM) + 384, 640}; meta_blocks(c, af2, wl(c, layer, WL_UKV), 256, NUKV / 16, WSP(float, WS_RAWU), NUQ + NUKV, NUQ); }
            stats_cumsum(c);
        } else if constexpr (ls == 4) {
            if (c.bid == 0) post_up(c);
            { ProbSimple P{WSP(bf16, WS_CQ), wl(c, layer, WL_UQ), PCQ, 384, 64, NUQ / 256, 0}; gemm_naive(c, P, EpiUq{c}); }
            { ProbSimple P{WSP(bf16, WS_CKV), wl(c, layer, WL_UKV), PCKV, 256, 64, NUKV / 256, 0}; gemm_naive(c, P, EpiUkv{c}); }
        } else if constexpr (ls == 5) {
            if (layer == 0) {
#ifndef NO_ATTNM
                if (c.bid == 0) attn_meta(c);
#endif
 meta_blocks(c, AfPlain{WSP(bf16, WS_HNM), DM}, wl(c, 0, WL_LATE), DM, NL / 16, WSP(float, WS_RAWL), NL, 0); }
#ifndef NO_ATTN
            attn_main_naive(c, layer);
#endif
        } else if constexpr (ls == 6) {
#ifndef NO_S67
            if (layer == 0) { for (int n = 0; n < 3; ++n) { const AfBranch af{WSP(bf16, WS_YM), WSP(float, WS_RAWL), n}; meta_blocks(c, af, wl(c, 0, WL_BR) + (size_t)n * DM * 512, 512, DM / 16, WSP(float, WS_RAWB) + (size_t)n * 16 * 1024, 1024, 0); } }
#endif
            { ProbSimple P{WSP(bf16, WS_HN), wl(c, layer, WL_LATE), DM, DM, 64, 6, 0}; gemm_naive(c, P, EpiLateZ{c}); }
            { ProbSimple P{WSP(bf16, WS_HN), wl(c, layer, WL_LATE), DM, DM, 64, 12, 6}; gemm_naive(c, P, EpiLateG{c}); }
        } else if constexpr (ls == 7) {
            if (layer == 0) { const AfMerged af{WSP(float, WS_RAWL), WSP(float, WS_RAWB)}; meta_blocks(c, af, wl(c, 0, WL_OUT), DM, DM / 16, WSP(float, WS_RAWO), DM, 0); }
            for (int z = 0; z < 3; ++z) { ProbBranch P{WSP(bf16, WS_QA), WSP(bf16, WS_YB), WSP(bf16, WS_QC), wl(c, layer, WL_BR), PY, 512, z};
                gemm_naive(c, P, EpiBranch{c}); asm volatile("s_waitcnt vmcnt(0)" ::: "memory"); }
        } else if constexpr (ls == 8) {
            if (layer == 0 && c.bid == 0) post_resid(c);
            ProbSimple P{WSP(bf16, WS_HN), wl(c, layer, WL_OUT), DM, DM, 64, DM / 256, 0};
            gemm_naive(c, P, EpiOut{layer == 0 ? c.x : c.out, c.out});
        }
}

__global__ void __launch_bounds__(NTHREADS, 2) skel_fwd(Args args) {
    const Ctx c = make_ctx();
    volatile LAS unsigned* MISC = (volatile LAS unsigned*)(c.lds + MISC_OFF);
    for (int u = c.tid; u < (LDS_BYTES - 131072) / 4; u += NTHREADS) ((LAS unsigned*)(c.lds + 131072))[u] = 0u;
    __syncthreads();
    XcdBarrier bar; bar.bar = (unsigned*)(c.ws + WS_CTL) + CW_BAR; bar.x = 0; bar.st = nullptr;
    const int lo = args.ph_lo, hi = args.ph_hi;
    if (hi - lo > 1) bar = xcd_barrier_post((unsigned*)(c.ws + WS_CTL) + CW_BAR, MISC + 8);

#ifndef SLOT_ON
#define SLOT_ON(k) true
#endif
#define RUN_SLOT(k) if (SLOT_ON(k) && lo <= (k) && (k) < hi) { run_slot<k>(); if ((k) + 1 < hi) xcd_barrier(bar); }
    RUN_SLOT(0) RUN_SLOT(1) RUN_SLOT(2) RUN_SLOT(3) RUN_SLOT(4) RUN_SLOT(5) RUN_SLOT(6) RUN_SLOT(7) RUN_SLOT(8)
    RUN_SLOT(9) RUN_SLOT(10) RUN_SLOT(11) RUN_SLOT(12) RUN_SLOT(13) RUN_SLOT(14) RUN_SLOT(15) RUN_SLOT(16) RUN_SLOT(17)
#undef RUN_SLOT
}

extern "C" void kernel_launch(void* const* d_in, const int* in_sizes, int n_in, void* d_out, int out_size, void* d_ws, size_t ws_size, hipStream_t stream) {
    static int grid = 0;
    if (grid == 0) {
        if (n_in != 13 || out_size != M * DM || ws_size < WS_END) { fprintf(stderr, "kernel_launch: unexpected shapes (n_in %d out %d ws %zu need %zu)\n", n_in, out_size, ws_size, (size_t)WS_END); grid = -1; return; }
        int dev = 0, cus = 0, per_cu = 0;
        if (hipGetDevice(&dev) != hipSuccess || hipDeviceGetAttribute(&cus, hipDeviceAttributeMultiprocessorCount, dev) != hipSuccess) { grid = -1; return; }
        if (hipFuncSetAttribute((const void*)skel_fwd, hipFuncAttributeMaxDynamicSharedMemorySize, LDS_BYTES) != hipSuccess) { fprintf(stderr, "kernel_launch: hipFuncSetAttribute failed\n"); grid = -1; return; }
        if (hipOccupancyMaxActiveBlocksPerMultiprocessor(&per_cu, (const void*)skel_fwd, NTHREADS, LDS_BYTES) != hipSuccess || per_cu < 1) fprintf(stderr, "kernel_launch: occupancy query says %d\n", per_cu);
        (void)hipGetLastError();
        grid = cus;
    }
    if (grid < 0) return;
    (void)hipMemsetAsync((char*)d_ws + WS_CTL, 0, CTL_BYTES, stream);
    Args a{};
    for (int i = 0; i < 13; ++i) a.in[i] = (const float*)d_in[i];
    a.out = (float*)d_out; a.ws = (unsigned char*)d_ws;
#if MK_SINGLE
    a.ph_lo = 0; a.ph_hi = NSLOTS;
    hipLaunchKernelGGL(skel_fwd, dim3(grid), dim3(NTHREADS), LDS_BYTES, stream, a);
#else
    for (int s = 0; s < NSLOTS; ++s) { a.ph_lo = s; a.ph_hi = s + 1; hipLaunchKernelGGL(skel_fwd, dim3(grid), dim3(NTHREADS), LDS_BYTES, stream, a); }
#endif
}
```

```cpp
#include <hip/hip_runtime.h>
#include <cstdio>
#include <cstdint>

#ifndef MK_SINGLE
#define MK_SINGLE 1
#endif

#define GAS __attribute__((address_space(1)))
#define LAS __attribute__((address_space(3)))
typedef unsigned short bf16;
typedef short bf16x8 __attribute__((ext_vector_type(8)));
typedef float f32x4 __attribute__((ext_vector_type(4)));
typedef unsigned u32x4 __attribute__((ext_vector_type(4)));
typedef unsigned u32x2 __attribute__((ext_vector_type(2)));
typedef float f32x2_t __attribute__((ext_vector_type(2)));
typedef __bf16 bf16x2_t __attribute__((ext_vector_type(2)));
typedef GAS unsigned gu32;
#define RLX_AGENT __ATOMIC_RELAXED, __HIP_MEMORY_SCOPE_AGENT

constexpr int DM = 1024, NBATCH = 4, SEQ = 4096, M = NBATCH * SEQ, NMETA = 16, FR = 64, MOFF = 48, NPOS = SEQ + NMETA;
constexpr int NIN = 7592, NWAVES = 8, NTHREADS = NWAVES * 64;
constexpr float EPS = 1e-6f, LOG2E = 1.4426950408889634f, LN2 = 0.6931471805599453f;
constexpr float C2A = 0.125f * LOG2E, C2B = 0.10206207261596575f * LOG2E, C2C = 0.125f * LOG2E;
constexpr int LC_AQ = 0, LC_AK = 512, LC_AV = 1024, LC_AF = 1536, LC_AZ = 1544, LC_BCQ = 2056, LC_BCKV = 2440, LC_BKR = 2696, LC_BZ = 2728,
              LC_CQ = 3240, LC_CK = 3752, LC_CV = 3880, LC_CZ = 4008, LC_G = 4520;
constexpr int NE = 3072, NL = 4608, NUQ = 768, NUKV = 1024;
constexpr int PQA = 512, PKA = 640, PVA = 512, PQB = 768, PKB = 768, PVB = 512, PQC = 512, PKC = 128, PVC = 128, PCQ = 384, PCKV = 256, PY = 512, PG = 3072;

constexpr size_t MiB = 1u << 20;
constexpr size_t al(size_t x) { return (x + 255) & ~(size_t)255; }
constexpr size_t WS_CTL = 0, CTL_BYTES = 1 * MiB;
constexpr size_t WS_COS64 = CTL_BYTES, WS_SIN64 = WS_COS64 + al((size_t)NPOS * 32 * 4), WS_COS32 = WS_SIN64 + al((size_t)NPOS * 32 * 4), WS_SIN32 = WS_COS32 + al((size_t)NPOS * 16 * 4);
constexpr size_t WS_LF = WS_SIN32 + al((size_t)NPOS * 16 * 4), WS_RQ = WS_LF + al((size_t)M * 8 * 4), WS_RKV = WS_RQ + al((size_t)M * 4);
constexpr size_t WS_HM = WS_RKV + al((size_t)M * 4);
constexpr size_t WS_HNM = WS_HM + al(16 * 1024 * 4);
constexpr size_t WS_RAWE = WS_HNM + al(16 * 1024 * 2);
constexpr size_t WS_RAWU = WS_RAWE + al(16 * NE * 4);
constexpr size_t WS_RAWL = WS_RAWU + al(16 * (NUQ + NUKV) * 4);
constexpr size_t WS_RAWB = WS_RAWL + al(16 * NL * 4);
constexpr size_t WS_RAWO = WS_RAWB + al(3 * 16 * 1024 * 4);
constexpr size_t WS_YM = WS_RAWO + al(16 * 1024 * 4);
constexpr size_t WS_CM = WS_YM + al(16 * 1536 * 2);
constexpr size_t WS_RQM = WS_CM + al(16 * 640 * 2);
constexpr size_t WS_LFM = WS_RQM + al(32 * 4);
constexpr size_t WS_QAM = WS_LFM + al(16 * 8 * 4);
constexpr size_t WS_QBM = WS_QAM + al(16 * 512 * 2);
constexpr size_t WS_QCM = WS_QBM + al(16 * 768 * 2);
constexpr size_t WS_SMALL_END = WS_QCM + al(16 * 512 * 2);
constexpr size_t WL_EARLY = 0, WL_LATE = WL_EARLY + (size_t)NE * DM * 2, WL_UQ = WL_LATE + (size_t)NL * DM * 2, WL_UKV = WL_UQ + (size_t)NUQ * 384 * 2,
                 WL_BR = WL_UKV + (size_t)NUKV * 256 * 2, WL_OUT = WL_BR + (size_t)3 * DM * 512 * 2, WL_BYTES = WL_OUT + (size_t)DM * DM * 2;
constexpr size_t WS_W = 6 * MiB;
static_assert(WS_SMALL_END <= WS_W, "small region");
constexpr size_t WS_HN = WS_W + al(2 * WL_BYTES);
constexpr size_t WS_QA = WS_HN + (size_t)M * DM * 2;
constexpr size_t WS_QC = WS_QA + (size_t)M * PQA * 2;
constexpr size_t WS_CQ = WS_QC + (size_t)M * PQC * 2;
constexpr size_t WS_CKV = WS_CQ + (size_t)M * PCQ * 2;
constexpr size_t WS_YB = WS_CQ;
constexpr size_t WS_QB = WS_CKV + (size_t)M * PCKV * 2;
constexpr size_t WS_KB = WS_QB + (size_t)M * PQB * 2;
constexpr size_t WS_VB = WS_KB + (size_t)(FR + M) * PKB * 2;
constexpr size_t WS_KA = WS_VB + (size_t)(FR + M) * PVB * 2;
constexpr size_t WS_VA = WS_KA + (size_t)(FR + M) * PKA * 2;
constexpr size_t WS_KC = WS_VA + (size_t)(FR + M) * PVA * 2;
constexpr size_t WS_VC = WS_KC + (size_t)(FR + M) * PKC * 2;
constexpr size_t WS_END = WS_VC + (size_t)(FR + M) * PVC * 2;
constexpr size_t WS_G = WS_QB;
static_assert(WS_G + (size_t)M * PG * 2 <= WS_KC, "G overlay");
static_assert((size_t)M * PY * 2 <= (size_t)M * (PCQ + PCKV) * 2, "YB overlay");
static_assert(WS_END <= 256 * MiB, "workspace");

__device__ __forceinline__ unsigned cvtpk(float lo, float hi) { f32x2_t v = {lo, hi}; bf16x2_t b = __builtin_convertvector(v, bf16x2_t); return __builtin_bit_cast(unsigned, b); }
__device__ __forceinline__ bf16 f2bf(float f) { return (bf16)(cvtpk(f, 0.f) & 0xffffu); }
__device__ __forceinline__ float bf2f(bf16 v) { return __uint_as_float((unsigned)v << 16); }
__device__ __forceinline__ float bflo(unsigned w) { return __uint_as_float(w << 16); }
__device__ __forceinline__ float bfhi(unsigned w) { return __uint_as_float(w & 0xffff0000u); }
__device__ __forceinline__ float fexp2(float x) { return __builtin_amdgcn_exp2f(x); }
__device__ __forceinline__ float frcp(float x) { return __builtin_amdgcn_rcpf(x); }
__device__ __forceinline__ float sigmoidf_(float x) { return frcp(1.f + fexp2(-x * LOG2E)); }
__device__ __forceinline__ float siluf_(float x) { return x * sigmoidf_(x); }
__device__ __forceinline__ float logsigf_(float x) { return fminf(x, 0.f) - __builtin_amdgcn_logf(1.f + fexp2(-fabsf(x) * LOG2E)) * LN2; }
__device__ __forceinline__ float wave_sum(float v) {
#pragma unroll
    for (int o = 1; o < 64; o <<= 1) v += __shfl_xor(v, o);
    return v;
}
__device__ __forceinline__ u32x4 pack8(f32x4 a, f32x4 b) { u32x4 w; w.x = cvtpk(a[0], a[1]); w.y = cvtpk(a[2], a[3]); w.z = cvtpk(b[0], b[1]); w.w = cvtpk(b[2], b[3]); return w; }
__device__ __forceinline__ void st8(bf16* p, f32x4 a, f32x4 b) { *(u32x4*)p = pack8(a, b); }
__device__ __forceinline__ void ld8(const bf16* p, f32x4& a, f32x4& b) { const u32x4 w = *(const u32x4*)p; a = (f32x4){bflo(w.x), bfhi(w.x), bflo(w.y), bfhi(w.y)}; b = (f32x4){bflo(w.z), bfhi(w.z), bflo(w.w), bfhi(w.w)}; }
__device__ __forceinline__ void split3(float b, bf16& h, bf16& m, bf16& l) { h = f2bf(b); const float r1 = b - bf2f(h); m = f2bf(r1); const float r2 = r1 - bf2f(m); l = f2bf(r2); }

enum { MAP_EARLY = 0, MAP_LATE = 1, MAP_UQ = 2, MAP_ID = 3 };
__device__ __forceinline__ int map_col(int kind, int p) {
    const int t = p >> 8, c = p & 255, half = c >> 7, c7 = c & 127;
    if (kind == MAP_EARLY) {
        if (t < 2) return LC_AQ + p;
        if (t < 4) return LC_AK + (p - 512);
        if (t < 6) return LC_AV + (p - 1024);
        if (t < 8) return LC_CQ + 256 * (t - 6) + 64 * (c7 >> 5) + 32 * half + (c7 & 31);
        if (t == 8) { if (c7 < 64) return LC_CK + 64 * (c7 >> 5) + 32 * half + (c7 & 31); return LC_CV + 64 * half + (c7 - 64); }
        if (t == 9) return LC_BCQ + c;
        if (t == 10) { if (c7 < 64) return LC_BCQ + 256 + 64 * half + c7; if (c7 < 80) return LC_BKR + 16 * half + (c7 - 64); if (c7 < 88 && half == 0) return LC_AF + (c7 - 80); return -1; }
        return LC_BCKV + c;
    }
    if (kind == MAP_LATE) {
        if (t < 2) return LC_AZ + p;
        if (t < 4) return LC_BZ + (p - 512);
        if (t < 6) return LC_CZ + (p - 1024);
        return LC_G + (p - 1536);
    }
    if (kind == MAP_UQ) {
        if (t < 2) return (4 * t + (c >> 6)) * 96 + (c & 63);
        return (c7 >> 4) * 96 + 64 + 16 * half + (c7 & 15);
    }
    return p;
}

struct Ctx {
    const float *x, *meta, *norm_g, *w_in, *b_f, *g_cq, *g_ckv, *w_uq, *w_ukv, *sinks, *w_branch, *w_out, *final_g;
    float* out; unsigned char* ws;
    LAS unsigned char* lds;
    int tid, lane, wave, G, bid;
};
#define WSP(T, off) ((T*)(c.ws + (off)))
__device__ __forceinline__ bf16* wl(const Ctx& c, int layer, size_t off) { return (bf16*)(c.ws + WS_W + (size_t)layer * WL_BYTES + off); }

__device__ __forceinline__ void conv_item(const float* W, int N, const float* gv, bf16* Bt, int K, int kind, int nblk, int item, LAS float* scr, int lane) {
    const int kb = item / nblk, nb = item % nblk, k0 = 64 * kb, n0 = 32 * nb;
    const int lc = map_col(kind, n0 + (lane & 31));
#pragma unroll 8
    for (int i = 0; i < 32; ++i) { const int kk = 2 * i + (lane >> 5); float v = 0.f; if (lc >= 0) { v = W[(size_t)(k0 + kk) * N + lc]; if (gv) v *= gv[k0 + kk]; } scr[kk * 33 + (lane & 31)] = v; }
    asm volatile("s_waitcnt lgkmcnt(0)" ::: "memory");
    const int ch = lane & 7;
#pragma unroll
    for (int j = 0; j < 4; ++j) { const int n = (lane >> 3) + 8 * j; const LAS float* s = scr + (8 * ch) * 33 + n;
        u32x4 o; o.x = cvtpk(s[0 * 33], s[1 * 33]); o.y = cvtpk(s[2 * 33], s[3 * 33]); o.z = cvtpk(s[4 * 33], s[5 * 33]); o.w = cvtpk(s[6 * 33], s[7 * 33]);
        *(u32x4*)(Bt + (size_t)(n0 + n) * K + k0 + 8 * ch) = o; }
    asm volatile("s_waitcnt lgkmcnt(0)" ::: "memory");
}
__device__ __forceinline__ void zero_fronts(const Ctx& c) {
    const int g = c.bid * NTHREADS + c.tid, NG = c.G * NTHREADS;
    const u32x4 z = {0u, 0u, 0u, 0u};
    for (int e = g; e < MOFF * PKB / 8; e += NG) WSP(u32x4, WS_KB)[e] = z;
    for (int e = g; e < MOFF * PVB / 8; e += NG) WSP(u32x4, WS_VB)[e] = z;
    for (int e = g; e < MOFF * PKA / 8; e += NG) WSP(u32x4, WS_KA)[e] = z;
    for (int e = g; e < MOFF * PVA / 8; e += NG) WSP(u32x4, WS_VA)[e] = z;
    for (int e = g; e < MOFF * PKC / 8; e += NG) WSP(u32x4, WS_KC)[e] = z;
    for (int e = g; e < MOFF * PVC / 8; e += NG) WSP(u32x4, WS_VC)[e] = z;
}
__device__ __forceinline__ void sincos_d(float ang, float& s, float& co) {
    const double x = (double)ang, TWO_PI = 6.283185307179586476925, INV = 0.15915494309189533577;
    const double n = __builtin_rint(x * INV), r = __builtin_fma(-n, TWO_PI, x), y = 0.5 * r, y2 = y * y;
    double sp, cp;
    double ts = 1.0, tc = 1.0; sp = 1.0; cp = 1.0;
#pragma unroll
    for (int j = 1; j <= 12; ++j) { tc = -tc * y2 / (double)((2 * j - 1) * (2 * j)); ts = -ts * y2 / (double)((2 * j) * (2 * j + 1)); cp += tc; sp += ts; }
    const double sy = y * sp, cy = cp;
    s = (float)(2.0 * sy * cy); co = (float)(1.0 - 2.0 * sy * sy);
}
__device__ __forceinline__ void rope_tables(const Ctx& c) {
    const int g = c.bid * NTHREADS + c.tid, NG = c.G * NTHREADS;
    for (int e = g; e < NPOS * 48; e += NG) {
        const int pos = e / 48, i = e % 48;
        float inv; if (i < 32) inv = fexp2(-(float)i * (13.287712379549449f / 32.f)); else inv = fexp2(-(float)(i - 32) * (13.287712379549449f / 16.f));
        const float ang = (float)pos * inv; float s, co; sincos_d(ang, s, co);
        if (i < 32) { WSP(float, WS_COS64)[pos * 32 + i] = co; WSP(float, WS_SIN64)[pos * 32 + i] = s; }
        else { WSP(float, WS_COS32)[pos * 16 + i - 32] = co; WSP(float, WS_SIN32)[pos * 16 + i - 32] = s; }
    }
}
__device__ __forceinline__ void rms_row_to_bf16(const float* xrow, bf16* orow, float* copy, int lane) {
    const f32x4* xr = (const f32x4*)xrow + lane;
    f32x4 v[4]; float s = 0.f;
#pragma unroll
    for (int j = 0; j < 4; ++j) { v[j] = xr[64 * j]; s += (v[j][0] * v[j][0] + v[j][1] * v[j][1]) + (v[j][2] * v[j][2] + v[j][3] * v[j][3]); }
    const float rstd = 1.f / sqrtf(wave_sum(s) * (1.f / DM) + EPS);
    u32x2* o8 = (u32x2*)orow + lane;
#pragma unroll
    for (int j = 0; j < 4; ++j) { u32x2 w; w.x = cvtpk(v[j][0] * rstd, v[j][1] * rstd); w.y = cvtpk(v[j][2] * rstd, v[j][3] * rstd); o8[64 * j] = w; if (copy) ((f32x4*)copy + lane)[64 * j] = v[j]; }
}
__device__ __forceinline__ void slot0(const Ctx& c) {
    LAS float* scr = (LAS float*)(c.lds + c.wave * 16384);
    const int gw = c.bid * NWAVES + c.wave, NGW = c.G * NWAVES;
    for (int layer = 0; layer < 2; ++layer) {
        const float* w_in = c.w_in + (size_t)layer * DM * NIN;
        const int I_E = 16 * (NE / 32), I_L = 16 * (NL / 32), I_UQ = 6 * (NUQ / 32), I_UKV = 4 * (NUKV / 32), I_BR = 8 * (DM / 32), I_O = 16 * (DM / 32);
        const int tot = I_E + I_L + I_UQ + I_UKV + 3 * I_BR + I_O;
        for (int it = gw; it < tot; it += NGW) {
            int r = it;
            if (r < I_E) { conv_item(w_in, NIN, c.norm_g + layer * DM, wl(c, layer, WL_EARLY), DM, MAP_EARLY, NE / 32, r, scr, c.lane); continue; } r -= I_E;
            if (r < I_L) { conv_item(w_in, NIN, c.norm_g + layer * DM, wl(c, layer, WL_LATE), DM, MAP_LATE, NL / 32, r, scr, c.lane); continue; } r -= I_L;
            if (r < I_UQ) { conv_item(c.w_uq + (size_t)layer * 384 * 768, 768, c.g_cq + layer * 384, wl(c, layer, WL_UQ), 384, MAP_UQ, NUQ / 32, r, scr, c.lane); continue; } r -= I_UQ;
            if (r < I_UKV) { conv_item(c.w_ukv + (size_t)layer * 256 * 1024, 1024, c.g_ckv + layer * 256, wl(c, layer, WL_UKV), 256, MAP_ID, NUKV / 32, r, scr, c.lane); continue; } r -= I_UKV;
            if (r < 3 * I_BR) { const int n = r / I_BR; conv_item(c.w_branch + ((size_t)layer * 3 + n) * 512 * DM, DM, nullptr, wl(c, layer, WL_BR) + (size_t)n * DM * 512, 512, MAP_ID, DM / 32, r % I_BR, scr, c.lane); continue; } r -= 3 * I_BR;
            conv_item(c.w_out + (size_t)layer * DM * DM, DM, nullptr, wl(c, layer, WL_OUT), DM, MAP_ID, DM / 32, r, scr, c.lane);
        }
    }
    rope_tables(c);
    if (gw < 16) rms_row_to_bf16(c.meta + (size_t)gw * DM, WSP(bf16, WS_HNM) + (size_t)gw * DM, WSP(float, WS_HM) + (size_t)gw * DM, c.lane);
}

__device__ __forceinline__ void norm_main(const Ctx& c, const float* src) {
    const int gw = c.bid * NWAVES + c.wave, NGW = c.G * NWAVES;
    for (int m = gw; m < M; m += NGW) rms_row_to_bf16(src + (size_t)m * DM, WSP(bf16, WS_HN) + (size_t)m * DM, nullptr, c.lane);
}

template <class AF>
__device__ __forceinline__ void meta_block(const AF& af, const bf16* Bt, int K, int col0, float* raw, int ldraw, int rcol0, int lane) {
    f32x4 acc = {0.f, 0.f, 0.f, 0.f};
    const int r = lane & 15, kq = 8 * (lane >> 4);
    for (int k0 = 0; k0 < K; k0 += 32) {
        const bf16x8 a = af(r, k0 + kq);
        const bf16x8 b = *(const bf16x8*)(Bt + (size_t)(col0 + r) * K + k0 + kq);
        acc = __builtin_amdgcn_mfma_f32_16x16x32_bf16(a, b, acc, 0, 0, 0);
    }
#pragma unroll
    for (int x = 0; x < 4; ++x) raw[(size_t)(4 * (lane >> 4) + x) * ldraw + rcol0 + r] = acc[x];
}
struct AfPlain { const bf16* A; int lda; __device__ __forceinline__ bf16x8 operator()(int r, int k) const { return *(const bf16x8*)(A + (size_t)r * lda + k); } };
struct AfBranch {
    const bf16* ym; const float* rawl; int n;
    __device__ __forceinline__ bf16x8 operator()(int r, int k) const {
        f32x4 y0, y1; ld8(ym + (size_t)r * 1536 + n * 512 + k, y0, y1);
        const f32x4 z0 = *(const f32x4*)(rawl + (size_t)r * NL + 512 * n + k), z1 = *(const f32x4*)(rawl + (size_t)r * NL + 512 * n + k + 4);
#pragma unroll
        for (int j = 0; j < 4; ++j) { y0[j] *= siluf_(z0[j]); y1[j] *= siluf_(z1[j]); }
        return __builtin_bit_cast(bf16x8, pack8(y0, y1));
    }
};
struct AfMerged {
    const float* rawl; const float* rawb;
    __device__ __forceinline__ bf16x8 operator()(int r, int k) const {
        f32x4 s0 = {0.f, 0.f, 0.f, 0.f}, s1 = s0;
#pragma unroll
        for (int n = 0; n < 3; ++n) {
            const float* g = rawl + (size_t)r * NL + 1536 + n * 1024 + k; const float* p = rawb + ((size_t)n * 16 + r) * 1024 + k;
#pragma unroll
            for (int j = 0; j < 4; ++j) { s0[j] += sigmoidf_(g[j]) * p[j]; s1[j] += sigmoidf_(g[4 + j]) * p[4 + j]; }
        }
        return __builtin_bit_cast(bf16x8, pack8(s0, s1));
    }
};
template <class AF>
__device__ __forceinline__ void meta_blocks(const Ctx& c, const AF& af, const bf16* Bt, int K, int nblocks, float* raw, int ldraw, int rcol0) {
    const int gw = c.bid * NWAVES + c.wave, NGW = c.G * NWAVES;
    for (int b = gw; b < nblocks; b += NGW) meta_block(af, Bt, K, 16 * b, raw, ldraw, rcol0 + 16 * b, c.lane);
}

__device__ __forceinline__ void post_early(const Ctx& c, int layer) {
    const float* raw = WSP(float, WS_RAWE);
    bf16 *QAm = WSP(bf16, WS_QAM), *QCm = WSP(bf16, WS_QCM), *cm = WSP(bf16, WS_CM);
    bf16 *KAf = WSP(bf16, WS_KA), *VAf = WSP(bf16, WS_VA), *KBf = WSP(bf16, WS_KB), *KCf = WSP(bf16, WS_KC), *VCf = WSP(bf16, WS_VC);
    float* LFm = WSP(float, WS_LFM);
    const float *cos64 = WSP(float, WS_COS64), *sin64 = WSP(float, WS_SIN64), *cos32 = WSP(float, WS_COS32), *sin32 = WSP(float, WS_SIN32);
    for (int e = c.tid; e < 16 * NE; e += NTHREADS) {
        const int r = e / NE, p = e % NE, t = p >> 8, cc = p & 255, half = cc >> 7, c7 = cc & 127; const float v = raw[e];
        if (t < 2) QAm[r * PQA + p] = f2bf(v * C2A);
        else if (t < 4) { const int L = p - 512; KAf[(size_t)(MOFF + r) * PKA + (L >> 6) * 80 + (L & 63)] = f2bf(v); }
        else if (t < 6) VAf[(size_t)(MOFF + r) * PVA + (p - 1024)] = f2bf(v);
        else if (t < 8) { if (half == 0) { const int hh = c7 >> 5, d = c7 & 31, head = 4 * (t - 6) + hh; const float x1 = v, x2 = raw[e + 128], cs = cos64[r * 32 + d], sn = sin64[r * 32 + d];
                QCm[r * PQC + head * 64 + d] = f2bf((x1 * cs - x2 * sn) * C2C); QCm[r * PQC + head * 64 + 32 + d] = f2bf((x2 * cs + x1 * sn) * C2C); } }
        else if (t == 8) { if (c7 < 64) { if (half == 0) { const int hh = c7 >> 5, d = c7 & 31; const float x1 = v, x2 = raw[e + 128], cs = cos64[r * 32 + d], sn = sin64[r * 32 + d];
                    KCf[(size_t)(MOFF + r) * PKC + hh * 64 + d] = f2bf(x1 * cs - x2 * sn); KCf[(size_t)(MOFF + r) * PKC + hh * 64 + 32 + d] = f2bf(x2 * cs + x1 * sn); } }
            else VCf[(size_t)(MOFF + r) * PVC + 64 * half + (c7 - 64)] = f2bf(v); }
        else if (t == 9) cm[r * 640 + cc] = f2bf(v);
        else if (t == 10) { if (c7 < 64) cm[r * 640 + 256 + 64 * half + c7] = f2bf(v);
            else if (c7 < 80) { if (half == 0) { const int d = c7 - 64; const float x1 = v, x2 = raw[e + 128], cs = cos32[r * 16 + d], sn = sin32[r * 16 + d]; const bf16 o1 = f2bf(x1 * cs - x2 * sn), o2 = f2bf(x2 * cs + x1 * sn);
                    for (int h = 0; h < 8; ++h) { KBf[(size_t)(MOFF + r) * PKB + h * 96 + 64 + d] = o1; KBf[(size_t)(MOFF + r) * PKB + h * 96 + 80 + d] = o2; } } }
            else if (c7 < 88 && half == 0) LFm[r * 8 + (c7 - 80)] = logsigf_(v + c.b_f[layer * 8 + (c7 - 80)]); }
        else cm[r * 640 + 384 + cc] = f2bf(v);
    }
    __syncthreads();
    float* rqm = WSP(float, WS_RQM);
    if (c.tid < 16) { float s = 0.f; for (int k = 0; k < 384; ++k) { const float v = bf2f(cm[c.tid * 640 + k]); s += v * v; } rqm[c.tid] = 1.f / sqrtf(s * (1.f / 384.f) + EPS); }
    else if (c.tid < 32) { const int r = c.tid - 16; float s = 0.f; for (int k = 0; k < 256; ++k) { const float v = bf2f(cm[r * 640 + 384 + k]); s += v * v; } rqm[16 + r] = 1.f / sqrtf(s * (1.f / 256.f) + EPS); }
    else if (c.tid < 40) { const int h = c.tid - 32; float suf = 0.f;
        for (int r = 15; r >= 0; --r) { bf16 bh, bm, bl; split3(suf * LOG2E, bh, bm, bl); bf16* kp = KAf + (size_t)(MOFF + r) * PKA + h * 80 + 64; kp[0] = bh; kp[1] = bm; kp[2] = bl; for (int j = 3; j < 16; ++j) kp[j] = 0; suf += LFm[r * 8 + h]; } }
}
__device__ __forceinline__ void post_up(const Ctx& c) {
    const float* raw = WSP(float, WS_RAWU); const float* rqm = WSP(float, WS_RQM);
    bf16 *QBm = WSP(bf16, WS_QBM), *KBf = WSP(bf16, WS_KB), *VBf = WSP(bf16, WS_VB);
    const float *cos32 = WSP(float, WS_COS32), *sin32 = WSP(float, WS_SIN32);
    for (int e = c.tid; e < 16 * (NUQ + NUKV); e += NTHREADS) {
        const int r = e / (NUQ + NUKV), p = e % (NUQ + NUKV); const float v = raw[e];
        if (p < 512) { const int h = p >> 6, d = p & 63; QBm[r * PQB + h * 96 + d] = f2bf(v * rqm[r] * C2B); }
        else if (p < 768) { const int cc = p - 512, half = cc >> 7, c7 = cc & 127; if (half == 0) { const int h = c7 >> 4, d = c7 & 15; const float sc = rqm[r] * C2B, x1 = v * sc, x2 = raw[e + 128] * sc, cs = cos32[r * 16 + d], sn = sin32[r * 16 + d];
                QBm[r * PQB + h * 96 + 64 + d] = f2bf(x1 * cs - x2 * sn); QBm[r * PQB + h * 96 + 80 + d] = f2bf(x2 * cs + x1 * sn); } }
        else { const int q = p - 768, h = q >> 7, d = q & 127; const float w = v * rqm[16 + r];
            if (d < 64) KBf[(size_t)(MOFF + r) * PKB + h * 96 + d] = f2bf(w); else VBf[(size_t)(MOFF + r) * PVB + h * 64 + (d - 64)] = f2bf(w); }
    }
}
__device__ __forceinline__ void post_resid(const Ctx& c) {
    for (int r = c.wave; r < 16; r += NWAVES) {
        float* hm = WSP(float, WS_HM) + (size_t)r * DM; const float* ro = WSP(float, WS_RAWO) + (size_t)r * DM;
        f32x4 v[4]; float s = 0.f;
#pragma unroll
        for (int j = 0; j < 4; ++j) { v[j] = ((const f32x4*)hm + c.lane)[64 * j] + ((const f32x4*)ro + c.lane)[64 * j]; s += (v[j][0] * v[j][0] + v[j][1] * v[j][1]) + (v[j][2] * v[j][2] + v[j][3] * v[j][3]); }
        const float rstd = 1.f / sqrtf(wave_sum(s) * (1.f / DM) + EPS);
        u32x2* o8 = (u32x2*)(WSP(bf16, WS_HNM) + (size_t)r * DM) + c.lane;
#pragma unroll
        for (int j = 0; j < 4; ++j) { u32x2 w; w.x = cvtpk(v[j][0] * rstd, v[j][1] * rstd); w.y = cvtpk(v[j][2] * rstd, v[j][3] * rstd); o8[64 * j] = w; ((f32x4*)hm + c.lane)[64 * j] = v[j]; }
    }
}

template <int DK, int MODE>
__device__ __forceinline__ void attn_row(const bf16* qrow, const bf16* Kf, const bf16* Km, int kpitch, int koff, const bf16* Vf, const bf16* Vm, int vpitch, int voff, int t, float sink2, bf16* orow) {
    float q[DK];
#pragma unroll
    for (int d = 0; d < DK; d += 8) { f32x4 a, b; ld8(qrow + d, a, b);
#pragma unroll
        for (int j = 0; j < 4; ++j) { q[d + j] = a[j]; q[d + 4 + j] = b[j]; } }
    float o[64];
#pragma unroll
    for (int d = 0; d < 64; ++d) o[d] = 0.f;
    float m = -1e30f, l = 0.f; if (MODE == 2) { m = sink2; l = 1.f; }
    const int s0 = (MODE == 2) ? (t - 127 > 0 ? t - 127 : 0) : 0;
    for (int s = s0; s <= t; ++s) {
        const bf16* kp = (s < NMETA) ? Kf + (size_t)(MOFF + s) * kpitch + koff : Km + (size_t)(s - NMETA) * kpitch + koff;
        const bf16* vp = (s < NMETA) ? Vf + (size_t)(MOFF + s) * vpitch + voff : Vm + (size_t)(s - NMETA) * vpitch + voff;
        float x = 0.f;
#pragma unroll
        for (int d = 0; d < DK; d += 8) { f32x4 a, b; ld8(kp + d, a, b);
#pragma unroll
            for (int j = 0; j < 4; ++j) { x += q[d + j] * a[j]; x += q[d + 4 + j] * b[j]; } }
        if (MODE == 0) x += bf2f(kp[64]) + bf2f(kp[65]) + bf2f(kp[66]);
        if (x > m) { const float f = fexp2(m - x); l *= f;
#pragma unroll
            for (int d = 0; d < 64; ++d) o[d] *= f;
            m = x; }
        const float p = fexp2(x - m); l += p;
#pragma unroll
        for (int d = 0; d < 64; d += 8) { f32x4 a, b; ld8(vp + d, a, b);
#pragma unroll
            for (int j = 0; j < 4; ++j) { o[d + j] += p * a[j]; o[d + 4 + j] += p * b[j]; } }
    }
    const float il = 1.f / l;
#pragma unroll
    for (int d = 0; d < 64; d += 8) { f32x4 a = {o[d] * il, o[d + 1] * il, o[d + 2] * il, o[d + 3] * il}, b = {o[d + 4] * il, o[d + 5] * il, o[d + 6] * il, o[d + 7] * il}; st8(orow + d, a, b); }
}
__device__ __forceinline__ void attn_main_naive(const Ctx& c, int layer) {
    const int g = c.bid * NTHREADS + c.tid, NG = c.G * NTHREADS;
    for (int e = g; e < M * 8; e += NG) {
        const int i = e % SEQ, bh = e / SEQ, b = bh >> 3, h = bh & 7; const size_t row = (size_t)b * SEQ + i; const int t = NMETA + i;
        attn_row<64, 0>(WSP(bf16, WS_QA) + row * PQA + h * 64, WSP(bf16, WS_KA), WSP(bf16, WS_KA) + (size_t)(FR + b * SEQ) * PKA, PKA, h * 80,
                        WSP(bf16, WS_VA), WSP(bf16, WS_VA) + (size_t)(FR + b * SEQ) * PVA, PVA, h * 64, t, 0.f, WSP(bf16, WS_QA) + row * PQA + h * 64);
    }
    for (int e = g; e < M * 8; e += NG) {
        const int i = e % SEQ, bh = e / SEQ, b = bh >> 3, h = bh & 7; const size_t row = (size_t)b * SEQ + i; const int t = NMETA + i;
        attn_row<96, 1>(WSP(bf16, WS_QB) + row * PQB + h * 96, WSP(bf16, WS_KB), WSP(bf16, WS_KB) + (size_t)(FR + b * SEQ) * PKB, PKB, h * 96,
                        WSP(bf16, WS_VB), WSP(bf16, WS_VB) + (size_t)(FR + b * SEQ) * PVB, PVB, h * 64, t, 0.f, WSP(bf16, WS_YB) + row * PY + h * 64);
    }
    for (int e = g; e < M * 8; e += NG) {
        const int i = e % SEQ, bh = e / SEQ, b = bh >> 3, h = bh & 7; const size_t row = (size_t)b * SEQ + i; const int t = NMETA + i;
        attn_row<64, 2>(WSP(bf16, WS_QC) + row * PQC + h * 64, WSP(bf16, WS_KC), WSP(bf16, WS_KC) + (size_t)(FR + b * SEQ) * PKC, PKC, (h >> 2) * 64,
                        WSP(bf16, WS_VC), WSP(bf16, WS_VC) + (size_t)(FR + b * SEQ) * PVC, PVC, (h >> 2) * 64, t, c.sinks[layer * 8 + h] * LOG2E, WSP(bf16, WS_QC) + row * PQC + h * 64);
    }
}
__device__ __forceinline__ void attn_meta(const Ctx& c) {
    if (c.tid >= 384) return;
    const int br = c.tid / 128, h = (c.tid >> 4) & 7, r = c.tid & 15; bf16* ym = WSP(bf16, WS_YM) + (size_t)r * 1536 + br * 512 + h * 64;
    if (br == 0) attn_row<64, 0>(WSP(bf16, WS_QAM) + r * PQA + h * 64, WSP(bf16, WS_KA), WSP(bf16, WS_KA), PKA, h * 80, WSP(bf16, WS_VA), WSP(bf16, WS_VA), PVA, h * 64, r, 0.f, ym);
    else if (br == 1) attn_row<96, 1>(WSP(bf16, WS_QBM) + r * PQB + h * 96, WSP(bf16, WS_KB), WSP(bf16, WS_KB), PKB, h * 96, WSP(bf16, WS_VB), WSP(bf16, WS_VB), PVB, h * 64, r, 0.f, ym);
    else attn_row<64, 2>(WSP(bf16, WS_QCM) + r * PQC + h * 64, WSP(bf16, WS_KC), WSP(bf16, WS_KC), PKC, (h >> 2) * 64, WSP(bf16, WS_VC), WSP(bf16, WS_VC), PVC, (h >> 2) * 64, r, c.sinks[h] * LOG2E, ym);
}

struct Unit { int pm, pn, z; };
__device__ __forceinline__ int perm32(int rho) { const int n = rho >> 4, i = rho & 15; return 8 * (i >> 2) + 4 * n + (i & 3); }
template <class Prob, class Epi, class Sched>
__device__ __forceinline__ void gemm_naive(const Ctx& c, const Prob& P, const Sched& S, const Epi& E) {
    const int wr = c.wave >> 2, wc = c.wave & 3, fr = c.lane & 15, fq = c.lane >> 4;
    Unit u;
    for (int ui = 0; S.next(ui, u); ++ui) {
        const bf16* A; const bf16* Bt; P.operands(u, A, Bt);
        const int K = P.K, lda = P.K;
        f32x4 acc[2][2][4][2];
#pragma unroll
        for (int a = 0; a < 2; ++a)
#pragma unroll
            for (int b = 0; b < 2; ++b)
#pragma unroll
                for (int m = 0; m < 4; ++m)
#pragma unroll
                    for (int n = 0; n < 2; ++n) acc[a][b][m][n] = (f32x4){0.f, 0.f, 0.f, 0.f};
        for (int k0 = 0; k0 < K; k0 += 64) {
#pragma unroll
            for (int ai = 0; ai < 2; ++ai) {
#pragma unroll
                for (int bj = 0; bj < 2; ++bj) {
                    bf16x8 Bf[2][2];
#pragma unroll
                    for (int n = 0; n < 2; ++n)
#pragma unroll
                        for (int k = 0; k < 2; ++k) Bf[n][k] = *(const bf16x8*)(Bt + (size_t)(256 * u.pn + 128 * bj + 32 * wc + perm32(16 * n + fr)) * K + k0 + 32 * k + 8 * fq);
#pragma unroll
                    for (int m = 0; m < 4; ++m) {
                        bf16x8 At[2];
#pragma unroll
                        for (int k = 0; k < 2; ++k) At[k] = *(const bf16x8*)(A + (size_t)(256 * u.pm + 128 * ai + 64 * wr + 16 * m + fr) * lda + k0 + 32 * k + 8 * fq);
#pragma unroll
                        for (int n = 0; n < 2; ++n)
#pragma unroll
                            for (int k = 0; k < 2; ++k) acc[ai][bj][m][n] = __builtin_amdgcn_mfma_f32_16x16x32_bf16(Bf[n][k], At[k], acc[ai][bj][m][n], 0, 0, 0);
                    }
                }
            }
        }
        asm volatile("" ::: "memory");
        E(acc, u, wr, wc, fr, fq);
    }
}
struct ProbSimple { const bf16* A; const bf16* Bt; int K;
    __device__ __forceinline__ void operands(const Unit&, const bf16*& a, const bf16*& b) const { a = A; b = Bt; } };
struct ProbBranch { const bf16 *A0, *A1, *A2; const bf16* Bt; int K;
    __device__ __forceinline__ void operands(const Unit& u, const bf16*& a, const bf16*& b) const { a = (u.z == 0) ? A0 : (u.z == 1) ? A1 : A2; b = Bt + (size_t)u.z * DM * 512; } };

namespace pg8 {
constexpr int BM = 256, BK = 64, HALF = 128, HTB = HALF * BK * 2, STAGE_BYTES = 8 * HTB, NXCD = 8, WGM = 8;
__host__ __device__ __forceinline__ int lds_byte(int r, int c) { const int st = (r >> 4) * 2 + (c >> 5), rr = r & 15, cc = c & 31, ob = rr * 64 + cc * 2; return st * 1024 + (ob ^ (((ob >> 9) & 1) << 5)); }
__host__ __device__ __forceinline__ void stage_rc(int b, int& R, int& C) { const int st = b / 1024, sb = b % 1024, swz = sb ^ (((sb >> 9) & 1) << 5); R = (st >> 1) * 16 + swz / 64; C = (st & 1) * 32 + (swz % 64) / 2; }
template <int ZN>
struct StaticOrder {
    int nM, nN, nwg, G, c, pn0;
    __device__ __forceinline__ void init(int nM_, int nN_, int pn0_, int G_, int c_) { nM = nM_; nN = nN_; nwg = nM * nN; G = G_; c = c_; pn0 = pn0_; }
    __device__ __forceinline__ bool next(int i, Unit& u) const {
        const int it = i / ZN;
        const long L = (long)it * G + c; if (L >= nwg) return false;
        int wgid = (int)L; { const int q = nwg / NXCD, r = nwg % NXCD, xcd = wgid % NXCD, off = wgid / NXCD; wgid = (xcd < r ? xcd * (q + 1) : r * (q + 1) + (xcd - r) * q) + off; }
        const int nig = WGM * nN, gid = wgid / nig, fm = gid * WGM, gsz = (nM - fm) < WGM ? (nM - fm) : WGM;
        u.pm = fm + ((wgid % nig) % gsz); u.pn = pn0 + (wgid % nig) / gsz; u.z = i - it * ZN; return true;
    }
};
template <class Prob, class Epi, class Sched, bool ALIGN_EPI, bool SP2>
__device__ __forceinline__ void gemm_phase(LAS unsigned char* lds, const Prob& P, const Sched& S, const Epi& E) {
    const int tid = threadIdx.x, wid = __builtin_amdgcn_readfirstlane(tid >> 6), lane = tid & 63, wr = wid >> 2, wc = wid & 3, fr = lane & 15, fq = lane >> 4;
    const int K = P.K, nt = K / BK;
    unsigned voffA[2], voffB[2];
#pragma unroll
    for (int i = 0; i < 2; ++i) { int R, C; stage_rc(tid * 16 + i * 8192, R, C); const int Rb = (R & ~31) + perm32(R & 31);
        voffA[i] = (unsigned)(R * K + C) * 2u; voffB[i] = (unsigned)(Rb * K + C) * 2u; }
    const size_t kstep = (size_t)(BK * 2);
    const size_t hstep = (size_t)HALF * K * 2;
    const size_t tstep = 2 * hstep;
    const unsigned ldsw = (unsigned)wid * 1024u;
    const int aoff = lds_byte(wr * 64 + fr, fq * 8), boff = lds_byte(wc * 32 + fr, fq * 8);
#define PG8_SA(b, h) (((b) * 2 + (h)) * HTB)
#define PG8_SB(b, h) ((4 + (b) * 2 + (h)) * HTB)
#define PG8_STAGE(bufoff, gbase, voff) do { _Pragma("unroll") for (int _i = 0; _i < 2; ++_i) \
        __builtin_amdgcn_global_load_lds((const unsigned*)((const char*)(gbase) + (voff)[_i]), (LAS unsigned*)(lds + (bufoff) + ldsw + _i * 8192), 16, 0, 0); } while (0)
#define PG8_LDA(dst, b, h) do { _Pragma("unroll") for (int m = 0; m < 4; ++m) _Pragma("unroll") for (int k = 0; k < 2; ++k) dst[m][k] = *(const LAS bf16x8*)(lds + PG8_SA(b, h) + aoff + m * 2048 + k * 1024); } while (0)
#define PG8_LDB(dst, b, h) do { _Pragma("unroll") for (int n = 0; n < 2; ++n) _Pragma("unroll") for (int k = 0; k < 2; ++k) dst[n][k] = *(const LAS bf16x8*)(lds + PG8_SB(b, h) + boff + n * 2048 + k * 1024); } while (0)
#define PG8_MMA(ai, bj, At, Bt) do { __builtin_amdgcn_s_setprio(1); _Pragma("unroll") for (int m = 0; m < 4; ++m) _Pragma("unroll") for (int n = 0; n < 2; ++n) _Pragma("unroll") for (int k = 0; k < 2; ++k) \
        acc[ai][bj][m][n] = __builtin_amdgcn_mfma_f32_16x16x32_bf16(Bt[n][k], At[m][k], acc[ai][bj][m][n], 0, 0, 0); __builtin_amdgcn_s_setprio(0); } while (0)
#define PG8_WAIT_V(n) asm volatile("s_waitcnt vmcnt(" #n ")" ::: "memory")
#define PG8_WAIT_L(n) asm volatile("s_waitcnt lgkmcnt(" #n ")" ::: "memory")
#define PG8_BAR __builtin_amdgcn_s_barrier()
#define PG8_SCHED __builtin_amdgcn_sched_barrier(0)
    Unit cur, nxt; int ui = 0;
    if (!S.next(0, cur)) return;
    f32x4 acc[2][2][4][2];
#pragma unroll
    for (int a = 0; a < 2; ++a)
#pragma unroll
        for (int b = 0; b < 2; ++b)
#pragma unroll
            for (int m = 0; m < 4; ++m)
#pragma unroll
                for (int n = 0; n < 2; ++n) acc[a][b][m][n] = (f32x4){0.f, 0.f, 0.f, 0.f};
    bf16x8 At[4][2], B0[2][2], B1[2][2];
    const char* cA; const char* cB;
    { const bf16 *pa, *pb; P.operands(cur, pa, pb); cA = (const char*)pa + (size_t)cur.pm * tstep; cB = (const char*)pb + (size_t)cur.pn * tstep; }
    if constexpr (SP2) {
        PG8_STAGE(PG8_SB(0, 0), cB, voffB); PG8_STAGE(PG8_SB(0, 1), cB + hstep, voffB); PG8_STAGE(PG8_SA(0, 0), cA, voffA); PG8_STAGE(PG8_SA(0, 1), cA + hstep, voffA);
        if (wr == 1) PG8_BAR;
        PG8_WAIT_V(2); PG8_BAR;
        PG8_STAGE(PG8_SB(1, 0), cB + kstep, voffB); PG8_STAGE(PG8_SA(1, 0), cA + kstep, voffA); PG8_STAGE(PG8_SB(1, 1), cB + hstep + kstep, voffB);
        PG8_WAIT_V(6); PG8_BAR;
    } else {
        PG8_STAGE(PG8_SB(0, 0), cB, voffB); PG8_STAGE(PG8_SA(0, 0), cA, voffA); PG8_STAGE(PG8_SB(0, 1), cB + hstep, voffB); PG8_STAGE(PG8_SA(0, 1), cA + hstep, voffA);
        if (wr == 1) PG8_BAR;
        PG8_WAIT_V(4); PG8_BAR;
        PG8_STAGE(PG8_SB(1, 0), cB + kstep, voffB); PG8_STAGE(PG8_SA(1, 0), cA + kstep, voffA); PG8_STAGE(PG8_SB(1, 1), cB + hstep + kstep, voffB);
        PG8_WAIT_V(6); PG8_BAR;
    }
    for (;;) {
        const bool has_next = S.next(ui + 1, nxt);
        const char* nA = cA; const char* nB = cB;
        if (has_next) { const bf16 *pa, *pb; P.operands(nxt, pa, pb); nA = (const char*)pa + (size_t)nxt.pm * tstep; nB = (const char*)pb + (size_t)nxt.pn * tstep; }
        for (int t = 0; t < nt; t += 2) {
            const bool last = (t == nt - 2);
            const char* a1 = cA + (size_t)(t + 1) * kstep;
            const char* a2 = last ? nA : cA + (size_t)(t + 2) * kstep; const char* b2 = last ? nB : cB + (size_t)(t + 2) * kstep;
            const char* a3 = a2 + kstep; const char* b3 = b2 + kstep;
            if constexpr (SP2) {
            PG8_LDB(B0, 0, 0); PG8_LDB(B1, 0, 1); PG8_SCHED; PG8_LDA(At, 0, 0); PG8_STAGE(PG8_SA(1, 1), a1 + hstep, voffA);
            PG8_WAIT_V(8); PG8_WAIT_L(0); PG8_BAR; PG8_MMA(0, 0, At, B0); PG8_MMA(0, 1, At, B1); PG8_BAR; PG8_SCHED;
            PG8_LDA(At, 0, 1); PG8_STAGE(PG8_SB(0, 0), b2, voffB); PG8_STAGE(PG8_SB(0, 1), b2 + hstep, voffB); PG8_STAGE(PG8_SA(0, 0), a2, voffA);
            PG8_WAIT_V(8); PG8_WAIT_L(0); PG8_BAR; PG8_MMA(1, 0, At, B0); PG8_MMA(1, 1, At, B1); PG8_BAR; PG8_SCHED;
            PG8_LDB(B0, 1, 0); PG8_LDB(B1, 1, 1); PG8_SCHED; PG8_LDA(At, 1, 0); PG8_STAGE(PG8_SA(0, 1), a2 + hstep, voffA);
            PG8_WAIT_V(8); PG8_WAIT_L(0); PG8_BAR; PG8_MMA(0, 0, At, B0); PG8_MMA(0, 1, At, B1); PG8_BAR; PG8_SCHED;
            PG8_LDA(At, 1, 1); PG8_STAGE(PG8_SB(1, 0), b3, voffB); PG8_STAGE(PG8_SB(1, 1), b3 + hstep, voffB); PG8_STAGE(PG8_SA(1, 0), a3, voffA);
            PG8_WAIT_V(8); PG8_WAIT_L(0); PG8_BAR; PG8_MMA(1, 0, At, B0); PG8_MMA(1, 1, At, B1); PG8_BAR; PG8_SCHED;
            } else {
            PG8_LDB(B0, 0, 0); PG8_SCHED; PG8_LDA(At, 0, 0); PG8_STAGE(PG8_SA(1, 1), a1 + hstep, voffA);
            PG8_WAIT_L(8); PG8_BAR; PG8_WAIT_L(0); PG8_MMA(0, 0, At, B0); PG8_BAR; PG8_SCHED;
            PG8_LDB(B1, 0, 1); PG8_STAGE(PG8_SB(0, 0), b2, voffB);
            PG8_BAR; PG8_WAIT_L(0); PG8_MMA(0, 1, At, B1); PG8_BAR;
            PG8_LDA(At, 0, 1); PG8_STAGE(PG8_SA(0, 0), a2, voffA);
            PG8_BAR; PG8_WAIT_L(0); PG8_MMA(1, 0, At, B0); PG8_BAR; PG8_SCHED;
            PG8_STAGE(PG8_SB(0, 1), b2 + hstep, voffB);
            PG8_WAIT_V(6); PG8_BAR; PG8_MMA(1, 1, At, B1); PG8_BAR;
            PG8_LDB(B0, 1, 0); PG8_SCHED; PG8_LDA(At, 1, 0); PG8_STAGE(PG8_SA(0, 1), a2 + hstep, voffA);
            PG8_WAIT_L(8); PG8_BAR; PG8_WAIT_L(0); PG8_MMA(0, 0, At, B0); PG8_BAR; PG8_SCHED;
            PG8_LDB(B1, 1, 1); PG8_STAGE(PG8_SB(1, 0), b3, voffB);
            PG8_BAR; PG8_WAIT_L(0); PG8_MMA(0, 1, At, B1); PG8_BAR;
            PG8_LDA(At, 1, 1); PG8_STAGE(PG8_SA(1, 0), a3, voffA);
            PG8_BAR; PG8_WAIT_L(0); PG8_MMA(1, 0, At, B0); PG8_BAR; PG8_SCHED;
            PG8_STAGE(PG8_SB(1, 1), b3 + hstep, voffB);
            PG8_WAIT_V(6); PG8_BAR; PG8_MMA(1, 1, At, B1); PG8_BAR;
            }
        }
        if constexpr (ALIGN_EPI) { if (wr == 0) PG8_BAR; }
        E(acc, cur, wr, wc, fr, fq);
        if (!has_next) break;
#pragma unroll
        for (int a = 0; a < 2; ++a)
#pragma unroll
            for (int b = 0; b < 2; ++b)
#pragma unroll
                for (int m = 0; m < 4; ++m)
#pragma unroll
                    for (int n = 0; n < 2; ++n) acc[a][b][m][n] = (f32x4){0.f, 0.f, 0.f, 0.f};
        cur = nxt; cA = nA; cB = nB; ++ui;
        if constexpr (ALIGN_EPI) { if (wr == 1) PG8_BAR; }
    }
    PG8_WAIT_V(0);
    if constexpr (!ALIGN_EPI) { if (wr == 0) PG8_BAR; }
    PG8_BAR;
#undef PG8_SA
#undef PG8_SB
#undef PG8_STAGE
#undef PG8_LDA
#undef PG8_LDB
#undef PG8_MMA
#undef PG8_WAIT_V
#undef PG8_WAIT_L
#undef PG8_BAR
#undef PG8_SCHED
}
}
#ifndef USE_PG8
#define USE_PG8 1
#endif
template <int ZN, class Prob, class Epi>
__device__ __forceinline__ void gemm_run(const Ctx& c, const Prob& P, const Epi& E, int nM, int nN, int pn0) {
#if USE_PG8
    pg8::StaticOrder<ZN> S; S.init(nM, nN, pn0, c.G, c.bid);
    pg8::gemm_phase<Prob, Epi, pg8::StaticOrder<ZN>, true, true>(c.lds, P, S, E);
#else
    pg8::StaticOrder<ZN> S; S.init(nM, nN, pn0, c.G, c.bid);
    gemm_naive(c, P, S, E);
#endif
}

#define EPI_ROWS_BEGIN _Pragma("unroll") for (int ai = 0; ai < 2; ++ai) _Pragma("unroll") for (int m = 0; m < 4; ++m) { const int row = 256 * u.pm + 128 * ai + 64 * wr + 16 * m + fr; \
    const f32x4 l0 = acc[ai][0][m][0], l1 = acc[ai][0][m][1], h0 = acc[ai][1][m][0], h1 = acc[ai][1][m][1]; (void)l0; (void)l1; (void)h0; (void)h1;
#define EPI_ROWS_END asm volatile("" ::: "memory"); }
typedef f32x4 Acc_t[2][2][4][2];

__device__ __forceinline__ void rope8(const float* cs, const float* sn, f32x4 x1a, f32x4 x1b, f32x4 x2a, f32x4 x2b, float sc, f32x4& o1a, f32x4& o1b, f32x4& o2a, f32x4& o2b) {
    const f32x4 ca = *(const f32x4*)cs, cb = *(const f32x4*)(cs + 4), sa = *(const f32x4*)sn, sb = *(const f32x4*)(sn + 4);
    o1a = (x1a * ca - x2a * sa) * sc; o1b = (x1b * cb - x2b * sb) * sc; o2a = (x2a * ca + x1a * sa) * sc; o2b = (x2b * cb + x1b * sb) * sc;
}
struct EpiEarly {
    const Ctx& c; int layer;
    __device__ __forceinline__ void operator()(const Acc_t& acc, const Unit& u, int wr, int wc, int fr, int fq) const {
        const int c8 = 32 * wc + 8 * fq, t = u.pn;
        bf16 *QA = WSP(bf16, WS_QA), *KA = WSP(bf16, WS_KA) + (size_t)FR * PKA, *VA = WSP(bf16, WS_VA) + (size_t)FR * PVA, *QC = WSP(bf16, WS_QC), *KC = WSP(bf16, WS_KC) + (size_t)FR * PKC,
             *VC = WSP(bf16, WS_VC) + (size_t)FR * PVC, *CQ = WSP(bf16, WS_CQ), *CKV = WSP(bf16, WS_CKV), *KB = WSP(bf16, WS_KB) + (size_t)FR * PKB;
        const float *cos64 = WSP(float, WS_COS64), *sin64 = WSP(float, WS_SIN64), *cos32 = WSP(float, WS_COS32), *sin32 = WSP(float, WS_SIN32);
        if (t < 2) { EPI_ROWS_BEGIN st8(QA + (size_t)row * PQA + 256 * t + c8, l0 * C2A, l1 * C2A); st8(QA + (size_t)row * PQA + 256 * t + 128 + c8, h0 * C2A, h1 * C2A); EPI_ROWS_END }
        else if (t < 4) { const int L0 = 256 * (t - 2) + c8, L1 = L0 + 128;
            EPI_ROWS_BEGIN st8(KA + (size_t)row * PKA + (L0 >> 6) * 80 + (L0 & 63), l0, l1); st8(KA + (size_t)row * PKA + (L1 >> 6) * 80 + (L1 & 63), h0, h1); EPI_ROWS_END }
        else if (t < 6) { EPI_ROWS_BEGIN st8(VA + (size_t)row * PVA + 256 * (t - 4) + c8, l0, l1); st8(VA + (size_t)row * PVA + 256 * (t - 4) + 128 + c8, h0, h1); EPI_ROWS_END }
        else if (t < 8) { const int head = 4 * (t - 6) + wc, d = 8 * fq;
            EPI_ROWS_BEGIN const int pos = NMETA + (row & (SEQ - 1)); f32x4 o1a, o1b, o2a, o2b; rope8(cos64 + pos * 32 + d, sin64 + pos * 32 + d, l0, l1, h0, h1, C2C, o1a, o1b, o2a, o2b);
                st8(QC + (size_t)row * PQC + head * 64 + d, o1a, o1b); st8(QC + (size_t)row * PQC + head * 64 + 32 + d, o2a, o2b); EPI_ROWS_END }
        else if (t == 8) {
            if (wc < 2) { const int d = 8 * fq;
                EPI_ROWS_BEGIN const int pos = NMETA + (row & (SEQ - 1)); f32x4 o1a, o1b, o2a, o2b; rope8(cos64 + pos * 32 + d, sin64 + pos * 32 + d, l0, l1, h0, h1, 1.f, o1a, o1b, o2a, o2b);
                    st8(KC + (size_t)row * PKC + wc * 64 + d, o1a, o1b); st8(KC + (size_t)row * PKC + wc * 64 + 32 + d, o2a, o2b); EPI_ROWS_END }
            else { const int j = 32 * (wc - 2) + 8 * fq;
                EPI_ROWS_BEGIN st8(VC + (size_t)row * PVC + j, l0, l1); st8(VC + (size_t)row * PVC + 64 + j, h0, h1); EPI_ROWS_END } }
        else if (t == 9) { EPI_ROWS_BEGIN st8(CQ + (size_t)row * PCQ + c8, l0, l1); st8(CQ + (size_t)row * PCQ + 128 + c8, h0, h1); EPI_ROWS_END }
        else if (t == 10) {
            if (wc < 2) { EPI_ROWS_BEGIN st8(CQ + (size_t)row * PCQ + 256 + c8, l0, l1); st8(CQ + (size_t)row * PCQ + 256 + 64 + c8, h0, h1); EPI_ROWS_END }
            else if (wc == 2) {
                if (fq < 2) { const int d = 8 * fq;
                    EPI_ROWS_BEGIN const int pos = NMETA + (row & (SEQ - 1)); f32x4 o1a, o1b, o2a, o2b; rope8(cos32 + pos * 16 + d, sin32 + pos * 16 + d, l0, l1, h0, h1, 1.f, o1a, o1b, o2a, o2b);
                        const u32x4 w1 = pack8(o1a, o1b), w2 = pack8(o2a, o2b);
#pragma unroll
                        for (int h = 0; h < 8; ++h) { *(u32x4*)(KB + (size_t)row * PKB + h * 96 + 64 + d) = w1; *(u32x4*)(KB + (size_t)row * PKB + h * 96 + 80 + d) = w2; } EPI_ROWS_END }
                else if (fq == 2) { float* LF = WSP(float, WS_LF); const f32x4 b0 = *(const f32x4*)(c.b_f + layer * 8), b1 = *(const f32x4*)(c.b_f + layer * 8 + 4);
                    EPI_ROWS_BEGIN f32x4 a = l0 + b0, b = l1 + b1;
#pragma unroll
                        for (int j = 0; j < 4; ++j) { a[j] = logsigf_(a[j]); b[j] = logsigf_(b[j]); }
                        *(f32x4*)(LF + (size_t)row * 8) = a; *(f32x4*)(LF + (size_t)row * 8 + 4) = b; EPI_ROWS_END } } }
        else { EPI_ROWS_BEGIN st8(CKV + (size_t)row * PCKV + c8, l0, l1); st8(CKV + (size_t)row * PCKV + 128 + c8, h0, h1); EPI_ROWS_END }
    }
};
struct EpiUq {
    const Ctx& c;
    __device__ __forceinline__ void operator()(const Acc_t& acc, const Unit& u, int wr, int wc, int fr, int fq) const {
        bf16* QB = WSP(bf16, WS_QB); const float* RQ = WSP(float, WS_RQ); const float *cos32 = WSP(float, WS_COS32), *sin32 = WSP(float, WS_SIN32);
        const int c8 = 32 * wc + 8 * fq;
        if (u.pn < 2) { const int ha = 4 * u.pn + (c8 >> 6), hb = ha + 2, e = c8 & 63;
            EPI_ROWS_BEGIN const float sc = RQ[row] * C2B; st8(QB + (size_t)row * PQB + ha * 96 + e, l0 * sc, l1 * sc); st8(QB + (size_t)row * PQB + hb * 96 + e, h0 * sc, h1 * sc); EPI_ROWS_END }
        else { const int h = c8 >> 4, d = c8 & 15;
            EPI_ROWS_BEGIN const float sc = RQ[row] * C2B; const int pos = NMETA + (row & (SEQ - 1)); f32x4 o1a, o1b, o2a, o2b; rope8(cos32 + pos * 16 + d, sin32 + pos * 16 + d, l0, l1, h0, h1, sc, o1a, o1b, o2a, o2b);
                st8(QB + (size_t)row * PQB + h * 96 + 64 + d, o1a, o1b); st8(QB + (size_t)row * PQB + h * 96 + 80 + d, o2a, o2b); EPI_ROWS_END }
    }
};
struct EpiUkv {
    const Ctx& c;
    __device__ __forceinline__ void operator()(const Acc_t& acc, const Unit& u, int wr, int wc, int fr, int fq) const {
        bf16 *KB = WSP(bf16, WS_KB) + (size_t)FR * PKB, *VB = WSP(bf16, WS_VB) + (size_t)FR * PVB; const float* RKV = WSP(float, WS_RKV);
        const int c8 = 32 * wc + 8 * fq, ha = 2 * u.pn, hb = ha + 1;
        if (wc < 2) { EPI_ROWS_BEGIN const float sc = RKV[row]; st8(KB + (size_t)row * PKB + ha * 96 + c8, l0 * sc, l1 * sc); st8(KB + (size_t)row * PKB + hb * 96 + c8, h0 * sc, h1 * sc); EPI_ROWS_END }
        else { EPI_ROWS_BEGIN const float sc = RKV[row]; st8(VB + (size_t)row * PVB + ha * 64 + c8 - 64, l0 * sc, l1 * sc); st8(VB + (size_t)row * PVB + hb * 64 + c8 - 64, h0 * sc, h1 * sc); EPI_ROWS_END }
    }
};
struct EpiLateZ {
    const Ctx& c;
    __device__ __forceinline__ void operator()(const Acc_t& acc, const Unit& u, int wr, int wc, int fr, int fq) const {
        const int c8 = 32 * wc + 8 * fq, t = u.pn;
        bf16* Y = (t < 2) ? WSP(bf16, WS_QA) : (t < 4) ? WSP(bf16, WS_YB) : WSP(bf16, WS_QC); const int col = 256 * (t & 1) + c8;
        EPI_ROWS_BEGIN
            { bf16* p = Y + (size_t)row * PY + col; f32x4 ya, yb; ld8(p, ya, yb);
#pragma unroll
              for (int j = 0; j < 4; ++j) { ya[j] *= siluf_(l0[j]); yb[j] *= siluf_(l1[j]); }
              st8(p, ya, yb); }
            { bf16* p = Y + (size_t)row * PY + col + 128; f32x4 ya, yb; ld8(p, ya, yb);
#pragma unroll
              for (int j = 0; j < 4; ++j) { ya[j] *= siluf_(h0[j]); yb[j] *= siluf_(h1[j]); }
              st8(p, ya, yb); }
        EPI_ROWS_END
    }
};
struct EpiLateG {
    const Ctx& c;
    __device__ __forceinline__ void operator()(const Acc_t& acc, const Unit& u, int wr, int wc, int fr, int fq) const {
        bf16* Gp = WSP(bf16, WS_G); const int col = 256 * (u.pn - 6) + 32 * wc + 8 * fq;
        EPI_ROWS_BEGIN f32x4 a = l0, b = l1, cc = h0, d = h1;
#pragma unroll
            for (int j = 0; j < 4; ++j) { a[j] = sigmoidf_(a[j]); b[j] = sigmoidf_(b[j]); cc[j] = sigmoidf_(cc[j]); d[j] = sigmoidf_(d[j]); }
            st8(Gp + (size_t)row * PG + col, a, b); st8(Gp + (size_t)row * PG + col + 128, cc, d); EPI_ROWS_END
    }
};
struct EpiBranch {
    const Ctx& c;
    __device__ __forceinline__ void operator()(const Acc_t& acc, const Unit& u, int wr, int wc, int fr, int fq) const {
        const bf16* Gp = WSP(bf16, WS_G); bf16* MG = WSP(bf16, WS_HN); const int col = 256 * u.pn + 32 * wc + 8 * fq;
        EPI_ROWS_BEGIN
#pragma unroll
            for (int bj = 0; bj < 2; ++bj) { f32x4 ga, gb; ld8(Gp + (size_t)row * PG + u.z * DM + col + 128 * bj, ga, gb); f32x4 va = (bj ? h0 : l0) * ga, vb = (bj ? h1 : l1) * gb;
                bf16* p = MG + (size_t)row * DM + col + 128 * bj; if (u.z > 0) { f32x4 pa, pb; ld8(p, pa, pb); va += pa; vb += pb; } st8(p, va, vb); } EPI_ROWS_END
    }
};
struct EpiOut {
    const float* resid; float* out;
    __device__ __forceinline__ void operator()(const Acc_t& acc, const Unit& u, int wr, int wc, int fr, int fq) const {
        const int col = 256 * u.pn + 32 * wc + 8 * fq;
        EPI_ROWS_BEGIN const size_t off = (size_t)row * DM + col;
            const f32x4 r0 = *(const f32x4*)(resid + off), r1 = *(const f32x4*)(resid + off + 4), r2 = *(const f32x4*)(resid + off + 128), r3 = *(const f32x4*)(resid + off + 132);
            *(f32x4*)(out + off) = r0 + l0; *(f32x4*)(out + off + 4) = r1 + l1; *(f32x4*)(out + off + 128) = r2 + h0; *(f32x4*)(out + off + 132) = r3 + h1; EPI_ROWS_END
    }
};

__device__ __forceinline__ void stats_cumsum(const Ctx& c) {
    const int gw = c.bid * NWAVES + c.wave, NGW = c.G * NWAVES;
    for (int m = gw; m < M; m += NGW) {
        float sq = 0.f, sk = 0.f;
        if (c.lane < 48) { f32x4 a, b; ld8(WSP(bf16, WS_CQ) + (size_t)m * PCQ + 8 * c.lane, a, b); sq = (a[0] * a[0] + a[1] * a[1]) + (a[2] * a[2] + a[3] * a[3]) + (b[0] * b[0] + b[1] * b[1]) + (b[2] * b[2] + b[3] * b[3]); }
        if (c.lane < 32) { f32x4 a, b; ld8(WSP(bf16, WS_CKV) + (size_t)m * PCKV + 8 * c.lane, a, b); sk = (a[0] * a[0] + a[1] * a[1]) + (a[2] * a[2] + a[3] * a[3]) + (b[0] * b[0] + b[1] * b[1]) + (b[2] * b[2] + b[3] * b[3]); }
        sq = wave_sum(sq); sk = wave_sum(sk);
        if (c.lane == 0) { WSP(float, WS_RQ)[m] = 1.f / sqrtf(sq * (1.f / 384.f) + EPS); WSP(float, WS_RKV)[m] = 1.f / sqrtf(sk * (1.f / 256.f) + EPS); }
    }
    LAS double* wsum = (LAS double*)(c.lds);
    for (int task = c.bid; task < NBATCH * 8; task += c.G) {
        const int b = task >> 3, h = task & 7; const float* LF = WSP(float, WS_LF) + (size_t)b * SEQ * 8 + h;
        double v[8]; double s = 0.0;
#pragma unroll
        for (int j = 0; j < 8; ++j) { s += (double)LF[(size_t)(8 * c.tid + j) * 8]; v[j] = s; }
        double inc = s;
#pragma unroll
        for (int o = 1; o < 64; o <<= 1) { const double n = __shfl_up(inc, o); if (c.lane >= o) inc += n; }
        __syncthreads();
        if (c.lane == 63) wsum[c.wave] = inc;
        __syncthreads();
        double base = inc - s;
        for (int w = 0; w < c.wave; ++w) base += wsum[w];
        bf16* KA = WSP(bf16, WS_KA) + (size_t)(FR + b * SEQ) * PKA + h * 80 + 64;
#pragma unroll
        for (int j = 0; j < 8; ++j) { const float bias = (float)(-(base + v[j]) * 1.4426950408889634); bf16 bh, bm, bl; split3(bias, bh, bm, bl);
            u32x4 w0 = {(unsigned)bh | ((unsigned)bm << 16), (unsigned)bl, 0u, 0u}, w1 = {0u, 0u, 0u, 0u}; bf16* kp = KA + (size_t)(8 * c.tid + j) * PKA; *(u32x4*)kp = w0; *(u32x4*)(kp + 8) = w1; }
    }
}
__device__ __forceinline__ void final_norm(const Ctx& c) {
    const int gw = c.bid * NWAVES + c.wave, NGW = c.G * NWAVES;
    for (int m = gw; m < M; m += NGW) {
        f32x4* xr = (f32x4*)(c.out + (size_t)m * DM) + c.lane; f32x4 v[4]; float s = 0.f;
#pragma unroll
        for (int j = 0; j < 4; ++j) { v[j] = xr[64 * j]; s += (v[j][0] * v[j][0] + v[j][1] * v[j][1]) + (v[j][2] * v[j][2] + v[j][3] * v[j][3]); }
        const float rstd = 1.f / sqrtf(wave_sum(s) * (1.f / DM) + EPS);
#pragma unroll
        for (int j = 0; j < 4; ++j) { const f32x4 g = ((const f32x4*)c.final_g + c.lane)[64 * j]; xr[64 * j] = v[j] * rstd * g; }
    }
}

#define XB_TMO      128
#define XB_XCNT(j)  (256  + 64 * (j))
#define XB_XSUB(j)  (1280 + 64 * (j))
#define XB_XGEN(j)  (2304 + 64 * (j))
#define XB_TOP      3328
#define XB_TOPGEN   3392
#define XCD_BAR_WORDS 3456
#define XB_SPIN_CAP (1u << 18)
__device__ __forceinline__ unsigned xb_ld(unsigned* p)              { return __hip_atomic_load(p, __ATOMIC_RELAXED, __HIP_MEMORY_SCOPE_AGENT); }
__device__ __forceinline__ unsigned xb_add(unsigned* p, unsigned v) { return __hip_atomic_fetch_add(p, v, __ATOMIC_RELAXED, __HIP_MEMORY_SCOPE_AGENT); }
__device__ __forceinline__ unsigned xb_xcc_id() { return (unsigned)__builtin_amdgcn_s_getreg((3 << 11) | 20) & 0xFu; }
#define XB_SPIN(cond, bar) do { unsigned _sp = 0; while (cond) { __builtin_amdgcn_s_sleep(1); \
    if ((++_sp & 255u) == 0u) { if (xb_ld(&(bar)[XB_TMO])) break; if (_sp > XB_SPIN_CAP) { atomicAdd(&(bar)[XB_TMO], 1u); break; } } } } while (0)
struct XcdBarrier { unsigned* bar; unsigned x; volatile LAS unsigned* st; };
__device__ __forceinline__ XcdBarrier xcd_barrier_post(unsigned* bar, volatile LAS unsigned* st) {
    XcdBarrier b; b.bar = bar; b.x = xb_xcc_id(); b.st = st;
    if (threadIdx.x == 0) (void)xb_add(&bar[XB_XCNT(b.x)], 1u);
    return b;
}
__device__ __forceinline__ void xcd_barrier_complete(unsigned* bar, unsigned x, unsigned& nloc, unsigned& nx) {
    const unsigned G = gridDim.x * gridDim.y * gridDim.z;
    unsigned sum, cnt, mine, sp = 0u;
    for (;;) {
        sum = 0u; cnt = 0u; mine = 0u;
#pragma unroll
        for (unsigned j = 0; j < 16; ++j) { const unsigned cc = xb_ld(&bar[XB_XCNT(j)]); sum += cc; cnt += (cc > 0u) ? 1u : 0u; mine = (j == x) ? cc : mine; }
        if (sum == G) break;
        __builtin_amdgcn_s_sleep(1);
        if ((++sp & 255u) == 0u) { if (xb_ld(&bar[XB_TMO])) break; if (sp > XB_SPIN_CAP) { atomicAdd(&bar[XB_TMO], 1u); break; } }
    }
    nloc = mine > 0u ? mine : 1u; nx = cnt > 0u ? cnt : 1u;
}
__device__ __forceinline__ void xcd_barrier(const XcdBarrier& b) {
    asm volatile("s_waitcnt vmcnt(0)" ::: "memory");
    __syncthreads();
    if (threadIdx.x == 0) {
        unsigned* bar = b.bar;
        __builtin_amdgcn_s_waitcnt(0);
        unsigned nloc = b.st[0], nx = b.st[1];
        if (nloc == 0u) { xcd_barrier_complete(bar, b.x, nloc, nx); b.st[0] = nloc; b.st[1] = nx; }
        const unsigned old = xb_add(&bar[XB_XSUB(b.x)], 1u);
        const unsigned gen = old / nloc;
        if (old + 1u == (gen + 1u) * nloc) {
            __builtin_amdgcn_fence(__ATOMIC_RELEASE, "agent");
            asm volatile("s_waitcnt vmcnt(0)" ::: "memory");
            const unsigned og = xb_add(&bar[XB_TOP], 1u);
            const unsigned tg = og / nx;
            if (og + 1u == (tg + 1u) * nx) xb_add(&bar[XB_TOPGEN], 1u);
            else XB_SPIN(xb_ld(&bar[XB_TOPGEN]) == tg, bar);
            __builtin_amdgcn_fence(__ATOMIC_ACQUIRE, "agent");
            xb_add(&bar[XB_XGEN(b.x)], 1u);
            asm volatile("s_waitcnt vmcnt(0)" ::: "memory");
        } else {
            XB_SPIN(xb_ld(&bar[XB_XGEN(b.x)]) == gen, bar);
            __builtin_amdgcn_fence(__ATOMIC_ACQUIRE, "agent");
            asm volatile("s_waitcnt vmcnt(0)" ::: "memory");
        }
    }
    __syncthreads();
}

constexpr int LDS_BYTES = 147456, MISC_OFF = 131072 + 320;
constexpr int NSLOTS = 18;
constexpr int CW_BAR = 4096;

struct Args { const float* in[13]; float* out; unsigned char* ws; int ph_lo, ph_hi, pad0, pad1; };
#define CAS __attribute__((address_space(4)))
__device__ __forceinline__ Ctx make_ctx() {
    const CAS char* kp = (const CAS char*)__builtin_amdgcn_kernarg_segment_ptr();
    asm volatile("" : "+s"(kp));
    const CAS Args* a = (const CAS Args*)kp;
    Ctx c;
    c.x = a->in[0]; c.meta = a->in[1]; c.norm_g = a->in[2]; c.w_in = a->in[3]; c.b_f = a->in[4]; c.g_cq = a->in[5]; c.g_ckv = a->in[6];
    c.w_uq = a->in[7]; c.w_ukv = a->in[8]; c.sinks = a->in[9]; c.w_branch = a->in[10]; c.w_out = a->in[11]; c.final_g = a->in[12];
    c.out = a->out; c.ws = a->ws;
    extern __shared__ __attribute__((aligned(16))) unsigned char lds_raw[];
    c.lds = (LAS unsigned char*)lds_raw;
    c.tid = threadIdx.x; c.lane = c.tid & 63; c.wave = __builtin_amdgcn_readfirstlane(c.tid >> 6); c.G = gridDim.x; c.bid = blockIdx.x;
    return c;
}

template <int SLOT>
__device__ __forceinline__ void run_slot() {
    const Ctx c = make_ctx();
    constexpr int slot = SLOT;
    constexpr int layer = (slot >= 9) ? 1 : 0;
    constexpr int ls = (slot >= 9) ? slot - 8 : slot;
        if constexpr (slot == 0) slot0(c);
        else if constexpr (slot == 17) final_norm(c);
        else if constexpr (ls == 1) {
            zero_fronts(c);
            norm_main(c, layer == 0 ? c.x : c.out);
            meta_blocks(c, AfPlain{WSP(bf16, WS_HNM), DM}, wl(c, layer, WL_EARLY), DM, NE / 16, WSP(float, WS_RAWE), NE, 0);
        } else if constexpr (ls == 2) {
            if (c.bid == 0) post_early(c, layer);
            ProbSimple P{WSP(bf16, WS_HN), wl(c, layer, WL_EARLY), DM};
            gemm_run<1>(c, P, EpiEarly{c, layer}, 64, NE / 256, 0);
        } else if constexpr (ls == 3) {
            { const AfPlain af{WSP(bf16, WS_CM), 640}; meta_blocks(c, af, wl(c, layer, WL_UQ), 384, NUQ / 16, WSP(float, WS_RAWU), NUQ + NUKV, 0);
              const AfPlain af2{WSP(bf16, WS_CM) + 384, 640}; meta_blocks(c, af2, wl(c, layer, WL_UKV), 256, NUKV / 16, WSP(float, WS_RAWU), NUQ + NUKV, NUQ); }
            stats_cumsum(c);
        } else if constexpr (ls == 4) {
            if (c.bid == 0) post_up(c);
            { ProbSimple P{WSP(bf16, WS_CQ), wl(c, layer, WL_UQ), 384}; gemm_run<1>(c, P, EpiUq{c}, 64, NUQ / 256, 0); }
            { ProbSimple P{WSP(bf16, WS_CKV), wl(c, layer, WL_UKV), 256}; gemm_run<1>(c, P, EpiUkv{c}, 64, NUKV / 256, 0); }
        } else if constexpr (ls == 5) {
            if (layer == 0) {
#ifndef NO_ATTNM
                if (c.bid == 0) attn_meta(c);
#endif
 meta_blocks(c, AfPlain{WSP(bf16, WS_HNM), DM}, wl(c, 0, WL_LATE), DM, NL / 16, WSP(float, WS_RAWL), NL, 0); }
#ifndef NO_ATTN
            attn_main_naive(c, layer);
#endif
        } else if constexpr (ls == 6) {
#ifndef NO_S67
            if (layer == 0) { for (int n = 0; n < 3; ++n) { const AfBranch af{WSP(bf16, WS_YM), WSP(float, WS_RAWL), n}; meta_blocks(c, af, wl(c, 0, WL_BR) + (size_t)n * DM * 512, 512, DM / 16, WSP(float, WS_RAWB) + (size_t)n * 16 * 1024, 1024, 0); } }
#endif
            { ProbSimple P{WSP(bf16, WS_HN), wl(c, layer, WL_LATE), DM}; gemm_run<1>(c, P, EpiLateZ{c}, 64, 6, 0); }
            { ProbSimple P{WSP(bf16, WS_HN), wl(c, layer, WL_LATE), DM}; gemm_run<1>(c, P, EpiLateG{c}, 64, 12, 6); }
        } else if constexpr (ls == 7) {
            if (layer == 0) { const AfMerged af{WSP(float, WS_RAWL), WSP(float, WS_RAWB)}; meta_blocks(c, af, wl(c, 0, WL_OUT), DM, DM / 16, WSP(float, WS_RAWO), DM, 0); }
            { ProbBranch P{WSP(bf16, WS_QA), WSP(bf16, WS_YB), WSP(bf16, WS_QC), wl(c, layer, WL_BR), 512}; gemm_run<3>(c, P, EpiBranch{c}, 64, 4, 0); }
        } else if constexpr (ls == 8) {
            if (layer == 0 && c.bid == 0) post_resid(c);
            ProbSimple P{WSP(bf16, WS_HN), wl(c, layer, WL_OUT), DM};
            gemm_run<1>(c, P, EpiOut{layer == 0 ? c.x : c.out, c.out}, 64, DM / 256, 0);
        }
}

__global__ void __launch_bounds__(NTHREADS, 2) skel_fwd(Args args) {
    const Ctx c = make_ctx();
    volatile LAS unsigned* MISC = (volatile LAS unsigned*)(c.lds + MISC_OFF);
    for (int u = c.tid; u < (LDS_BYTES - 131072) / 4; u += NTHREADS) ((LAS unsigned*)(c.lds + 131072))[u] = 0u;
    __syncthreads();
    XcdBarrier bar; bar.bar = (unsigned*)(c.ws + WS_CTL) + CW_BAR; bar.x = 0; bar.st = nullptr;
    const int lo = args.ph_lo, hi = args.ph_hi;
    if (hi - lo > 1) bar = xcd_barrier_post((unsigned*)(c.ws + WS_CTL) + CW_BAR, MISC + 8);

#ifndef SLOT_ON
#define SLOT_ON(k) true
#endif
#define RUN_SLOT(k) if (SLOT_ON(k) && lo <= (k) && (k) < hi) { run_slot<k>(); if ((k) + 1 < hi) xcd_barrier(bar); }
    RUN_SLOT(0) RUN_SLOT(1) RUN_SLOT(2) RUN_SLOT(3) RUN_SLOT(4) RUN_SLOT(5) RUN_SLOT(6) RUN_SLOT(7) RUN_SLOT(8)
    RUN_SLOT(9) RUN_SLOT(10) RUN_SLOT(11) RUN_SLOT(12) RUN_SLOT(13) RUN_SLOT(14) RUN_SLOT(15) RUN_SLOT(16) RUN_SLOT(17)
#undef RUN_SLOT
}

extern "C" void kernel_launch(void* const* d_in, const int* in_sizes, int n_in, void* d_out, int out_size, void* d_ws, size_t ws_size, hipStream_t stream) {
    static int grid = 0;
    if (grid == 0) {
        if (n_in != 13 || out_size != M * DM || ws_size < WS_END) { fprintf(stderr, "kernel_launch: unexpected shapes (n_in %d out %d ws %zu need %zu)\n", n_in, out_size, ws_size, (size_t)WS_END); grid = -1; return; }
        int dev = 0, cus = 0, per_cu = 0;
        if (hipGetDevice(&dev) != hipSuccess || hipDeviceGetAttribute(&cus, hipDeviceAttributeMultiprocessorCount, dev) != hipSuccess) { grid = -1; return; }
        if (hipFuncSetAttribute((const void*)skel_fwd, hipFuncAttributeMaxDynamicSharedMemorySize, LDS_BYTES) != hipSuccess) { fprintf(stderr, "kernel_launch: hipFuncSetAttribute failed\n"); grid = -1; return; }
        if (hipOccupancyMaxActiveBlocksPerMultiprocessor(&per_cu, (const void*)skel_fwd, NTHREADS, LDS_BYTES) != hipSuccess || per_cu < 1) fprintf(stderr, "kernel_launch: occupancy query says %d\n", per_cu);
        (void)hipGetLastError();
        grid = cus;
    }
    if (grid < 0) return;
    (void)hipMemsetAsync((char*)d_ws + WS_CTL, 0, CTL_BYTES, stream);
    Args a{};
    for (int i = 0; i < 13; ++i) a.in[i] = (const float*)d_in[i];
    a.out = (float*)d_out; a.ws = (unsigned char*)d_ws;
#if MK_SINGLE
    a.ph_lo = 0; a.ph_hi = NSLOTS;
    hipLaunchKernelGGL(skel_fwd, dim3(grid), dim3(NTHREADS), LDS_BYTES, stream, a);
#else
    for (int s = 0; s < NSLOTS; ++s) { a.ph_lo = s; a.ph_hi = s + 1; hipLaunchKernelGGL(skel_fwd, dim3(grid), dim3(NTHREADS), LDS_BYTES, stream, a); }
#endif
}
```

```cpp
#include <hip/hip_runtime.h>
#include <cstdio>
#include <cstdint>

#ifndef MK_SINGLE
#define MK_SINGLE 1
#endif

#define GAS __attribute__((address_space(1)))
#define LAS __attribute__((address_space(3)))
typedef unsigned short bf16;
typedef short bf16x8 __attribute__((ext_vector_type(8)));
typedef float f32x4 __attribute__((ext_vector_type(4)));
typedef unsigned u32x4 __attribute__((ext_vector_type(4)));
typedef unsigned u32x2 __attribute__((ext_vector_type(2)));
typedef float f32x2_t __attribute__((ext_vector_type(2)));
typedef __bf16 bf16x2_t __attribute__((ext_vector_type(2)));
typedef GAS unsigned gu32;
#define RLX_AGENT __ATOMIC_RELAXED, __HIP_MEMORY_SCOPE_AGENT

constexpr int DM = 1024, NBATCH = 4, SEQ = 4096, M = NBATCH * SEQ, NMETA = 16, FR = 64, MOFF = 48, NPOS = SEQ + NMETA;
constexpr int NIN = 7592, NWAVES = 8, NTHREADS = NWAVES * 64;
constexpr float EPS = 1e-6f, LOG2E = 1.4426950408889634f, LN2 = 0.6931471805599453f;
constexpr float C2A = 0.125f * LOG2E, C2B = 0.10206207261596575f * LOG2E, C2C = 0.125f * LOG2E;
constexpr int LC_AQ = 0, LC_AK = 512, LC_AV = 1024, LC_AF = 1536, LC_AZ = 1544, LC_BCQ = 2056, LC_BCKV = 2440, LC_BKR = 2696, LC_BZ = 2728,
              LC_CQ = 3240, LC_CK = 3752, LC_CV = 3880, LC_CZ = 4008, LC_G = 4520;
constexpr int NE = 3072, NL = 4608, NUQ = 768, NUKV = 1024;
constexpr int PQA = 512, PKA = 640, PVA = 512, PQB = 768, PKB = 768, PVB = 512, PQC = 512, PKC = 128, PVC = 128, PCQ = 384, PCKV = 256, PY = 512, PG = 3072;

constexpr size_t MiB = 1u << 20;
constexpr size_t al(size_t x) { return (x + 255) & ~(size_t)255; }
constexpr size_t WS_CTL = 0, CTL_BYTES = 1 * MiB;
constexpr size_t WS_COS64 = CTL_BYTES, WS_SIN64 = WS_COS64 + al((size_t)NPOS * 32 * 4), WS_COS32 = WS_SIN64 + al((size_t)NPOS * 32 * 4), WS_SIN32 = WS_COS32 + al((size_t)NPOS * 16 * 4);
constexpr size_t WS_LF = WS_SIN32 + al((size_t)NPOS * 16 * 4), WS_RQ = WS_LF + al((size_t)M * 8 * 4), WS_RKV = WS_RQ + al((size_t)M * 4);
constexpr size_t WS_HM = WS_RKV + al((size_t)M * 4);
constexpr size_t WS_HNM = WS_HM + al(16 * 1024 * 4);
constexpr size_t WS_RAWE = WS_HNM + al(16 * 1024 * 2);
constexpr size_t WS_RAWU = WS_RAWE + al(16 * NE * 4);
constexpr size_t WS_RAWL = WS_RAWU + al(16 * (NUQ + NUKV) * 4);
constexpr size_t WS_RAWB = WS_RAWL + al(16 * NL * 4);
constexpr size_t WS_RAWO = WS_RAWB + al(3 * 16 * 1024 * 4);
constexpr size_t WS_YM = WS_RAWO + al(16 * 1024 * 4);
constexpr size_t WS_CM = WS_YM + al(16 * 1536 * 2);
constexpr size_t WS_RQM = WS_CM + al(16 * 640 * 2);
constexpr size_t WS_LFM = WS_RQM + al(32 * 4);
constexpr size_t WS_QAM = WS_LFM + al(16 * 8 * 4);
constexpr size_t WS_QBM = WS_QAM + al(16 * 512 * 2);
constexpr size_t WS_QCM = WS_QBM + al(16 * 768 * 2);
constexpr size_t WS_SMALL_END = WS_QCM + al(16 * 512 * 2);
constexpr size_t WL_EARLY = 0, WL_LATE = WL_EARLY + (size_t)NE * DM * 2, WL_UQ = WL_LATE + (size_t)NL * DM * 2, WL_UKV = WL_UQ + (size_t)NUQ * 384 * 2,
                 WL_BR = WL_UKV + (size_t)NUKV * 256 * 2, WL_OUT = WL_BR + (size_t)3 * DM * 512 * 2, WL_BYTES = WL_OUT + (size_t)DM * DM * 2;
constexpr size_t WS_W = 6 * MiB;
static_assert(WS_SMALL_END <= WS_W, "small region");
constexpr size_t WS_HN = WS_W + al(2 * WL_BYTES);
constexpr size_t WS_QA = WS_HN + (size_t)M * DM * 2;
constexpr size_t WS_QC = WS_QA + (size_t)M * PQA * 2;
constexpr size_t WS_CQ = WS_QC + (size_t)M * PQC * 2;
constexpr size_t WS_CKV = WS_CQ + (size_t)M * PCQ * 2;
constexpr size_t WS_YB = WS_CQ;
constexpr size_t WS_QB = WS_CKV + (size_t)M * PCKV * 2;
constexpr size_t WS_KB = WS_QB + (size_t)M * PQB * 2;
constexpr size_t WS_VB = WS_KB + (size_t)(FR + M) * PKB * 2;
constexpr size_t WS_KA = WS_VB + (size_t)(FR + M) * PVB * 2;
constexpr size_t WS_VA = WS_KA + (size_t)(FR + M) * PKA * 2;
constexpr size_t WS_KC = WS_VA + (size_t)(FR + M) * PVA * 2;
constexpr size_t WS_VC = WS_KC + (size_t)(FR + M) * PKC * 2;
constexpr size_t WS_END = WS_VC + (size_t)(FR + M) * PVC * 2;
constexpr size_t WS_G = WS_QB;
static_assert(WS_G + (size_t)M * PG * 2 <= WS_KC, "G overlay");
static_assert((size_t)M * PY * 2 <= (size_t)M * (PCQ + PCKV) * 2, "YB overlay");
static_assert(WS_END <= 256 * MiB, "workspace");

__device__ __forceinline__ unsigned cvtpk(float lo, float hi) { f32x2_t v = {lo, hi}; bf16x2_t b = __builtin_convertvector(v, bf16x2_t); return __builtin_bit_cast(unsigned, b); }
__device__ __forceinline__ bf16 f2bf(float f) { return (bf16)(cvtpk(f, 0.f) & 0xffffu); }
__device__ __forceinline__ float bf2f(bf16 v) { return __uint_as_float((unsigned)v << 16); }
__device__ __forceinline__ float bflo(unsigned w) { return __uint_as_float(w << 16); }
__device__ __forceinline__ float bfhi(unsigned w) { return __uint_as_float(w & 0xffff0000u); }
__device__ __forceinline__ float fexp2(float x) { return __builtin_amdgcn_exp2f(x); }
__device__ __forceinline__ float frcp(float x) { return __builtin_amdgcn_rcpf(x); }
__device__ __forceinline__ float sigmoidf_(float x) { return frcp(1.f + fexp2(-x * LOG2E)); }
__device__ __forceinline__ float siluf_(float x) { return x * sigmoidf_(x); }
__device__ __forceinline__ float logsigf_(float x) { return fminf(x, 0.f) - __builtin_amdgcn_logf(1.f + fexp2(-fabsf(x) * LOG2E)) * LN2; }
__device__ __forceinline__ float wave_sum(float v) {
#pragma unroll
    for (int o = 1; o < 64; o <<= 1) v += __shfl_xor(v, o);
    return v;
}
__device__ __forceinline__ u32x4 pack8(f32x4 a, f32x4 b) { u32x4 w; w.x = cvtpk(a[0], a[1]); w.y = cvtpk(a[2], a[3]); w.z = cvtpk(b[0], b[1]); w.w = cvtpk(b[2], b[3]); return w; }
__device__ __forceinline__ void st8(bf16* p, f32x4 a, f32x4 b) { *(u32x4*)p = pack8(a, b); }
__device__ __forceinline__ void ld8(const bf16* p, f32x4& a, f32x4& b) { const u32x4 w = *(const u32x4*)p; a = (f32x4){bflo(w.x), bfhi(w.x), bflo(w.y), bfhi(w.y)}; b = (f32x4){bflo(w.z), bfhi(w.z), bflo(w.w), bfhi(w.w)}; }
__device__ __forceinline__ void split3(float b, bf16& h, bf16& m, bf16& l) { h = f2bf(b); const float r1 = b - bf2f(h); m = f2bf(r1); const float r2 = r1 - bf2f(m); l = f2bf(r2); }

enum { MAP_EARLY = 0, MAP_LATE = 1, MAP_UQ = 2, MAP_ID = 3 };
__device__ __forceinline__ int map_col(int kind, int p) {
    const int t = p >> 8, c = p & 255, half = c >> 7, c7 = c & 127;
    if (kind == MAP_EARLY) {
        if (t < 2) return LC_AQ + p;
        if (t < 4) return LC_AK + (p - 512);
        if (t < 6) return LC_AV + (p - 1024);
        if (t < 8) return LC_CQ + 256 * (t - 6) + 64 * (c7 >> 5) + 32 * half + (c7 & 31);
        if (t == 8) { if (c7 < 64) return LC_CK + 64 * (c7 >> 5) + 32 * half + (c7 & 31); return LC_CV + 64 * half + (c7 - 64); }
        if (t == 9) return LC_BCQ + c;
        if (t == 10) { if (c7 < 64) return LC_BCQ + 256 + 64 * half + c7; if (c7 < 80) return LC_BKR + 16 * half + (c7 - 64); if (c7 < 88 && half == 0) return LC_AF + (c7 - 80); return -1; }
        return LC_BCKV + c;
    }
    if (kind == MAP_LATE) {
        if (t < 2) return LC_AZ + p;
        if (t < 4) return LC_BZ + (p - 512);
        if (t < 6) return LC_CZ + (p - 1024);
        return LC_G + (p - 1536);
    }
    if (kind == MAP_UQ) {
        if (t < 2) return (4 * t + (c >> 6)) * 96 + (c & 63);
        return (c7 >> 4) * 96 + 64 + 16 * half + (c7 & 15);
    }
    return p;
}

struct Ctx {
    const float *x, *meta, *norm_g, *w_in, *b_f, *g_cq, *g_ckv, *w_uq, *w_ukv, *sinks, *w_branch, *w_out, *final_g;
    float* out; unsigned char* ws;
    LAS unsigned char* lds;
    int tid, lane, wave, G, bid;
};
#define WSP(T, off) ((T*)(c.ws + (off)))
__device__ __forceinline__ bf16* wl(const Ctx& c, int layer, size_t off) { return (bf16*)(c.ws + WS_W + (size_t)layer * WL_BYTES + off); }

__device__ __forceinline__ void conv_item(const float* W, int N, const float* gv, bf16* Bt, int K, int kind, int nblk, int item, LAS float* scr, int lane) {
    const int kb = item / nblk, nb = item % nblk, k0 = 64 * kb, n0 = 32 * nb;
    const int lc = map_col(kind, n0 + (lane & 31));
#pragma unroll 8
    for (int i = 0; i < 32; ++i) { const int kk = 2 * i + (lane >> 5); float v = 0.f; if (lc >= 0) { v = W[(size_t)(k0 + kk) * N + lc]; if (gv) v *= gv[k0 + kk]; } scr[kk * 33 + (lane & 31)] = v; }
    asm volatile("s_waitcnt lgkmcnt(0)" ::: "memory");
    const int ch = lane & 7;
#pragma unroll
    for (int j = 0; j < 4; ++j) { const int n = (lane >> 3) + 8 * j; const LAS float* s = scr + (8 * ch) * 33 + n;
        u32x4 o; o.x = cvtpk(s[0 * 33], s[1 * 33]); o.y = cvtpk(s[2 * 33], s[3 * 33]); o.z = cvtpk(s[4 * 33], s[5 * 33]); o.w = cvtpk(s[6 * 33], s[7 * 33]);
        *(u32x4*)(Bt + (size_t)(n0 + n) * K + k0 + 8 * ch) = o; }
    asm volatile("s_waitcnt lgkmcnt(0)" ::: "memory");
}
__device__ __forceinline__ void zero_fronts(const Ctx& c) {
    const int g = c.bid * NTHREADS + c.tid, NG = c.G * NTHREADS;
    const u32x4 z = {0u, 0u, 0u, 0u};
    for (int e = g; e < MOFF * PKB / 8; e += NG) WSP(u32x4, WS_KB)[e] = z;
    for (int e = g; e < MOFF * PVB / 8; e += NG) WSP(u32x4, WS_VB)[e] = z;
    for (int e = g; e < MOFF * PKA / 8; e += NG) WSP(u32x4, WS_KA)[e] = z;
    for (int e = g; e < MOFF * PVA / 8; e += NG) WSP(u32x4, WS_VA)[e] = z;
    for (int e = g; e < MOFF * PKC / 8; e += NG) WSP(u32x4, WS_KC)[e] = z;
    for (int e = g; e < MOFF * PVC / 8; e += NG) WSP(u32x4, WS_VC)[e] = z;
}
__device__ __forceinline__ void sincos_d(float ang, float& s, float& co) {
    const double x = (double)ang, TWO_PI = 6.283185307179586476925, INV = 0.15915494309189533577;
    const double n = __builtin_rint(x * INV), r = __builtin_fma(-n, TWO_PI, x), y = 0.5 * r, y2 = y * y;
    double sp, cp;
    double ts = 1.0, tc = 1.0; sp = 1.0; cp = 1.0;
#pragma unroll
    for (int j = 1; j <= 12; ++j) { tc = -tc * y2 / (double)((2 * j - 1) * (2 * j)); ts = -ts * y2 / (double)((2 * j) * (2 * j + 1)); cp += tc; sp += ts; }
    const double sy = y * sp, cy = cp;
    s = (float)(2.0 * sy * cy); co = (float)(1.0 - 2.0 * sy * sy);
}
__device__ __forceinline__ void rope_tables(const Ctx& c) {
    const int g = c.bid * NTHREADS + c.tid, NG = c.G * NTHREADS;
    for (int e = g; e < NPOS * 48; e += NG) {
        const int pos = e / 48, i = e % 48;
        float inv; if (i < 32) inv = fexp2(-(float)i * (13.287712379549449f / 32.f)); else inv = fexp2(-(float)(i - 32) * (13.287712379549449f / 16.f));
        const float ang = (float)pos * inv; float s, co; sincos_d(ang, s, co);
        if (i < 32) { WSP(float, WS_COS64)[pos * 32 + i] = co; WSP(float, WS_SIN64)[pos * 32 + i] = s; }
        else { WSP(float, WS_COS32)[pos * 16 + i - 32] = co; WSP(float, WS_SIN32)[pos * 16 + i - 32] = s; }
    }
}
__device__ __forceinline__ void rms_row_to_bf16(const float* xrow, bf16* orow, float* copy, int lane) {
    const f32x4* xr = (const f32x4*)xrow + lane;
    f32x4 v[4]; float s = 0.f;
#pragma unroll
    for (int j = 0; j < 4; ++j) { v[j] = xr[64 * j]; s += (v[j][0] * v[j][0] + v[j][1] * v[j][1]) + (v[j][2] * v[j][2] + v[j][3] * v[j][3]); }
    const float rstd = 1.f / sqrtf(wave_sum(s) * (1.f / DM) + EPS);
    u32x2* o8 = (u32x2*)orow + lane;
#pragma unroll
    for (int j = 0; j < 4; ++j) { u32x2 w; w.x = cvtpk(v[j][0] * rstd, v[j][1] * rstd); w.y = cvtpk(v[j][2] * rstd, v[j][3] * rstd); o8[64 * j] = w; if (copy) ((f32x4*)copy + lane)[64 * j] = v[j]; }
}
__device__ __forceinline__ void slot0(const Ctx& c) {
    LAS float* scr = (LAS float*)(c.lds + c.wave * 16384);
    const int gw = c.bid * NWAVES + c.wave, NGW = c.G * NWAVES;
    for (int layer = 0; layer < 2; ++layer) {
        const float* w_in = c.w_in + (size_t)layer * DM * NIN;
        const int I_E = 16 * (NE / 32), I_L = 16 * (NL / 32), I_UQ = 6 * (NUQ / 32), I_UKV = 4 * (NUKV / 32), I_BR = 8 * (DM / 32), I_O = 16 * (DM / 32);
        const int tot = I_E + I_L + I_UQ + I_UKV + 3 * I_BR + I_O;
        for (int it = gw; it < tot; it += NGW) {
            int r = it;
            if (r < I_E) { conv_item(w_in, NIN, c.norm_g + layer * DM, wl(c, layer, WL_EARLY), DM, MAP_EARLY, NE / 32, r, scr, c.lane); continue; } r -= I_E;
            if (r < I_L) { conv_item(w_in, NIN, c.norm_g + layer * DM, wl(c, layer, WL_LATE), DM, MAP_LATE, NL / 32, r, scr, c.lane); continue; } r -= I_L;
            if (r < I_UQ) { conv_item(c.w_uq + (size_t)layer * 384 * 768, 768, c.g_cq + layer * 384, wl(c, layer, WL_UQ), 384, MAP_UQ, NUQ / 32, r, scr, c.lane); continue; } r -= I_UQ;
            if (r < I_UKV) { conv_item(c.w_ukv + (size_t)layer * 256 * 1024, 1024, c.g_ckv + layer * 256, wl(c, layer, WL_UKV), 256, MAP_ID, NUKV / 32, r, scr, c.lane); continue; } r -= I_UKV;
            if (r < 3 * I_BR) { const int n = r / I_BR; conv_item(c.w_branch + ((size_t)layer * 3 + n) * 512 * DM, DM, nullptr, wl(c, layer, WL_BR) + (size_t)n * DM * 512, 512, MAP_ID, DM / 32, r % I_BR, scr, c.lane); continue; } r -= 3 * I_BR;
            conv_item(c.w_out + (size_t)layer * DM * DM, DM, nullptr, wl(c, layer, WL_OUT), DM, MAP_ID, DM / 32, r, scr, c.lane);
        }
    }
    rope_tables(c);
    if (gw < 16) rms_row_to_bf16(c.meta + (size_t)gw * DM, WSP(bf16, WS_HNM) + (size_t)gw * DM, WSP(float, WS_HM) + (size_t)gw * DM, c.lane);
}

__device__ __forceinline__ void norm_main(const Ctx& c, const float* src) {
    const int gw = c.bid * NWAVES + c.wave, NGW = c.G * NWAVES;
    for (int m = gw; m < M; m += NGW) rms_row_to_bf16(src + (size_t)m * DM, WSP(bf16, WS_HN) + (size_t)m * DM, nullptr, c.lane);
}

template <class AF>
__device__ __forceinline__ void meta_block(const AF& af, const bf16* Bt, int K, int col0, float* raw, int ldraw, int rcol0, int lane) {
    f32x4 acc = {0.f, 0.f, 0.f, 0.f};
    const int r = lane & 15, kq = 8 * (lane >> 4);
    for (int k0 = 0; k0 < K; k0 += 32) {
        const bf16x8 a = af(r, k0 + kq);
        const bf16x8 b = *(const bf16x8*)(Bt + (size_t)(col0 + r) * K + k0 + kq);
        acc = __builtin_amdgcn_mfma_f32_16x16x32_bf16(a, b, acc, 0, 0, 0);
    }
#pragma unroll
    for (int x = 0; x < 4; ++x) raw[(size_t)(4 * (lane >> 4) + x) * ldraw + rcol0 + r] = acc[x];
}
struct AfPlain { const bf16* A; int lda; __device__ __forceinline__ bf16x8 operator()(int r, int k) const { return *(const bf16x8*)(A + (size_t)r * lda + k); } };
struct AfBranch {
    const bf16* ym; const float* rawl; int n;
    __device__ __forceinline__ bf16x8 operator()(int r, int k) const {
        f32x4 y0, y1; ld8(ym + (size_t)r * 1536 + n * 512 + k, y0, y1);
        const f32x4 z0 = *(const f32x4*)(rawl + (size_t)r * NL + 512 * n + k), z1 = *(const f32x4*)(rawl + (size_t)r * NL + 512 * n + k + 4);
#pragma unroll
        for (int j = 0; j < 4; ++j) { y0[j] *= siluf_(z0[j]); y1[j] *= siluf_(z1[j]); }
        return __builtin_bit_cast(bf16x8, pack8(y0, y1));
    }
};
struct AfMerged {
    const float* rawl; const float* rawb;
    __device__ __forceinline__ bf16x8 operator()(int r, int k) const {
        f32x4 s0 = {0.f, 0.f, 0.f, 0.f}, s1 = s0;
#pragma unroll
        for (int n = 0; n < 3; ++n) {
            const float* g = rawl + (size_t)r * NL + 1536 + n * 1024 + k; const float* p = rawb + ((size_t)n * 16 + r) * 1024 + k;
#pragma unroll
            for (int j = 0; j < 4; ++j) { s0[j] += sigmoidf_(g[j]) * p[j]; s1[j] += sigmoidf_(g[4 + j]) * p[4 + j]; }
        }
        return __builtin_bit_cast(bf16x8, pack8(s0, s1));
    }
};
template <class AF>
__device__ __forceinline__ void meta_blocks(const Ctx& c, const AF& af, const bf16* Bt, int K, int nblocks, float* raw, int ldraw, int rcol0) {
    const int gw = c.bid * NWAVES + c.wave, NGW = c.G * NWAVES;
    for (int b = gw; b < nblocks; b += NGW) meta_block(af, Bt, K, 16 * b, raw, ldraw, rcol0 + 16 * b, c.lane);
}

__device__ __forceinline__ void post_early(const Ctx& c, int layer) {
    const float* raw = WSP(float, WS_RAWE);
    bf16 *QAm = WSP(bf16, WS_QAM), *QCm = WSP(bf16, WS_QCM), *cm = WSP(bf16, WS_CM);
    bf16 *KAf = WSP(bf16, WS_KA), *VAf = WSP(bf16, WS_VA), *KBf = WSP(bf16, WS_KB), *KCf = WSP(bf16, WS_KC), *VCf = WSP(bf16, WS_VC);
    float* LFm = WSP(float, WS_LFM);
    const float *cos64 = WSP(float, WS_COS64), *sin64 = WSP(float, WS_SIN64), *cos32 = WSP(float, WS_COS32), *sin32 = WSP(float, WS_SIN32);
    for (int e = c.tid; e < 16 * NE; e += NTHREADS) {
        const int r = e / NE, p = e % NE, t = p >> 8, cc = p & 255, half = cc >> 7, c7 = cc & 127; const float v = raw[e];
        if (t < 2) QAm[r * PQA + p] = f2bf(v * C2A);
        else if (t < 4) { const int L = p - 512; KAf[(size_t)(MOFF + r) * PKA + (L >> 6) * 80 + (L & 63)] = f2bf(v); }
        else if (t < 6) VAf[(size_t)(MOFF + r) * PVA + (p - 1024)] = f2bf(v);
        else if (t < 8) { if (half == 0) { const int hh = c7 >> 5, d = c7 & 31, head = 4 * (t - 6) + hh; const float x1 = v, x2 = raw[e + 128], cs = cos64[r * 32 + d], sn = sin64[r * 32 + d];
                QCm[r * PQC + head * 64 + d] = f2bf((x1 * cs - x2 * sn) * C2C); QCm[r * PQC + head * 64 + 32 + d] = f2bf((x2 * cs + x1 * sn) * C2C); } }
        else if (t == 8) { if (c7 < 64) { if (half == 0) { const int hh = c7 >> 5, d = c7 & 31; const float x1 = v, x2 = raw[e + 128], cs = cos64[r * 32 + d], sn = sin64[r * 32 + d];
                    KCf[(size_t)(MOFF + r) * PKC + hh * 64 + d] = f2bf(x1 * cs - x2 * sn); KCf[(size_t)(MOFF + r) * PKC + hh * 64 + 32 + d] = f2bf(x2 * cs + x1 * sn); } }
            else VCf[(size_t)(MOFF + r) * PVC + 64 * half + (c7 - 64)] = f2bf(v); }
        else if (t == 9) cm[r * 640 + cc] = f2bf(v);
        else if (t == 10) { if (c7 < 64) cm[r * 640 + 256 + 64 * half + c7] = f2bf(v);
            else if (c7 < 80) { if (half == 0) { const int d = c7 - 64; const float x1 = v, x2 = raw[e + 128], cs = cos32[r * 16 + d], sn = sin32[r * 16 + d]; const bf16 o1 = f2bf(x1 * cs - x2 * sn), o2 = f2bf(x2 * cs + x1 * sn);
                    for (int h = 0; h < 8; ++h) { KBf[(size_t)(MOFF + r) * PKB + h * 96 + 64 + d] = o1; KBf[(size_t)(MOFF + r) * PKB + h * 96 + 80 + d] = o2; } } }
            else if (c7 < 88 && half == 0) LFm[r * 8 + (c7 - 80)] = logsigf_(v + c.b_f[layer * 8 + (c7 - 80)]); }
        else cm[r * 640 + 384 + cc] = f2bf(v);
    }
    __syncthreads();
    float* rqm = WSP(float, WS_RQM);
    if (c.tid < 16) { float s = 0.f; for (int k = 0; k < 384; ++k) { const float v = bf2f(cm[c.tid * 640 + k]); s += v * v; } rqm[c.tid] = 1.f / sqrtf(s * (1.f / 384.f) + EPS); }
    else if (c.tid < 32) { const int r = c.tid - 16; float s = 0.f; for (int k = 0; k < 256; ++k) { const float v = bf2f(cm[r * 640 + 384 + k]); s += v * v; } rqm[16 + r] = 1.f / sqrtf(s * (1.f / 256.f) + EPS); }
    else if (c.tid < 40) { const int h = c.tid - 32; float suf = 0.f;
        for (int r = 15; r >= 0; --r) { bf16 bh, bm, bl; split3(suf * LOG2E, bh, bm, bl); bf16* kp = KAf + (size_t)(MOFF + r) * PKA + h * 80 + 64; kp[0] = bh; kp[1] = bm; kp[2] = bl; for (int j = 3; j < 16; ++j) kp[j] = 0; suf += LFm[r * 8 + h]; } }
}
__device__ __forceinline__ void post_up(const Ctx& c) {
    const float* raw = WSP(float, WS_RAWU); const float* rqm = WSP(float, WS_RQM);
    bf16 *QBm = WSP(bf16, WS_QBM), *KBf = WSP(bf16, WS_KB), *VBf = WSP(bf16, WS_VB);
    const float *cos32 = WSP(float, WS_COS32), *sin32 = WSP(float, WS_SIN32);
    for (int e = c.tid; e < 16 * (NUQ + NUKV); e += NTHREADS) {
        const int r = e / (NUQ + NUKV), p = e % (NUQ + NUKV); const float v = raw[e];
        if (p < 512) { const int h = p >> 6, d = p & 63; QBm[r * PQB + h * 96 + d] = f2bf(v * rqm[r] * C2B); }
        else if (p < 768) { const int cc = p - 512, half = cc >> 7, c7 = cc & 127; if (half == 0) { const int h = c7 >> 4, d = c7 & 15; const float sc = rqm[r] * C2B, x1 = v * sc, x2 = raw[e + 128] * sc, cs = cos32[r * 16 + d], sn = sin32[r * 16 + d];
                QBm[r * PQB + h * 96 + 64 + d] = f2bf(x1 * cs - x2 * sn); QBm[r * PQB + h * 96 + 80 + d] = f2bf(x2 * cs + x1 * sn); } }
        else { const int q = p - 768, h = q >> 7, d = q & 127; const float w = v * rqm[16 + r];
            if (d < 64) KBf[(size_t)(MOFF + r) * PKB + h * 96 + d] = f2bf(w); else VBf[(size_t)(MOFF + r) * PVB + h * 64 + (d - 64)] = f2bf(w); }
    }
}
__device__ __forceinline__ void post_resid(const Ctx& c) {
    for (int r = c.wave; r < 16; r += NWAVES) {
        float* hm = WSP(float, WS_HM) + (size_t)r * DM; const float* ro = WSP(float, WS_RAWO) + (size_t)r * DM;
        f32x4 v[4]; float s = 0.f;
#pragma unroll
        for (int j = 0; j < 4; ++j) { v[j] = ((const f32x4*)hm + c.lane)[64 * j] + ((const f32x4*)ro + c.lane)[64 * j]; s += (v[j][0] * v[j][0] + v[j][1] * v[j][1]) + (v[j][2] * v[j][2] + v[j][3] * v[j][3]); }
        const float rstd = 1.f / sqrtf(wave_sum(s) * (1.f / DM) + EPS);
        u32x2* o8 = (u32x2*)(WSP(bf16, WS_HNM) + (size_t)r * DM) + c.lane;
#pragma unroll
        for (int j = 0; j < 4; ++j) { u32x2 w; w.x = cvtpk(v[j][0] * rstd, v[j][1] * rstd); w.y = cvtpk(v[j][2] * rstd, v[j][3] * rstd); o8[64 * j] = w; ((f32x4*)hm + c.lane)[64 * j] = v[j]; }
    }
}

template <int DK, int MODE>
__device__ __forceinline__ void attn_row(const bf16* qrow, const bf16* Kf, const bf16* Km, int kpitch, int koff, const bf16* Vf, const bf16* Vm, int vpitch, int voff, int t, float sink2, bf16* orow) {
    float q[DK];
#pragma unroll
    for (int d = 0; d < DK; d += 8) { f32x4 a, b; ld8(qrow + d, a, b);
#pragma unroll
        for (int j = 0; j < 4; ++j) { q[d + j] = a[j]; q[d + 4 + j] = b[j]; } }
    float o[64];
#pragma unroll
    for (int d = 0; d < 64; ++d) o[d] = 0.f;
    float m = -1e30f, l = 0.f; if (MODE == 2) { m = sink2; l = 1.f; }
    const int s0 = (MODE == 2) ? (t - 127 > 0 ? t - 127 : 0) : 0;
    for (int s = s0; s <= t; ++s) {
        const bf16* kp = (s < NMETA) ? Kf + (size_t)(MOFF + s) * kpitch + koff : Km + (size_t)(s - NMETA) * kpitch + koff;
        const bf16* vp = (s < NMETA) ? Vf + (size_t)(MOFF + s) * vpitch + voff : Vm + (size_t)(s - NMETA) * vpitch + voff;
        float x = 0.f;
#pragma unroll
        for (int d = 0; d < DK; d += 8) { f32x4 a, b; ld8(kp + d, a, b);
#pragma unroll
            for (int j = 0; j < 4; ++j) { x += q[d + j] * a[j]; x += q[d + 4 + j] * b[j]; } }
        if (MODE == 0) x += bf2f(kp[64]) + bf2f(kp[65]) + bf2f(kp[66]);
        if (x > m) { const float f = fexp2(m - x); l *= f;
#pragma unroll
            for (int d = 0; d < 64; ++d) o[d] *= f;
            m = x; }
        const float p = fexp2(x - m); l += p;
#pragma unroll
        for (int d = 0; d < 64; d += 8) { f32x4 a, b; ld8(vp + d, a, b);
#pragma unroll
            for (int j = 0; j < 4; ++j) { o[d + j] += p * a[j]; o[d + 4 + j] += p * b[j]; } }
    }
    const float il = 1.f / l;
#pragma unroll
    for (int d = 0; d < 64; d += 8) { f32x4 a = {o[d] * il, o[d + 1] * il, o[d + 2] * il, o[d + 3] * il}, b = {o[d + 4] * il, o[d + 5] * il, o[d + 6] * il, o[d + 7] * il}; st8(orow + d, a, b); }
}
__device__ __forceinline__ void attn_main_naive(const Ctx& c, int layer) {
    const int g = c.bid * NTHREADS + c.tid, NG = c.G * NTHREADS;
    for (int e = g; e < M * 8; e += NG) {
        const int i = e % SEQ, bh = e / SEQ, b = bh >> 3, h = bh & 7; const size_t row = (size_t)b * SEQ + i; const int t = NMETA + i;
        attn_row<64, 0>(WSP(bf16, WS_QA) + row * PQA + h * 64, WSP(bf16, WS_KA), WSP(bf16, WS_KA) + (size_t)(FR + b * SEQ) * PKA, PKA, h * 80,
                        WSP(bf16, WS_VA), WSP(bf16, WS_VA) + (size_t)(FR + b * SEQ) * PVA, PVA, h * 64, t, 0.f, WSP(bf16, WS_QA) + row * PQA + h * 64);
    }
    for (int e = g; e < M * 8; e += NG) {
        const int i = e % SEQ, bh = e / SEQ, b = bh >> 3, h = bh & 7; const size_t row = (size_t)b * SEQ + i; const int t = NMETA + i;
        attn_row<96, 1>(WSP(bf16, WS_QB) + row * PQB + h * 96, WSP(bf16, WS_KB), WSP(bf16, WS_KB) + (size_t)(FR + b * SEQ) * PKB, PKB, h * 96,
                        WSP(bf16, WS_VB), WSP(bf16, WS_VB) + (size_t)(FR + b * SEQ) * PVB, PVB, h * 64, t, 0.f, WSP(bf16, WS_YB) + row * PY + h * 64);
    }
    for (int e = g; e < M * 8; e += NG) {
        const int i = e % SEQ, bh = e / SEQ, b = bh >> 3, h = bh & 7; const size_t row = (size_t)b * SEQ + i; const int t = NMETA + i;
        attn_row<64, 2>(WSP(bf16, WS_QC) + row * PQC + h * 64, WSP(bf16, WS_KC), WSP(bf16, WS_KC) + (size_t)(FR + b * SEQ) * PKC, PKC, (h >> 2) * 64,
                        WSP(bf16, WS_VC), WSP(bf16, WS_VC) + (size_t)(FR + b * SEQ) * PVC, PVC, (h >> 2) * 64, t, c.sinks[layer * 8 + h] * LOG2E, WSP(bf16, WS_QC) + row * PQC + h * 64);
    }
}

namespace fa {
typedef float f32x16 __attribute__((ext_vector_type(16)));
typedef short s16x4 __attribute__((ext_vector_type(4)));
constexpr int KSLOT = 12288, VSLOT = 8192, OFF_K = 0, OFF_V = 2 * KSLOT, OFF_WS = OFF_V + 2 * VSLOT, OFF_OST = OFF_WS + NWAVES * 256, LDS_END = OFF_OST + NWAVES * 4096;
__device__ __forceinline__ int crow(int r, int hi) { return (r & 3) + 8 * (r >> 2) + 4 * hi; }
#define FA_SBAR() __builtin_amdgcn_sched_barrier(0)
__device__ __forceinline__ void pv(f32x16* o, int vb, bf16x8 pa0, bf16x8 pa1, bf16x8 pa2, bf16x8 pa3) {
#pragma unroll
    for (int d0 = 0; d0 < 2; ++d0) { s16x4 lo[4], hi[4];
#pragma unroll
        for (int ks = 0; ks < 4; ++ks) {
            asm volatile("ds_read_b64_tr_b16 %0,%1 offset:%c2" : "=&v"(lo[ks]) : "v"(vb), "i"(d0 * 4096 + ks * 1024) : "memory");
            asm volatile("ds_read_b64_tr_b16 %0,%1 offset:%c2" : "=&v"(hi[ks]) : "v"(vb), "i"(d0 * 4096 + ks * 1024 + 512) : "memory"); }
        asm volatile("s_waitcnt lgkmcnt(0)" ::: "memory"); FA_SBAR();
#define FA_PK(k) (bf16x8){lo[k][0], lo[k][1], lo[k][2], lo[k][3], hi[k][0], hi[k][1], hi[k][2], hi[k][3]}
        o[d0] = __builtin_amdgcn_mfma_f32_32x32x16_bf16(pa0, FA_PK(0), o[d0], 0, 0, 0);
        o[d0] = __builtin_amdgcn_mfma_f32_32x32x16_bf16(pa1, FA_PK(1), o[d0], 0, 0, 0);
        o[d0] = __builtin_amdgcn_mfma_f32_32x32x16_bf16(pa2, FA_PK(2), o[d0], 0, 0, 0);
        o[d0] = __builtin_amdgcn_mfma_f32_32x32x16_bf16(pa3, FA_PK(3), o[d0], 0, 0, 0);
#undef FA_PK
    }
}
struct Tensors { const bf16* Q; int qpitch, qoff; const bf16* Kf; const bf16* Km; int kpitch, koff; const bf16* Vf; const bf16* Vm; int vpitch, voff; bf16* O; int opitch, ooff; };
template <int NK, int MODE>
__device__ __forceinline__ void attn_unit(const Ctx& c, const Tensors& T, int j, float sink2) {
    constexpr int NCH = 2 * NK;
    LAS unsigned char* lds = c.lds;
    const int lane = c.lane, wid = c.wave, r32 = lane & 31, hi = lane >> 5;
    const unsigned lds0 = (unsigned)(size_t)lds;
    LAS float* wsf = (LAS float*)(lds + OFF_WS) + wid * 64;
    const int q0 = 256 * j;
    const int t_hi = 4 * j + 4, t_lo = (MODE == 2) ? (4 * j - 1 > 0 ? 4 * j - 1 : 0) : 0;
    bf16x8 qr[NK];
    { const bf16* qp = T.Q + (size_t)(q0 + wid * 32 + r32) * T.qpitch + T.qoff + hi * 8;
#pragma unroll
      for (int d0 = 0; d0 < NK; ++d0) { if (MODE == 0 && d0 == NK - 1) { const short one = (short)0x3F80; qr[d0] = hi ? (bf16x8){0, 0, 0, 0, 0, 0, 0, 0} : (bf16x8){one, one, one, 0, 0, 0, 0, 0}; } else qr[d0] = *(const bf16x8*)(qp + d0 * 16); } }
    u32x4 sk0, sk1 = {0u, 0u, 0u, 0u}, sv;
    const bool k2 = (wid + 8 < NCH);
#define FA_LOAD(t) do { const bf16* kt = ((t) == 0) ? T.Kf : T.Km + (size_t)(64 * ((t) - 1)) * T.kpitch; const bf16* vt = ((t) == 0) ? T.Vf : T.Vm + (size_t)(64 * ((t) - 1)) * T.vpitch; \
        sk0 = *(const u32x4*)(kt + (size_t)lane * T.kpitch + T.koff + wid * 8); if (k2) sk1 = *(const u32x4*)(kt + (size_t)lane * T.kpitch + T.koff + (wid + 8) * 8); \
        sv = *(const u32x4*)(vt + (size_t)(16 * (wid & 3) + (lane >> 2)) * T.vpitch + T.voff + (wid >> 2) * 32 + (lane & 3) * 8); } while (0)
#define FA_WRITE(b) do { *(LAS u32x4*)(lds + OFF_K + (b) * KSLOT + wid * 1024 + lane * 16) = sk0; if (k2) *(LAS u32x4*)(lds + OFF_K + (b) * KSLOT + (wid + 8) * 1024 + lane * 16) = sk1; \
        *(LAS u32x4*)(lds + OFF_V + (b) * VSLOT + wid * 1024 + lane * 16) = sv; } while (0)
    float m = (MODE == 2) ? sink2 : -INFINITY, l = (MODE == 2 && hi == 0) ? 1.f : 0.f;
    f32x16 o[2]; o[0] = f32x16{}; o[1] = f32x16{};
    const int qpos = NMETA + q0 + wid * 32 + r32;
    FA_LOAD(t_lo); FA_WRITE(0);
    int buf = 0;
    for (int t = t_lo; t <= t_hi; ++t) {
        __syncthreads();
        if (t < t_hi) FA_LOAD(t + 1);
        f32x16 p0 = f32x16{}, p1 = f32x16{};
        { const LAS unsigned char* kb = lds + OFF_K + buf * KSLOT + hi * 1024 + r32 * 16;
#pragma unroll
          for (int d0 = 0; d0 < NK; ++d0) { const bf16x8 b0 = *(const LAS bf16x8*)(kb + d0 * 2048), b1 = *(const LAS bf16x8*)(kb + d0 * 2048 + 512);
              p0 = __builtin_amdgcn_mfma_f32_32x32x16_bf16(b0, qr[d0], p0, 0, 0, 0); p1 = __builtin_amdgcn_mfma_f32_32x32x16_bf16(b1, qr[d0], p1, 0, 0, 0); } }
        const int kpos0 = (t == 0) ? -MOFF : NMETA + 64 * (t - 1);
        const bool need = (t == 0) || (t > t_hi - 4) || (MODE == 2);
        if (need) {
#pragma unroll
            for (int r = 0; r < 16; ++r) { const int ka = kpos0 + crow(r, hi), kb2 = ka + 32;
                bool ma = (ka > qpos) || (ka < 0), mb = (kb2 > qpos) || (kb2 < 0);
                if (MODE == 2) { ma = ma || (qpos - ka >= 128); mb = mb || (qpos - kb2 >= 128); }
                if (ma) p0[r] = -INFINITY; if (mb) p1[r] = -INFINITY; }
        }
        float rm = fmaxf(p0[0], p1[0]);
#pragma unroll
        for (int r = 1; r < 16; ++r) rm = fmaxf(rm, fmaxf(p0[r], p1[r]));
        { auto rr = __builtin_amdgcn_permlane32_swap(__float_as_uint(rm), __float_as_uint(rm), false, false); rm = fmaxf(__uint_as_float(rr[0]), __uint_as_float(rr[1])); }
        const float mn = fmaxf(m, rm);
        const bool grew = mn > m;
        const float alpha = (mn == -INFINITY) ? 1.f : fexp2(m - mn);
        const float msub = (mn == -INFINITY) ? 0.f : mn;
        float rs = 0.f;
#pragma unroll
        for (int r = 0; r < 16; ++r) { p0[r] = fexp2(p0[r] - msub); p1[r] = fexp2(p1[r] - msub); rs += p0[r] + p1[r]; }
        l = l * alpha + rs; m = mn;
        if (__any(grew)) {
            if (hi == 0) wsf[r32] = alpha;
            asm volatile("s_waitcnt lgkmcnt(0)" ::: "memory");
#pragma unroll
            for (int r = 0; r < 16; ++r) { const float f = wsf[crow(r, hi)]; o[0][r] *= f; o[1][r] *= f; }
        }
        u32x4 pw0, pw1, pw2, pw3;
        pw0 = (u32x4){cvtpk(p0[0], p0[1]), cvtpk(p0[2], p0[3]), cvtpk(p0[4], p0[5]), cvtpk(p0[6], p0[7])}; pw1 = (u32x4){cvtpk(p0[8], p0[9]), cvtpk(p0[10], p0[11]), cvtpk(p0[12], p0[13]), cvtpk(p0[14], p0[15])};
        pw2 = (u32x4){cvtpk(p1[0], p1[1]), cvtpk(p1[2], p1[3]), cvtpk(p1[4], p1[5]), cvtpk(p1[6], p1[7])}; pw3 = (u32x4){cvtpk(p1[8], p1[9]), cvtpk(p1[10], p1[11]), cvtpk(p1[12], p1[13]), cvtpk(p1[14], p1[15])};
        if (t < t_hi) FA_WRITE(buf ^ 1);
        const int vb = (int)(lds0 + OFF_V + buf * VSLOT) + ((lane >> 4) & 1) * 32 + (lane & 3) * 8 + (4 * hi + ((lane & 15) >> 2)) * 64;
        pv(o, vb, __builtin_bit_cast(bf16x8, pw0), __builtin_bit_cast(bf16x8, pw1), __builtin_bit_cast(bf16x8, pw2), __builtin_bit_cast(bf16x8, pw3));
        buf ^= 1;
    }
    { auto rr = __builtin_amdgcn_permlane32_swap(__float_as_uint(l), __float_as_uint(l), false, false); l = __uint_as_float(rr[0]) + __uint_as_float(rr[1]); }
    if (hi == 0) wsf[32 + r32] = l;
    asm volatile("s_waitcnt lgkmcnt(0)" ::: "memory");
    LAS bf16* stg = (LAS bf16*)(lds + OFF_OST) + wid * 2048;
#pragma unroll
    for (int r = 0; r < 16; ++r) { const int orow = crow(r, hi); const float rl = frcp(wsf[32 + orow]);
        stg[orow * 64 + r32] = f2bf(o[0][r] * rl); stg[orow * 64 + 32 + r32] = f2bf(o[1][r] * rl); }
    asm volatile("s_waitcnt lgkmcnt(0)" ::: "memory");
    bf16* Ow = T.O + (size_t)(q0 + wid * 32) * T.opitch + T.ooff;
#pragma unroll
    for (int i = 0; i < 4; ++i) { const int row = i * 8 + (lane >> 3), ch = lane & 7; const u32x4 v = *(const LAS u32x4*)(stg + row * 64 + ch * 8); *(u32x4*)(Ow + (size_t)row * T.opitch + ch * 8) = v; }
    __syncthreads();
#undef FA_LOAD
#undef FA_WRITE
}
#undef FA_SBAR
}
static_assert(fa::LDS_END <= 131072, "attention LDS");

__device__ __forceinline__ void attn_main_mfma(const Ctx& c, int layer) {
    const int vcu = (c.G % 8 == 0) ? (c.bid % 8) * (c.G / 8) + c.bid / 8 : c.bid;
    for (int u = vcu; u < 256; u += c.G) {
        const int bh = u >> 3, s8 = u & 7, b = bh >> 3, h = bh & 7; const size_t r0 = (size_t)b * SEQ;
        { fa::Tensors T{WSP(bf16, WS_QB) + r0 * PQB, PQB, h * 96, WSP(bf16, WS_KB), WSP(bf16, WS_KB) + (FR + r0) * PKB, PKB, h * 96, WSP(bf16, WS_VB), WSP(bf16, WS_VB) + (FR + r0) * PVB, PVB, h * 64, WSP(bf16, WS_YB) + r0 * PY, PY, h * 64};
          fa::attn_unit<6, 1>(c, T, 15 - s8, 0.f); fa::attn_unit<6, 1>(c, T, s8, 0.f); }
        { fa::Tensors T{WSP(bf16, WS_QA) + r0 * PQA, PQA, h * 64, WSP(bf16, WS_KA), WSP(bf16, WS_KA) + (FR + r0) * PKA, PKA, h * 80, WSP(bf16, WS_VA), WSP(bf16, WS_VA) + (FR + r0) * PVA, PVA, h * 64, WSP(bf16, WS_QA) + r0 * PQA, PQA, h * 64};
          fa::attn_unit<5, 0>(c, T, 15 - s8, 0.f); fa::attn_unit<5, 0>(c, T, s8, 0.f); }
        { fa::Tensors T{WSP(bf16, WS_QC) + r0 * PQC, PQC, h * 64, WSP(bf16, WS_KC), WSP(bf16, WS_KC) + (FR + r0) * PKC, PKC, (h >> 2) * 64, WSP(bf16, WS_VC), WSP(bf16, WS_VC) + (FR + r0) * PVC, PVC, (h >> 2) * 64, WSP(bf16, WS_QC) + r0 * PQC, PQC, h * 64};
          const float sk = c.sinks[layer * 8 + h] * LOG2E;
          fa::attn_unit<4, 2>(c, T, 15 - s8, sk); fa::attn_unit<4, 2>(c, T, s8, sk); }
    }
}

__device__ __forceinline__ void attn_meta(const Ctx& c) {
    if (c.tid >= 384) return;
    const int br = c.tid / 128, h = (c.tid >> 4) & 7, r = c.tid & 15; bf16* ym = WSP(bf16, WS_YM) + (size_t)r * 1536 + br * 512 + h * 64;
    if (br == 0) attn_row<64, 0>(WSP(bf16, WS_QAM) + r * PQA + h * 64, WSP(bf16, WS_KA), WSP(bf16, WS_KA), PKA, h * 80, WSP(bf16, WS_VA), WSP(bf16, WS_VA), PVA, h * 64, r, 0.f, ym);
    else if (br == 1) attn_row<96, 1>(WSP(bf16, WS_QBM) + r * PQB + h * 96, WSP(bf16, WS_KB), WSP(bf16, WS_KB), PKB, h * 96, WSP(bf16, WS_VB), WSP(bf16, WS_VB), PVB, h * 64, r, 0.f, ym);
    else attn_row<64, 2>(WSP(bf16, WS_QCM) + r * PQC + h * 64, WSP(bf16, WS_KC), WSP(bf16, WS_KC), PKC, (h >> 2) * 64, WSP(bf16, WS_VC), WSP(bf16, WS_VC), PVC, (h >> 2) * 64, r, c.sinks[h] * LOG2E, ym);
}

struct Unit { int pm, pn, z; };
__device__ __forceinline__ int perm32(int rho) { const int n = rho >> 4, i = rho & 15; return 8 * (i >> 2) + 4 * n + (i & 3); }
template <class Prob, class Epi, class Sched>
__device__ __forceinline__ void gemm_naive(const Ctx& c, const Prob& P, const Sched& S, const Epi& E) {
    const int wr = c.wave >> 2, wc = c.wave & 3, fr = c.lane & 15, fq = c.lane >> 4;
    Unit u;
    for (int ui = 0; S.next(ui, u); ++ui) {
        const bf16* A; const bf16* Bt; P.operands(u, A, Bt);
        const int K = P.K, lda = P.K;
        f32x4 acc[2][2][4][2];
#pragma unroll
        for (int a = 0; a < 2; ++a)
#pragma unroll
            for (int b = 0; b < 2; ++b)
#pragma unroll
                for (int m = 0; m < 4; ++m)
#pragma unroll
                    for (int n = 0; n < 2; ++n) acc[a][b][m][n] = (f32x4){0.f, 0.f, 0.f, 0.f};
        for (int k0 = 0; k0 < K; k0 += 64) {
#pragma unroll
            for (int ai = 0; ai < 2; ++ai) {
#pragma unroll
                for (int bj = 0; bj < 2; ++bj) {
                    bf16x8 Bf[2][2];
#pragma unroll
                    for (int n = 0; n < 2; ++n)
#pragma unroll
                        for (int k = 0; k < 2; ++k) Bf[n][k] = *(const bf16x8*)(Bt + (size_t)(256 * u.pn + 128 * bj + 32 * wc + perm32(16 * n + fr)) * K + k0 + 32 * k + 8 * fq);
#pragma unroll
                    for (int m = 0; m < 4; ++m) {
                        bf16x8 At[2];
#pragma unroll
                        for (int k = 0; k < 2; ++k) At[k] = *(const bf16x8*)(A + (size_t)(256 * u.pm + 128 * ai + 64 * wr + 16 * m + fr) * lda + k0 + 32 * k + 8 * fq);
#pragma unroll
                        for (int n = 0; n < 2; ++n)
#pragma unroll
                            for (int k = 0; k < 2; ++k) acc[ai][bj][m][n] = __builtin_amdgcn_mfma_f32_16x16x32_bf16(Bf[n][k], At[k], acc[ai][bj][m][n], 0, 0, 0);
                    }
                }
            }
        }
        asm volatile("" ::: "memory");
        E(acc, u, wr, wc, fr, fq);
    }
}
struct ProbSimple { const bf16* A; const bf16* Bt; int K;
    __device__ __forceinline__ void operands(const Unit&, const bf16*& a, const bf16*& b) const { a = A; b = Bt; } };
struct ProbBranch { const bf16 *A0, *A1, *A2; const bf16* Bt; int K;
    __device__ __forceinline__ void operands(const Unit& u, const bf16*& a, const bf16*& b) const { a = (u.z == 0) ? A0 : (u.z == 1) ? A1 : A2; b = Bt + (size_t)u.z * DM * 512; } };

namespace pg8 {
constexpr int BM = 256, BK = 64, HALF = 128, HTB = HALF * BK * 2, STAGE_BYTES = 8 * HTB, NXCD = 8, WGM = 8;
__host__ __device__ __forceinline__ int lds_byte(int r, int c) { const int st = (r >> 4) * 2 + (c >> 5), rr = r & 15, cc = c & 31, ob = rr * 64 + cc * 2; return st * 1024 + (ob ^ (((ob >> 9) & 1) << 5)); }
__host__ __device__ __forceinline__ void stage_rc(int b, int& R, int& C) { const int st = b / 1024, sb = b % 1024, swz = sb ^ (((sb >> 9) & 1) << 5); R = (st >> 1) * 16 + swz / 64; C = (st & 1) * 32 + (swz % 64) / 2; }
template <int ZN>
struct StaticOrder {
    int nM, nN, nwg, G, c, pn0;
    __device__ __forceinline__ void init(int nM_, int nN_, int pn0_, int G_, int c_) { nM = nM_; nN = nN_; nwg = nM * nN; G = G_; c = c_; pn0 = pn0_; }
    __device__ __forceinline__ bool next(int i, Unit& u) const {
        const int it = i / ZN;
        const long L = (long)it * G + c; if (L >= nwg) return false;
        int wgid = (int)L; { const int q = nwg / NXCD, r = nwg % NXCD, xcd = wgid % NXCD, off = wgid / NXCD; wgid = (xcd < r ? xcd * (q + 1) : r * (q + 1) + (xcd - r) * q) + off; }
        const int nig = WGM * nN, gid = wgid / nig, fm = gid * WGM, gsz = (nM - fm) < WGM ? (nM - fm) : WGM;
        u.pm = fm + ((wgid % nig) % gsz); u.pn = pn0 + (wgid % nig) / gsz; u.z = i - it * ZN; return true;
    }
};
template <class Prob, class Epi, class Sched, bool ALIGN_EPI, bool SP2>
__device__ __forceinline__ void gemm_phase(LAS unsigned char* lds, const Prob& P, const Sched& S, const Epi& E) {
    const int tid = threadIdx.x, wid = __builtin_amdgcn_readfirstlane(tid >> 6), lane = tid & 63, wr = wid >> 2, wc = wid & 3, fr = lane & 15, fq = lane >> 4;
    const int K = P.K, nt = K / BK;
    unsigned voffA[2], voffB[2];
#pragma unroll
    for (int i = 0; i < 2; ++i) { int R, C; stage_rc(tid * 16 + i * 8192, R, C); const int Rb = (R & ~31) + perm32(R & 31);
        voffA[i] = (unsigned)(R * K + C) * 2u; voffB[i] = (unsigned)(Rb * K + C) * 2u; }
    const size_t kstep = (size_t)(BK * 2);
    const size_t hstep = (size_t)HALF * K * 2;
    const size_t tstep = 2 * hstep;
    const unsigned ldsw = (unsigned)wid * 1024u;
    const int aoff = lds_byte(wr * 64 + fr, fq * 8), boff = lds_byte(wc * 32 + fr, fq * 8);
#define PG8_SA(b, h) (((b) * 2 + (h)) * HTB)
#define PG8_SB(b, h) ((4 + (b) * 2 + (h)) * HTB)
#define PG8_STAGE(bufoff, gbase, voff) do { _Pragma("unroll") for (int _i = 0; _i < 2; ++_i) \
        __builtin_amdgcn_global_load_lds((const unsigned*)((const char*)(gbase) + (voff)[_i]), (LAS unsigned*)(lds + (bufoff) + ldsw + _i * 8192), 16, 0, 0); } while (0)
#define PG8_LDA(dst, b, h) do { _Pragma("unroll") for (int m = 0; m < 4; ++m) _Pragma("unroll") for (int k = 0; k < 2; ++k) dst[m][k] = *(const LAS bf16x8*)(lds + PG8_SA(b, h) + aoff + m * 2048 + k * 1024); } while (0)
#define PG8_LDB(dst, b, h) do { _Pragma("unroll") for (int n = 0; n < 2; ++n) _Pragma("unroll") for (int k = 0; k < 2; ++k) dst[n][k] = *(const LAS bf16x8*)(lds + PG8_SB(b, h) + boff + n * 2048 + k * 1024); } while (0)
#define PG8_MMA(ai, bj, At, Bt) do { __builtin_amdgcn_s_setprio(1); _Pragma("unroll") for (int m = 0; m < 4; ++m) _Pragma("unroll") for (int n = 0; n < 2; ++n) _Pragma("unroll") for (int k = 0; k < 2; ++k) \
        acc[ai][bj][m][n] = __builtin_amdgcn_mfma_f32_16x16x32_bf16(Bt[n][k], At[m][k], acc[ai][bj][m][n], 0, 0, 0); __builtin_amdgcn_s_setprio(0); } while (0)
#define PG8_WAIT_V(n) asm volatile("s_waitcnt vmcnt(" #n ")" ::: "memory")
#define PG8_WAIT_L(n) asm volatile("s_waitcnt lgkmcnt(" #n ")" ::: "memory")
#define PG8_BAR __builtin_amdgcn_s_barrier()
#define PG8_SCHED __builtin_amdgcn_sched_barrier(0)
    Unit cur, nxt; int ui = 0;
    if (!S.next(0, cur)) return;
    f32x4 acc[2][2][4][2];
#pragma unroll
    for (int a = 0; a < 2; ++a)
#pragma unroll
        for (int b = 0; b < 2; ++b)
#pragma unroll
            for (int m = 0; m < 4; ++m)
#pragma unroll
                for (int n = 0; n < 2; ++n) acc[a][b][m][n] = (f32x4){0.f, 0.f, 0.f, 0.f};
    bf16x8 At[4][2], B0[2][2], B1[2][2];
    const char* cA; const char* cB;
    { const bf16 *pa, *pb; P.operands(cur, pa, pb); cA = (const char*)pa + (size_t)cur.pm * tstep; cB = (const char*)pb + (size_t)cur.pn * tstep; }
    if constexpr (SP2) {
        PG8_STAGE(PG8_SB(0, 0), cB, voffB); PG8_STAGE(PG8_SB(0, 1), cB + hstep, voffB); PG8_STAGE(PG8_SA(0, 0), cA, voffA); PG8_STAGE(PG8_SA(0, 1), cA + hstep, voffA);
        if (wr == 1) PG8_BAR;
        PG8_WAIT_V(2); PG8_BAR;
        PG8_STAGE(PG8_SB(1, 0), cB + kstep, voffB); PG8_STAGE(PG8_SA(1, 0), cA + kstep, voffA); PG8_STAGE(PG8_SB(1, 1), cB + hstep + kstep, voffB);
        PG8_WAIT_V(6); PG8_BAR;
    } else {
        PG8_STAGE(PG8_SB(0, 0), cB, voffB); PG8_STAGE(PG8_SA(0, 0), cA, voffA); PG8_STAGE(PG8_SB(0, 1), cB + hstep, voffB); PG8_STAGE(PG8_SA(0, 1), cA + hstep, voffA);
        if (wr == 1) PG8_BAR;
        PG8_WAIT_V(4); PG8_BAR;
        PG8_STAGE(PG8_SB(1, 0), cB + kstep, voffB); PG8_STAGE(PG8_SA(1, 0), cA + kstep, voffA); PG8_STAGE(PG8_SB(1, 1), cB + hstep + kstep, voffB);
        PG8_WAIT_V(6); PG8_BAR;
    }
    for (;;) {
        const bool has_next = S.next(ui + 1, nxt);
        const char* nA = cA; const char* nB = cB;
        if (has_next) { const bf16 *pa, *pb; P.operands(nxt, pa, pb); nA = (const char*)pa + (size_t)nxt.pm * tstep; nB = (const char*)pb + (size_t)nxt.pn * tstep; }
        for (int t = 0; t < nt; t += 2) {
            const bool last = (t == nt - 2);
            const char* a1 = cA + (size_t)(t + 1) * kstep;
            const char* a2 = last ? nA : cA + (size_t)(t + 2) * kstep; const char* b2 = last ? nB : cB + (size_t)(t + 2) * kstep;
            const char* a3 = a2 + kstep; const char* b3 = b2 + kstep;
            if constexpr (SP2) {
            PG8_LDB(B0, 0, 0); PG8_LDB(B1, 0, 1); PG8_SCHED; PG8_LDA(At, 0, 0); PG8_STAGE(PG8_SA(1, 1), a1 + hstep, voffA);
            PG8_WAIT_V(8); PG8_WAIT_L(0); PG8_BAR; PG8_MMA(0, 0, At, B0); PG8_MMA(0, 1, At, B1); PG8_BAR; PG8_SCHED;
            PG8_LDA(At, 0, 1); PG8_STAGE(PG8_SB(0, 0), b2, voffB); PG8_STAGE(PG8_SB(0, 1), b2 + hstep, voffB); PG8_STAGE(PG8_SA(0, 0), a2, voffA);
            PG8_WAIT_V(8); PG8_WAIT_L(0); PG8_BAR; PG8_MMA(1, 0, At, B0); PG8_MMA(1, 1, At, B1); PG8_BAR; PG8_SCHED;
            PG8_LDB(B0, 1, 0); PG8_LDB(B1, 1, 1); PG8_SCHED; PG8_LDA(At, 1, 0); PG8_STAGE(PG8_SA(0, 1), a2 + hstep, voffA);
            PG8_WAIT_V(8); PG8_WAIT_L(0); PG8_BAR; PG8_MMA(0, 0, At, B0); PG8_MMA(0, 1, At, B1); PG8_BAR; PG8_SCHED;
            PG8_LDA(At, 1, 1); PG8_STAGE(PG8_SB(1, 0), b3, voffB); PG8_STAGE(PG8_SB(1, 1), b3 + hstep, voffB); PG8_STAGE(PG8_SA(1, 0), a3, voffA);
            PG8_WAIT_V(8); PG8_WAIT_L(0); PG8_BAR; PG8_MMA(1, 0, At, B0); PG8_MMA(1, 1, At, B1); PG8_BAR; PG8_SCHED;
            } else {
            PG8_LDB(B0, 0, 0); PG8_SCHED; PG8_LDA(At, 0, 0); PG8_STAGE(PG8_SA(1, 1), a1 + hstep, voffA);
            PG8_WAIT_L(8); PG8_BAR; PG8_WAIT_L(0); PG8_MMA(0, 0, At, B0); PG8_BAR; PG8_SCHED;
            PG8_LDB(B1, 0, 1); PG8_STAGE(PG8_SB(0, 0), b2, voffB);
            PG8_BAR; PG8_WAIT_L(0); PG8_MMA(0, 1, At, B1); PG8_BAR;
            PG8_LDA(At, 0, 1); PG8_STAGE(PG8_SA(0, 0), a2, voffA);
            PG8_BAR; PG8_WAIT_L(0); PG8_MMA(1, 0, At, B0); PG8_BAR; PG8_SCHED;
            PG8_STAGE(PG8_SB(0, 1), b2 + hstep, voffB);
            PG8_WAIT_V(6); PG8_BAR; PG8_MMA(1, 1, At, B1); PG8_BAR;
            PG8_LDB(B0, 1, 0); PG8_SCHED; PG8_LDA(At, 1, 0); PG8_STAGE(PG8_SA(0, 1), a2 + hstep, voffA);
            PG8_WAIT_L(8); PG8_BAR; PG8_WAIT_L(0); PG8_MMA(0, 0, At, B0); PG8_BAR; PG8_SCHED;
            PG8_LDB(B1, 1, 1); PG8_STAGE(PG8_SB(1, 0), b3, voffB);
            PG8_BAR; PG8_WAIT_L(0); PG8_MMA(0, 1, At, B1); PG8_BAR;
            PG8_LDA(At, 1, 1); PG8_STAGE(PG8_SA(1, 0), a3, voffA);
            PG8_BAR; PG8_WAIT_L(0); PG8_MMA(1, 0, At, B0); PG8_BAR; PG8_SCHED;
            PG8_STAGE(PG8_SB(1, 1), b3 + hstep, voffB);
            PG8_WAIT_V(6); PG8_BAR; PG8_MMA(1, 1, At, B1); PG8_BAR;
            }
        }
        if constexpr (ALIGN_EPI) { if (wr == 0) PG8_BAR; }
        E(acc, cur, wr, wc, fr, fq);
        if (!has_next) break;
#pragma unroll
        for (int a = 0; a < 2; ++a)
#pragma unroll
            for (int b = 0; b < 2; ++b)
#pragma unroll
                for (int m = 0; m < 4; ++m)
#pragma unroll
                    for (int n = 0; n < 2; ++n) acc[a][b][m][n] = (f32x4){0.f, 0.f, 0.f, 0.f};
        cur = nxt; cA = nA; cB = nB; ++ui;
        if constexpr (ALIGN_EPI) { if (wr == 1) PG8_BAR; }
    }
    PG8_WAIT_V(0);
    if constexpr (!ALIGN_EPI) { if (wr == 0) PG8_BAR; }
    PG8_BAR;
#undef PG8_SA
#undef PG8_SB
#undef PG8_STAGE
#undef PG8_LDA
#undef PG8_LDB
#undef PG8_MMA
#undef PG8_WAIT_V
#undef PG8_WAIT_L
#undef PG8_BAR
#undef PG8_SCHED
}
}
#ifndef USE_PG8
#define USE_PG8 1
#endif
template <int ZN, class Prob, class Epi>
__device__ __forceinline__ void gemm_run(const Ctx& c, const Prob& P, const Epi& E, int nM, int nN, int pn0) {
#if USE_PG8
    pg8::StaticOrder<ZN> S; S.init(nM, nN, pn0, c.G, c.bid);
    pg8::gemm_phase<Prob, Epi, pg8::StaticOrder<ZN>, true, true>(c.lds, P, S, E);
#else
    pg8::StaticOrder<ZN> S; S.init(nM, nN, pn0, c.G, c.bid);
    gemm_naive(c, P, S, E);
#endif
}

#define EPI_ROWS_BEGIN _Pragma("unroll") for (int ai = 0; ai < 2; ++ai) _Pragma("unroll") for (int m = 0; m < 4; ++m) { const int row = 256 * u.pm + 128 * ai + 64 * wr + 16 * m + fr; \
    const f32x4 l0 = acc[ai][0][m][0], l1 = acc[ai][0][m][1], h0 = acc[ai][1][m][0], h1 = acc[ai][1][m][1]; (void)l0; (void)l1; (void)h0; (void)h1;
#define EPI_ROWS_END asm volatile("" ::: "memory"); }
typedef f32x4 Acc_t[2][2][4][2];

__device__ __forceinline__ void rope8(const float* cs, const float* sn, f32x4 x1a, f32x4 x1b, f32x4 x2a, f32x4 x2b, float sc, f32x4& o1a, f32x4& o1b, f32x4& o2a, f32x4& o2b) {
    const f32x4 ca = *(const f32x4*)cs, cb = *(const f32x4*)(cs + 4), sa = *(const f32x4*)sn, sb = *(const f32x4*)(sn + 4);
    o1a = (x1a * ca - x2a * sa) * sc; o1b = (x1b * cb - x2b * sb) * sc; o2a = (x2a * ca + x1a * sa) * sc; o2b = (x2b * cb + x1b * sb) * sc;
}
struct EpiEarly {
    const Ctx& c; int layer;
    __device__ __forceinline__ void operator()(const Acc_t& acc, const Unit& u, int wr, int wc, int fr, int fq) const {
        const int c8 = 32 * wc + 8 * fq, t = u.pn;
        bf16 *QA = WSP(bf16, WS_QA), *KA = WSP(bf16, WS_KA) + (size_t)FR * PKA, *VA = WSP(bf16, WS_VA) + (size_t)FR * PVA, *QC = WSP(bf16, WS_QC), *KC = WSP(bf16, WS_KC) + (size_t)FR * PKC,
             *VC = WSP(bf16, WS_VC) + (size_t)FR * PVC, *CQ = WSP(bf16, WS_CQ), *CKV = WSP(bf16, WS_CKV), *KB = WSP(bf16, WS_KB) + (size_t)FR * PKB;
        const float *cos64 = WSP(float, WS_COS64), *sin64 = WSP(float, WS_SIN64), *cos32 = WSP(float, WS_COS32), *sin32 = WSP(float, WS_SIN32);
        if (t < 2) { EPI_ROWS_BEGIN st8(QA + (size_t)row * PQA + 256 * t + c8, l0 * C2A, l1 * C2A); st8(QA + (size_t)row * PQA + 256 * t + 128 + c8, h0 * C2A, h1 * C2A); EPI_ROWS_END }
        else if (t < 4) { const int L0 = 256 * (t - 2) + c8, L1 = L0 + 128;
            EPI_ROWS_BEGIN st8(KA + (size_t)row * PKA + (L0 >> 6) * 80 + (L0 & 63), l0, l1); st8(KA + (size_t)row * PKA + (L1 >> 6) * 80 + (L1 & 63), h0, h1); EPI_ROWS_END }
        else if (t < 6) { EPI_ROWS_BEGIN st8(VA + (size_t)row * PVA + 256 * (t - 4) + c8, l0, l1); st8(VA + (size_t)row * PVA + 256 * (t - 4) + 128 + c8, h0, h1); EPI_ROWS_END }
        else if (t < 8) { const int head = 4 * (t - 6) + wc, d = 8 * fq;
            EPI_ROWS_BEGIN const int pos = NMETA + (row & (SEQ - 1)); f32x4 o1a, o1b, o2a, o2b; rope8(cos64 + pos * 32 + d, sin64 + pos * 32 + d, l0, l1, h0, h1, C2C, o1a, o1b, o2a, o2b);
                st8(QC + (size_t)row * PQC + head * 64 + d, o1a, o1b); st8(QC + (size_t)row * PQC + head * 64 + 32 + d, o2a, o2b); EPI_ROWS_END }
        else if (t == 8) {
            if (wc < 2) { const int d = 8 * fq;
                EPI_ROWS_BEGIN const int pos = NMETA + (row & (SEQ - 1)); f32x4 o1a, o1b, o2a, o2b; rope8(cos64 + pos * 32 + d, sin64 + pos * 32 + d, l0, l1, h0, h1, 1.f, o1a, o1b, o2a, o2b);
                    st8(KC + (size_t)row * PKC + wc * 64 + d, o1a, o1b); st8(KC + (size_t)row * PKC + wc * 64 + 32 + d, o2a, o2b); EPI_ROWS_END }
            else { const int j = 32 * (wc - 2) + 8 * fq;
                EPI_ROWS_BEGIN st8(VC + (size_t)row * PVC + j, l0, l1); st8(VC + (size_t)row * PVC + 64 + j, h0, h1); EPI_ROWS_END } }
        else if (t == 9) { EPI_ROWS_BEGIN st8(CQ + (size_t)row * PCQ + c8, l0, l1); st8(CQ + (size_t)row * PCQ + 128 + c8, h0, h1); EPI_ROWS_END }
        else if (t == 10) {
            if (wc < 2) { EPI_ROWS_BEGIN st8(CQ + (size_t)row * PCQ + 256 + c8, l0, l1); st8(CQ + (size_t)row * PCQ + 256 + 64 + c8, h0, h1); EPI_ROWS_END }
            else if (wc == 2) {
                if (fq < 2) { const int d = 8 * fq;
                    EPI_ROWS_BEGIN const int pos = NMETA + (row & (SEQ - 1)); f32x4 o1a, o1b, o2a, o2b; rope8(cos32 + pos * 16 + d, sin32 + pos * 16 + d, l0, l1, h0, h1, 1.f, o1a, o1b, o2a, o2b);
                        const u32x4 w1 = pack8(o1a, o1b), w2 = pack8(o2a, o2b);
#pragma unroll
                        for (int h = 0; h < 8; ++h) { *(u32x4*)(KB + (size_t)row * PKB + h * 96 + 64 + d) = w1; *(u32x4*)(KB + (size_t)row * PKB + h * 96 + 80 + d) = w2; } EPI_ROWS_END }
                else if (fq == 2) { float* LF = WSP(float, WS_LF); const f32x4 b0 = *(const f32x4*)(c.b_f + layer * 8), b1 = *(const f32x4*)(c.b_f + layer * 8 + 4);
                    EPI_ROWS_BEGIN f32x4 a = l0 + b0, b = l1 + b1;
#pragma unroll
                        for (int j = 0; j < 4; ++j) { a[j] = logsigf_(a[j]); b[j] = logsigf_(b[j]); }
                        *(f32x4*)(LF + (size_t)row * 8) = a; *(f32x4*)(LF + (size_t)row * 8 + 4) = b; EPI_ROWS_END } } }
        else { EPI_ROWS_BEGIN st8(CKV + (size_t)row * PCKV + c8, l0, l1); st8(CKV + (size_t)row * PCKV + 128 + c8, h0, h1); EPI_ROWS_END }
    }
};
struct EpiUq {
    const Ctx& c;
    __device__ __forceinline__ void operator()(const Acc_t& acc, const Unit& u, int wr, int wc, int fr, int fq) const {
        bf16* QB = WSP(bf16, WS_QB); const float* RQ = WSP(float, WS_RQ); const float *cos32 = WSP(float, WS_COS32), *sin32 = WSP(float, WS_SIN32);
        const int c8 = 32 * wc + 8 * fq;
        if (u.pn < 2) { const int ha = 4 * u.pn + (c8 >> 6), hb = ha + 2, e = c8 & 63;
            EPI_ROWS_BEGIN const float sc = RQ[row] * C2B; st8(QB + (size_t)row * PQB + ha * 96 + e, l0 * sc, l1 * sc); st8(QB + (size_t)row * PQB + hb * 96 + e, h0 * sc, h1 * sc); EPI_ROWS_END }
        else { const int h = c8 >> 4, d = c8 & 15;
            EPI_ROWS_BEGIN const float sc = RQ[row] * C2B; const int pos = NMETA + (row & (SEQ - 1)); f32x4 o1a, o1b, o2a, o2b; rope8(cos32 + pos * 16 + d, sin32 + pos * 16 + d, l0, l1, h0, h1, sc, o1a, o1b, o2a, o2b);
                st8(QB + (size_t)row * PQB + h * 96 + 64 + d, o1a, o1b); st8(QB + (size_t)row * PQB + h * 96 + 80 + d, o2a, o2b); EPI_ROWS_END }
    }
};
struct EpiUkv {
    const Ctx& c;
    __device__ __forceinline__ void operator()(const Acc_t& acc, const Unit& u, int wr, int wc, int fr, int fq) const {
        bf16 *KB = WSP(bf16, WS_KB) + (size_t)FR * PKB, *VB = WSP(bf16, WS_VB) + (size_t)FR * PVB; const float* RKV = WSP(float, WS_RKV);
        const int c8 = 32 * wc + 8 * fq, ha = 2 * u.pn, hb = ha + 1;
        if (wc < 2) { EPI_ROWS_BEGIN const float sc = RKV[row]; st8(KB + (size_t)row * PKB + ha * 96 + c8, l0 * sc, l1 * sc); st8(KB + (size_t)row * PKB + hb * 96 + c8, h0 * sc, h1 * sc); EPI_ROWS_END }
        else { EPI_ROWS_BEGIN const float sc = RKV[row]; st8(VB + (size_t)row * PVB + ha * 64 + c8 - 64, l0 * sc, l1 * sc); st8(VB + (size_t)row * PVB + hb * 64 + c8 - 64, h0 * sc, h1 * sc); EPI_ROWS_END }
    }
};
struct EpiLateZ {
    const Ctx& c;
    __device__ __forceinline__ void operator()(const Acc_t& acc, const Unit& u, int wr, int wc, int fr, int fq) const {
        const int c8 = 32 * wc + 8 * fq, t = u.pn;
        bf16* Y = (t < 2) ? WSP(bf16, WS_QA) : (t < 4) ? WSP(bf16, WS_YB) : WSP(bf16, WS_QC); const int col = 256 * (t & 1) + c8;
        EPI_ROWS_BEGIN
            { bf16* p = Y + (size_t)row * PY + col; f32x4 ya, yb; ld8(p, ya, yb);
#pragma unroll
              for (int j = 0; j < 4; ++j) { ya[j] *= siluf_(l0[j]); yb[j] *= siluf_(l1[j]); }
              st8(p, ya, yb); }
            { bf16* p = Y + (size_t)row * PY + col + 128; f32x4 ya, yb; ld8(p, ya, yb);
#pragma unroll
              for (int j = 0; j < 4; ++j) { ya[j] *= siluf_(h0[j]); yb[j] *= siluf_(h1[j]); }
              st8(p, ya, yb); }
        EPI_ROWS_END
    }
};
struct EpiLateG {
    const Ctx& c;
    __device__ __forceinline__ void operator()(const Acc_t& acc, const Unit& u, int wr, int wc, int fr, int fq) const {
        bf16* Gp = WSP(bf16, WS_G); const int col = 256 * (u.pn - 6) + 32 * wc + 8 * fq;
        EPI_ROWS_BEGIN f32x4 a = l0, b = l1, cc = h0, d = h1;
#pragma unroll
            for (int j = 0; j < 4; ++j) { a[j] = sigmoidf_(a[j]); b[j] = sigmoidf_(b[j]); cc[j] = sigmoidf_(cc[j]); d[j] = sigmoidf_(d[j]); }
            st8(Gp + (size_t)row * PG + col, a, b); st8(Gp + (size_t)row * PG + col + 128, cc, d); EPI_ROWS_END
    }
};
struct EpiBranch {
    const Ctx& c;
    __device__ __forceinline__ void operator()(const Acc_t& acc, const Unit& u, int wr, int wc, int fr, int fq) const {
        const bf16* Gp = WSP(bf16, WS_G); bf16* MG = WSP(bf16, WS_HN); const int col = 256 * u.pn + 32 * wc + 8 * fq;
        EPI_ROWS_BEGIN
#pragma unroll
            for (int bj = 0; bj < 2; ++bj) { f32x4 ga, gb; ld8(Gp + (size_t)row * PG + u.z * DM + col + 128 * bj, ga, gb); f32x4 va = (bj ? h0 : l0) * ga, vb = (bj ? h1 : l1) * gb;
                bf16* p = MG + (size_t)row * DM + col + 128 * bj; if (u.z > 0) { f32x4 pa, pb; ld8(p, pa, pb); va += pa; vb += pb; } st8(p, va, vb); } EPI_ROWS_END
    }
};
struct EpiOut {
    const float* resid; float* out;
    __device__ __forceinline__ void operator()(const Acc_t& acc, const Unit& u, int wr, int wc, int fr, int fq) const {
        const int col = 256 * u.pn + 32 * wc + 8 * fq;
        EPI_ROWS_BEGIN const size_t off = (size_t)row * DM + col;
            const f32x4 r0 = *(const f32x4*)(resid + off), r1 = *(const f32x4*)(resid + off + 4), r2 = *(const f32x4*)(resid + off + 128), r3 = *(const f32x4*)(resid + off + 132);
            *(f32x4*)(out + off) = r0 + l0; *(f32x4*)(out + off + 4) = r1 + l1; *(f32x4*)(out + off + 128) = r2 + h0; *(f32x4*)(out + off + 132) = r3 + h1; EPI_ROWS_END
    }
};

__device__ __forceinline__ void stats_cumsum(const Ctx& c) {
    const int gw = c.bid * NWAVES + c.wave, NGW = c.G * NWAVES;
    for (int m = gw; m < M; m += NGW) {
        float sq = 0.f, sk = 0.f;
        if (c.lane < 48) { f32x4 a, b; ld8(WSP(bf16, WS_CQ) + (size_t)m * PCQ + 8 * c.lane, a, b); sq = (a[0] * a[0] + a[1] * a[1]) + (a[2] * a[2] + a[3] * a[3]) + (b[0] * b[0] + b[1] * b[1]) + (b[2] * b[2] + b[3] * b[3]); }
        if (c.lane < 32) { f32x4 a, b; ld8(WSP(bf16, WS_CKV) + (size_t)m * PCKV + 8 * c.lane, a, b); sk = (a[0] * a[0] + a[1] * a[1]) + (a[2] * a[2] + a[3] * a[3]) + (b[0] * b[0] + b[1] * b[1]) + (b[2] * b[2] + b[3] * b[3]); }
        sq = wave_sum(sq); sk = wave_sum(sk);
        if (c.lane == 0) { WSP(float, WS_RQ)[m] = 1.f / sqrtf(sq * (1.f / 384.f) + EPS); WSP(float, WS_RKV)[m] = 1.f / sqrtf(sk * (1.f / 256.f) + EPS); }
    }
    LAS double* wsum = (LAS double*)(c.lds);
    for (int task = c.bid; task < NBATCH * 8; task += c.G) {
        const int b = task >> 3, h = task & 7; const float* LF = WSP(float, WS_LF) + (size_t)b * SEQ * 8 + h;
        double v[8]; double s = 0.0;
#pragma unroll
        for (int j = 0; j < 8; ++j) { s += (double)LF[(size_t)(8 * c.tid + j) * 8]; v[j] = s; }
        double inc = s;
#pragma unroll
        for (int o = 1; o < 64; o <<= 1) { const double n = __shfl_up(inc, o); if (c.lane >= o) inc += n; }
        __syncthreads();
        if (c.lane == 63) wsum[c.wave] = inc;
        __syncthreads();
        double base = inc - s;
        for (int w = 0; w < c.wave; ++w) base += wsum[w];
        bf16* KA = WSP(bf16, WS_KA) + (size_t)(FR + b * SEQ) * PKA + h * 80 + 64;
#pragma unroll
        for (int j = 0; j < 8; ++j) { const float bias = (float)(-(base + v[j]) * 1.4426950408889634); bf16 bh, bm, bl; split3(bias, bh, bm, bl);
            u32x4 w0 = {(unsigned)bh | ((unsigned)bm << 16), (unsigned)bl, 0u, 0u}, w1 = {0u, 0u, 0u, 0u}; bf16* kp = KA + (size_t)(8 * c.tid + j) * PKA; *(u32x4*)kp = w0; *(u32x4*)(kp + 8) = w1; }
    }
}
__device__ __forceinline__ void final_norm(const Ctx& c) {
    const int gw = c.bid * NWAVES + c.wave, NGW = c.G * NWAVES;
    for (int m = gw; m < M; m += NGW) {
        f32x4* xr = (f32x4*)(c.out + (size_t)m * DM) + c.lane; f32x4 v[4]; float s = 0.f;
#pragma unroll
        for (int j = 0; j < 4; ++j) { v[j] = xr[64 * j]; s += (v[j][0] * v[j][0] + v[j][1] * v[j][1]) + (v[j][2] * v[j][2] + v[j][3] * v[j][3]); }
        const float rstd = 1.f / sqrtf(wave_sum(s) * (1.f / DM) + EPS);
#pragma unroll
        for (int j = 0; j < 4; ++j) { const f32x4 g = ((const f32x4*)c.final_g + c.lane)[64 * j]; xr[64 * j] = v[j] * rstd * g; }
    }
}

#define XB_TMO      128
#define XB_XCNT(j)  (256  + 64 * (j))
#define XB_XSUB(j)  (1280 + 64 * (j))
#define XB_XGEN(j)  (2304 + 64 * (j))
#define XB_TOP      3328
#define XB_TOPGEN   3392
#define XCD_BAR_WORDS 3456
#define XB_SPIN_CAP (1u << 18)
__device__ __forceinline__ unsigned xb_ld(unsigned* p)              { return __hip_atomic_load(p, __ATOMIC_RELAXED, __HIP_MEMORY_SCOPE_AGENT); }
__device__ __forceinline__ unsigned xb_add(unsigned* p, unsigned v) { return __hip_atomic_fetch_add(p, v, __ATOMIC_RELAXED, __HIP_MEMORY_SCOPE_AGENT); }
__device__ __forceinline__ unsigned xb_xcc_id() { return (unsigned)__builtin_amdgcn_s_getreg((3 << 11) | 20) & 0xFu; }
#define XB_SPIN(cond, bar) do { unsigned _sp = 0; while (cond) { __builtin_amdgcn_s_sleep(1); \
    if ((++_sp & 255u) == 0u) { if (xb_ld(&(bar)[XB_TMO])) break; if (_sp > XB_SPIN_CAP) { atomicAdd(&(bar)[XB_TMO], 1u); break; } } } } while (0)
struct XcdBarrier { unsigned* bar; unsigned x; volatile LAS unsigned* st; };
__device__ __forceinline__ XcdBarrier xcd_barrier_post(unsigned* bar, volatile LAS unsigned* st) {
    XcdBarrier b; b.bar = bar; b.x = xb_xcc_id(); b.st = st;
    if (threadIdx.x == 0) (void)xb_add(&bar[XB_XCNT(b.x)], 1u);
    return b;
}
__device__ __forceinline__ void xcd_barrier_complete(unsigned* bar, unsigned x, unsigned& nloc, unsigned& nx) {
    const unsigned G = gridDim.x * gridDim.y * gridDim.z;
    unsigned sum, cnt, mine, sp = 0u;
    for (;;) {
        sum = 0u; cnt = 0u; mine = 0u;
#pragma unroll
        for (unsigned j = 0; j < 16; ++j) { const unsigned cc = xb_ld(&bar[XB_XCNT(j)]); sum += cc; cnt += (cc > 0u) ? 1u : 0u; mine = (j == x) ? cc : mine; }
        if (sum == G) break;
        __builtin_amdgcn_s_sleep(1);
        if ((++sp & 255u) == 0u) { if (xb_ld(&bar[XB_TMO])) break; if (sp > XB_SPIN_CAP) { atomicAdd(&bar[XB_TMO], 1u); break; } }
    }
    nloc = mine > 0u ? mine : 1u; nx = cnt > 0u ? cnt : 1u;
}
__device__ __forceinline__ void xcd_barrier(const XcdBarrier& b) {
    asm volatile("s_waitcnt vmcnt(0)" ::: "memory");
    __syncthreads();
    if (threadIdx.x == 0) {
        unsigned* bar = b.bar;
        __builtin_amdgcn_s_waitcnt(0);
        unsigned nloc = b.st[0], nx = b.st[1];
        if (nloc == 0u) { xcd_barrier_complete(bar, b.x, nloc, nx); b.st[0] = nloc; b.st[1] = nx; }
        const unsigned old = xb_add(&bar[XB_XSUB(b.x)], 1u);
        const unsigned gen = old / nloc;
        if (old + 1u == (gen + 1u) * nloc) {
            __builtin_amdgcn_fence(__ATOMIC_RELEASE, "agent");
            asm volatile("s_waitcnt vmcnt(0)" ::: "memory");
            const unsigned og = xb_add(&bar[XB_TOP], 1u);
            const unsigned tg = og / nx;
            if (og + 1u == (tg + 1u) * nx) xb_add(&bar[XB_TOPGEN], 1u);
            else XB_SPIN(xb_ld(&bar[XB_TOPGEN]) == tg, bar);
            __builtin_amdgcn_fence(__ATOMIC_ACQUIRE, "agent");
            xb_add(&bar[XB_XGEN(b.x)], 1u);
            asm volatile("s_waitcnt vmcnt(0)" ::: "memory");
        } else {
            XB_SPIN(xb_ld(&bar[XB_XGEN(b.x)]) == gen, bar);
            __builtin_amdgcn_fence(__ATOMIC_ACQUIRE, "agent");
            asm volatile("s_waitcnt vmcnt(0)" ::: "memory");
        }
    }
    __syncthreads();
}

constexpr int LDS_BYTES = 147456, MISC_OFF = 131072 + 320;
constexpr int NSLOTS = 18;
constexpr int CW_BAR = 4096;

struct Args { const float* in[13]; float* out; unsigned char* ws; int ph_lo, ph_hi, pad0, pad1; };
#define CAS __attribute__((address_space(4)))
__device__ __forceinline__ Ctx make_ctx() {
    const CAS char* kp = (const CAS char*)__builtin_amdgcn_kernarg_segment_ptr();
    asm volatile("" : "+s"(kp));
    const CAS Args* a = (const CAS Args*)kp;
    Ctx c;
    c.x = a->in[0]; c.meta = a->in[1]; c.norm_g = a->in[2]; c.w_in = a->in[3]; c.b_f = a->in[4]; c.g_cq = a->in[5]; c.g_ckv = a->in[6];
    c.w_uq = a->in[7]; c.w_ukv = a->in[8]; c.sinks = a->in[9]; c.w_branch = a->in[10]; c.w_out = a->in[11]; c.final_g = a->in[12];
    c.out = a->out; c.ws = a->ws;
    extern __shared__ __attribute__((aligned(16))) unsigned char lds_raw[];
    c.lds = (LAS unsigned char*)lds_raw;
    c.tid = threadIdx.x; c.lane = c.tid & 63; c.wave = __builtin_amdgcn_readfirstlane(c.tid >> 6); c.G = gridDim.x; c.bid = blockIdx.x;
    return c;
}

template <int SLOT>
__device__ __forceinline__ void run_slot() {
    const Ctx c = make_ctx();
    constexpr int slot = SLOT;
    constexpr int layer = (slot >= 9) ? 1 : 0;
    constexpr int ls = (slot >= 9) ? slot - 8 : slot;
        if constexpr (slot == 0) slot0(c);
        else if constexpr (slot == 17) final_norm(c);
        else if constexpr (ls == 1) {
            zero_fronts(c);
            norm_main(c, layer == 0 ? c.x : c.out);
            meta_blocks(c, AfPlain{WSP(bf16, WS_HNM), DM}, wl(c, layer, WL_EARLY), DM, NE / 16, WSP(float, WS_RAWE), NE, 0);
        } else if constexpr (ls == 2) {
            if (c.bid == 0) post_early(c, layer);
            ProbSimple P{WSP(bf16, WS_HN), wl(c, layer, WL_EARLY), DM};
            gemm_run<1>(c, P, EpiEarly{c, layer}, 64, NE / 256, 0);
        } else if constexpr (ls == 3) {
            { const AfPlain af{WSP(bf16, WS_CM), 640}; meta_blocks(c, af, wl(c, layer, WL_UQ), 384, NUQ / 16, WSP(float, WS_RAWU), NUQ + NUKV, 0);
              const AfPlain af2{WSP(bf16, WS_CM) + 384, 640}; meta_blocks(c, af2, wl(c, layer, WL_UKV), 256, NUKV / 16, WSP(float, WS_RAWU), NUQ + NUKV, NUQ); }
            stats_cumsum(c);
        } else if constexpr (ls == 4) {
            if (c.bid == 0) post_up(c);
            { ProbSimple P{WSP(bf16, WS_CQ), wl(c, layer, WL_UQ), 384}; gemm_run<1>(c, P, EpiUq{c}, 64, NUQ / 256, 0); }
            { ProbSimple P{WSP(bf16, WS_CKV), wl(c, layer, WL_UKV), 256}; gemm_run<1>(c, P, EpiUkv{c}, 64, NUKV / 256, 0); }
        } else if constexpr (ls == 5) {
            if (layer == 0) {
#ifndef NO_ATTNM
                if (c.bid == 0) attn_meta(c);
#endif
 meta_blocks(c, AfPlain{WSP(bf16, WS_HNM), DM}, wl(c, 0, WL_LATE), DM, NL / 16, WSP(float, WS_RAWL), NL, 0); }
#ifdef NAIVE_ATTN
            attn_main_naive(c, layer);
#else
            attn_main_mfma(c, layer);
#endif
        } else if constexpr (ls == 6) {
#ifndef NO_S67
            if (layer == 0) { for (int n = 0; n < 3; ++n) { const AfBranch af{WSP(bf16, WS_YM), WSP(float, WS_RAWL), n}; meta_blocks(c, af, wl(c, 0, WL_BR) + (size_t)n * DM * 512, 512, DM / 16, WSP(float, WS_RAWB) + (size_t)n * 16 * 1024, 1024, 0); } }
#endif
            { ProbSimple P{WSP(bf16, WS_HN), wl(c, layer, WL_LATE), DM}; gemm_run<1>(c, P, EpiLateZ{c}, 64, 6, 0); }
            { ProbSimple P{WSP(bf16, WS_HN), wl(c, layer, WL_LATE), DM}; gemm_run<1>(c, P, EpiLateG{c}, 64, 12, 6); }
        } else if constexpr (ls == 7) {
            if (layer == 0) { const AfMerged af{WSP(float, WS_RAWL), WSP(float, WS_RAWB)}; meta_blocks(c, af, wl(c, 0, WL_OUT), DM, DM / 16, WSP(float, WS_RAWO), DM, 0); }
            { ProbBranch P{WSP(bf16, WS_QA), WSP(bf16, WS_YB), WSP(bf16, WS_QC), wl(c, layer, WL_BR), 512}; gemm_run<3>(c, P, EpiBranch{c}, 64, 4, 0); }
        } else if constexpr (ls == 8) {
            if (layer == 0 && c.bid == 0) post_resid(c);
            ProbSimple P{WSP(bf16, WS_HN), wl(c, layer, WL_OUT), DM};
            gemm_run<1>(c, P, EpiOut{layer == 0 ? c.x : c.out, c.out}, 64, DM / 256, 0);
        }
}

__global__ void __launch_bounds__(NTHREADS, 2) skel_fwd(Args args) {
    const Ctx c = make_ctx();
    volatile LAS unsigned* MISC = (volatile LAS unsigned*)(c.lds + MISC_OFF);
    for (int u = c.tid; u < (LDS_BYTES - 131072) / 4; u += NTHREADS) ((LAS unsigned*)(c.lds + 131072))[u] = 0u;
    __syncthreads();
    XcdBarrier bar; bar.bar = (unsigned*)(c.ws + WS_CTL) + CW_BAR; bar.x = 0; bar.st = nullptr;
    const int lo = args.ph_lo, hi = args.ph_hi;
    if (hi - lo > 1) bar = xcd_barrier_post((unsigned*)(c.ws + WS_CTL) + CW_BAR, MISC + 8);

#ifndef SLOT_ON
#define SLOT_ON(k) true
#endif
#define RUN_SLOT(k) if (SLOT_ON(k) && lo <= (k) && (k) < hi) { run_slot<k>(); if ((k) + 1 < hi) xcd_barrier(bar); }
    RUN_SLOT(0) RUN_SLOT(1) RUN_SLOT(2) RUN_SLOT(3) RUN_SLOT(4) RUN_SLOT(5) RUN_SLOT(6) RUN_SLOT(7) RUN_SLOT(8)
    RUN_SLOT(9) RUN_SLOT(10) RUN_SLOT(11) RUN_SLOT(12) RUN_SLOT(13) RUN_SLOT(14) RUN_SLOT(15) RUN_SLOT(16) RUN_SLOT(17)
#undef RUN_SLOT
}

extern "C" void kernel_launch(void* const* d_in, const int* in_sizes, int n_in, void* d_out, int out_size, void* d_ws, size_t ws_size, hipStream_t stream) {
    static int grid = 0;
    if (grid == 0) {
        if (n_in != 13 || out_size != M * DM || ws_size < WS_END) { fprintf(stderr, "kernel_launch: unexpected shapes (n_in %d out %d ws %zu need %zu)\n", n_in, out_size, ws_size, (size_t)WS_END); grid = -1; return; }
        int dev = 0, cus = 0, per_cu = 0;
        if (hipGetDevice(&dev) != hipSuccess || hipDeviceGetAttribute(&cus, hipDeviceAttributeMultiprocessorCount, dev) != hipSuccess) { grid = -1; return; }
        if (hipFuncSetAttribute((const void*)skel_fwd, hipFuncAttributeMaxDynamicSharedMemorySize, LDS_BYTES) != hipSuccess) { fprintf(stderr, "kernel_launch: hipFuncSetAttribute failed\n"); grid = -1; return; }
        if (hipOccupancyMaxActiveBlocksPerMultiprocessor(&per_cu, (const void*)skel_fwd, NTHREADS, LDS_BYTES) != hipSuccess || per_cu < 1) fprintf(stderr, "kernel_launch: occupancy query says %d\n", per_cu);
        (void)hipGetLastError();
        grid = cus;
    }
    if (grid < 0) return;
    (void)hipMemsetAsync((char*)d_ws + WS_CTL, 0, CTL_BYTES, stream);
    Args a{};
    for (int i = 0; i < 13; ++i) a.in[i] = (const float*)d_in[i];
    a.out = (float*)d_out; a.ws = (unsigned char*)d_ws;
#if MK_SINGLE
    a.ph_lo = 0; a.ph_hi = NSLOTS;
    hipLaunchKernelGGL(skel_fwd, dim3(grid), dim3(NTHREADS), LDS_BYTES, stream, a);
#else
    for (int s = 0; s < NSLOTS; ++s) { a.ph_lo = s; a.ph_hi = s + 1; hipLaunchKernelGGL(skel_fwd, dim3(grid), dim3(NTHREADS), LDS_BYTES, stream, a); }
#endif
}
```

```cpp
#include <hip/hip_runtime.h>
#include <cstdio>
#include <cstdint>

#ifndef USE_FB
#define USE_FB 1
#endif
#ifndef MK_SINGLE
#define MK_SINGLE 1
#endif

#define GAS __attribute__((address_space(1)))
#define LAS __attribute__((address_space(3)))
typedef unsigned short bf16;
typedef short bf16x8 __attribute__((ext_vector_type(8)));
typedef float f32x4 __attribute__((ext_vector_type(4)));
typedef unsigned u32x4 __attribute__((ext_vector_type(4)));
typedef unsigned u32x2 __attribute__((ext_vector_type(2)));
typedef float f32x2_t __attribute__((ext_vector_type(2)));
typedef __bf16 bf16x2_t __attribute__((ext_vector_type(2)));
typedef GAS unsigned gu32;
#define RLX_AGENT __ATOMIC_RELAXED, __HIP_MEMORY_SCOPE_AGENT

constexpr int DM = 1024, NBATCH = 4, SEQ = 4096, M = NBATCH * SEQ, NMETA = 16, FR = 64, MOFF = 48, NPOS = SEQ + NMETA;
constexpr int NIN = 7592, NWAVES = 8, NTHREADS = NWAVES * 64;
constexpr float EPS = 1e-6f, LOG2E = 1.4426950408889634f, LN2 = 0.6931471805599453f;
constexpr float C2A = 0.125f * LOG2E, C2B = 0.10206207261596575f * LOG2E, C2C = 0.125f * LOG2E;
constexpr int LC_AQ = 0, LC_AK = 512, LC_AV = 1024, LC_AF = 1536, LC_AZ = 1544, LC_BCQ = 2056, LC_BCKV = 2440, LC_BKR = 2696, LC_BZ = 2728,
              LC_CQ = 3240, LC_CK = 3752, LC_CV = 3880, LC_CZ = 4008, LC_G = 4520;
constexpr int NE = 3072, NL = 4608, NUQ = 768, NUKV = 1024;
constexpr int PQA = 512, PKA = 640, PVA = 512, PQB = 768, PKB = 768, PVB = 512, PQC = 512, PKC = 128, PVC = 128, PCQ = 384, PCKV = 256, PY = 512, PG = 3072;

constexpr size_t MiB = 1u << 20;
constexpr size_t al(size_t x) { return (x + 255) & ~(size_t)255; }
constexpr size_t WS_CTL = 0, CTL_BYTES = 1 * MiB;
constexpr size_t WS_COS64 = CTL_BYTES, WS_SIN64 = WS_COS64 + al((size_t)NPOS * 32 * 4), WS_COS32 = WS_SIN64 + al((size_t)NPOS * 32 * 4), WS_SIN32 = WS_COS32 + al((size_t)NPOS * 16 * 4);
constexpr size_t WS_LF = WS_SIN32 + al((size_t)NPOS * 16 * 4), WS_RQ = WS_LF + al((size_t)M * 8 * 4), WS_RKV = WS_RQ + al((size_t)M * 4);
constexpr size_t WS_HM = WS_RKV + al((size_t)M * 4);
constexpr size_t WS_HNM = WS_HM + al(16 * 1024 * 4);
constexpr size_t WS_RAWE = WS_HNM + al(16 * 1024 * 2);
constexpr size_t WS_RAWU = WS_RAWE + al(16 * NE * 4);
constexpr size_t WS_RAWL = WS_RAWU + al(16 * (NUQ + NUKV) * 4);
constexpr size_t WS_RAWB = WS_RAWL + al(16 * NL * 4);
constexpr size_t WS_RAWO = WS_RAWB + al(3 * 16 * 1024 * 4);
constexpr size_t WS_YM = WS_RAWO + al(16 * 1024 * 4);
constexpr size_t WS_CM = WS_YM + al(16 * 1536 * 2);
constexpr size_t WS_RQM = WS_CM + al(16 * 640 * 2);
constexpr size_t WS_LFM = WS_RQM + al(32 * 4);
constexpr size_t WS_QAM = WS_LFM + al(16 * 8 * 4);
constexpr size_t WS_QBM = WS_QAM + al(16 * 512 * 2);
constexpr size_t WS_QCM = WS_QBM + al(16 * 768 * 2);
constexpr size_t WS_SMALL_END = WS_QCM + al(16 * 512 * 2);
constexpr size_t WL_EARLY = 0, WL_LATE = WL_EARLY + (size_t)NE * DM * 2, WL_UQ = WL_LATE + (size_t)NL * DM * 2, WL_UKV = WL_UQ + (size_t)NUQ * 384 * 2,
                 WL_BR = WL_UKV + (size_t)NUKV * 256 * 2, WL_OUT = WL_BR + (size_t)3 * DM * 512 * 2, WL_BYTES = WL_OUT + (size_t)DM * DM * 2;
constexpr size_t WS_W = 6 * MiB;
static_assert(WS_SMALL_END <= WS_W, "small region");
constexpr size_t WS_HN = WS_W + al(2 * WL_BYTES);
constexpr size_t WS_QA = WS_HN + (size_t)M * DM * 2;
constexpr size_t WS_QC = WS_QA + (size_t)M * PQA * 2;
constexpr size_t WS_CQ = WS_QC + (size_t)M * PQC * 2;
constexpr size_t WS_CKV = WS_CQ + (size_t)M * PCQ * 2;
constexpr size_t WS_YB = WS_CQ;
constexpr size_t WS_QB = WS_CKV + (size_t)M * PCKV * 2;
constexpr size_t WS_KB = WS_QB + (size_t)M * PQB * 2;
constexpr size_t WS_VB = WS_KB + (size_t)(FR + M) * PKB * 2;
constexpr size_t WS_KA = WS_VB + (size_t)(FR + M) * PVB * 2;
constexpr size_t WS_VA = WS_KA + (size_t)(FR + M) * PKA * 2;
constexpr size_t WS_KC = WS_VA + (size_t)(FR + M) * PVA * 2;
constexpr size_t WS_VC = WS_KC + (size_t)(FR + M) * PKC * 2;
constexpr size_t WS_END = WS_VC + (size_t)(FR + M) * PVC * 2;
constexpr size_t WS_G = WS_QB;
static_assert(WS_G + (size_t)M * PG * 2 <= WS_KC, "G overlay");
static_assert((size_t)M * PY * 2 <= (size_t)M * (PCQ + PCKV) * 2, "YB overlay");
static_assert(WS_END <= 256 * MiB, "workspace");

__device__ __forceinline__ unsigned cvtpk(float lo, float hi) { f32x2_t v = {lo, hi}; bf16x2_t b = __builtin_convertvector(v, bf16x2_t); return __builtin_bit_cast(unsigned, b); }
__device__ __forceinline__ bf16 f2bf(float f) { return (bf16)(cvtpk(f, 0.f) & 0xffffu); }
__device__ __forceinline__ float bf2f(bf16 v) { return __uint_as_float((unsigned)v << 16); }
__device__ __forceinline__ float bflo(unsigned w) { return __uint_as_float(w << 16); }
__device__ __forceinline__ float bfhi(unsigned w) { return __uint_as_float(w & 0xffff0000u); }
__device__ __forceinline__ float fexp2(float x) { return __builtin_amdgcn_exp2f(x); }
__device__ __forceinline__ float frcp(float x) { return __builtin_amdgcn_rcpf(x); }
__device__ __forceinline__ float sigmoidf_(float x) { return frcp(1.f + fexp2(-x * LOG2E)); }
__device__ __forceinline__ float siluf_(float x) { return x * sigmoidf_(x); }
__device__ __forceinline__ float logsigf_(float x) { return fminf(x, 0.f) - __builtin_amdgcn_logf(1.f + fexp2(-fabsf(x) * LOG2E)) * LN2; }
__device__ __forceinline__ float wave_sum(float v) {
#pragma unroll
    for (int o = 1; o < 64; o <<= 1) v += __shfl_xor(v, o);
    return v;
}
__device__ __forceinline__ u32x4 pack8(f32x4 a, f32x4 b) { u32x4 w; w.x = cvtpk(a[0], a[1]); w.y = cvtpk(a[2], a[3]); w.z = cvtpk(b[0], b[1]); w.w = cvtpk(b[2], b[3]); return w; }
__device__ __forceinline__ void st8(bf16* p, f32x4 a, f32x4 b) { *(u32x4*)p = pack8(a, b); }
__device__ __forceinline__ void ld8(const bf16* p, f32x4& a, f32x4& b) { const u32x4 w = *(const u32x4*)p; a = (f32x4){bflo(w.x), bfhi(w.x), bflo(w.y), bfhi(w.y)}; b = (f32x4){bflo(w.z), bfhi(w.z), bflo(w.w), bfhi(w.w)}; }
__device__ __forceinline__ void split3(float b, bf16& h, bf16& m, bf16& l) { h = f2bf(b); const float r1 = b - bf2f(h); m = f2bf(r1); const float r2 = r1 - bf2f(m); l = f2bf(r2); }

enum { MAP_EARLY = 0, MAP_LATE = 1, MAP_UQ = 2, MAP_ID = 3 };
__device__ __forceinline__ int map_col(int kind, int p) {
    const int t = p >> 8, c = p & 255, half = c >> 7, c7 = c & 127;
    if (kind == MAP_EARLY) {
        if (t < 2) return LC_AQ + p;
        if (t < 4) return LC_AK + (p - 512);
        if (t < 6) return LC_AV + (p - 1024);
        if (t < 8) return LC_CQ + 256 * (t - 6) + 64 * (c7 >> 5) + 32 * half + (c7 & 31);
        if (t == 8) { if (c7 < 64) return LC_CK + 64 * (c7 >> 5) + 32 * half + (c7 & 31); return LC_CV + 64 * half + (c7 - 64); }
        if (t == 9) return LC_BCQ + c;
        if (t == 10) { if (c7 < 64) return LC_BCQ + 256 + 64 * half + c7; if (c7 < 80) return LC_BKR + 16 * half + (c7 - 64); if (c7 < 88 && half == 0) return LC_AF + (c7 - 80); return -1; }
        return LC_BCKV + c;
    }
    if (kind == MAP_LATE) {
        if (t < 2) return LC_AZ + p;
        if (t < 4) return LC_BZ + (p - 512);
        if (t < 6) return LC_CZ + (p - 1024);
        return LC_G + (p - 1536);
    }
    if (kind == MAP_UQ) {
        if (t < 2) return (4 * t + (c >> 6)) * 96 + (c & 63);
        return (c7 >> 4) * 96 + 64 + 16 * half + (c7 & 15);
    }
    return p;
}

struct Ctx {
    const float *x, *meta, *norm_g, *w_in, *b_f, *g_cq, *g_ckv, *w_uq, *w_ukv, *sinks, *w_branch, *w_out, *final_g;
    float* out; unsigned char* ws;
    LAS unsigned char* lds;
    int tid, lane, wave, G, bid;
};
#define WSP(T, off) ((T*)(c.ws + (off)))
__device__ __forceinline__ bf16* wl(const Ctx& c, int layer, size_t off) { return (bf16*)(c.ws + WS_W + (size_t)layer * WL_BYTES + off); }

__device__ __forceinline__ void conv_item(const float* W, int N, const float* gv, bf16* Bt, int K, int kind, int nblk, int item, LAS float* scr, int lane) {
    const int kb = item / nblk, nb = item % nblk, k0 = 64 * kb, n0 = 32 * nb;
    const int lc = map_col(kind, n0 + (lane & 31));
#pragma unroll 8
    for (int i = 0; i < 32; ++i) { const int kk = 2 * i + (lane >> 5); float v = 0.f; if (lc >= 0) { v = W[(size_t)(k0 + kk) * N + lc]; if (gv) v *= gv[k0 + kk]; } scr[kk * 33 + (lane & 31)] = v; }
    asm volatile("s_waitcnt lgkmcnt(0)" ::: "memory");
    const int ch = lane & 7;
#pragma unroll
    for (int j = 0; j < 4; ++j) { const int n = (lane >> 3) + 8 * j; const LAS float* s = scr + (8 * ch) * 33 + n;
        u32x4 o; o.x = cvtpk(s[0 * 33], s[1 * 33]); o.y = cvtpk(s[2 * 33], s[3 * 33]); o.z = cvtpk(s[4 * 33], s[5 * 33]); o.w = cvtpk(s[6 * 33], s[7 * 33]);
        *(u32x4*)(Bt + (size_t)(n0 + n) * K + k0 + 8 * ch) = o; }
    asm volatile("s_waitcnt lgkmcnt(0)" ::: "memory");
}
__device__ __forceinline__ void zero_fronts(const Ctx& c) {
    const int g = c.bid * NTHREADS + c.tid, NG = c.G * NTHREADS;
    const u32x4 z = {0u, 0u, 0u, 0u};
    for (int e = g; e < MOFF * PKB / 8; e += NG) WSP(u32x4, WS_KB)[e] = z;
    for (int e = g; e < MOFF * PVB / 8; e += NG) WSP(u32x4, WS_VB)[e] = z;
    for (int e = g; e < MOFF * PKA / 8; e += NG) WSP(u32x4, WS_KA)[e] = z;
    for (int e = g; e < MOFF * PVA / 8; e += NG) WSP(u32x4, WS_VA)[e] = z;
    for (int e = g; e < MOFF * PKC / 8; e += NG) WSP(u32x4, WS_KC)[e] = z;
    for (int e = g; e < MOFF * PVC / 8; e += NG) WSP(u32x4, WS_VC)[e] = z;
}
__device__ __forceinline__ void sincos_d(float ang, float& s, float& co) {
    const double x = (double)ang, TWO_PI = 6.283185307179586476925, INV = 0.15915494309189533577;
    const double n = __builtin_rint(x * INV), r = __builtin_fma(-n, TWO_PI, x), y = 0.5 * r, y2 = y * y;
    double sp, cp;
    double ts = 1.0, tc = 1.0; sp = 1.0; cp = 1.0;
#pragma unroll
    for (int j = 1; j <= 12; ++j) { tc = -tc * y2 / (double)((2 * j - 1) * (2 * j)); ts = -ts * y2 / (double)((2 * j) * (2 * j + 1)); cp += tc; sp += ts; }
    const double sy = y * sp, cy = cp;
    s = (float)(2.0 * sy * cy); co = (float)(1.0 - 2.0 * sy * sy);
}
__device__ __forceinline__ void rope_tables(const Ctx& c) {
    const int g = c.bid * NTHREADS + c.tid, NG = c.G * NTHREADS;
    for (int e = g; e < NPOS * 48; e += NG) {
        const int pos = e / 48, i = e % 48;
        float inv; if (i < 32) inv = fexp2(-(float)i * (13.287712379549449f / 32.f)); else inv = fexp2(-(float)(i - 32) * (13.287712379549449f / 16.f));
        const float ang = (float)pos * inv; float s, co; sincos_d(ang, s, co);
        if (i < 32) { WSP(float, WS_COS64)[pos * 32 + i] = co; WSP(float, WS_SIN64)[pos * 32 + i] = s; }
        else { WSP(float, WS_COS32)[pos * 16 + i - 32] = co; WSP(float, WS_SIN32)[pos * 16 + i - 32] = s; }
    }
}
__device__ __forceinline__ void rms_row_to_bf16(const float* xrow, bf16* orow, float* copy, int lane) {
    const f32x4* xr = (const f32x4*)xrow + lane;
    f32x4 v[4]; float s = 0.f;
#pragma unroll
    for (int j = 0; j < 4; ++j) { v[j] = xr[64 * j]; s += (v[j][0] * v[j][0] + v[j][1] * v[j][1]) + (v[j][2] * v[j][2] + v[j][3] * v[j][3]); }
    const float rstd = 1.f / sqrtf(wave_sum(s) * (1.f / DM) + EPS);
    u32x2* o8 = (u32x2*)orow + lane;
#pragma unroll
    for (int j = 0; j < 4; ++j) { u32x2 w; w.x = cvtpk(v[j][0] * rstd, v[j][1] * rstd); w.y = cvtpk(v[j][2] * rstd, v[j][3] * rstd); o8[64 * j] = w; if (copy) ((f32x4*)copy + lane)[64 * j] = v[j]; }
}
__device__ __forceinline__ void slot0(const Ctx& c) {
    LAS float* scr = (LAS float*)(c.lds + c.wave * 16384);
    const int gw = c.bid * NWAVES + c.wave, NGW = c.G * NWAVES;
    for (int layer = 0; layer < 2; ++layer) {
        const float* w_in = c.w_in + (size_t)layer * DM * NIN;
        const int I_E = 16 * (NE / 32), I_L = 16 * (NL / 32), I_UQ = 6 * (NUQ / 32), I_UKV = 4 * (NUKV / 32), I_BR = 8 * (DM / 32), I_O = 16 * (DM / 32);
        const int tot = I_E + I_L + I_UQ + I_UKV + 3 * I_BR + I_O;
        for (int it = gw; it < tot; it += NGW) {
            int r = it;
            if (r < I_E) { conv_item(w_in, NIN, c.norm_g + layer * DM, wl(c, layer, WL_EARLY), DM, MAP_EARLY, NE / 32, r, scr, c.lane); continue; } r -= I_E;
            if (r < I_L) { conv_item(w_in, NIN, c.norm_g + layer * DM, wl(c, layer, WL_LATE), DM, MAP_LATE, NL / 32, r, scr, c.lane); continue; } r -= I_L;
            if (r < I_UQ) { conv_item(c.w_uq + (size_t)layer * 384 * 768, 768, c.g_cq + layer * 384, wl(c, layer, WL_UQ), 384, MAP_UQ, NUQ / 32, r, scr, c.lane); continue; } r -= I_UQ;
            if (r < I_UKV) { conv_item(c.w_ukv + (size_t)layer * 256 * 1024, 1024, c.g_ckv + layer * 256, wl(c, layer, WL_UKV), 256, MAP_ID, NUKV / 32, r, scr, c.lane); continue; } r -= I_UKV;
            if (r < 3 * I_BR) { const int n = r / I_BR; conv_item(c.w_branch + ((size_t)layer * 3 + n) * 512 * DM, DM, nullptr, wl(c, layer, WL_BR) + (size_t)n * DM * 512, 512, MAP_ID, DM / 32, r % I_BR, scr, c.lane); continue; } r -= 3 * I_BR;
            conv_item(c.w_out + (size_t)layer * DM * DM, DM, nullptr, wl(c, layer, WL_OUT), DM, MAP_ID, DM / 32, r, scr, c.lane);
        }
    }
    rope_tables(c);
    if (gw < 16) rms_row_to_bf16(c.meta + (size_t)gw * DM, WSP(bf16, WS_HNM) + (size_t)gw * DM, WSP(float, WS_HM) + (size_t)gw * DM, c.lane);
}

__device__ __forceinline__ void norm_main(const Ctx& c, const float* src) {
    const int gw = c.bid * NWAVES + c.wave, NGW = c.G * NWAVES;
    for (int m = gw; m < M; m += NGW) rms_row_to_bf16(src + (size_t)m * DM, WSP(bf16, WS_HN) + (size_t)m * DM, nullptr, c.lane);
}

template <class AF>
__device__ __forceinline__ void meta_block(const AF& af, const bf16* Bt, int K, int col0, float* raw, int ldraw, int rcol0, int lane) {
    f32x4 acc = {0.f, 0.f, 0.f, 0.f};
    const int r = lane & 15, kq = 8 * (lane >> 4);
    for (int k0 = 0; k0 < K; k0 += 32) {
        const bf16x8 a = af(r, k0 + kq);
        const bf16x8 b = *(const bf16x8*)(Bt + (size_t)(col0 + r) * K + k0 + kq);
        acc = __builtin_amdgcn_mfma_f32_16x16x32_bf16(a, b, acc, 0, 0, 0);
    }
#pragma unroll
    for (int x = 0; x < 4; ++x) raw[(size_t)(4 * (lane >> 4) + x) * ldraw + rcol0 + r] = acc[x];
}
struct AfPlain { const bf16* A; int lda; __device__ __forceinline__ bf16x8 operator()(int r, int k) const { return *(const bf16x8*)(A + (size_t)r * lda + k); } };
struct AfBranch {
    const bf16* ym; const float* rawl; int n;
    __device__ __forceinline__ bf16x8 operator()(int r, int k) const {
        f32x4 y0, y1; ld8(ym + (size_t)r * 1536 + n * 512 + k, y0, y1);
        const f32x4 z0 = *(const f32x4*)(rawl + (size_t)r * NL + 512 * n + k), z1 = *(const f32x4*)(rawl + (size_t)r * NL + 512 * n + k + 4);
#pragma unroll
        for (int j = 0; j < 4; ++j) { y0[j] *= siluf_(z0[j]); y1[j] *= siluf_(z1[j]); }
        return __builtin_bit_cast(bf16x8, pack8(y0, y1));
    }
};
struct AfMerged {
    const float* rawl; const float* rawb;
    __device__ __forceinline__ bf16x8 operator()(int r, int k) const {
        f32x4 s0 = {0.f, 0.f, 0.f, 0.f}, s1 = s0;
#pragma unroll
        for (int n = 0; n < 3; ++n) {
            const float* g = rawl + (size_t)r * NL + 1536 + n * 1024 + k; const float* p = rawb + ((size_t)n * 16 + r) * 1024 + k;
#pragma unroll
            for (int j = 0; j < 4; ++j) { s0[j] += sigmoidf_(g[j]) * p[j]; s1[j] += sigmoidf_(g[4 + j]) * p[4 + j]; }
        }
        return __builtin_bit_cast(bf16x8, pack8(s0, s1));
    }
};
template <class AF>
__device__ __forceinline__ void meta_blocks(const Ctx& c, const AF& af, const bf16* Bt, int K, int nblocks, float* raw, int ldraw, int rcol0) {
    const int gw = c.bid * NWAVES + c.wave, NGW = c.G * NWAVES;
    for (int b = gw; b < nblocks; b += NGW) meta_block(af, Bt, K, 16 * b, raw, ldraw, rcol0 + 16 * b, c.lane);
}

__device__ __forceinline__ void post_early(const Ctx& c, int layer) {
    const float* raw = WSP(float, WS_RAWE);
    bf16 *QAm = WSP(bf16, WS_QAM), *QCm = WSP(bf16, WS_QCM), *cm = WSP(bf16, WS_CM);
    bf16 *KAf = WSP(bf16, WS_KA), *VAf = WSP(bf16, WS_VA), *KBf = WSP(bf16, WS_KB), *KCf = WSP(bf16, WS_KC), *VCf = WSP(bf16, WS_VC);
    float* LFm = WSP(float, WS_LFM);
    const float *cos64 = WSP(float, WS_COS64), *sin64 = WSP(float, WS_SIN64), *cos32 = WSP(float, WS_COS32), *sin32 = WSP(float, WS_SIN32);
    for (int e = c.tid; e < 16 * NE; e += NTHREADS) {
        const int r = e / NE, p = e % NE, t = p >> 8, cc = p & 255, half = cc >> 7, c7 = cc & 127; const float v = raw[e];
        if (t < 2) QAm[r * PQA + p] = f2bf(v * C2A);
        else if (t < 4) { const int L = p - 512; KAf[(size_t)(MOFF + r) * PKA + (L >> 6) * 80 + (L & 63)] = f2bf(v); }
        else if (t < 6) VAf[(size_t)(MOFF + r) * PVA + (p - 1024)] = f2bf(v);
        else if (t < 8) { if (half == 0) { const int hh = c7 >> 5, d = c7 & 31, head = 4 * (t - 6) + hh; const float x1 = v, x2 = raw[e + 128], cs = cos64[r * 32 + d], sn = sin64[r * 32 + d];
                QCm[r * PQC + head * 64 + d] = f2bf((x1 * cs - x2 * sn) * C2C); QCm[r * PQC + head * 64 + 32 + d] = f2bf((x2 * cs + x1 * sn) * C2C); } }
        else if (t == 8) { if (c7 < 64) { if (half == 0) { const int hh = c7 >> 5, d = c7 & 31; const float x1 = v, x2 = raw[e + 128], cs = cos64[r * 32 + d], sn = sin64[r * 32 + d];
                    KCf[(size_t)(MOFF + r) * PKC + hh * 64 + d] = f2bf(x1 * cs - x2 * sn); KCf[(size_t)(MOFF + r) * PKC + hh * 64 + 32 + d] = f2bf(x2 * cs + x1 * sn); } }
            else VCf[(size_t)(MOFF + r) * PVC + 64 * half + (c7 - 64)] = f2bf(v); }
        else if (t == 9) cm[r * 640 + cc] = f2bf(v);
        else if (t == 10) { if (c7 < 64) cm[r * 640 + 256 + 64 * half + c7] = f2bf(v);
            else if (c7 < 80) { if (half == 0) { const int d = c7 - 64; const float x1 = v, x2 = raw[e + 128], cs = cos32[r * 16 + d], sn = sin32[r * 16 + d]; const bf16 o1 = f2bf(x1 * cs - x2 * sn), o2 = f2bf(x2 * cs + x1 * sn);
                    for (int h = 0; h < 8; ++h) { KBf[(size_t)(MOFF + r) * PKB + h * 96 + 64 + d] = o1; KBf[(size_t)(MOFF + r) * PKB + h * 96 + 80 + d] = o2; } } }
            else if (c7 < 88 && half == 0) LFm[r * 8 + (c7 - 80)] = logsigf_(v + c.b_f[layer * 8 + (c7 - 80)]); }
        else cm[r * 640 + 384 + cc] = f2bf(v);
    }
    __syncthreads();
    float* rqm = WSP(float, WS_RQM);
    if (c.tid < 16) { float s = 0.f; for (int k = 0; k < 384; ++k) { const float v = bf2f(cm[c.tid * 640 + k]); s += v * v; } rqm[c.tid] = 1.f / sqrtf(s * (1.f / 384.f) + EPS); }
    else if (c.tid < 32) { const int r = c.tid - 16; float s = 0.f; for (int k = 0; k < 256; ++k) { const float v = bf2f(cm[r * 640 + 384 + k]); s += v * v; } rqm[16 + r] = 1.f / sqrtf(s * (1.f / 256.f) + EPS); }
    else if (c.tid < 40) { const int h = c.tid - 32; float suf = 0.f;
        for (int r = 15; r >= 0; --r) { bf16 bh, bm, bl; split3(suf * LOG2E, bh, bm, bl); bf16* kp = KAf + (size_t)(MOFF + r) * PKA + h * 80 + 64; kp[0] = bh; kp[1] = bm; kp[2] = bl; kp[3] = 0x3F80; kp[4] = 0x3F80; kp[5] = 0x3F80; for (int j = 6; j < 16; ++j) kp[j] = 0; suf += LFm[r * 8 + h]; } }
}
__device__ __forceinline__ void post_up(const Ctx& c) {
    const float* raw = WSP(float, WS_RAWU); const float* rqm = WSP(float, WS_RQM);
    bf16 *QBm = WSP(bf16, WS_QBM), *KBf = WSP(bf16, WS_KB), *VBf = WSP(bf16, WS_VB);
    const float *cos32 = WSP(float, WS_COS32), *sin32 = WSP(float, WS_SIN32);
    for (int e = c.tid; e < 16 * (NUQ + NUKV); e += NTHREADS) {
        const int r = e / (NUQ + NUKV), p = e % (NUQ + NUKV); const float v = raw[e];
        if (p < 512) { const int h = p >> 6, d = p & 63; QBm[r * PQB + h * 96 + d] = f2bf(v * rqm[r] * C2B); }
        else if (p < 768) { const int cc = p - 512, half = cc >> 7, c7 = cc & 127; if (half == 0) { const int h = c7 >> 4, d = c7 & 15; const float sc = rqm[r] * C2B, x1 = v * sc, x2 = raw[e + 128] * sc, cs = cos32[r * 16 + d], sn = sin32[r * 16 + d];
                QBm[r * PQB + h * 96 + 64 + d] = f2bf(x1 * cs - x2 * sn); QBm[r * PQB + h * 96 + 80 + d] = f2bf(x2 * cs + x1 * sn); } }
        else { const int q = p - 768, h = q >> 7, d = q & 127; const float w = v * rqm[16 + r];
            if (d < 64) KBf[(size_t)(MOFF + r) * PKB + h * 96 + d] = f2bf(w); else VBf[(size_t)(MOFF + r) * PVB + h * 64 + (d - 64)] = f2bf(w); }
    }
}
__device__ __forceinline__ void post_resid(const Ctx& c) {
    for (int r = c.wave; r < 16; r += NWAVES) {
        float* hm = WSP(float, WS_HM) + (size_t)r * DM; const float* ro = WSP(float, WS_RAWO) + (size_t)r * DM;
        f32x4 v[4]; float s = 0.f;
#pragma unroll
        for (int j = 0; j < 4; ++j) { v[j] = ((const f32x4*)hm + c.lane)[64 * j] + ((const f32x4*)ro + c.lane)[64 * j]; s += (v[j][0] * v[j][0] + v[j][1] * v[j][1]) + (v[j][2] * v[j][2] + v[j][3] * v[j][3]); }
        const float rstd = 1.f / sqrtf(wave_sum(s) * (1.f / DM) + EPS);
        u32x2* o8 = (u32x2*)(WSP(bf16, WS_HNM) + (size_t)r * DM) + c.lane;
#pragma unroll
        for (int j = 0; j < 4; ++j) { u32x2 w; w.x = cvtpk(v[j][0] * rstd, v[j][1] * rstd); w.y = cvtpk(v[j][2] * rstd, v[j][3] * rstd); o8[64 * j] = w; ((f32x4*)hm + c.lane)[64 * j] = v[j]; }
    }
}

template <int DK, int MODE>
__device__ __forceinline__ void attn_row(const bf16* qrow, const bf16* Kf, const bf16* Km, int kpitch, int koff, const bf16* Vf, const bf16* Vm, int vpitch, int voff, int t, float sink2, bf16* orow) {
    float q[DK];
#pragma unroll
    for (int d = 0; d < DK; d += 8) { f32x4 a, b; ld8(qrow + d, a, b);
#pragma unroll
        for (int j = 0; j < 4; ++j) { q[d + j] = a[j]; q[d + 4 + j] = b[j]; } }
    float o[64];
#pragma unroll
    for (int d = 0; d < 64; ++d) o[d] = 0.f;
    float m = -1e30f, l = 0.f; if (MODE == 2) { m = sink2; l = 1.f; }
    const int s0 = (MODE == 2) ? (t - 127 > 0 ? t - 127 : 0) : 0;
    for (int s = s0; s <= t; ++s) {
        const bf16* kp = (s < NMETA) ? Kf + (size_t)(MOFF + s) * kpitch + koff : Km + (size_t)(s - NMETA) * kpitch + koff;
        const bf16* vp = (s < NMETA) ? Vf + (size_t)(MOFF + s) * vpitch + voff : Vm + (size_t)(s - NMETA) * vpitch + voff;
        float x = 0.f;
#pragma unroll
        for (int d = 0; d < DK; d += 8) { f32x4 a, b; ld8(kp + d, a, b);
#pragma unroll
            for (int j = 0; j < 4; ++j) { x += q[d + j] * a[j]; x += q[d + 4 + j] * b[j]; } }
        if (MODE == 0) x += bf2f(kp[64]) + bf2f(kp[65]) + bf2f(kp[66]);
        if (x > m) { const float f = fexp2(m - x); l *= f;
#pragma unroll
            for (int d = 0; d < 64; ++d) o[d] *= f;
            m = x; }
        const float p = fexp2(x - m); l += p;
#pragma unroll
        for (int d = 0; d < 64; d += 8) { f32x4 a, b; ld8(vp + d, a, b);
#pragma unroll
            for (int j = 0; j < 4; ++j) { o[d + j] += p * a[j]; o[d + 4 + j] += p * b[j]; } }
    }
    const float il = 1.f / l;
#pragma unroll
    for (int d = 0; d < 64; d += 8) { f32x4 a = {o[d] * il, o[d + 1] * il, o[d + 2] * il, o[d + 3] * il}, b = {o[d + 4] * il, o[d + 5] * il, o[d + 6] * il, o[d + 7] * il}; st8(orow + d, a, b); }
}
__device__ __forceinline__ void attn_main_naive(const Ctx& c, int layer) {
    const int g = c.bid * NTHREADS + c.tid, NG = c.G * NTHREADS;
    for (int e = g; e < M * 8; e += NG) {
        const int i = e % SEQ, bh = e / SEQ, b = bh >> 3, h = bh & 7; const size_t row = (size_t)b * SEQ + i; const int t = NMETA + i;
        attn_row<64, 0>(WSP(bf16, WS_QA) + row * PQA + h * 64, WSP(bf16, WS_KA), WSP(bf16, WS_KA) + (size_t)(FR + b * SEQ) * PKA, PKA, h * 80,
                        WSP(bf16, WS_VA), WSP(bf16, WS_VA) + (size_t)(FR + b * SEQ) * PVA, PVA, h * 64, t, 0.f, WSP(bf16, WS_QA) + row * PQA + h * 64);
    }
    for (int e = g; e < M * 8; e += NG) {
        const int i = e % SEQ, bh = e / SEQ, b = bh >> 3, h = bh & 7; const size_t row = (size_t)b * SEQ + i; const int t = NMETA + i;
        attn_row<96, 1>(WSP(bf16, WS_QB) + row * PQB + h * 96, WSP(bf16, WS_KB), WSP(bf16, WS_KB) + (size_t)(FR + b * SEQ) * PKB, PKB, h * 96,
                        WSP(bf16, WS_VB), WSP(bf16, WS_VB) + (size_t)(FR + b * SEQ) * PVB, PVB, h * 64, t, 0.f, WSP(bf16, WS_YB) + row * PY + h * 64);
    }
    for (int e = g; e < M * 8; e += NG) {
        const int i = e % SEQ, bh = e / SEQ, b = bh >> 3, h = bh & 7; const size_t row = (size_t)b * SEQ + i; const int t = NMETA + i;
        attn_row<64, 2>(WSP(bf16, WS_QC) + row * PQC + h * 64, WSP(bf16, WS_KC), WSP(bf16, WS_KC) + (size_t)(FR + b * SEQ) * PKC, PKC, (h >> 2) * 64,
                        WSP(bf16, WS_VC), WSP(bf16, WS_VC) + (size_t)(FR + b * SEQ) * PVC, PVC, (h >> 2) * 64, t, c.sinks[layer * 8 + h] * LOG2E, WSP(bf16, WS_QC) + row * PQC + h * 64);
    }
}

namespace fa {
typedef float f32x16 __attribute__((ext_vector_type(16)));
typedef short s16x4 __attribute__((ext_vector_type(4)));
constexpr int KSLOT = 12288, VSLOT = 8192, OFF_K = 0, OFF_V = 2 * KSLOT, OFF_WS = OFF_V + 2 * VSLOT, OFF_OST = OFF_WS + NWAVES * 256, LDS_END = OFF_OST + NWAVES * 4096;
__device__ __forceinline__ int crow(int r, int hi) { return (r & 3) + 8 * (r >> 2) + 4 * hi; }
#define FA_SBAR() __builtin_amdgcn_sched_barrier(0)
__device__ __forceinline__ void pv(f32x16* o, int vb, bf16x8 pa0, bf16x8 pa1, bf16x8 pa2, bf16x8 pa3) {
#pragma unroll
    for (int d0 = 0; d0 < 2; ++d0) { s16x4 lo[4], hi[4];
#pragma unroll
        for (int ks = 0; ks < 4; ++ks) {
            asm volatile("ds_read_b64_tr_b16 %0,%1 offset:%c2" : "=&v"(lo[ks]) : "v"(vb), "i"(d0 * 4096 + ks * 1024) : "memory");
            asm volatile("ds_read_b64_tr_b16 %0,%1 offset:%c2" : "=&v"(hi[ks]) : "v"(vb), "i"(d0 * 4096 + ks * 1024 + 512) : "memory"); }
        asm volatile("s_waitcnt lgkmcnt(0)" ::: "memory"); FA_SBAR();
#define FA_PK(k) (bf16x8){lo[k][0], lo[k][1], lo[k][2], lo[k][3], hi[k][0], hi[k][1], hi[k][2], hi[k][3]}
        o[d0] = __builtin_amdgcn_mfma_f32_32x32x16_bf16(pa0, FA_PK(0), o[d0], 0, 0, 0);
        o[d0] = __builtin_amdgcn_mfma_f32_32x32x16_bf16(pa1, FA_PK(1), o[d0], 0, 0, 0);
        o[d0] = __builtin_amdgcn_mfma_f32_32x32x16_bf16(pa2, FA_PK(2), o[d0], 0, 0, 0);
        o[d0] = __builtin_amdgcn_mfma_f32_32x32x16_bf16(pa3, FA_PK(3), o[d0], 0, 0, 0);
#undef FA_PK
    }
}
struct Tensors { const bf16* Q; int qpitch, qoff; const bf16* Kf; const bf16* Km; int kpitch, koff; const bf16* Vf; const bf16* Vm; int vpitch, voff; bf16* O; int opitch, ooff; };
template <int NK, int MODE>
__device__ __forceinline__ void attn_unit(const Ctx& c, const Tensors& T, int j, float sink2) {
    constexpr int NCH = 2 * NK;
    LAS unsigned char* lds = c.lds;
    const int lane = c.lane, wid = c.wave, r32 = lane & 31, hi = lane >> 5;
    const unsigned lds0 = (unsigned)(size_t)lds;
    LAS float* wsf = (LAS float*)(lds + OFF_WS) + wid * 64;
    const int q0 = 256 * j;
    const int t_hi = 4 * j + 4, t_lo = (MODE == 2) ? (4 * j - 1 > 0 ? 4 * j - 1 : 0) : 0;
    bf16x8 qr[NK];
    { const bf16* qp = T.Q + (size_t)(q0 + wid * 32 + r32) * T.qpitch + T.qoff + hi * 8;
#pragma unroll
      for (int d0 = 0; d0 < NK; ++d0) { if (MODE == 0 && d0 == NK - 1) { const short one = (short)0x3F80; qr[d0] = hi ? (bf16x8){0, 0, 0, 0, 0, 0, 0, 0} : (bf16x8){one, one, one, 0, 0, 0, 0, 0}; } else qr[d0] = *(const bf16x8*)(qp + d0 * 16); } }
    u32x4 sk0, sk1 = {0u, 0u, 0u, 0u}, sv;
    const bool k2 = (wid + 8 < NCH);
#define FA_LOAD(t) do { const bf16* kt = ((t) == 0) ? T.Kf : T.Km + (size_t)(64 * ((t) - 1)) * T.kpitch; const bf16* vt = ((t) == 0) ? T.Vf : T.Vm + (size_t)(64 * ((t) - 1)) * T.vpitch; \
        sk0 = *(const u32x4*)(kt + (size_t)lane * T.kpitch + T.koff + wid * 8); if (k2) sk1 = *(const u32x4*)(kt + (size_t)lane * T.kpitch + T.koff + (wid + 8) * 8); \
        sv = *(const u32x4*)(vt + (size_t)(16 * (wid & 3) + (lane >> 2)) * T.vpitch + T.voff + (wid >> 2) * 32 + (lane & 3) * 8); } while (0)
#define FA_WRITE(b) do { *(LAS u32x4*)(lds + OFF_K + (b) * KSLOT + wid * 1024 + lane * 16) = sk0; if (k2) *(LAS u32x4*)(lds + OFF_K + (b) * KSLOT + (wid + 8) * 1024 + lane * 16) = sk1; \
        *(LAS u32x4*)(lds + OFF_V + (b) * VSLOT + wid * 1024 + lane * 16) = sv; } while (0)
    float m = (MODE == 2) ? sink2 : -INFINITY, l = (MODE == 2 && hi == 0) ? 1.f : 0.f;
    f32x16 o[2]; o[0] = f32x16{}; o[1] = f32x16{};
    const int qpos = NMETA + q0 + wid * 32 + r32;
    FA_LOAD(t_lo); FA_WRITE(0);
    int buf = 0;
    for (int t = t_lo; t <= t_hi; ++t) {
        __syncthreads();
        if (t < t_hi) FA_LOAD(t + 1);
        f32x16 p0 = f32x16{}, p1 = f32x16{};
        { const LAS unsigned char* kb = lds + OFF_K + buf * KSLOT + hi * 1024 + r32 * 16;
#pragma unroll
          for (int d0 = 0; d0 < NK; ++d0) { const bf16x8 b0 = *(const LAS bf16x8*)(kb + d0 * 2048), b1 = *(const LAS bf16x8*)(kb + d0 * 2048 + 512);
              p0 = __builtin_amdgcn_mfma_f32_32x32x16_bf16(b0, qr[d0], p0, 0, 0, 0); p1 = __builtin_amdgcn_mfma_f32_32x32x16_bf16(b1, qr[d0], p1, 0, 0, 0); } }
        const int kpos0 = (t == 0) ? -MOFF : NMETA + 64 * (t - 1);
        const bool need = (t == 0) || (t > t_hi - 4) || (MODE == 2);
        if (need) {
#pragma unroll
            for (int r = 0; r < 16; ++r) { const int ka = kpos0 + crow(r, hi), kb2 = ka + 32;
                bool ma = (ka > qpos) || (ka < 0), mb = (kb2 > qpos) || (kb2 < 0);
                if (MODE == 2) { ma = ma || (qpos - ka >= 128); mb = mb || (qpos - kb2 >= 128); }
                if (ma) p0[r] = -INFINITY; if (mb) p1[r] = -INFINITY; }
        }
        float rm = fmaxf(p0[0], p1[0]);
#pragma unroll
        for (int r = 1; r < 16; ++r) rm = fmaxf(rm, fmaxf(p0[r], p1[r]));
        { auto rr = __builtin_amdgcn_permlane32_swap(__float_as_uint(rm), __float_as_uint(rm), false, false); rm = fmaxf(__uint_as_float(rr[0]), __uint_as_float(rr[1])); }
        const float mn = fmaxf(m, rm);
        const bool grew = mn > m;
        const float alpha = (mn == -INFINITY) ? 1.f : fexp2(m - mn);
        const float msub = (mn == -INFINITY) ? 0.f : mn;
        float rs = 0.f;
#pragma unroll
        for (int r = 0; r < 16; ++r) { p0[r] = fexp2(p0[r] - msub); p1[r] = fexp2(p1[r] - msub); rs += p0[r] + p1[r]; }
        l = l * alpha + rs; m = mn;
        if (__any(grew)) {
            if (hi == 0) wsf[r32] = alpha;
            asm volatile("s_waitcnt lgkmcnt(0)" ::: "memory");
#pragma unroll
            for (int r = 0; r < 16; ++r) { const float f = wsf[crow(r, hi)]; o[0][r] *= f; o[1][r] *= f; }
        }
        u32x4 pw0, pw1, pw2, pw3;
        pw0 = (u32x4){cvtpk(p0[0], p0[1]), cvtpk(p0[2], p0[3]), cvtpk(p0[4], p0[5]), cvtpk(p0[6], p0[7])}; pw1 = (u32x4){cvtpk(p0[8], p0[9]), cvtpk(p0[10], p0[11]), cvtpk(p0[12], p0[13]), cvtpk(p0[14], p0[15])};
        pw2 = (u32x4){cvtpk(p1[0], p1[1]), cvtpk(p1[2], p1[3]), cvtpk(p1[4], p1[5]), cvtpk(p1[6], p1[7])}; pw3 = (u32x4){cvtpk(p1[8], p1[9]), cvtpk(p1[10], p1[11]), cvtpk(p1[12], p1[13]), cvtpk(p1[14], p1[15])};
        if (t < t_hi) FA_WRITE(buf ^ 1);
        const int vb = (int)(lds0 + OFF_V + buf * VSLOT) + ((lane >> 4) & 1) * 32 + (lane & 3) * 8 + (4 * hi + ((lane & 15) >> 2)) * 64;
        pv(o, vb, __builtin_bit_cast(bf16x8, pw0), __builtin_bit_cast(bf16x8, pw1), __builtin_bit_cast(bf16x8, pw2), __builtin_bit_cast(bf16x8, pw3));
        buf ^= 1;
    }
    { auto rr = __builtin_amdgcn_permlane32_swap(__float_as_uint(l), __float_as_uint(l), false, false); l = __uint_as_float(rr[0]) + __uint_as_float(rr[1]); }
    if (hi == 0) wsf[32 + r32] = l;
    asm volatile("s_waitcnt lgkmcnt(0)" ::: "memory");
    LAS bf16* stg = (LAS bf16*)(lds + OFF_OST) + wid * 2048;
#pragma unroll
    for (int r = 0; r < 16; ++r) { const int orow = crow(r, hi); const float rl = frcp(wsf[32 + orow]);
        stg[orow * 64 + r32] = f2bf(o[0][r] * rl); stg[orow * 64 + 32 + r32] = f2bf(o[1][r] * rl); }
    asm volatile("s_waitcnt lgkmcnt(0)" ::: "memory");
    bf16* Ow = T.O + (size_t)(q0 + wid * 32) * T.opitch + T.ooff;
#pragma unroll
    for (int i = 0; i < 4; ++i) { const int row = i * 8 + (lane >> 3), ch = lane & 7; const u32x4 v = *(const LAS u32x4*)(stg + row * 64 + ch * 8); *(u32x4*)(Ow + (size_t)row * T.opitch + ch * 8) = v; }
    __syncthreads();
#undef FA_LOAD
#undef FA_WRITE
}
#undef FA_SBAR
}
static_assert(fa::LDS_END <= 131072, "attention LDS");


namespace fb {
typedef float f32x16 __attribute__((ext_vector_type(16)));
typedef short s16x4 __attribute__((ext_vector_type(4)));
typedef short v4i16_t __attribute__((ext_vector_type(4)));
typedef __attribute__((address_space(3))) const char* lds_cptr;
__device__ __forceinline__ int crow(int r, int hi) { return (r & 3) + 8 * (r >> 2) + 4 * hi; }
#define SBAR() __builtin_amdgcn_sched_barrier(0)
__device__ __forceinline__ void cmask(f32x16& p0, f32x16& p1, int jb, int qrel, int hi) {
    const float NEG = -INFINITY; const int kb = 64 * jb + 4 * hi;
#pragma unroll
    for (int r = 0; r < 16; ++r) { const int kv = kb + (r & 3) + 8 * (r >> 2); if (kv > qrel) p0[r] = NEG; if (kv + 32 > qrel) p1[r] = NEG; }
}
__device__ __forceinline__ void glds16(const void* gsrc, unsigned lds_dst) { unsigned keep;
    asm volatile("s_mov_b32 %0, m0\n\ts_mov_b32 m0, %2\n\ts_nop 0\n\tglobal_load_lds_dwordx4 %1, off\n\ts_mov_b32 m0, %0" : "=&s"(keep) : "v"(gsrc), "s"(lds_dst) : "memory"); }
__device__ __forceinline__ float max3f(float a, float b, float c) { float r; asm("v_max3_f32 %0, %1, %2, %3" : "=v"(r) : "v"(a), "v"(b), "v"(c)); return r; }
__device__ __forceinline__ float max2f(float a, float b) { float r; asm("v_max_f32_e32 %0, %1, %2" : "=v"(r) : "v"(a), "v"(b)); return r; }
__device__ __forceinline__ float fadd_s(float a, float b) { float r; asm("v_add_f32_e32 %0, %1, %2" : "=v"(r) : "v"(a), "v"(b)); return r; }
__device__ __forceinline__ float fsub_s(float a, float b) { float r; asm("v_sub_f32_e32 %0, %1, %2" : "=v"(r) : "v"(a), "v"(b)); return r; }
#define WAIT_BAR(N) asm volatile("s_waitcnt vmcnt(" #N ") lgkmcnt(0)\n\ts_barrier" ::: "memory")
__device__ __forceinline__ void kload2(bf16x8* kf, lds_cptr kp, int j) { kf[2 * j] = *(const LAS bf16x8*)(kp + j * 2048); kf[2 * j + 1] = *(const LAS bf16x8*)(kp + j * 2048 + 512); }
__device__ __forceinline__ s16x4 vtr(lds_cptr p) { return __builtin_bit_cast(s16x4, __builtin_amdgcn_ds_read_tr16_b64_v4i16((LAS v4i16_t*)p)); }
__device__ __forceinline__ float rowmax(const f32x16& p0, const f32x16& p1) {
    float a = max3f(p0[0], p0[1], p1[0]), b = max3f(p0[2], p0[3], p1[1]); a = max3f(a, p1[2], p1[3]);
#pragma unroll
    for (int r = 4; r < 16; r += 4) { a = max3f(a, p0[r], p0[r + 1]); b = max3f(b, p0[r + 2], p0[r + 3]); a = max3f(a, p1[r], p1[r + 1]); b = max3f(b, p1[r + 2], p1[r + 3]); }
    const float m = max2f(a, b);
    auto rr = __builtin_amdgcn_permlane32_swap(__float_as_uint(m), __float_as_uint(m), false, false);
    return max2f(__uint_as_float(rr[0]), __uint_as_float(rr[1]));
}
__device__ __forceinline__ void pv(f32x16* o, int vb, bf16x8 pa0, bf16x8 pa1, bf16x8 pa2, bf16x8 pa3) {
#pragma unroll
    for (int d0 = 0; d0 < 2; ++d0) { s16x4 lo[4], hi[4];
#pragma unroll
        for (int ks = 0; ks < 4; ++ks) {
            asm volatile("ds_read_b64_tr_b16 %0,%1 offset:%c2" : "=&v"(lo[ks]) : "v"(vb), "i"(d0 * 4096 + ks * 1024) : "memory");
            asm volatile("ds_read_b64_tr_b16 %0,%1 offset:%c2" : "=&v"(hi[ks]) : "v"(vb), "i"(d0 * 4096 + ks * 1024 + 512) : "memory"); }
        asm volatile("s_waitcnt lgkmcnt(0)" ::: "memory"); SBAR();
#define PK(k) (bf16x8){lo[k][0], lo[k][1], lo[k][2], lo[k][3], hi[k][0], hi[k][1], hi[k][2], hi[k][3]}
        o[d0] = __builtin_amdgcn_mfma_f32_32x32x16_bf16(pa0, PK(0), o[d0], 0, 0, 0);
        o[d0] = __builtin_amdgcn_mfma_f32_32x32x16_bf16(pa1, PK(1), o[d0], 0, 0, 0);
        o[d0] = __builtin_amdgcn_mfma_f32_32x32x16_bf16(pa2, PK(2), o[d0], 0, 0, 0);
        o[d0] = __builtin_amdgcn_mfma_f32_32x32x16_bf16(pa3, PK(3), o[d0], 0, 0, 0);
#undef PK
    }
}
template <int NK> struct Geo { static constexpr int SLOTB = NK * 2048, LDS_K = 0, LDS_V = 3 * SLOTB, LDS_WS = 6 * SLOTB, LDS_OST = LDS_WS + NWAVES * 256, LDS_BYTES = LDS_OST + NWAVES * 4096; };
template <int NK, bool AUG, int QP, int KP, int VP, int OP, int THRL>
__device__ __forceinline__ void attn_unit(const bf16* Qb, const bf16* Kf, const bf16* Km, const bf16* Vf, const bf16* Vm, bf16* Ob, int j, char* shm, int tid) {
    typedef Geo<NK> G; constexpr int SLOTB = G::SLOTB, LDS_K = G::LDS_K, LDS_V = G::LDS_V, LDS_WS = G::LDS_WS, LDS_OST = G::LDS_OST, NCH = 2 * NK, NKD = (NK > 4) ? 2 : 1, NSLOT = 3;
    const int lane = tid & 63, r32 = lane & 31, hi = lane >> 5; const int wid = __builtin_amdgcn_readfirstlane(tid >> 6);
    const int q0 = 256 * j;
    const bf16* Qw = Qb + (size_t)(q0 + wid * 32) * QP;
    const unsigned lds0 = (unsigned)(uintptr_t)shm;
    float* wsf = (float*)(shm + LDS_WS) + wid * 64;
    const int c2 = 8 + (wid % (NCH > 8 ? NCH - 8 : 1));
    const bf16* ksrc_f = Kf + (size_t)lane * KP + wid * 8; const bf16* ksrc_m = Km + (size_t)lane * KP + wid * 8;
    const bf16* vsrc_f = Vf + (size_t)(16 * (wid & 3) + (lane >> 2)) * VP + (wid >> 2) * 32 + (lane & 3) * 8; const bf16* vsrc_m = Vm + (size_t)(16 * (wid & 3) + (lane >> 2)) * VP + (wid >> 2) * 32 + (lane & 3) * 8;
    const unsigned kdst = lds0 + LDS_K + wid * 1024, kdst2 = lds0 + LDS_K + c2 * 1024, vdst = lds0 + LDS_V + wid * 1024;
#define RFL(x) ((unsigned)__builtin_amdgcn_readfirstlane(x))
#define DMA_KP(src, slot) do { glds16((src), RFL(kdst + (slot))); if (NKD == 2) glds16((src) + (c2 - wid) * 8, RFL(kdst2 + (slot))); } while (0)
#define DMA_K0(slot) DMA_KP(ksrc_f, slot)
#define DMA_KM(t, slot) DMA_KP(ksrc_m + (size_t)((t) - 1) * 64 * KP, slot)
#define DMA_V0(slot) glds16(vsrc_f, RFL(vdst + (slot)))
#define DMA_VM(t, slot) glds16(vsrc_m + (size_t)((t) - 1) * 64 * VP, RFL(vdst + (slot)))
#define WAIT_KV() do { if (NKD == 2) { WAIT_BAR(3); } else { WAIT_BAR(2); } } while (0)
    const int vb0 = (int)(lds0 + LDS_V) + ((lane >> 4) & 1) * 32 + (lane & 3) * 8 + (4 * hi + ((lane & 15) >> 2)) * 64;
    bf16x8 kf[2 * NK];
    const lds_cptr shm3 = (lds_cptr)shm; const lds_cptr kp0 = shm3 + LDS_K + hi * 1024 + r32 * 16; const lds_cptr vp0 = shm3 + LDS_V + ((lane >> 4) & 1) * 32 + (lane & 3) * 8 + (4 * hi + ((lane & 15) >> 2)) * 64;
    const int NT = 4 * j + 5;
    DMA_K0(0); DMA_V0(0); DMA_KM(1, SLOTB);
    bf16x8 qr[NK];
#pragma unroll
    for (int d0 = 0; d0 < NK; ++d0) { if (AUG && d0 == NK - 1) { const short one = (short)0x3F80; qr[d0] = hi ? (bf16x8){0, 0, 0, 0, 0, 0, 0, 0} : (bf16x8){one, one, one, 0, 0, 0, 0, 0}; }
        else qr[d0] = *reinterpret_cast<const bf16x8*>(&Qw[(size_t)r32 * QP + d0 * 16 + hi * 8]); }
    float mhat = 0.f, l_reg = 0.f; f32x16 o[2]; o[0] = f32x16{}; o[1] = f32x16{}; f32x16 negm = f32x16{}; if (!AUG) asm volatile("" : "+v"(negm));
#define SETREF() do { if (AUG) { bf16 h_, m_, l_; split3(-mhat, h_, m_, l_); if (hi == 0) { u32x4 w_ = {0x3F803F80u, 0x3F80u | ((unsigned)h_ << 16), (unsigned)m_ | ((unsigned)l_ << 16), 0u}; qr[NK - 1] = __builtin_bit_cast(bf16x8, w_); } } \
        else { _Pragma("unroll") for (int r = 0; r < 16; ++r) negm[r] = -mhat; asm volatile("" : "+v"(negm)); } } while (0)
#define CIN (AUG ? f32x16{} : negm)
    const int qrel = wid * 32 + r32;
#define CMASK(P0, P1, t) do { int jb_ = (t) - (NT - 4); if (jb_ >= 0) cmask(P0, P1, jb_, qrel, hi); } while (0)
    bool resc = false;
#define START(P0, P1) do { const float rm = rowmax(P0, P1); resc = false; \
    { const float dl = rm; mhat = fadd_s(mhat, dl); \
      _Pragma("unroll") for (int r = 0; r < 16; ++r) { P0[r] = fsub_s(P0[r], dl); P1[r] = fsub_s(P1[r], dl); } \
      SETREF(); } \
    _Pragma("unroll") for (int r = 0; r < 16; ++r) P0[r] = __builtin_amdgcn_exp2f(P0[r]); } while (0)
#define RESC() do { if (resc) { asm volatile("s_waitcnt lgkmcnt(0)" ::: "memory"); \
      _Pragma("unroll") for (int d_ = 0; d_ < 2; ++d_) _Pragma("unroll") for (int r = 0; r < 16; ++r) o[d_][r] *= wsf[crow(r, hi)]; } } while (0)
    f32x16 pA0, pA1, pB0, pB1;
    int sl_prev = 0, sl_cur = 0, sl_next = SLOTB;
#define ROT() do { sl_prev = sl_cur; sl_cur = sl_next; sl_next = (sl_next == (NSLOT - 1) * SLOTB) ? 0 : sl_next + SLOTB; } while (0)
    DMA_KM(2, 2 * SLOTB);
    if (NKD == 2) { WAIT_BAR(5); } else { WAIT_BAR(3); }
    { pA0 = CIN; pA1 = CIN; const char* kb = shm + LDS_K + hi * 1024 + r32 * 16;
#pragma unroll
      for (int d0 = 0; d0 < NK; ++d0) { const bf16x8 b0 = *reinterpret_cast<const bf16x8*>(kb + d0 * 2048), b1 = *reinterpret_cast<const bf16x8*>(kb + d0 * 2048 + 512);
          pA0 = __builtin_amdgcn_mfma_f32_32x32x16_bf16(b0, qr[d0], pA0, 0, 0, 0); pA1 = __builtin_amdgcn_mfma_f32_32x32x16_bf16(b1, qr[d0], pA1, 0, 0, 0); } }
    asm volatile("s_nop 15\n\ts_nop 7" : "+v"(pA0), "+v"(pA1));
#pragma unroll
    for (int r = 0; r < 16; ++r) { pA0[r] = -INFINITY; if (r < 8) pA1[r] = -INFINITY; }
    START(pA0, pA1);
#pragma unroll
    for (int r = 0; r < 16; ++r) pA1[r] = __builtin_amdgcn_exp2f(pA1[r]);
    WAIT_BAR(0);
    DMA_KM(3, 0); DMA_VM(1, SLOTB);
    ROT();
#pragma unroll
    for (int jj = 0; jj < NK; ++jj) kload2(kf, kp0 + sl_cur, jj);
    WAIT_KV();
    s16x4 vlo[8], vhi[8]; u32x4 pw0, pw1, pw2, pw3;
#define PKW(P, B) cvtpk(P[B], P[B + 1])
#define PAF(k) __builtin_bit_cast(bf16x8, pw##k)
#define VFR(i) (bf16x8){vlo[i][0], vlo[i][1], vlo[i][2], vlo[i][3], vhi[i][0], vhi[i][1], vhi[i][2], vhi[i][3]}
#define PIN(x) asm volatile("" : "+v"(x))
#define MX3(a, b, c) __builtin_fmaxf(__builtin_fmaxf((a), (b)), (c))
#define MF(c_, a_, b_) __builtin_amdgcn_mfma_f32_32x32x16_bf16(a_, b_, c_, 0, 0, 0)
#define GAPA(MFX, A0, A1, A2, A3, W0, W1, PW) do { MFX; sacc += A0; sacc += A1; sacc += A2; sacc += A3; PIN(sacc); W0; W1; PIN(PW); SBAR(); } while (0)
#define EX(v) __builtin_amdgcn_exp2f(v)
#define GAPB(MFX, X, B) do { MFX; X[B] = EX(X[B]); X[B + 1] = EX(X[B + 1]); X[B + 2] = EX(X[B + 2]); X[B + 3] = EX(X[B + 3]); PIN(X); SBAR(); } while (0)
#define VRD(i) do { vlo[i] = vtr(vp_ + (((i) >> 2) * 4096 + ((i) & 3) * 1024)); vhi[i] = vtr(vp_ + (((i) >> 2) * 4096 + ((i) & 3) * 1024 + 512)); } while (0)
#define KRD(Gf, jj) do { if (Gf) { kload2(kf, kp0 + sl_next, jj); SBAR(); } } while (0)
#define STEP(C0, C1, P0, P1, t, GK, GV, GL) do { SBAR(); \
    const lds_cptr vp_ = vp0 + sl_prev; \
    VRD(0); SBAR(); float sacc = (P0[0] + P0[1]); \
    GAPA(C0 = MF(CIN, kf[0], qr[0]), P0[2], P0[3], P0[4], P0[5],     pw0[0] = PKW(P0, 0), pw0[1] = PKW(P0, 2), pw0); \
    VRD(4); SBAR(); GAPA(C1 = MF(CIN, kf[1], qr[0]), P0[6], P0[7], P0[8], P0[9],     pw0[2] = PKW(P0, 4), pw0[3] = PKW(P0, 6), pw0); \
    VRD(1); SBAR(); GAPA(C0 = MF(C0, kf[2], qr[1]),   P0[10], P0[11], P0[12], P0[13], pw1[0] = PKW(P0, 8), pw1[1] = PKW(P0, 10), pw1); \
    VRD(5); SBAR(); GAPA(C1 = MF(C1, kf[3], qr[1]),   P0[14], P0[15], P1[0], P1[1],   pw1[2] = PKW(P0, 12), pw1[3] = PKW(P0, 14), pw1); \
    VRD(2); SBAR(); GAPA(C0 = MF(C0, kf[4], qr[2]),   P1[2], P1[3], P1[4], P1[5],     pw2[0] = PKW(P1, 0), pw2[1] = PKW(P1, 2), pw2); \
    VRD(6); SBAR(); GAPA(C1 = MF(C1, kf[5], qr[2]),   P1[6], P1[7], P1[8], P1[9],     pw2[2] = PKW(P1, 4), pw2[3] = PKW(P1, 6), pw2); \
    VRD(3); SBAR(); GAPA(C0 = MF(C0, kf[6], qr[3]),   P1[10], P1[11], P1[12], P1[13], pw3[0] = PKW(P1, 8), pw3[1] = PKW(P1, 10), pw3); \
    VRD(7); SBAR(); GAPA(C1 = MF(C1, kf[7], qr[3]),   P1[14], P1[15], 0.f, 0.f,       pw3[2] = PKW(P1, 12), pw3[3] = PKW(P1, 14), pw3); \
    if (NK > 4) { C0 = MF(C0, kf[8 % (2 * NK)], qr[4 % NK]); C1 = MF(C1, kf[9 % (2 * NK)], qr[4 % NK]); SBAR(); } \
    if (NK > 5) { C0 = MF(C0, kf[10 % (2 * NK)], qr[5 % NK]); C1 = MF(C1, kf[11 % (2 * NK)], qr[5 % NK]); SBAR(); } \
    l_reg += sacc; \
    if (GK) { DMA_KM((t) + 3, sl_cur); } if (GV) { DMA_VM((t) + 1, sl_next); } \
    CMASK(C0, C1, t); \
    { float a = MX3(C0[0], C0[1], C1[0]), b = MX3(C0[2], C0[3], C1[1]); a = MX3(a, C1[2], C1[3]); \
      _Pragma("unroll") for (int r = 4; r < 16; r += 4) { a = MX3(a, C0[r], C0[r + 1]); b = MX3(b, C0[r + 2], C0[r + 3]); a = MX3(a, C1[r], C1[r + 1]); b = MX3(b, C1[r + 2], C1[r + 3]); } \
      float rm = __builtin_fmaxf(a, b); { auto rr = __builtin_amdgcn_permlane32_swap(__float_as_uint(rm), __float_as_uint(rm), false, false); rm = __builtin_fmaxf(__uint_as_float(rr[0]), __uint_as_float(rr[1])); } \
      resc = false; \
      if (__builtin_expect(__any(rm > (float)THRL), 0)) { const float dl = __builtin_fmaxf(rm, 0.f); mhat += dl; \
        _Pragma("unroll") for (int r = 0; r < 16; ++r) { C0[r] -= dl; C1[r] -= dl; } \
        SETREF(); \
        const float f = __builtin_amdgcn_exp2f(-dl); l_reg *= f; if (hi == 0) wsf[r32] = f; resc = true; } } \
    SBAR(); \
    GAPB(o[0] = MF(o[0], PAF(0), VFR(0)), C0, 0); \
    GAPB(o[1] = MF(o[1], PAF(0), VFR(4)), C0, 4); \
    KRD(GL, 0); GAPB(o[0] = MF(o[0], PAF(1), VFR(1)), C0, 8); \
    KRD(GL, 1); GAPB(o[1] = MF(o[1], PAF(1), VFR(5)), C0, 12); \
    KRD(GL, 2); GAPB(o[0] = MF(o[0], PAF(2), VFR(2)), C1, 0); \
    KRD(GL, 3); GAPB(o[1] = MF(o[1], PAF(2), VFR(6)), C1, 4); \
    if (NK > 4) KRD(GL, 4 % NK); GAPB(o[0] = MF(o[0], PAF(3), VFR(3)), C1, 8); \
    if (NK > 5) KRD(GL, 5 % NK); GAPB(o[1] = MF(o[1], PAF(3), VFR(7)), C1, 12); \
    } while (0)
    int t = 1;
#undef CMASK
#define CMASK(P0, P1, t) do { } while (0)
    for (; t + 5 < NT; t += 2) {
        STEP(pB0, pB1, pA0, pA1, t, true, true, true);     WAIT_KV(); RESC(); ROT();
        STEP(pA0, pA1, pB0, pB1, t + 1, true, true, true); WAIT_KV(); RESC(); ROT();
    }
#undef CMASK
#define CMASK(P0, P1, t) do { int jb_ = (t) - (NT - 4); if (jb_ >= 0) cmask(P0, P1, jb_, qrel, hi); } while (0)
#define ENDW(tt) do { if ((tt) + 3 < NT) { WAIT_KV(); } else if ((tt) + 2 < NT) { WAIT_BAR(1); } else { WAIT_BAR(0); } } while (0)
    for (; t + 1 < NT; t += 2) {
        STEP(pB0, pB1, pA0, pA1, t, (t + 3 < NT), (t + 1 < NT), (t + 1 < NT));       ENDW(t);     RESC(); ROT();
        STEP(pA0, pA1, pB0, pB1, t + 1, (t + 4 < NT), (t + 2 < NT), (t + 2 < NT));   ENDW(t + 1); RESC(); ROT();
    }
    { float sacc = pA0[0] + pA0[1];
#pragma unroll
      for (int r = 2; r < 16; ++r) sacc += pA0[r];
#pragma unroll
      for (int r = 0; r < 16; ++r) sacc += pA1[r];
      l_reg += sacc;
      pw0 = (u32x4){PKW(pA0, 0), PKW(pA0, 2), PKW(pA0, 4), PKW(pA0, 6)}; pw1 = (u32x4){PKW(pA0, 8), PKW(pA0, 10), PKW(pA0, 12), PKW(pA0, 14)}; pw2 = (u32x4){PKW(pA1, 0), PKW(pA1, 2), PKW(pA1, 4), PKW(pA1, 6)}; pw3 = (u32x4){PKW(pA1, 8), PKW(pA1, 10), PKW(pA1, 12), PKW(pA1, 14)};
      SBAR(); pv(o, vb0 + sl_prev, PAF(0), PAF(1), PAF(2), PAF(3)); }
    { auto rr = __builtin_amdgcn_permlane32_swap(__float_as_uint(l_reg), __float_as_uint(l_reg), false, false); l_reg = __uint_as_float(rr[0]) + __uint_as_float(rr[1]); }
    if (hi == 0) wsf[32 + r32] = l_reg; asm volatile("s_waitcnt lgkmcnt(0)" ::: "memory");
    float rli[16];
#pragma unroll
    for (int r = 0; r < 16; ++r) rli[r] = __builtin_amdgcn_rcpf(wsf[32 + crow(r, hi)]);
    bf16* Ow = Ob + (size_t)(q0 + wid * 32) * OP;
    { bf16* stg = (bf16*)(shm + LDS_OST) + wid * 2048;
#pragma unroll
      for (int r = 0; r < 16; ++r) { const int orow = crow(r, hi);
#pragma unroll
          for (int d0 = 0; d0 < 2; ++d0) stg[orow * 64 + d0 * 32 + r32] = f2bf(o[d0][r] * rli[r]); }
      asm volatile("s_waitcnt lgkmcnt(0)" ::: "memory");
#pragma unroll
      for (int i = 0; i < 4; ++i) { const int row = i * 8 + (lane >> 3), ch = lane & 7; const u32x4 v = *(const u32x4*)(stg + row * 64 + ch * 8); *(u32x4*)(Ow + (size_t)row * OP + ch * 8) = v; } }
    asm volatile("s_waitcnt vmcnt(0) lgkmcnt(0)\n\ts_barrier" ::: "memory");
#undef SETREF
#undef CIN
#undef RFL
#undef DMA_KP
#undef DMA_K0
#undef DMA_KM
#undef DMA_V0
#undef DMA_VM
#undef WAIT_KV
#undef CMASK
#undef START
#undef RESC
#undef ROT
#undef PKW
#undef PAF
#undef VFR
#undef PIN
#undef MX3
#undef MF
#undef GAPA
#undef GAPB
#undef EX
#undef VRD
#undef KRD
#undef STEP
#undef ENDW
}
#undef SBAR
#undef WAIT_BAR
}
static_assert(fb::Geo<6>::LDS_BYTES <= 131072, "attention LDS");

#ifndef FB_THR
#define FB_THR 0
#endif
#ifndef USE_FB_A
#define USE_FB_A USE_FB
#endif
#ifndef USE_FB_B
#define USE_FB_B 0
#endif
__device__ __forceinline__ void attn_main_mfma(const Ctx& c0, int layer) {
#define LAUNDER() Ctx c = c0; asm volatile("" : "+v"(c.tid)); c.lane = c.tid & 63; c.wave = __builtin_amdgcn_readfirstlane(c.tid >> 6);
    const int vcu = (c0.G % 8 == 0) ? (c0.bid % 8) * (c0.G / 8) + c0.bid / 8 : c0.bid;
    char* shm = (char*)(__attribute__((address_space(0))) char*)c0.lds; (void)shm;
    { LAUNDER()
#pragma nounroll
    for (int uu = 2 * vcu; uu < 512; uu += 2 * c.G) {
#pragma nounroll
        for (int k = 0; k < 2; ++k) {
            const int u = uu >> 1, bh = u >> 3, s8 = u & 7, b = bh >> 3, h = bh & 7, j = k ? s8 : 15 - s8; const size_t r0 = (size_t)b * SEQ;
#if USE_FB_B
            fb::attn_unit<6, false, PQB, PKB, PVB, PY, FB_THR>(WSP(bf16, WS_QB) + r0 * PQB + h * 96, WSP(bf16, WS_KB) + h * 96, WSP(bf16, WS_KB) + (FR + r0) * PKB + h * 96, WSP(bf16, WS_VB) + h * 64, WSP(bf16, WS_VB) + (FR + r0) * PVB + h * 64, WSP(bf16, WS_YB) + r0 * PY + h * 64, j, shm, c.tid);
#else
            const fa::Tensors TB{WSP(bf16, WS_QB) + r0 * PQB, PQB, h * 96, WSP(bf16, WS_KB), WSP(bf16, WS_KB) + (FR + r0) * PKB, PKB, h * 96, WSP(bf16, WS_VB), WSP(bf16, WS_VB) + (FR + r0) * PVB, PVB, h * 64, WSP(bf16, WS_YB) + r0 * PY, PY, h * 64};
            fa::attn_unit<6, 1>(c, TB, j, 0.f);
#endif
        }
    }
    }
    { LAUNDER()
#pragma nounroll
    for (int uu = 2 * vcu; uu < 512; uu += 2 * c.G) {
#pragma nounroll
        for (int k = 0; k < 2; ++k) {
            const int u = uu >> 1, bh = u >> 3, s8 = u & 7, b = bh >> 3, h = bh & 7, j = k ? s8 : 15 - s8; const size_t r0 = (size_t)b * SEQ;
#if USE_FB_A
            fb::attn_unit<5, true, PQA, PKA, PVA, PQA, FB_THR>(WSP(bf16, WS_QA) + r0 * PQA + h * 64, WSP(bf16, WS_KA) + h * 80, WSP(bf16, WS_KA) + (FR + r0) * PKA + h * 80, WSP(bf16, WS_VA) + h * 64, WSP(bf16, WS_VA) + (FR + r0) * PVA + h * 64, WSP(bf16, WS_QA) + r0 * PQA + h * 64, j, shm, c.tid);
#else
            const fa::Tensors TA{WSP(bf16, WS_QA) + r0 * PQA, PQA, h * 64, WSP(bf16, WS_KA), WSP(bf16, WS_KA) + (FR + r0) * PKA, PKA, h * 80, WSP(bf16, WS_VA), WSP(bf16, WS_VA) + (FR + r0) * PVA, PVA, h * 64, WSP(bf16, WS_QA) + r0 * PQA, PQA, h * 64};
            fa::attn_unit<5, 0>(c, TA, j, 0.f);
#endif
        }
    }
    }
    { LAUNDER()
#pragma nounroll
    for (int uu = 2 * vcu; uu < 512; uu += 2 * c.G) {
#pragma nounroll
        for (int k = 0; k < 2; ++k) {
            const int u = uu >> 1, bh = u >> 3, s8 = u & 7, b = bh >> 3, h = bh & 7, j = k ? s8 : 15 - s8; const size_t r0 = (size_t)b * SEQ;
            const fa::Tensors TC{WSP(bf16, WS_QC) + r0 * PQC, PQC, h * 64, WSP(bf16, WS_KC), WSP(bf16, WS_KC) + (FR + r0) * PKC, PKC, (h >> 2) * 64, WSP(bf16, WS_VC), WSP(bf16, WS_VC) + (FR + r0) * PVC, PVC, (h >> 2) * 64, WSP(bf16, WS_QC) + r0 * PQC, PQC, h * 64};
            fa::attn_unit<4, 2>(c, TC, j, c.sinks[layer * 8 + h] * LOG2E);
        }
    }
    }
#undef LAUNDER
}

__device__ __forceinline__ void attn_meta(const Ctx& c) {
    if (c.tid >= 384) return;
    const int br = c.tid / 128, h = (c.tid >> 4) & 7, r = c.tid & 15; bf16* ym = WSP(bf16, WS_YM) + (size_t)r * 1536 + br * 512 + h * 64;
    if (br == 0) attn_row<64, 0>(WSP(bf16, WS_QAM) + r * PQA + h * 64, WSP(bf16, WS_KA), WSP(bf16, WS_KA), PKA, h * 80, WSP(bf16, WS_VA), WSP(bf16, WS_VA), PVA, h * 64, r, 0.f, ym);
    else if (br == 1) attn_row<96, 1>(WSP(bf16, WS_QBM) + r * PQB + h * 96, WSP(bf16, WS_KB), WSP(bf16, WS_KB), PKB, h * 96, WSP(bf16, WS_VB), WSP(bf16, WS_VB), PVB, h * 64, r, 0.f, ym);
    else attn_row<64, 2>(WSP(bf16, WS_QCM) + r * PQC + h * 64, WSP(bf16, WS_KC), WSP(bf16, WS_KC), PKC, (h >> 2) * 64, WSP(bf16, WS_VC), WSP(bf16, WS_VC), PVC, (h >> 2) * 64, r, c.sinks[h] * LOG2E, ym);
}

struct Unit { int pm, pn, z; };
__device__ __forceinline__ int perm32(int rho) { const int n = rho >> 4, i = rho & 15; return 8 * (i >> 2) + 4 * n + (i & 3); }
template <class Prob, class Epi, class Sched>
__device__ __forceinline__ void gemm_naive(const Ctx& c, const Prob& P, const Sched& S, const Epi& E) {
    const int wr = c.wave >> 2, wc = c.wave & 3, fr = c.lane & 15, fq = c.lane >> 4;
    Unit u;
    for (int ui = 0; S.next(ui, u); ++ui) {
        const bf16* A; const bf16* Bt; P.operands(u, A, Bt);
        const int K = P.K, lda = P.K;
        f32x4 acc[2][2][4][2];
#pragma unroll
        for (int a = 0; a < 2; ++a)
#pragma unroll
            for (int b = 0; b < 2; ++b)
#pragma unroll
                for (int m = 0; m < 4; ++m)
#pragma unroll
                    for (int n = 0; n < 2; ++n) acc[a][b][m][n] = (f32x4){0.f, 0.f, 0.f, 0.f};
        for (int k0 = 0; k0 < K; k0 += 64) {
#pragma unroll
            for (int ai = 0; ai < 2; ++ai) {
#pragma unroll
                for (int bj = 0; bj < 2; ++bj) {
                    bf16x8 Bf[2][2];
#pragma unroll
                    for (int n = 0; n < 2; ++n)
#pragma unroll
                        for (int k = 0; k < 2; ++k) Bf[n][k] = *(const bf16x8*)(Bt + (size_t)(256 * u.pn + 128 * bj + 32 * wc + perm32(16 * n + fr)) * K + k0 + 32 * k + 8 * fq);
#pragma unroll
                    for (int m = 0; m < 4; ++m) {
                        bf16x8 At[2];
#pragma unroll
                        for (int k = 0; k < 2; ++k) At[k] = *(const bf16x8*)(A + (size_t)(256 * u.pm + 128 * ai + 64 * wr + 16 * m + fr) * lda + k0 + 32 * k + 8 * fq);
#pragma unroll
                        for (int n = 0; n < 2; ++n)
#pragma unroll
                            for (int k = 0; k < 2; ++k) acc[ai][bj][m][n] = __builtin_amdgcn_mfma_f32_16x16x32_bf16(Bf[n][k], At[k], acc[ai][bj][m][n], 0, 0, 0);
                    }
                }
            }
        }
        asm volatile("" ::: "memory");
        E(acc, u, wr, wc, fr, fq);
    }
}
struct ProbSimple { const bf16* A; const bf16* Bt; int K;
    __device__ __forceinline__ void operands(const Unit&, const bf16*& a, const bf16*& b) const { a = A; b = Bt; } };
struct ProbBranch { const bf16 *A0, *A1, *A2; const bf16* Bt; int K;
    __device__ __forceinline__ void operands(const Unit& u, const bf16*& a, const bf16*& b) const { a = (u.z == 0) ? A0 : (u.z == 1) ? A1 : A2; b = Bt + (size_t)u.z * DM * 512; } };

namespace pg8 {
constexpr int BM = 256, BK = 64, HALF = 128, HTB = HALF * BK * 2, STAGE_BYTES = 8 * HTB, NXCD = 8, WGM = 8;
__host__ __device__ __forceinline__ int lds_byte(int r, int c) { const int st = (r >> 4) * 2 + (c >> 5), rr = r & 15, cc = c & 31, ob = rr * 64 + cc * 2; return st * 1024 + (ob ^ (((ob >> 9) & 1) << 5)); }
__host__ __device__ __forceinline__ void stage_rc(int b, int& R, int& C) { const int st = b / 1024, sb = b % 1024, swz = sb ^ (((sb >> 9) & 1) << 5); R = (st >> 1) * 16 + swz / 64; C = (st & 1) * 32 + (swz % 64) / 2; }
template <int ZN>
struct StaticOrder {
    int nM, nN, nwg, G, c, pn0;
    __device__ __forceinline__ void init(int nM_, int nN_, int pn0_, int G_, int c_) { nM = nM_; nN = nN_; nwg = nM * nN; G = G_; c = c_; pn0 = pn0_; }
    __device__ __forceinline__ bool next(int i, Unit& u) const {
        const int it = i / ZN;
        const long L = (long)it * G + c; if (L >= nwg) return false;
        int wgid = (int)L; { const int q = nwg / NXCD, r = nwg % NXCD, xcd = wgid % NXCD, off = wgid / NXCD; wgid = (xcd < r ? xcd * (q + 1) : r * (q + 1) + (xcd - r) * q) + off; }
        const int nig = WGM * nN, gid = wgid / nig, fm = gid * WGM, gsz = (nM - fm) < WGM ? (nM - fm) : WGM;
        u.pm = fm + ((wgid % nig) % gsz); u.pn = pn0 + (wgid % nig) / gsz; u.z = i - it * ZN; return true;
    }
};
template <class Prob, class Epi, class Sched, bool ALIGN_EPI, bool SP2>
__device__ __forceinline__ void gemm_phase(LAS unsigned char* lds, const Prob& P, const Sched& S, const Epi& E) {
    const int tid = threadIdx.x, wid = __builtin_amdgcn_readfirstlane(tid >> 6), lane = tid & 63, wr = wid >> 2, wc = wid & 3, fr = lane & 15, fq = lane >> 4;
    const int K = P.K, nt = K / BK;
    unsigned voffA[2], voffB[2];
#pragma unroll
    for (int i = 0; i < 2; ++i) { int R, C; stage_rc(tid * 16 + i * 8192, R, C); const int Rb = (R & ~31) + perm32(R & 31);
        voffA[i] = (unsigned)(R * K + C) * 2u; voffB[i] = (unsigned)(Rb * K + C) * 2u; }
    const size_t kstep = (size_t)(BK * 2);
    const size_t hstep = (size_t)HALF * K * 2;
    const size_t tstep = 2 * hstep;
    const unsigned ldsw = (unsigned)wid * 1024u;
    const int aoff = lds_byte(wr * 64 + fr, fq * 8), boff = lds_byte(wc * 32 + fr, fq * 8);
#define PG8_SA(b, h) (((b) * 2 + (h)) * HTB)
#define PG8_SB(b, h) ((4 + (b) * 2 + (h)) * HTB)
#define PG8_STAGE(bufoff, gbase, voff) do { _Pragma("unroll") for (int _i = 0; _i < 2; ++_i) \
        __builtin_amdgcn_global_load_lds((const unsigned*)((const char*)(gbase) + (voff)[_i]), (LAS unsigned*)(lds + (bufoff) + ldsw + _i * 8192), 16, 0, 0); } while (0)
#define PG8_LDA(dst, b, h) do { _Pragma("unroll") for (int m = 0; m < 4; ++m) _Pragma("unroll") for (int k = 0; k < 2; ++k) dst[m][k] = *(const LAS bf16x8*)(lds + PG8_SA(b, h) + aoff + m * 2048 + k * 1024); } while (0)
#define PG8_LDB(dst, b, h) do { _Pragma("unroll") for (int n = 0; n < 2; ++n) _Pragma("unroll") for (int k = 0; k < 2; ++k) dst[n][k] = *(const LAS bf16x8*)(lds + PG8_SB(b, h) + boff + n * 2048 + k * 1024); } while (0)
#define PG8_MMA(ai, bj, At, Bt) do { __builtin_amdgcn_s_setprio(1); _Pragma("unroll") for (int m = 0; m < 4; ++m) _Pragma("unroll") for (int n = 0; n < 2; ++n) _Pragma("unroll") for (int k = 0; k < 2; ++k) \
        acc[ai][bj][m][n] = __builtin_amdgcn_mfma_f32_16x16x32_bf16(Bt[n][k], At[m][k], acc[ai][bj][m][n], 0, 0, 0); __builtin_amdgcn_s_setprio(0); } while (0)
#define PG8_WAIT_V(n) asm volatile("s_waitcnt vmcnt(" #n ")" ::: "memory")
#define PG8_WAIT_L(n) asm volatile("s_waitcnt lgkmcnt(" #n ")" ::: "memory")
#define PG8_BAR __builtin_amdgcn_s_barrier()
#define PG8_SCHED __builtin_amdgcn_sched_barrier(0)
    Unit cur, nxt; int ui = 0;
    if (!S.next(0, cur)) return;
    f32x4 acc[2][2][4][2];
#pragma unroll
    for (int a = 0; a < 2; ++a)
#pragma unroll
        for (int b = 0; b < 2; ++b)
#pragma unroll
            for (int m = 0; m < 4; ++m)
#pragma unroll
                for (int n = 0; n < 2; ++n) acc[a][b][m][n] = (f32x4){0.f, 0.f, 0.f, 0.f};
    bf16x8 At[4][2], B0[2][2], B1[2][2];
    const char* cA; const char* cB;
    { const bf16 *pa, *pb; P.operands(cur, pa, pb); cA = (const char*)pa + (size_t)cur.pm * tstep; cB = (const char*)pb + (size_t)cur.pn * tstep; }
    if constexpr (SP2) {
        PG8_STAGE(PG8_SB(0, 0), cB, voffB); PG8_STAGE(PG8_SB(0, 1), cB + hstep, voffB); PG8_STAGE(PG8_SA(0, 0), cA, voffA); PG8_STAGE(PG8_SA(0, 1), cA + hstep, voffA);
        if (wr == 1) PG8_BAR;
        PG8_WAIT_V(2); PG8_BAR;
        PG8_STAGE(PG8_SB(1, 0), cB + kstep, voffB); PG8_STAGE(PG8_SA(1, 0), cA + kstep, voffA); PG8_STAGE(PG8_SB(1, 1), cB + hstep + kstep, voffB);
        PG8_WAIT_V(6); PG8_BAR;
    } else {
        PG8_STAGE(PG8_SB(0, 0), cB, voffB); PG8_STAGE(PG8_SA(0, 0), cA, voffA); PG8_STAGE(PG8_SB(0, 1), cB + hstep, voffB); PG8_STAGE(PG8_SA(0, 1), cA + hstep, voffA);
        if (wr == 1) PG8_BAR;
        PG8_WAIT_V(4); PG8_BAR;
        PG8_STAGE(PG8_SB(1, 0), cB + kstep, voffB); PG8_STAGE(PG8_SA(1, 0), cA + kstep, voffA); PG8_STAGE(PG8_SB(1, 1), cB + hstep + kstep, voffB);
        PG8_WAIT_V(6); PG8_BAR;
    }
    for (;;) {
        const bool has_next = S.next(ui + 1, nxt);
        const char* nA = cA; const char* nB = cB;
        if (has_next) { const bf16 *pa, *pb; P.operands(nxt, pa, pb); nA = (const char*)pa + (size_t)nxt.pm * tstep; nB = (const char*)pb + (size_t)nxt.pn * tstep; }
        for (int t = 0; t < nt; t += 2) {
            const bool last = (t == nt - 2);
            const char* a1 = cA + (size_t)(t + 1) * kstep;
            const char* a2 = last ? nA : cA + (size_t)(t + 2) * kstep; const char* b2 = last ? nB : cB + (size_t)(t + 2) * kstep;
            const char* a3 = a2 + kstep; const char* b3 = b2 + kstep;
            if constexpr (SP2) {
            PG8_LDB(B0, 0, 0); PG8_LDB(B1, 0, 1); PG8_SCHED; PG8_LDA(At, 0, 0); PG8_STAGE(PG8_SA(1, 1), a1 + hstep, voffA);
            PG8_WAIT_V(8); PG8_WAIT_L(0); PG8_BAR; PG8_MMA(0, 0, At, B0); PG8_MMA(0, 1, At, B1); PG8_BAR; PG8_SCHED;
            PG8_LDA(At, 0, 1); PG8_STAGE(PG8_SB(0, 0), b2, voffB); PG8_STAGE(PG8_SB(0, 1), b2 + hstep, voffB); PG8_STAGE(PG8_SA(0, 0), a2, voffA);
            PG8_WAIT_V(8); PG8_WAIT_L(0); PG8_BAR; PG8_MMA(1, 0, At, B0); PG8_MMA(1, 1, At, B1); PG8_BAR; PG8_SCHED;
            PG8_LDB(B0, 1, 0); PG8_LDB(B1, 1, 1); PG8_SCHED; PG8_LDA(At, 1, 0); PG8_STAGE(PG8_SA(0, 1), a2 + hstep, voffA);
            PG8_WAIT_V(8); PG8_WAIT_L(0); PG8_BAR; PG8_MMA(0, 0, At, B0); PG8_MMA(0, 1, At, B1); PG8_BAR; PG8_SCHED;
            PG8_LDA(At, 1, 1); PG8_STAGE(PG8_SB(1, 0), b3, voffB); PG8_STAGE(PG8_SB(1, 1), b3 + hstep, voffB); PG8_STAGE(PG8_SA(1, 0), a3, voffA);
            PG8_WAIT_V(8); PG8_WAIT_L(0); PG8_BAR; PG8_MMA(1, 0, At, B0); PG8_MMA(1, 1, At, B1); PG8_BAR; PG8_SCHED;
            } else {
            PG8_LDB(B0, 0, 0); PG8_SCHED; PG8_LDA(At, 0, 0); PG8_STAGE(PG8_SA(1, 1), a1 + hstep, voffA);
            PG8_WAIT_L(8); PG8_BAR; PG8_WAIT_L(0); PG8_MMA(0, 0, At, B0); PG8_BAR; PG8_SCHED;
            PG8_LDB(B1, 0, 1); PG8_STAGE(PG8_SB(0, 0), b2, voffB);
            PG8_BAR; PG8_WAIT_L(0); PG8_MMA(0, 1, At, B1); PG8_BAR;
            PG8_LDA(At, 0, 1); PG8_STAGE(PG8_SA(0, 0), a2, voffA);
            PG8_BAR; PG8_WAIT_L(0); PG8_MMA(1, 0, At, B0); PG8_BAR; PG8_SCHED;
            PG8_STAGE(PG8_SB(0, 1), b2 + hstep, voffB);
            PG8_WAIT_V(6); PG8_BAR; PG8_MMA(1, 1, At, B1); PG8_BAR;
            PG8_LDB(B0, 1, 0); PG8_SCHED; PG8_LDA(At, 1, 0); PG8_STAGE(PG8_SA(0, 1), a2 + hstep, voffA);
            PG8_WAIT_L(8); PG8_BAR; PG8_WAIT_L(0); PG8_MMA(0, 0, At, B0); PG8_BAR; PG8_SCHED;
            PG8_LDB(B1, 1, 1); PG8_STAGE(PG8_SB(1, 0), b3, voffB);
            PG8_BAR; PG8_WAIT_L(0); PG8_MMA(0, 1, At, B1); PG8_BAR;
            PG8_LDA(At, 1, 1); PG8_STAGE(PG8_SA(1, 0), a3, voffA);
            PG8_BAR; PG8_WAIT_L(0); PG8_MMA(1, 0, At, B0); PG8_BAR; PG8_SCHED;
            PG8_STAGE(PG8_SB(1, 1), b3 + hstep, voffB);
            PG8_WAIT_V(6); PG8_BAR; PG8_MMA(1, 1, At, B1); PG8_BAR;
            }
        }
        if constexpr (ALIGN_EPI) { if (wr == 0) PG8_BAR; }
        E(acc, cur, wr, wc, fr, fq);
        if (!has_next) break;
#pragma unroll
        for (int a = 0; a < 2; ++a)
#pragma unroll
            for (int b = 0; b < 2; ++b)
#pragma unroll
                for (int m = 0; m < 4; ++m)
#pragma unroll
                    for (int n = 0; n < 2; ++n) acc[a][b][m][n] = (f32x4){0.f, 0.f, 0.f, 0.f};
        cur = nxt; cA = nA; cB = nB; ++ui;
        if constexpr (ALIGN_EPI) { if (wr == 1) PG8_BAR; }
    }
    PG8_WAIT_V(0);
    if constexpr (!ALIGN_EPI) { if (wr == 0) PG8_BAR; }
    PG8_BAR;
#undef PG8_SA
#undef PG8_SB
#undef PG8_STAGE
#undef PG8_LDA
#undef PG8_LDB
#undef PG8_MMA
#undef PG8_WAIT_V
#undef PG8_WAIT_L
#undef PG8_BAR
#undef PG8_SCHED
}
}
#ifndef USE_PG8
#define USE_PG8 1
#endif
template <int ZN, class Prob, class Epi>
__device__ __forceinline__ void gemm_run(const Ctx& c, const Prob& P, const Epi& E, int nM, int nN, int pn0) {
#if USE_PG8
    pg8::StaticOrder<ZN> S; S.init(nM, nN, pn0, c.G, c.bid);
    pg8::gemm_phase<Prob, Epi, pg8::StaticOrder<ZN>, true, true>(c.lds, P, S, E);
#else
    pg8::StaticOrder<ZN> S; S.init(nM, nN, pn0, c.G, c.bid);
    gemm_naive(c, P, S, E);
#endif
}

#define EPI_ROWS_BEGIN _Pragma("unroll") for (int ai = 0; ai < 2; ++ai) _Pragma("unroll") for (int m = 0; m < 4; ++m) { const int row = 256 * u.pm + 128 * ai + 64 * wr + 16 * m + fr; \
    const f32x4 l0 = acc[ai][0][m][0], l1 = acc[ai][0][m][1], h0 = acc[ai][1][m][0], h1 = acc[ai][1][m][1]; (void)l0; (void)l1; (void)h0; (void)h1;
#define EPI_ROWS_END asm volatile("" ::: "memory"); }
typedef f32x4 Acc_t[2][2][4][2];

__device__ __forceinline__ void rope8(const float* cs, const float* sn, f32x4 x1a, f32x4 x1b, f32x4 x2a, f32x4 x2b, float sc, f32x4& o1a, f32x4& o1b, f32x4& o2a, f32x4& o2b) {
    const f32x4 ca = *(const f32x4*)cs, cb = *(const f32x4*)(cs + 4), sa = *(const f32x4*)sn, sb = *(const f32x4*)(sn + 4);
    o1a = (x1a * ca - x2a * sa) * sc; o1b = (x1b * cb - x2b * sb) * sc; o2a = (x2a * ca + x1a * sa) * sc; o2b = (x2b * cb + x1b * sb) * sc;
}
struct EpiEarly {
    const Ctx& c; int layer;
    __device__ __forceinline__ void operator()(const Acc_t& acc, const Unit& u, int wr, int wc, int fr, int fq) const {
        const int c8 = 32 * wc + 8 * fq, t = u.pn;
        bf16 *QA = WSP(bf16, WS_QA), *KA = WSP(bf16, WS_KA) + (size_t)FR * PKA, *VA = WSP(bf16, WS_VA) + (size_t)FR * PVA, *QC = WSP(bf16, WS_QC), *KC = WSP(bf16, WS_KC) + (size_t)FR * PKC,
             *VC = WSP(bf16, WS_VC) + (size_t)FR * PVC, *CQ = WSP(bf16, WS_CQ), *CKV = WSP(bf16, WS_CKV), *KB = WSP(bf16, WS_KB) + (size_t)FR * PKB;
        const float *cos64 = WSP(float, WS_COS64), *sin64 = WSP(float, WS_SIN64), *cos32 = WSP(float, WS_COS32), *sin32 = WSP(float, WS_SIN32);
        if (t < 2) { EPI_ROWS_BEGIN st8(QA + (size_t)row * PQA + 256 * t + c8, l0 * C2A, l1 * C2A); st8(QA + (size_t)row * PQA + 256 * t + 128 + c8, h0 * C2A, h1 * C2A); EPI_ROWS_END }
        else if (t < 4) { const int L0 = 256 * (t - 2) + c8, L1 = L0 + 128;
            EPI_ROWS_BEGIN st8(KA + (size_t)row * PKA + (L0 >> 6) * 80 + (L0 & 63), l0, l1); st8(KA + (size_t)row * PKA + (L1 >> 6) * 80 + (L1 & 63), h0, h1); EPI_ROWS_END }
        else if (t < 6) { EPI_ROWS_BEGIN st8(VA + (size_t)row * PVA + 256 * (t - 4) + c8, l0, l1); st8(VA + (size_t)row * PVA + 256 * (t - 4) + 128 + c8, h0, h1); EPI_ROWS_END }
        else if (t < 8) { const int head = 4 * (t - 6) + wc, d = 8 * fq;
            EPI_ROWS_BEGIN const int pos = NMETA + (row & (SEQ - 1)); f32x4 o1a, o1b, o2a, o2b; rope8(cos64 + pos * 32 + d, sin64 + pos * 32 + d, l0, l1, h0, h1, C2C, o1a, o1b, o2a, o2b);
                st8(QC + (size_t)row * PQC + head * 64 + d, o1a, o1b); st8(QC + (size_t)row * PQC + head * 64 + 32 + d, o2a, o2b); EPI_ROWS_END }
        else if (t == 8) {
            if (wc < 2) { const int d = 8 * fq;
                EPI_ROWS_BEGIN const int pos = NMETA + (row & (SEQ - 1)); f32x4 o1a, o1b, o2a, o2b; rope8(cos64 + pos * 32 + d, sin64 + pos * 32 + d, l0, l1, h0, h1, 1.f, o1a, o1b, o2a, o2b);
                    st8(KC + (size_t)row * PKC + wc * 64 + d, o1a, o1b); st8(KC + (size_t)row * PKC + wc * 64 + 32 + d, o2a, o2b); EPI_ROWS_END }
            else { const int j = 32 * (wc - 2) + 8 * fq;
                EPI_ROWS_BEGIN st8(VC + (size_t)row * PVC + j, l0, l1); st8(VC + (size_t)row * PVC + 64 + j, h0, h1); EPI_ROWS_END } }
        else if (t == 9) { EPI_ROWS_BEGIN st8(CQ + (size_t)row * PCQ + c8, l0, l1); st8(CQ + (size_t)row * PCQ + 128 + c8, h0, h1); EPI_ROWS_END }
        else if (t == 10) {
            if (wc < 2) { EPI_ROWS_BEGIN st8(CQ + (size_t)row * PCQ + 256 + c8, l0, l1); st8(CQ + (size_t)row * PCQ + 256 + 64 + c8, h0, h1); EPI_ROWS_END }
            else if (wc == 2) {
                if (fq < 2) { const int d = 8 * fq;
                    EPI_ROWS_BEGIN const int pos = NMETA + (row & (SEQ - 1)); f32x4 o1a, o1b, o2a, o2b; rope8(cos32 + pos * 16 + d, sin32 + pos * 16 + d, l0, l1, h0, h1, 1.f, o1a, o1b, o2a, o2b);
                        const u32x4 w1 = pack8(o1a, o1b), w2 = pack8(o2a, o2b);
#pragma unroll
                        for (int h = 0; h < 8; ++h) { *(u32x4*)(KB + (size_t)row * PKB + h * 96 + 64 + d) = w1; *(u32x4*)(KB + (size_t)row * PKB + h * 96 + 80 + d) = w2; } EPI_ROWS_END }
                else if (fq == 2) { float* LF = WSP(float, WS_LF); const f32x4 b0 = *(const f32x4*)(c.b_f + layer * 8), b1 = *(const f32x4*)(c.b_f + layer * 8 + 4);
                    EPI_ROWS_BEGIN f32x4 a = l0 + b0, b = l1 + b1;
#pragma unroll
                        for (int j = 0; j < 4; ++j) { a[j] = logsigf_(a[j]); b[j] = logsigf_(b[j]); }
                        *(f32x4*)(LF + (size_t)row * 8) = a; *(f32x4*)(LF + (size_t)row * 8 + 4) = b; EPI_ROWS_END } } }
        else { EPI_ROWS_BEGIN st8(CKV + (size_t)row * PCKV + c8, l0, l1); st8(CKV + (size_t)row * PCKV + 128 + c8, h0, h1); EPI_ROWS_END }
    }
};
struct EpiUq {
    const Ctx& c;
    __device__ __forceinline__ void operator()(const Acc_t& acc, const Unit& u, int wr, int wc, int fr, int fq) const {
        bf16* QB = WSP(bf16, WS_QB); const float* RQ = WSP(float, WS_RQ); const float *cos32 = WSP(float, WS_COS32), *sin32 = WSP(float, WS_SIN32);
        const int c8 = 32 * wc + 8 * fq;
        if (u.pn < 2) { const int ha = 4 * u.pn + (c8 >> 6), hb = ha + 2, e = c8 & 63;
            EPI_ROWS_BEGIN const float sc = RQ[row] * C2B; st8(QB + (size_t)row * PQB + ha * 96 + e, l0 * sc, l1 * sc); st8(QB + (size_t)row * PQB + hb * 96 + e, h0 * sc, h1 * sc); EPI_ROWS_END }
        else { const int h = c8 >> 4, d = c8 & 15;
            EPI_ROWS_BEGIN const float sc = RQ[row] * C2B; const int pos = NMETA + (row & (SEQ - 1)); f32x4 o1a, o1b, o2a, o2b; rope8(cos32 + pos * 16 + d, sin32 + pos * 16 + d, l0, l1, h0, h1, sc, o1a, o1b, o2a, o2b);
                st8(QB + (size_t)row * PQB + h * 96 + 64 + d, o1a, o1b); st8(QB + (size_t)row * PQB + h * 96 + 80 + d, o2a, o2b); EPI_ROWS_END }
    }
};
struct EpiUkv {
    const Ctx& c;
    __device__ __forceinline__ void operator()(const Acc_t& acc, const Unit& u, int wr, int wc, int fr, int fq) const {
        bf16 *KB = WSP(bf16, WS_KB) + (size_t)FR * PKB, *VB = WSP(bf16, WS_VB) + (size_t)FR * PVB; const float* RKV = WSP(float, WS_RKV);
        const int c8 = 32 * wc + 8 * fq, ha = 2 * u.pn, hb = ha + 1;
        if (wc < 2) { EPI_ROWS_BEGIN const float sc = RKV[row]; st8(KB + (size_t)row * PKB + ha * 96 + c8, l0 * sc, l1 * sc); st8(KB + (size_t)row * PKB + hb * 96 + c8, h0 * sc, h1 * sc); EPI_ROWS_END }
        else { EPI_ROWS_BEGIN const float sc = RKV[row]; st8(VB + (size_t)row * PVB + ha * 64 + c8 - 64, l0 * sc, l1 * sc); st8(VB + (size_t)row * PVB + hb * 64 + c8 - 64, h0 * sc, h1 * sc); EPI_ROWS_END }
    }
};
struct EpiLateZ {
    const Ctx& c;
    __device__ __forceinline__ void operator()(const Acc_t& acc, const Unit& u, int wr, int wc, int fr, int fq) const {
        const int c8 = 32 * wc + 8 * fq, t = u.pn;
        bf16* Y = (t < 2) ? WSP(bf16, WS_QA) : (t < 4) ? WSP(bf16, WS_YB) : WSP(bf16, WS_QC); const int col = 256 * (t & 1) + c8;
        EPI_ROWS_BEGIN
            { bf16* p = Y + (size_t)row * PY + col; f32x4 ya, yb; ld8(p, ya, yb);
#pragma unroll
              for (int j = 0; j < 4; ++j) { ya[j] *= siluf_(l0[j]); yb[j] *= siluf_(l1[j]); }
              st8(p, ya, yb); }
            { bf16* p = Y + (size_t)row * PY + col + 128; f32x4 ya, yb; ld8(p, ya, yb);
#pragma unroll
              for (int j = 0; j < 4; ++j) { ya[j] *= siluf_(h0[j]); yb[j] *= siluf_(h1[j]); }
              st8(p, ya, yb); }
        EPI_ROWS_END
    }
};
struct EpiLateG {
    const Ctx& c;
    __device__ __forceinline__ void operator()(const Acc_t& acc, const Unit& u, int wr, int wc, int fr, int fq) const {
        bf16* Gp = WSP(bf16, WS_G); const int col = 256 * (u.pn - 6) + 32 * wc + 8 * fq;
        EPI_ROWS_BEGIN f32x4 a = l0, b = l1, cc = h0, d = h1;
#pragma unroll
            for (int j = 0; j < 4; ++j) { a[j] = sigmoidf_(a[j]); b[j] = sigmoidf_(b[j]); cc[j] = sigmoidf_(cc[j]); d[j] = sigmoidf_(d[j]); }
            st8(Gp + (size_t)row * PG + col, a, b); st8(Gp + (size_t)row * PG + col + 128, cc, d); EPI_ROWS_END
    }
};
struct EpiBranch {
    const Ctx& c;
    __device__ __forceinline__ void operator()(const Acc_t& acc, const Unit& u, int wr, int wc, int fr, int fq) const {
        const bf16* Gp = WSP(bf16, WS_G); bf16* MG = WSP(bf16, WS_HN); const int col = 256 * u.pn + 32 * wc + 8 * fq;
        EPI_ROWS_BEGIN
#pragma unroll
            for (int bj = 0; bj < 2; ++bj) { f32x4 ga, gb; ld8(Gp + (size_t)row * PG + u.z * DM + col + 128 * bj, ga, gb); f32x4 va = (bj ? h0 : l0) * ga, vb = (bj ? h1 : l1) * gb;
                bf16* p = MG + (size_t)row * DM + col + 128 * bj; if (u.z > 0) { f32x4 pa, pb; ld8(p, pa, pb); va += pa; vb += pb; } st8(p, va, vb); } EPI_ROWS_END
    }
};
struct EpiOut {
    const float* resid; float* out;
    __device__ __forceinline__ void operator()(const Acc_t& acc, const Unit& u, int wr, int wc, int fr, int fq) const {
        const int col = 256 * u.pn + 32 * wc + 8 * fq;
        EPI_ROWS_BEGIN const size_t off = (size_t)row * DM + col;
            const f32x4 r0 = *(const f32x4*)(resid + off), r1 = *(const f32x4*)(resid + off + 4), r2 = *(const f32x4*)(resid + off + 128), r3 = *(const f32x4*)(resid + off + 132);
            *(f32x4*)(out + off) = r0 + l0; *(f32x4*)(out + off + 4) = r1 + l1; *(f32x4*)(out + off + 128) = r2 + h0; *(f32x4*)(out + off + 132) = r3 + h1; EPI_ROWS_END
    }
};

__device__ __forceinline__ void stats_cumsum(const Ctx& c) {
    const int gw = c.bid * NWAVES + c.wave, NGW = c.G * NWAVES;
    for (int m = gw; m < M; m += NGW) {
        float sq = 0.f, sk = 0.f;
        if (c.lane < 48) { f32x4 a, b; ld8(WSP(bf16, WS_CQ) + (size_t)m * PCQ + 8 * c.lane, a, b); sq = (a[0] * a[0] + a[1] * a[1]) + (a[2] * a[2] + a[3] * a[3]) + (b[0] * b[0] + b[1] * b[1]) + (b[2] * b[2] + b[3] * b[3]); }
        if (c.lane < 32) { f32x4 a, b; ld8(WSP(bf16, WS_CKV) + (size_t)m * PCKV + 8 * c.lane, a, b); sk = (a[0] * a[0] + a[1] * a[1]) + (a[2] * a[2] + a[3] * a[3]) + (b[0] * b[0] + b[1] * b[1]) + (b[2] * b[2] + b[3] * b[3]); }
        sq = wave_sum(sq); sk = wave_sum(sk);
        if (c.lane == 0) { WSP(float, WS_RQ)[m] = 1.f / sqrtf(sq * (1.f / 384.f) + EPS); WSP(float, WS_RKV)[m] = 1.f / sqrtf(sk * (1.f / 256.f) + EPS); }
    }
    LAS double* wsum = (LAS double*)(c.lds);
    for (int task = c.bid; task < NBATCH * 8; task += c.G) {
        const int b = task >> 3, h = task & 7; const float* LF = WSP(float, WS_LF) + (size_t)b * SEQ * 8 + h;
        double v[8]; double s = 0.0;
#pragma unroll
        for (int j = 0; j < 8; ++j) { s += (double)LF[(size_t)(8 * c.tid + j) * 8]; v[j] = s; }
        double inc = s;
#pragma unroll
        for (int o = 1; o < 64; o <<= 1) { const double n = __shfl_up(inc, o); if (c.lane >= o) inc += n; }
        __syncthreads();
        if (c.lane == 63) wsum[c.wave] = inc;
        __syncthreads();
        double base = inc - s;
        for (int w = 0; w < c.wave; ++w) base += wsum[w];
        bf16* KA = WSP(bf16, WS_KA) + (size_t)(FR + b * SEQ) * PKA + h * 80 + 64;
#pragma unroll
        for (int j = 0; j < 8; ++j) { const float bias = (float)(-(base + v[j]) * 1.4426950408889634); bf16 bh, bm, bl; split3(bias, bh, bm, bl);
            u32x4 w0 = {(unsigned)bh | ((unsigned)bm << 16), (unsigned)bl | 0x3F800000u, 0x3F803F80u, 0u}, w1 = {0u, 0u, 0u, 0u};   bf16* kp = KA + (size_t)(8 * c.tid + j) * PKA; *(u32x4*)kp = w0; *(u32x4*)(kp + 8) = w1; }
    }
}
__device__ __forceinline__ void final_norm(const Ctx& c) {
    const int gw = c.bid * NWAVES + c.wave, NGW = c.G * NWAVES;
    for (int m = gw; m < M; m += NGW) {
        f32x4* xr = (f32x4*)(c.out + (size_t)m * DM) + c.lane; f32x4 v[4]; float s = 0.f;
#pragma unroll
        for (int j = 0; j < 4; ++j) { v[j] = xr[64 * j]; s += (v[j][0] * v[j][0] + v[j][1] * v[j][1]) + (v[j][2] * v[j][2] + v[j][3] * v[j][3]); }
        const float rstd = 1.f / sqrtf(wave_sum(s) * (1.f / DM) + EPS);
#pragma unroll
        for (int j = 0; j < 4; ++j) { const f32x4 g = ((const f32x4*)c.final_g + c.lane)[64 * j]; xr[64 * j] = v[j] * rstd * g; }
    }
}

#define XB_TMO      128
#define XB_XCNT(j)  (256  + 64 * (j))
#define XB_XSUB(j)  (1280 + 64 * (j))
#define XB_XGEN(j)  (2304 + 64 * (j))
#define XB_TOP      3328
#define XB_TOPGEN   3392
#define XCD_BAR_WORDS 3456
#define XB_SPIN_CAP (1u << 18)
__device__ __forceinline__ unsigned xb_ld(unsigned* p)              { return __hip_atomic_load(p, __ATOMIC_RELAXED, __HIP_MEMORY_SCOPE_AGENT); }
__device__ __forceinline__ unsigned xb_add(unsigned* p, unsigned v) { return __hip_atomic_fetch_add(p, v, __ATOMIC_RELAXED, __HIP_MEMORY_SCOPE_AGENT); }
__device__ __forceinline__ unsigned xb_xcc_id() { return (unsigned)__builtin_amdgcn_s_getreg((3 << 11) | 20) & 0xFu; }
#define XB_SPIN(cond, bar) do { unsigned _sp = 0; while (cond) { __builtin_amdgcn_s_sleep(1); \
    if ((++_sp & 255u) == 0u) { if (xb_ld(&(bar)[XB_TMO])) break; if (_sp > XB_SPIN_CAP) { atomicAdd(&(bar)[XB_TMO], 1u); break; } } } } while (0)
struct XcdBarrier { unsigned* bar; unsigned x; volatile LAS unsigned* st; };
__device__ __forceinline__ XcdBarrier xcd_barrier_post(unsigned* bar, volatile LAS unsigned* st) {
    XcdBarrier b; b.bar = bar; b.x = xb_xcc_id(); b.st = st;
    if (threadIdx.x == 0) (void)xb_add(&bar[XB_XCNT(b.x)], 1u);
    return b;
}
__device__ __forceinline__ void xcd_barrier_complete(unsigned* bar, unsigned x, unsigned& nloc, unsigned& nx) {
    const unsigned G = gridDim.x * gridDim.y * gridDim.z;
    unsigned sum, cnt, mine, sp = 0u;
    for (;;) {
        sum = 0u; cnt = 0u; mine = 0u;
#pragma unroll
        for (unsigned j = 0; j < 16; ++j) { const unsigned cc = xb_ld(&bar[XB_XCNT(j)]); sum += cc; cnt += (cc > 0u) ? 1u : 0u; mine = (j == x) ? cc : mine; }
        if (sum == G) break;
        __builtin_amdgcn_s_sleep(1);
        if ((++sp & 255u) == 0u) { if (xb_ld(&bar[XB_TMO])) break; if (sp > XB_SPIN_CAP) { atomicAdd(&bar[XB_TMO], 1u); break; } }
    }
    nloc = mine > 0u ? mine : 1u; nx = cnt > 0u ? cnt : 1u;
}
__device__ __forceinline__ void xcd_barrier(const XcdBarrier& b) {
    asm volatile("s_waitcnt vmcnt(0)" ::: "memory");
    __syncthreads();
    if (threadIdx.x == 0) {
        unsigned* bar = b.bar;
        __builtin_amdgcn_s_waitcnt(0);
        unsigned nloc = b.st[0], nx = b.st[1];
        if (nloc == 0u) { xcd_barrier_complete(bar, b.x, nloc, nx); b.st[0] = nloc; b.st[1] = nx; }
        const unsigned old = xb_add(&bar[XB_XSUB(b.x)], 1u);
        const unsigned gen = old / nloc;
        if (old + 1u == (gen + 1u) * nloc) {
            __builtin_amdgcn_fence(__ATOMIC_RELEASE, "agent");
            asm volatile("s_waitcnt vmcnt(0)" ::: "memory");
            const unsigned og = xb_add(&bar[XB_TOP], 1u);
            const unsigned tg = og / nx;
            if (og + 1u == (tg + 1u) * nx) xb_add(&bar[XB_TOPGEN], 1u);
            else XB_SPIN(xb_ld(&bar[XB_TOPGEN]) == tg, bar);
            __builtin_amdgcn_fence(__ATOMIC_ACQUIRE, "agent");
            xb_add(&bar[XB_XGEN(b.x)], 1u);
            asm volatile("s_waitcnt vmcnt(0)" ::: "memory");
        } else {
            XB_SPIN(xb_ld(&bar[XB_XGEN(b.x)]) == gen, bar);
            __builtin_amdgcn_fence(__ATOMIC_ACQUIRE, "agent");
            asm volatile("s_waitcnt vmcnt(0)" ::: "memory");
        }
    }
    __syncthreads();
}

constexpr int LDS_BYTES = 147456, MISC_OFF = 131072 + 320;
constexpr int NSLOTS = 18;
constexpr int CW_BAR = 4096;

struct Args { const float* in[13]; float* out; unsigned char* ws; int ph_lo, ph_hi, pad0, pad1; };
#define CAS __attribute__((address_space(4)))
__device__ __forceinline__ Ctx make_ctx() {
    const CAS char* kp = (const CAS char*)__builtin_amdgcn_kernarg_segment_ptr();
    asm volatile("" : "+s"(kp));
    const CAS Args* a = (const CAS Args*)kp;
    Ctx c;
    c.x = a->in[0]; c.meta = a->in[1]; c.norm_g = a->in[2]; c.w_in = a->in[3]; c.b_f = a->in[4]; c.g_cq = a->in[5]; c.g_ckv = a->in[6];
    c.w_uq = a->in[7]; c.w_ukv = a->in[8]; c.sinks = a->in[9]; c.w_branch = a->in[10]; c.w_out = a->in[11]; c.final_g = a->in[12];
    c.out = a->out; c.ws = a->ws;
    extern __shared__ __attribute__((aligned(16))) unsigned char lds_raw[];
    c.lds = (LAS unsigned char*)lds_raw;
    c.tid = threadIdx.x; c.lane = c.tid & 63; c.wave = __builtin_amdgcn_readfirstlane(c.tid >> 6); c.G = gridDim.x; c.bid = blockIdx.x;
    return c;
}

template <int SLOT>
__device__ __forceinline__ void run_slot() {
    const Ctx c = make_ctx();
    constexpr int slot = SLOT;
    constexpr int layer = (slot >= 9) ? 1 : 0;
    constexpr int ls = (slot >= 9) ? slot - 8 : slot;
        if constexpr (slot == 0) slot0(c);
        else if constexpr (slot == 17) final_norm(c);
        else if constexpr (ls == 1) {
            zero_fronts(c);
            norm_main(c, layer == 0 ? c.x : c.out);
            meta_blocks(c, AfPlain{WSP(bf16, WS_HNM), DM}, wl(c, layer, WL_EARLY), DM, NE / 16, WSP(float, WS_RAWE), NE, 0);
        } else if constexpr (ls == 2) {
            if (c.bid == 0) post_early(c, layer);
            ProbSimple P{WSP(bf16, WS_HN), wl(c, layer, WL_EARLY), DM};
            gemm_run<1>(c, P, EpiEarly{c, layer}, 64, NE / 256, 0);
        } else if constexpr (ls == 3) {
            { const AfPlain af{WSP(bf16, WS_CM), 640}; meta_blocks(c, af, wl(c, layer, WL_UQ), 384, NUQ / 16, WSP(float, WS_RAWU), NUQ + NUKV, 0);
              const AfPlain af2{WSP(bf16, WS_CM) + 384, 640}; meta_blocks(c, af2, wl(c, layer, WL_UKV), 256, NUKV / 16, WSP(float, WS_RAWU), NUQ + NUKV, NUQ); }
            stats_cumsum(c);
        } else if constexpr (ls == 4) {
            if (c.bid == 0) post_up(c);
            { ProbSimple P{WSP(bf16, WS_CQ), wl(c, layer, WL_UQ), 384}; gemm_run<1>(c, P, EpiUq{c}, 64, NUQ / 256, 0); }
            { ProbSimple P{WSP(bf16, WS_CKV), wl(c, layer, WL_UKV), 256}; gemm_run<1>(c, P, EpiUkv{c}, 64, NUKV / 256, 0); }
        } else if constexpr (ls == 5) {
            if (layer == 0) {
#ifndef NO_ATTNM
                if (c.bid == 0) attn_meta(c);
#endif
 meta_blocks(c, AfPlain{WSP(bf16, WS_HNM), DM}, wl(c, 0, WL_LATE), DM, NL / 16, WSP(float, WS_RAWL), NL, 0); }
#ifdef NAIVE_ATTN
            attn_main_naive(c, layer);
#else
            attn_main_mfma(c, layer);
#endif
        } else if constexpr (ls == 6) {
#ifndef NO_S67
            if (layer == 0) { for (int n = 0; n < 3; ++n) { const AfBranch af{WSP(bf16, WS_YM), WSP(float, WS_RAWL), n}; meta_blocks(c, af, wl(c, 0, WL_BR) + (size_t)n * DM * 512, 512, DM / 16, WSP(float, WS_RAWB) + (size_t)n * 16 * 1024, 1024, 0); } }
#endif
            { ProbSimple P{WSP(bf16, WS_HN), wl(c, layer, WL_LATE), DM}; gemm_run<1>(c, P, EpiLateZ{c}, 64, 6, 0); }
            { ProbSimple P{WSP(bf16, WS_HN), wl(c, layer, WL_LATE), DM}; gemm_run<1>(c, P, EpiLateG{c}, 64, 12, 6); }
        } else if constexpr (ls == 7) {
            if (layer == 0) { const AfMerged af{WSP(float, WS_RAWL), WSP(float, WS_RAWB)}; meta_blocks(c, af, wl(c, 0, WL_OUT), DM, DM / 16, WSP(float, WS_RAWO), DM, 0); }
            { ProbBranch P{WSP(bf16, WS_QA), WSP(bf16, WS_YB), WSP(bf16, WS_QC), wl(c, layer, WL_BR), 512}; gemm_run<3>(c, P, EpiBranch{c}, 64, 4, 0); }
        } else if constexpr (ls == 8) {
            if (layer == 0 && c.bid == 0) post_resid(c);
            ProbSimple P{WSP(bf16, WS_HN), wl(c, layer, WL_OUT), DM};
            gemm_run<1>(c, P, EpiOut{layer == 0 ? c.x : c.out, c.out}, 64, DM / 256, 0);
        }
}

__global__ void __launch_bounds__(NTHREADS, 2) skel_fwd(Args args) {
    const Ctx c = make_ctx();
    volatile LAS unsigned* MISC = (volatile LAS unsigned*)(c.lds + MISC_OFF);
    for (int u = c.tid; u < (LDS_BYTES - 131072) / 4; u += NTHREADS) ((LAS unsigned*)(c.lds + 131072))[u] = 0u;
    __syncthreads();
    XcdBarrier bar; bar.bar = (unsigned*)(c.ws + WS_CTL) + CW_BAR; bar.x = 0; bar.st = nullptr;
    const int lo = args.ph_lo, hi = args.ph_hi;
    if (hi - lo > 1) bar = xcd_barrier_post((unsigned*)(c.ws + WS_CTL) + CW_BAR, MISC + 8);

#ifndef SLOT_ON
#define SLOT_ON(k) true
#endif
#define RUN_SLOT(k) if (SLOT_ON(k) && lo <= (k) && (k) < hi) { run_slot<k>(); if ((k) + 1 < hi) xcd_barrier(bar); }
    RUN_SLOT(0) RUN_SLOT(1) RUN_SLOT(2) RUN_SLOT(3) RUN_SLOT(4) RUN_SLOT(5) RUN_SLOT(6) RUN_SLOT(7) RUN_SLOT(8)
    RUN_SLOT(9) RUN_SLOT(10) RUN_SLOT(11) RUN_SLOT(12) RUN_SLOT(13) RUN_SLOT(14) RUN_SLOT(15) RUN_SLOT(16) RUN_SLOT(17)
#undef RUN_SLOT
}

extern "C" void kernel_launch(void* const* d_in, const int* in_sizes, int n_in, void* d_out, int out_size, void* d_ws, size_t ws_size, hipStream_t stream) {
    static int grid = 0;
    if (grid == 0) {
        if (n_in != 13 || out_size != M * DM || ws_size < WS_END) { fprintf(stderr, "kernel_launch: unexpected shapes (n_in %d out %d ws %zu need %zu)\n", n_in, out_size, ws_size, (size_t)WS_END); grid = -1; return; }
        int dev = 0, cus = 0, per_cu = 0;
        if (hipGetDevice(&dev) != hipSuccess || hipDeviceGetAttribute(&cus, hipDeviceAttributeMultiprocessorCount, dev) != hipSuccess) { grid = -1; return; }
        if (hipFuncSetAttribute((const void*)skel_fwd, hipFuncAttributeMaxDynamicSharedMemorySize, LDS_BYTES) != hipSuccess) { fprintf(stderr, "kernel_launch: hipFuncSetAttribute failed\n"); grid = -1; return; }
        if (hipOccupancyMaxActiveBlocksPerMultiprocessor(&per_cu, (const void*)skel_fwd, NTHREADS, LDS_BYTES) != hipSuccess || per_cu < 1) fprintf(stderr, "kernel_launch: occupancy query says %d\n", per_cu);
        (void)hipGetLastError();
        grid = cus;
    }
    if (grid < 0) return;
    (void)hipMemsetAsync((char*)d_ws + WS_CTL, 0, CTL_BYTES, stream);
    Args a{};
    for (int i = 0; i < 13; ++i) a.in[i] = (const float*)d_in[i];
    a.out = (float*)d_out; a.ws = (unsigned char*)d_ws;
#if MK_SINGLE
    a.ph_lo = 0; a.ph_hi = NSLOTS;
    hipLaunchKernelGGL(skel_fwd, dim3(grid), dim3(NTHREADS), LDS_BYTES, stream, a);
#else
    for (int s = 0; s < NSLOTS; ++s) { a.ph_lo = s; a.ph_hi = s + 1; hipLaunchKernelGGL(skel_fwd, dim3(grid), dim3(NTHREADS), LDS_BYTES, stream, a); }
#endif
}
```

```cpp
#include <hip/hip_runtime.h>
#include <cstdio>
#include <cstdint>

#ifndef USE_FB
#define USE_FB 1
#endif
#ifndef MK_SINGLE
#define MK_SINGLE 1
#endif

#define GAS __attribute__((address_space(1)))
#define LAS __attribute__((address_space(3)))
typedef unsigned short bf16;
typedef short bf16x8 __attribute__((ext_vector_type(8)));
typedef float f32x4 __attribute__((ext_vector_type(4)));
typedef unsigned u32x4 __attribute__((ext_vector_type(4)));
typedef unsigned u32x2 __attribute__((ext_vector_type(2)));
typedef float f32x2_t __attribute__((ext_vector_type(2)));
typedef __bf16 bf16x2_t __attribute__((ext_vector_type(2)));
typedef GAS unsigned gu32;
#define RLX_AGENT __ATOMIC_RELAXED, __HIP_MEMORY_SCOPE_AGENT

constexpr int DM = 1024, NBATCH = 4, SEQ = 4096, M = NBATCH * SEQ, NMETA = 16, FR = 64, MOFF = 48, NPOS = SEQ + NMETA;
constexpr int NIN = 7592, NWAVES = 8, NTHREADS = NWAVES * 64;
constexpr float EPS = 1e-6f, LOG2E = 1.4426950408889634f, LN2 = 0.6931471805599453f;
constexpr float C2A = 0.125f * LOG2E, C2B = 0.10206207261596575f * LOG2E, C2C = 0.125f * LOG2E;
constexpr int LC_AQ = 0, LC_AK = 512, LC_AV = 1024, LC_AF = 1536, LC_AZ = 1544, LC_BCQ = 2056, LC_BCKV = 2440, LC_BKR = 2696, LC_BZ = 2728,
              LC_CQ = 3240, LC_CK = 3752, LC_CV = 3880, LC_CZ = 4008, LC_G = 4520;
constexpr int NE = 3072, NL = 4608, NUQ = 768, NUKV = 1024;
constexpr int PQA = 512, PKA = 640, PVA = 512, PQB = 768, PKB = 768, PVB = 512, PQC = 512, PKC = 128, PVC = 128, PCQ = 384, PCKV = 256, PY = 512, PG = 3072;

constexpr size_t MiB = 1u << 20;
constexpr size_t al(size_t x) { return (x + 255) & ~(size_t)255; }
constexpr size_t WS_CTL = 0, CTL_BYTES = 1 * MiB;
constexpr size_t WS_COS64 = CTL_BYTES, WS_SIN64 = WS_COS64 + al((size_t)NPOS * 32 * 4), WS_COS32 = WS_SIN64 + al((size_t)NPOS * 32 * 4), WS_SIN32 = WS_COS32 + al((size_t)NPOS * 16 * 4);
constexpr size_t WS_LF = WS_SIN32 + al((size_t)NPOS * 16 * 4), WS_RQ = WS_LF + al((size_t)M * 8 * 4), WS_RKV = WS_RQ + al((size_t)M * 4);
constexpr size_t WS_HM = WS_RKV + al((size_t)M * 4);
constexpr size_t WS_HNM = WS_HM + al(16 * 1024 * 4);
constexpr size_t WS_RAWE = WS_HNM + al(16 * 1024 * 2);
constexpr size_t WS_RAWU = WS_RAWE + al(16 * NE * 4);
constexpr size_t WS_RAWL = WS_RAWU + al(16 * (NUQ + NUKV) * 4);
constexpr size_t WS_RAWB = WS_RAWL + al(16 * NL * 4);
constexpr size_t WS_RAWO = WS_RAWB + al(3 * 16 * 1024 * 4);
constexpr size_t WS_YM = WS_RAWO + al(16 * 1024 * 4);
constexpr size_t WS_CM = WS_YM + al(16 * 1536 * 2);
constexpr size_t WS_RQM = WS_CM + al(16 * 640 * 2);
constexpr size_t WS_LFM = WS_RQM + al(32 * 4);
constexpr size_t WS_QAM = WS_LFM + al(16 * 8 * 4);
constexpr size_t WS_QBM = WS_QAM + al(16 * 512 * 2);
constexpr size_t WS_QCM = WS_QBM + al(16 * 768 * 2);
constexpr size_t WS_SMALL_END = WS_QCM + al(16 * 512 * 2);
constexpr size_t WL_EARLY = 0, WL_LATE = WL_EARLY + (size_t)NE * DM * 2, WL_UQ = WL_LATE + (size_t)NL * DM * 2, WL_UKV = WL_UQ + (size_t)NUQ * 384 * 2,
                 WL_BR = WL_UKV + (size_t)NUKV * 256 * 2, WL_OUT = WL_BR + (size_t)3 * DM * 512 * 2, WL_BYTES = WL_OUT + (size_t)DM * DM * 2;
constexpr size_t WS_W = 6 * MiB;
static_assert(WS_SMALL_END <= WS_W, "small region");
constexpr size_t WS_HN = WS_W + al(2 * WL_BYTES);
constexpr size_t WS_QA = WS_HN + (size_t)M * DM * 2;
constexpr size_t WS_QC = WS_QA + (size_t)M * PQA * 2;
constexpr size_t WS_CQ = WS_QC + (size_t)M * PQC * 2;
constexpr size_t WS_CKV = WS_CQ + (size_t)M * PCQ * 2;
constexpr size_t WS_YB = WS_CQ;
constexpr size_t WS_QB = WS_CKV + (size_t)M * PCKV * 2;
constexpr size_t WS_KB = WS_QB + (size_t)M * PQB * 2;
constexpr size_t WS_VB = WS_KB + (size_t)(FR + M) * PKB * 2;
constexpr size_t WS_KA = WS_VB + (size_t)(FR + M) * PVB * 2;
constexpr size_t WS_VA = WS_KA + (size_t)(FR + M) * PKA * 2;
constexpr size_t WS_KC = WS_VA + (size_t)(FR + M) * PVA * 2;
constexpr size_t WS_VC = WS_KC + (size_t)(FR + M) * PKC * 2;
constexpr size_t WS_END = WS_VC + (size_t)(FR + M) * PVC * 2;
constexpr size_t WS_G = WS_QB;
static_assert(WS_G + (size_t)M * PG * 2 <= WS_KC, "G overlay");
static_assert((size_t)M * PY * 2 <= (size_t)M * (PCQ + PCKV) * 2, "YB overlay");
static_assert(WS_END <= 256 * MiB, "workspace");

__device__ __forceinline__ unsigned cvtpk(float lo, float hi) { f32x2_t v = {lo, hi}; bf16x2_t b = __builtin_convertvector(v, bf16x2_t); return __builtin_bit_cast(unsigned, b); }
__device__ __forceinline__ bf16 f2bf(float f) { return (bf16)(cvtpk(f, 0.f) & 0xffffu); }
__device__ __forceinline__ float bf2f(bf16 v) { return __uint_as_float((unsigned)v << 16); }
__device__ __forceinline__ float bflo(unsigned w) { return __uint_as_float(w << 16); }
__device__ __forceinline__ float bfhi(unsigned w) { return __uint_as_float(w & 0xffff0000u); }
__device__ __forceinline__ float fexp2(float x) { return __builtin_amdgcn_exp2f(x); }
__device__ __forceinline__ float frcp(float x) { return __builtin_amdgcn_rcpf(x); }
__device__ __forceinline__ float sigmoidf_(float x) { return frcp(1.f + fexp2(-x * LOG2E)); }
__device__ __forceinline__ float siluf_(float x) { return x * sigmoidf_(x); }
__device__ __forceinline__ float logsigf_(float x) { return fminf(x, 0.f) - __builtin_amdgcn_logf(1.f + fexp2(-fabsf(x) * LOG2E)) * LN2; }
__device__ __forceinline__ float wave_sum(float v) {
#pragma unroll
    for (int o = 1; o < 64; o <<= 1) v += __shfl_xor(v, o);
    return v;
}
__device__ __forceinline__ u32x4 pack8(f32x4 a, f32x4 b) { u32x4 w; w.x = cvtpk(a[0], a[1]); w.y = cvtpk(a[2], a[3]); w.z = cvtpk(b[0], b[1]); w.w = cvtpk(b[2], b[3]); return w; }
__device__ __forceinline__ void st8(bf16* p, f32x4 a, f32x4 b) { *(u32x4*)p = pack8(a, b); }
__device__ __forceinline__ void ld8(const bf16* p, f32x4& a, f32x4& b) { const u32x4 w = *(const u32x4*)p; a = (f32x4){bflo(w.x), bfhi(w.x), bflo(w.y), bfhi(w.y)}; b = (f32x4){bflo(w.z), bfhi(w.z), bflo(w.w), bfhi(w.w)}; }
__device__ __forceinline__ void split3(float b, bf16& h, bf16& m, bf16& l) { h = f2bf(b); const float r1 = b - bf2f(h); m = f2bf(r1); const float r2 = r1 - bf2f(m); l = f2bf(r2); }

enum { MAP_EARLY = 0, MAP_LATE = 1, MAP_UQ = 2, MAP_ID = 3 };
__device__ __forceinline__ int map_col(int kind, int p) {
    const int t = p >> 8, c = p & 255, half = c >> 7, c7 = c & 127;
    if (kind == MAP_EARLY) {
        if (t < 2) return LC_AQ + p;
        if (t < 4) return LC_AK + (p - 512);
        if (t < 6) return LC_AV + (p - 1024);
        if (t < 8) return LC_CQ + 256 * (t - 6) + 64 * (c7 >> 5) + 32 * half + (c7 & 31);
        if (t == 8) { if (c7 < 64) return LC_CK + 64 * (c7 >> 5) + 32 * half + (c7 & 31); return LC_CV + 64 * half + (c7 - 64); }
        if (t == 9) return LC_BCQ + c;
        if (t == 10) { if (c7 < 64) return LC_BCQ + 256 + 64 * half + c7; if (c7 < 80) return LC_BKR + 16 * half + (c7 - 64); if (c7 < 88 && half == 0) return LC_AF + (c7 - 80); return -1; }
        return LC_BCKV + c;
    }
    if (kind == MAP_LATE) {
        if (t < 2) return LC_AZ + p;
        if (t < 4) return LC_BZ + (p - 512);
        if (t < 6) return LC_CZ + (p - 1024);
        return LC_G + (p - 1536);
    }
    if (kind == MAP_UQ) {
        if (t < 2) return (4 * t + (c >> 6)) * 96 + (c & 63);
        return (c7 >> 4) * 96 + 64 + 16 * half + (c7 & 15);
    }
    return p;
}

struct Ctx {
    const float *x, *meta, *norm_g, *w_in, *b_f, *g_cq, *g_ckv, *w_uq, *w_ukv, *sinks, *w_branch, *w_out, *final_g;
    float* out; unsigned char* ws;
    LAS unsigned char* lds;
    int tid, lane, wave, G, bid;
};
#define WSP(T, off) ((T*)(c.ws + (off)))
__device__ __forceinline__ bf16* wl(const Ctx& c, int layer, size_t off) { return (bf16*)(c.ws + WS_W + (size_t)layer * WL_BYTES + off); }

__device__ __forceinline__ void conv_item(const float* W, int N, const float* gv, bf16* Bt, int K, int kind, int nblk, int item, LAS float* scr, int lane) {
    const int kb = item / nblk, nb = item % nblk, k0 = 64 * kb, n0 = 32 * nb;
    const int lc = map_col(kind, n0 + (lane & 31));
#pragma unroll 8
    for (int i = 0; i < 32; ++i) { const int kk = 2 * i + (lane >> 5); float v = 0.f; if (lc >= 0) { v = W[(size_t)(k0 + kk) * N + lc]; if (gv) v *= gv[k0 + kk]; } scr[kk * 33 + (lane & 31)] = v; }
    asm volatile("s_waitcnt lgkmcnt(0)" ::: "memory");
    const int ch = lane & 7;
#pragma unroll
    for (int j = 0; j < 4; ++j) { const int n = (lane >> 3) + 8 * j; const LAS float* s = scr + (8 * ch) * 33 + n;
        u32x4 o; o.x = cvtpk(s[0 * 33], s[1 * 33]); o.y = cvtpk(s[2 * 33], s[3 * 33]); o.z = cvtpk(s[4 * 33], s[5 * 33]); o.w = cvtpk(s[6 * 33], s[7 * 33]);
        *(u32x4*)(Bt + (size_t)(n0 + n) * K + k0 + 8 * ch) = o; }
    asm volatile("s_waitcnt lgkmcnt(0)" ::: "memory");
}
__device__ __forceinline__ void zero_fronts(const Ctx& c) {
    const int g = c.bid * NTHREADS + c.tid, NG = c.G * NTHREADS;
    const u32x4 z = {0u, 0u, 0u, 0u};
    for (int e = g; e < MOFF * PKB / 8; e += NG) WSP(u32x4, WS_KB)[e] = z;
    for (int e = g; e < MOFF * PVB / 8; e += NG) WSP(u32x4, WS_VB)[e] = z;
    for (int e = g; e < MOFF * PKA / 8; e += NG) WSP(u32x4, WS_KA)[e] = z;
    for (int e = g; e < MOFF * PVA / 8; e += NG) WSP(u32x4, WS_VA)[e] = z;
    for (int e = g; e < MOFF * PKC / 8; e += NG) WSP(u32x4, WS_KC)[e] = z;
    for (int e = g; e < MOFF * PVC / 8; e += NG) WSP(u32x4, WS_VC)[e] = z;
}
__device__ __forceinline__ void sincos_d(float ang, float& s, float& co) {
    const double x = (double)ang, TWO_PI = 6.283185307179586476925, INV = 0.15915494309189533577;
    const double n = __builtin_rint(x * INV), r = __builtin_fma(-n, TWO_PI, x), y = 0.5 * r, y2 = y * y;
    double sp, cp;
    double ts = 1.0, tc = 1.0; sp = 1.0; cp = 1.0;
#pragma unroll
    for (int j = 1; j <= 12; ++j) { tc = -tc * y2 / (double)((2 * j - 1) * (2 * j)); ts = -ts * y2 / (double)((2 * j) * (2 * j + 1)); cp += tc; sp += ts; }
    const double sy = y * sp, cy = cp;
    s = (float)(2.0 * sy * cy); co = (float)(1.0 - 2.0 * sy * sy);
}
__device__ __forceinline__ void rope_tables(const Ctx& c) {
    const int g = c.bid * NTHREADS + c.tid, NG = c.G * NTHREADS;
    for (int e = g; e < NPOS * 48; e += NG) {
        const int pos = e / 48, i = e % 48;
        float inv; if (i < 32) inv = fexp2(-(float)i * (13.287712379549449f / 32.f)); else inv = fexp2(-(float)(i - 32) * (13.287712379549449f / 16.f));
        const float ang = (float)pos * inv; float s, co; sincos_d(ang, s, co);
        if (i < 32) { WSP(float, WS_COS64)[pos * 32 + i] = co; WSP(float, WS_SIN64)[pos * 32 + i] = s; }
        else { WSP(float, WS_COS32)[pos * 16 + i - 32] = co; WSP(float, WS_SIN32)[pos * 16 + i - 32] = s; }
    }
}
__device__ __forceinline__ void rms_row_to_bf16(const float* xrow, bf16* orow, float* copy, int lane) {
    const f32x4* xr = (const f32x4*)xrow + lane;
    f32x4 v[4]; float s = 0.f;
#pragma unroll
    for (int j = 0; j < 4; ++j) { v[j] = xr[64 * j]; s += (v[j][0] * v[j][0] + v[j][1] * v[j][1]) + (v[j][2] * v[j][2] + v[j][3] * v[j][3]); }
    const float rstd = 1.f / sqrtf(wave_sum(s) * (1.f / DM) + EPS);
    u32x2* o8 = (u32x2*)orow + lane;
#pragma unroll
    for (int j = 0; j < 4; ++j) { u32x2 w; w.x = cvtpk(v[j][0] * rstd, v[j][1] * rstd); w.y = cvtpk(v[j][2] * rstd, v[j][3] * rstd); o8[64 * j] = w; if (copy) ((f32x4*)copy + lane)[64 * j] = v[j]; }
}
__device__ __forceinline__ void slot0(const Ctx& c) {
    LAS float* scr = (LAS float*)(c.lds + c.wave * 16384);
    const int gw = c.bid * NWAVES + c.wave, NGW = c.G * NWAVES;
    for (int layer = 0; layer < 2; ++layer) {
        const float* w_in = c.w_in + (size_t)layer * DM * NIN;
        const int I_E = 16 * (NE / 32), I_L = 16 * (NL / 32), I_UQ = 6 * (NUQ / 32), I_UKV = 4 * (NUKV / 32), I_BR = 8 * (DM / 32), I_O = 16 * (DM / 32);
        const int tot = I_E + I_L + I_UQ + I_UKV + 3 * I_BR + I_O;
        for (int it = gw; it < tot; it += NGW) {
            int r = it;
            if (r < I_E) { conv_item(w_in, NIN, c.norm_g + layer * DM, wl(c, layer, WL_EARLY), DM, MAP_EARLY, NE / 32, r, scr, c.lane); continue; } r -= I_E;
            if (r < I_L) { conv_item(w_in, NIN, c.norm_g + layer * DM, wl(c, layer, WL_LATE), DM, MAP_LATE, NL / 32, r, scr, c.lane); continue; } r -= I_L;
            if (r < I_UQ) { conv_item(c.w_uq + (size_t)layer * 384 * 768, 768, c.g_cq + layer * 384, wl(c, layer, WL_UQ), 384, MAP_UQ, NUQ / 32, r, scr, c.lane); continue; } r -= I_UQ;
            if (r < I_UKV) { conv_item(c.w_ukv + (size_t)layer * 256 * 1024, 1024, c.g_ckv + layer * 256, wl(c, layer, WL_UKV), 256, MAP_ID, NUKV / 32, r, scr, c.lane); continue; } r -= I_UKV;
            if (r < 3 * I_BR) { const int n = r / I_BR; conv_item(c.w_branch + ((size_t)layer * 3 + n) * 512 * DM, DM, nullptr, wl(c, layer, WL_BR) + (size_t)n * DM * 512, 512, MAP_ID, DM / 32, r % I_BR, scr, c.lane); continue; } r -= 3 * I_BR;
            conv_item(c.w_out + (size_t)layer * DM * DM, DM, nullptr, wl(c, layer, WL_OUT), DM, MAP_ID, DM / 32, r, scr, c.lane);
        }
    }
    rope_tables(c);
    if (gw < 16) rms_row_to_bf16(c.meta + (size_t)gw * DM, WSP(bf16, WS_HNM) + (size_t)gw * DM, WSP(float, WS_HM) + (size_t)gw * DM, c.lane);
}

__device__ __forceinline__ void norm_main(const Ctx& c, const float* src) {
    const int gw = c.bid * NWAVES + c.wave, NGW = c.G * NWAVES;
    for (int m = gw; m < M; m += NGW) rms_row_to_bf16(src + (size_t)m * DM, WSP(bf16, WS_HN) + (size_t)m * DM, nullptr, c.lane);
}

template <class AF>
__device__ __forceinline__ void meta_block(const AF& af, const bf16* Bt, int K, int col0, float* raw, int ldraw, int rcol0, int lane) {
    f32x4 acc = {0.f, 0.f, 0.f, 0.f};
    const int r = lane & 15, kq = 8 * (lane >> 4);
    for (int k0 = 0; k0 < K; k0 += 32) {
        const bf16x8 a = af(r, k0 + kq);
        const bf16x8 b = *(const bf16x8*)(Bt + (size_t)(col0 + r) * K + k0 + kq);
        acc = __builtin_amdgcn_mfma_f32_16x16x32_bf16(a, b, acc, 0, 0, 0);
    }
#pragma unroll
    for (int x = 0; x < 4; ++x) raw[(size_t)(4 * (lane >> 4) + x) * ldraw + rcol0 + r] = acc[x];
}
struct AfPlain { const bf16* A; int lda; __device__ __forceinline__ bf16x8 operator()(int r, int k) const { return *(const bf16x8*)(A + (size_t)r * lda + k); } };
struct AfBranch {
    const bf16* ym; const float* rawl; int n;
    __device__ __forceinline__ bf16x8 operator()(int r, int k) const {
        f32x4 y0, y1; ld8(ym + (size_t)r * 1536 + n * 512 + k, y0, y1);
        const f32x4 z0 = *(const f32x4*)(rawl + (size_t)r * NL + 512 * n + k), z1 = *(const f32x4*)(rawl + (size_t)r * NL + 512 * n + k + 4);
#pragma unroll
        for (int j = 0; j < 4; ++j) { y0[j] *= siluf_(z0[j]); y1[j] *= siluf_(z1[j]); }
        return __builtin_bit_cast(bf16x8, pack8(y0, y1));
    }
};
struct AfMerged {
    const float* rawl; const float* rawb;
    __device__ __forceinline__ bf16x8 operator()(int r, int k) const {
        f32x4 s0 = {0.f, 0.f, 0.f, 0.f}, s1 = s0;
#pragma unroll
        for (int n = 0; n < 3; ++n) {
            const float* g = rawl + (size_t)r * NL + 1536 + n * 1024 + k; const float* p = rawb + ((size_t)n * 16 + r) * 1024 + k;
#pragma unroll
            for (int j = 0; j < 4; ++j) { s0[j] += sigmoidf_(g[j]) * p[j]; s1[j] += sigmoidf_(g[4 + j]) * p[4 + j]; }
        }
        return __builtin_bit_cast(bf16x8, pack8(s0, s1));
    }
};
template <class AF>
__device__ __forceinline__ void meta_blocks(const Ctx& c, const AF& af, const bf16* Bt, int K, int nblocks, float* raw, int ldraw, int rcol0) {
    LAS f32x4* red = (LAS f32x4*)(c.lds + 65536);
    const int r = c.lane & 15, kq = 8 * (c.lane >> 4), nks = K >> 5;
    for (int blk = c.bid; blk < nblocks; blk += c.G) {
        f32x4 acc = {0.f, 0.f, 0.f, 0.f};
#pragma unroll 4
        for (int ks = c.wave; ks < nks; ks += NWAVES) {
            const bf16x8 a = af(r, 32 * ks + kq);
            const bf16x8 bb = *(const bf16x8*)(Bt + (size_t)(16 * blk + r) * K + 32 * ks + kq);
            acc = __builtin_amdgcn_mfma_f32_16x16x32_bf16(a, bb, acc, 0, 0, 0);
        }
        asm volatile("s_nop 15\n\ts_nop 7" : "+v"(acc));
        red[c.wave * 64 + c.lane] = acc;
        __syncthreads();
        if (c.wave == 0) {
            f32x4 sm = red[c.lane];
#pragma unroll
            for (int w = 1; w < NWAVES; ++w) sm += red[w * 64 + c.lane];
#pragma unroll
            for (int x = 0; x < 4; ++x) raw[(size_t)(4 * (c.lane >> 4) + x) * ldraw + rcol0 + 16 * blk + r] = sm[x];
        }
        __syncthreads();
    }
}

__device__ __forceinline__ void post_early(const Ctx& c, int layer) {
    const float* raw = WSP(float, WS_RAWE);
    bf16 *QAm = WSP(bf16, WS_QAM), *QCm = WSP(bf16, WS_QCM), *cm = WSP(bf16, WS_CM);
    bf16 *KAf = WSP(bf16, WS_KA), *VAf = WSP(bf16, WS_VA), *KBf = WSP(bf16, WS_KB), *KCf = WSP(bf16, WS_KC), *VCf = WSP(bf16, WS_VC);
    float* LFm = WSP(float, WS_LFM);
    const float *cos64 = WSP(float, WS_COS64), *sin64 = WSP(float, WS_SIN64), *cos32 = WSP(float, WS_COS32), *sin32 = WSP(float, WS_SIN32);
    for (int e = c.bid * NTHREADS + c.tid; e < 16 * NE; e += c.G * NTHREADS) {
        const int r = e / NE, p = e % NE, t = p >> 8, cc = p & 255, half = cc >> 7, c7 = cc & 127; const float v = raw[e];
        if (t < 2) QAm[r * PQA + p] = f2bf(v * C2A);
        else if (t < 4) { const int L = p - 512; KAf[(size_t)(MOFF + r) * PKA + (L >> 6) * 80 + (L & 63)] = f2bf(v); }
        else if (t < 6) VAf[(size_t)(MOFF + r) * PVA + (p - 1024)] = f2bf(v);
        else if (t < 8) { if (half == 0) { const int hh = c7 >> 5, d = c7 & 31, head = 4 * (t - 6) + hh; const float x1 = v, x2 = raw[e + 128], cs = cos64[r * 32 + d], sn = sin64[r * 32 + d];
                QCm[r * PQC + head * 64 + d] = f2bf((x1 * cs - x2 * sn) * C2C); QCm[r * PQC + head * 64 + 32 + d] = f2bf((x2 * cs + x1 * sn) * C2C); } }
        else if (t == 8) { if (c7 < 64) { if (half == 0) { const int hh = c7 >> 5, d = c7 & 31; const float x1 = v, x2 = raw[e + 128], cs = cos64[r * 32 + d], sn = sin64[r * 32 + d];
                    KCf[(size_t)(MOFF + r) * PKC + hh * 64 + d] = f2bf(x1 * cs - x2 * sn); KCf[(size_t)(MOFF + r) * PKC + hh * 64 + 32 + d] = f2bf(x2 * cs + x1 * sn); } }
            else VCf[(size_t)(MOFF + r) * PVC + 64 * half + (c7 - 64)] = f2bf(v); }
        else if (t == 9) cm[r * 640 + cc] = f2bf(v);
        else if (t == 10) { if (c7 < 64) cm[r * 640 + 256 + 64 * half + c7] = f2bf(v);
            else if (c7 < 80) { if (half == 0) { const int d = c7 - 64; const float x1 = v, x2 = raw[e + 128], cs = cos32[r * 16 + d], sn = sin32[r * 16 + d]; const bf16 o1 = f2bf(x1 * cs - x2 * sn), o2 = f2bf(x2 * cs + x1 * sn);
                    for (int h = 0; h < 8; ++h) { KBf[(size_t)(MOFF + r) * PKB + h * 96 + 64 + d] = o1; KBf[(size_t)(MOFF + r) * PKB + h * 96 + 80 + d] = o2; } } }
            else if (c7 < 88 && half == 0) LFm[r * 8 + (c7 - 80)] = logsigf_(v + c.b_f[layer * 8 + (c7 - 80)]); }
        else cm[r * 640 + 384 + cc] = f2bf(v);
    }
}
__device__ __forceinline__ void post_early_reduce(const Ctx& c) {
    const bf16* cm = WSP(bf16, WS_CM); float* rqm = WSP(float, WS_RQM); const float* LFm = WSP(float, WS_LFM); bf16* KAf = WSP(bf16, WS_KA);
    for (int r = c.wave; r < 16; r += NWAVES) {
        float sq = 0.f, sk = 0.f;
        if (c.lane < 48) { f32x4 a, b; ld8(cm + r * 640 + 8 * c.lane, a, b); sq = (a[0] * a[0] + a[1] * a[1]) + (a[2] * a[2] + a[3] * a[3]) + (b[0] * b[0] + b[1] * b[1]) + (b[2] * b[2] + b[3] * b[3]); }
        if (c.lane < 32) { f32x4 a, b; ld8(cm + r * 640 + 384 + 8 * c.lane, a, b); sk = (a[0] * a[0] + a[1] * a[1]) + (a[2] * a[2] + a[3] * a[3]) + (b[0] * b[0] + b[1] * b[1]) + (b[2] * b[2] + b[3] * b[3]); }
        sq = wave_sum(sq); sk = wave_sum(sk);
        if (c.lane == 0) { rqm[r] = 1.f / sqrtf(sq * (1.f / 384.f) + EPS); rqm[16 + r] = 1.f / sqrtf(sk * (1.f / 256.f) + EPS); }
    }
    if (c.tid < 8) { const int h = c.tid; float lf[16];
#pragma unroll
        for (int r = 0; r < 16; ++r) lf[r] = LFm[r * 8 + h];
        float suf = 0.f;
#pragma unroll
        for (int r = 15; r >= 0; --r) { bf16 bh, bm, bl; split3(suf * LOG2E, bh, bm, bl); bf16* kp = KAf + (size_t)(MOFF + r) * PKA + h * 80 + 64;
            const u32x4 w0 = {(unsigned)bh | ((unsigned)bm << 16), (unsigned)bl | 0x3F800000u, 0x3F803F80u, 0u}, w1 = {0u, 0u, 0u, 0u}; *(u32x4*)kp = w0; *(u32x4*)(kp + 8) = w1; suf += lf[r]; } }
}
__device__ __forceinline__ void post_up(const Ctx& c) {
    const float* raw = WSP(float, WS_RAWU); const float* rqm = WSP(float, WS_RQM);
    bf16 *QBm = WSP(bf16, WS_QBM), *KBf = WSP(bf16, WS_KB), *VBf = WSP(bf16, WS_VB);
    const float *cos32 = WSP(float, WS_COS32), *sin32 = WSP(float, WS_SIN32);
    for (int e = c.bid * NTHREADS + c.tid; e < 16 * (NUQ + NUKV); e += c.G * NTHREADS) {
        const int r = e / (NUQ + NUKV), p = e % (NUQ + NUKV); const float v = raw[e];
        if (p < 512) { const int h = p >> 6, d = p & 63; QBm[r * PQB + h * 96 + d] = f2bf(v * rqm[r] * C2B); }
        else if (p < 768) { const int cc = p - 512, half = cc >> 7, c7 = cc & 127; if (half == 0) { const int h = c7 >> 4, d = c7 & 15; const float sc = rqm[r] * C2B, x1 = v * sc, x2 = raw[e + 128] * sc, cs = cos32[r * 16 + d], sn = sin32[r * 16 + d];
                QBm[r * PQB + h * 96 + 64 + d] = f2bf(x1 * cs - x2 * sn); QBm[r * PQB + h * 96 + 80 + d] = f2bf(x2 * cs + x1 * sn); } }
        else { const int q = p - 768, h = q >> 7, d = q & 127; const float w = v * rqm[16 + r];
            if (d < 64) KBf[(size_t)(MOFF + r) * PKB + h * 96 + d] = f2bf(w); else VBf[(size_t)(MOFF + r) * PVB + h * 64 + (d - 64)] = f2bf(w); }
    }
}
__device__ __forceinline__ void post_resid(const Ctx& c) {
    for (int r = c.wave; r < 16; r += NWAVES) {
        float* hm = WSP(float, WS_HM) + (size_t)r * DM; const float* ro = WSP(float, WS_RAWO) + (size_t)r * DM;
        f32x4 v[4]; float s = 0.f;
#pragma unroll
        for (int j = 0; j < 4; ++j) { v[j] = ((const f32x4*)hm + c.lane)[64 * j] + ((const f32x4*)ro + c.lane)[64 * j]; s += (v[j][0] * v[j][0] + v[j][1] * v[j][1]) + (v[j][2] * v[j][2] + v[j][3] * v[j][3]); }
        const float rstd = 1.f / sqrtf(wave_sum(s) * (1.f / DM) + EPS);
        u32x2* o8 = (u32x2*)(WSP(bf16, WS_HNM) + (size_t)r * DM) + c.lane;
#pragma unroll
        for (int j = 0; j < 4; ++j) { u32x2 w; w.x = cvtpk(v[j][0] * rstd, v[j][1] * rstd); w.y = cvtpk(v[j][2] * rstd, v[j][3] * rstd); o8[64 * j] = w; ((f32x4*)hm + c.lane)[64 * j] = v[j]; }
    }
}

template <int DK, int MODE>
__device__ __forceinline__ void attn_row(const bf16* qrow, const bf16* Kf, const bf16* Km, int kpitch, int koff, const bf16* Vf, const bf16* Vm, int vpitch, int voff, int t, float sink2, bf16* orow) {
    float q[DK];
#pragma unroll
    for (int d = 0; d < DK; d += 8) { f32x4 a, b; ld8(qrow + d, a, b);
#pragma unroll
        for (int j = 0; j < 4; ++j) { q[d + j] = a[j]; q[d + 4 + j] = b[j]; } }
    float o[64];
#pragma unroll
    for (int d = 0; d < 64; ++d) o[d] = 0.f;
    float m = -1e30f, l = 0.f; if (MODE == 2) { m = sink2; l = 1.f; }
    const int s0 = (MODE == 2) ? (t - 127 > 0 ? t - 127 : 0) : 0;
    for (int s = s0; s <= t; ++s) {
        const bf16* kp = (s < NMETA) ? Kf + (size_t)(MOFF + s) * kpitch + koff : Km + (size_t)(s - NMETA) * kpitch + koff;
        const bf16* vp = (s < NMETA) ? Vf + (size_t)(MOFF + s) * vpitch + voff : Vm + (size_t)(s - NMETA) * vpitch + voff;
        float x = 0.f;
#pragma unroll
        for (int d = 0; d < DK; d += 8) { f32x4 a, b; ld8(kp + d, a, b);
#pragma unroll
            for (int j = 0; j < 4; ++j) { x += q[d + j] * a[j]; x += q[d + 4 + j] * b[j]; } }
        if (MODE == 0) x += bf2f(kp[64]) + bf2f(kp[65]) + bf2f(kp[66]);
        if (x > m) { const float f = fexp2(m - x); l *= f;
#pragma unroll
            for (int d = 0; d < 64; ++d) o[d] *= f;
            m = x; }
        const float p = fexp2(x - m); l += p;
#pragma unroll
        for (int d = 0; d < 64; d += 8) { f32x4 a, b; ld8(vp + d, a, b);
#pragma unroll
            for (int j = 0; j < 4; ++j) { o[d + j] += p * a[j]; o[d + 4 + j] += p * b[j]; } }
    }
    const float il = 1.f / l;
#pragma unroll
    for (int d = 0; d < 64; d += 8) { f32x4 a = {o[d] * il, o[d + 1] * il, o[d + 2] * il, o[d + 3] * il}, b = {o[d + 4] * il, o[d + 5] * il, o[d + 6] * il, o[d + 7] * il}; st8(orow + d, a, b); }
}
__device__ __forceinline__ void attn_main_naive(const Ctx& c, int layer) {
    const int g = c.bid * NTHREADS + c.tid, NG = c.G * NTHREADS;
    for (int e = g; e < M * 8; e += NG) {
        const int i = e % SEQ, bh = e / SEQ, b = bh >> 3, h = bh & 7; const size_t row = (size_t)b * SEQ + i; const int t = NMETA + i;
        attn_row<64, 0>(WSP(bf16, WS_QA) + row * PQA + h * 64, WSP(bf16, WS_KA), WSP(bf16, WS_KA) + (size_t)(FR + b * SEQ) * PKA, PKA, h * 80,
                        WSP(bf16, WS_VA), WSP(bf16, WS_VA) + (size_t)(FR + b * SEQ) * PVA, PVA, h * 64, t, 0.f, WSP(bf16, WS_QA) + row * PQA + h * 64);
    }
    for (int e = g; e < M * 8; e += NG) {
        const int i = e % SEQ, bh = e / SEQ, b = bh >> 3, h = bh & 7; const size_t row = (size_t)b * SEQ + i; const int t = NMETA + i;
        attn_row<96, 1>(WSP(bf16, WS_QB) + row * PQB + h * 96, WSP(bf16, WS_KB), WSP(bf16, WS_KB) + (size_t)(FR + b * SEQ) * PKB, PKB, h * 96,
                        WSP(bf16, WS_VB), WSP(bf16, WS_VB) + (size_t)(FR + b * SEQ) * PVB, PVB, h * 64, t, 0.f, WSP(bf16, WS_YB) + row * PY + h * 64);
    }
    for (int e = g; e < M * 8; e += NG) {
        const int i = e % SEQ, bh = e / SEQ, b = bh >> 3, h = bh & 7; const size_t row = (size_t)b * SEQ + i; const int t = NMETA + i;
        attn_row<64, 2>(WSP(bf16, WS_QC) + row * PQC + h * 64, WSP(bf16, WS_KC), WSP(bf16, WS_KC) + (size_t)(FR + b * SEQ) * PKC, PKC, (h >> 2) * 64,
                        WSP(bf16, WS_VC), WSP(bf16, WS_VC) + (size_t)(FR + b * SEQ) * PVC, PVC, (h >> 2) * 64, t, c.sinks[layer * 8 + h] * LOG2E, WSP(bf16, WS_QC) + row * PQC + h * 64);
    }
}

namespace fa {
typedef float f32x16 __attribute__((ext_vector_type(16)));
typedef short s16x4 __attribute__((ext_vector_type(4)));
constexpr int KSLOT = 12288, VSLOT = 8192, OFF_K = 0, OFF_V = 2 * KSLOT, OFF_WS = OFF_V + 2 * VSLOT, OFF_OST = OFF_WS + NWAVES * 256, LDS_END = OFF_OST + NWAVES * 4096;
__device__ __forceinline__ int crow(int r, int hi) { return (r & 3) + 8 * (r >> 2) + 4 * hi; }
#define FA_SBAR() __builtin_amdgcn_sched_barrier(0)
__device__ __forceinline__ void pv(f32x16* o, int vb, bf16x8 pa0, bf16x8 pa1, bf16x8 pa2, bf16x8 pa3) {
#pragma unroll
    for (int d0 = 0; d0 < 2; ++d0) { s16x4 lo[4], hi[4];
#pragma unroll
        for (int ks = 0; ks < 4; ++ks) {
            asm volatile("ds_read_b64_tr_b16 %0,%1 offset:%c2" : "=&v"(lo[ks]) : "v"(vb), "i"(d0 * 4096 + ks * 1024) : "memory");
            asm volatile("ds_read_b64_tr_b16 %0,%1 offset:%c2" : "=&v"(hi[ks]) : "v"(vb), "i"(d0 * 4096 + ks * 1024 + 512) : "memory"); }
        asm volatile("s_waitcnt lgkmcnt(0)" ::: "memory"); FA_SBAR();
#define FA_PK(k) (bf16x8){lo[k][0], lo[k][1], lo[k][2], lo[k][3], hi[k][0], hi[k][1], hi[k][2], hi[k][3]}
        o[d0] = __builtin_amdgcn_mfma_f32_32x32x16_bf16(pa0, FA_PK(0), o[d0], 0, 0, 0);
        o[d0] = __builtin_amdgcn_mfma_f32_32x32x16_bf16(pa1, FA_PK(1), o[d0], 0, 0, 0);
        o[d0] = __builtin_amdgcn_mfma_f32_32x32x16_bf16(pa2, FA_PK(2), o[d0], 0, 0, 0);
        o[d0] = __builtin_amdgcn_mfma_f32_32x32x16_bf16(pa3, FA_PK(3), o[d0], 0, 0, 0);
#undef FA_PK
    }
}
struct Tensors { const bf16* Q; int qpitch, qoff; const bf16* Kf; const bf16* Km; int kpitch, koff; const bf16* Vf; const bf16* Vm; int vpitch, voff; bf16* O; int opitch, ooff; };
template <int NK, int MODE>
__device__ __forceinline__ void attn_unit(const Ctx& c, const Tensors& T, int j, float sink2) {
    constexpr int NCH = 2 * NK;
    LAS unsigned char* lds = c.lds;
    const int lane = c.lane, wid = c.wave, r32 = lane & 31, hi = lane >> 5;
    const unsigned lds0 = (unsigned)(size_t)lds;
    LAS float* wsf = (LAS float*)(lds + OFF_WS) + wid * 64;
    const int q0 = 256 * j;
    const int t_hi = 4 * j + 4, t_lo = (MODE == 2) ? (4 * j - 1 > 0 ? 4 * j - 1 : 0) : 0;
    bf16x8 qr[NK];
    { const bf16* qp = T.Q + (size_t)(q0 + wid * 32 + r32) * T.qpitch + T.qoff + hi * 8;
#pragma unroll
      for (int d0 = 0; d0 < NK; ++d0) { if (MODE == 0 && d0 == NK - 1) { const short one = (short)0x3F80; qr[d0] = hi ? (bf16x8){0, 0, 0, 0, 0, 0, 0, 0} : (bf16x8){one, one, one, 0, 0, 0, 0, 0}; } else qr[d0] = *(const bf16x8*)(qp + d0 * 16); } }
    u32x4 sk0, sk1 = {0u, 0u, 0u, 0u}, sv;
    const bool k2 = (wid + 8 < NCH);
#define FA_LOAD(t) do { const bf16* kt = ((t) == 0) ? T.Kf : T.Km + (size_t)(64 * ((t) - 1)) * T.kpitch; const bf16* vt = ((t) == 0) ? T.Vf : T.Vm + (size_t)(64 * ((t) - 1)) * T.vpitch; \
        sk0 = *(const u32x4*)(kt + (size_t)lane * T.kpitch + T.koff + wid * 8); if (k2) sk1 = *(const u32x4*)(kt + (size_t)lane * T.kpitch + T.koff + (wid + 8) * 8); \
        sv = *(const u32x4*)(vt + (size_t)(16 * (wid & 3) + (lane >> 2)) * T.vpitch + T.voff + (wid >> 2) * 32 + (lane & 3) * 8); } while (0)
#define FA_WRITE(b) do { *(LAS u32x4*)(lds + OFF_K + (b) * KSLOT + wid * 1024 + lane * 16) = sk0; if (k2) *(LAS u32x4*)(lds + OFF_K + (b) * KSLOT + (wid + 8) * 1024 + lane * 16) = sk1; \
        *(LAS u32x4*)(lds + OFF_V + (b) * VSLOT + wid * 1024 + lane * 16) = sv; } while (0)
    float m = (MODE == 2) ? sink2 : -INFINITY, l = (MODE == 2 && hi == 0) ? 1.f : 0.f;
    f32x16 o[2]; o[0] = f32x16{}; o[1] = f32x16{};
    const int qpos = NMETA + q0 + wid * 32 + r32;
    FA_LOAD(t_lo); FA_WRITE(0);
    int buf = 0;
    for (int t = t_lo; t <= t_hi; ++t) {
        __syncthreads();
        if (t < t_hi) FA_LOAD(t + 1);
        f32x16 p0 = f32x16{}, p1 = f32x16{};
        { const LAS unsigned char* kb = lds + OFF_K + buf * KSLOT + hi * 1024 + r32 * 16;
#pragma unroll
          for (int d0 = 0; d0 < NK; ++d0) { const bf16x8 b0 = *(const LAS bf16x8*)(kb + d0 * 2048), b1 = *(const LAS bf16x8*)(kb + d0 * 2048 + 512);
              p0 = __builtin_amdgcn_mfma_f32_32x32x16_bf16(b0, qr[d0], p0, 0, 0, 0); p1 = __builtin_amdgcn_mfma_f32_32x32x16_bf16(b1, qr[d0], p1, 0, 0, 0); } }
        const int kpos0 = (t == 0) ? -MOFF : NMETA + 64 * (t - 1);
        const bool need = (t == 0) || (t > t_hi - 4) || (MODE == 2);
        if (need) {
#pragma unroll
            for (int r = 0; r < 16; ++r) { const int ka = kpos0 + crow(r, hi), kb2 = ka + 32;
                bool ma = (ka > qpos) || (ka < 0), mb = (kb2 > qpos) || (kb2 < 0);
                if (MODE == 2) { ma = ma || (qpos - ka >= 128); mb = mb || (qpos - kb2 >= 128); }
                if (ma) p0[r] = -INFINITY; if (mb) p1[r] = -INFINITY; }
        }
        float rm = fmaxf(p0[0], p1[0]);
#pragma unroll
        for (int r = 1; r < 16; ++r) rm = fmaxf(rm, fmaxf(p0[r], p1[r]));
        { auto rr = __builtin_amdgcn_permlane32_swap(__float_as_uint(rm), __float_as_uint(rm), false, false); rm = fmaxf(__uint_as_float(rr[0]), __uint_as_float(rr[1])); }
        const float mn = fmaxf(m, rm);
        const bool grew = mn > m;
        const float alpha = (mn == -INFINITY) ? 1.f : fexp2(m - mn);
        const float msub = (mn == -INFINITY) ? 0.f : mn;
        float rs = 0.f;
#pragma unroll
        for (int r = 0; r < 16; ++r) { p0[r] = fexp2(p0[r] - msub); p1[r] = fexp2(p1[r] - msub); rs += p0[r] + p1[r]; }
        l = l * alpha + rs; m = mn;
        if (__any(grew)) {
            if (hi == 0) wsf[r32] = alpha;
            asm volatile("s_waitcnt lgkmcnt(0)" ::: "memory");
#pragma unroll
            for (int r = 0; r < 16; ++r) { const float f = wsf[crow(r, hi)]; o[0][r] *= f; o[1][r] *= f; }
        }
        u32x4 pw0, pw1, pw2, pw3;
        pw0 = (u32x4){cvtpk(p0[0], p0[1]), cvtpk(p0[2], p0[3]), cvtpk(p0[4], p0[5]), cvtpk(p0[6], p0[7])}; pw1 = (u32x4){cvtpk(p0[8], p0[9]), cvtpk(p0[10], p0[11]), cvtpk(p0[12], p0[13]), cvtpk(p0[14], p0[15])};
        pw2 = (u32x4){cvtpk(p1[0], p1[1]), cvtpk(p1[2], p1[3]), cvtpk(p1[4], p1[5]), cvtpk(p1[6], p1[7])}; pw3 = (u32x4){cvtpk(p1[8], p1[9]), cvtpk(p1[10], p1[11]), cvtpk(p1[12], p1[13]), cvtpk(p1[14], p1[15])};
        if (t < t_hi) FA_WRITE(buf ^ 1);
        const int vb = (int)(lds0 + OFF_V + buf * VSLOT) + ((lane >> 4) & 1) * 32 + (lane & 3) * 8 + (4 * hi + ((lane & 15) >> 2)) * 64;
        pv(o, vb, __builtin_bit_cast(bf16x8, pw0), __builtin_bit_cast(bf16x8, pw1), __builtin_bit_cast(bf16x8, pw2), __builtin_bit_cast(bf16x8, pw3));
        buf ^= 1;
    }
    { auto rr = __builtin_amdgcn_permlane32_swap(__float_as_uint(l), __float_as_uint(l), false, false); l = __uint_as_float(rr[0]) + __uint_as_float(rr[1]); }
    if (hi == 0) wsf[32 + r32] = l;
    asm volatile("s_waitcnt lgkmcnt(0)" ::: "memory");
    LAS bf16* stg = (LAS bf16*)(lds + OFF_OST) + wid * 2048;
#pragma unroll
    for (int r = 0; r < 16; ++r) { const int orow = crow(r, hi); const float rl = frcp(wsf[32 + orow]);
        stg[orow * 64 + r32] = f2bf(o[0][r] * rl); stg[orow * 64 + 32 + r32] = f2bf(o[1][r] * rl); }
    asm volatile("s_waitcnt lgkmcnt(0)" ::: "memory");
    bf16* Ow = T.O + (size_t)(q0 + wid * 32) * T.opitch + T.ooff;
#pragma unroll
    for (int i = 0; i < 4; ++i) { const int row = i * 8 + (lane >> 3), ch = lane & 7; const u32x4 v = *(const LAS u32x4*)(stg + row * 64 + ch * 8); *(u32x4*)(Ow + (size_t)row * T.opitch + ch * 8) = v; }
    __syncthreads();
#undef FA_LOAD
#undef FA_WRITE
}
#undef FA_SBAR
}
static_assert(fa::LDS_END <= 131072, "attention LDS");


namespace fb {
typedef float f32x16 __attribute__((ext_vector_type(16)));
typedef short s16x4 __attribute__((ext_vector_type(4)));
typedef short v4i16_t __attribute__((ext_vector_type(4)));
typedef __attribute__((address_space(3))) const char* lds_cptr;
__device__ __forceinline__ int crow(int r, int hi) { return (r & 3) + 8 * (r >> 2) + 4 * hi; }
#define SBAR() __builtin_amdgcn_sched_barrier(0)
__device__ __forceinline__ void cmask(f32x16& p0, f32x16& p1, int jb, int qrel, int hi) {
    const float NEG = -INFINITY; const int kb = 64 * jb + 4 * hi;
#pragma unroll
    for (int r = 0; r < 16; ++r) { const int kv = kb + (r & 3) + 8 * (r >> 2); if (kv > qrel) p0[r] = NEG; if (kv + 32 > qrel) p1[r] = NEG; }
}
__device__ __forceinline__ void glds16(const void* gsrc, unsigned lds_dst) { unsigned keep;
    asm volatile("s_mov_b32 %0, m0\n\ts_mov_b32 m0, %2\n\ts_nop 0\n\tglobal_load_lds_dwordx4 %1, off\n\ts_mov_b32 m0, %0" : "=&s"(keep) : "v"(gsrc), "s"(lds_dst) : "memory"); }
__device__ __forceinline__ float max3f(float a, float b, float c) { float r; asm("v_max3_f32 %0, %1, %2, %3" : "=v"(r) : "v"(a), "v"(b), "v"(c)); return r; }
__device__ __forceinline__ float max2f(float a, float b) { float r; asm("v_max_f32_e32 %0, %1, %2" : "=v"(r) : "v"(a), "v"(b)); return r; }
__device__ __forceinline__ float fadd_s(float a, float b) { float r; asm("v_add_f32_e32 %0, %1, %2" : "=v"(r) : "v"(a), "v"(b)); return r; }
__device__ __forceinline__ float fsub_s(float a, float b) { float r; asm("v_sub_f32_e32 %0, %1, %2" : "=v"(r) : "v"(a), "v"(b)); return r; }
#define WAIT_BAR(N) asm volatile("s_waitcnt vmcnt(" #N ") lgkmcnt(0)\n\ts_barrier" ::: "memory")
__device__ __forceinline__ void kload2(bf16x8* kf, lds_cptr kp, int j) { kf[2 * j] = *(const LAS bf16x8*)(kp + j * 2048); kf[2 * j + 1] = *(const LAS bf16x8*)(kp + j * 2048 + 512); }
__device__ __forceinline__ s16x4 vtr(lds_cptr p) { return __builtin_bit_cast(s16x4, __builtin_amdgcn_ds_read_tr16_b64_v4i16((LAS v4i16_t*)p)); }
__device__ __forceinline__ float rowmax(const f32x16& p0, const f32x16& p1) {
    float a = max3f(p0[0], p0[1], p1[0]), b = max3f(p0[2], p0[3], p1[1]); a = max3f(a, p1[2], p1[3]);
#pragma unroll
    for (int r = 4; r < 16; r += 4) { a = max3f(a, p0[r], p0[r + 1]); b = max3f(b, p0[r + 2], p0[r + 3]); a = max3f(a, p1[r], p1[r + 1]); b = max3f(b, p1[r + 2], p1[r + 3]); }
    const float m = max2f(a, b);
    auto rr = __builtin_amdgcn_permlane32_swap(__float_as_uint(m), __float_as_uint(m), false, false);
    return max2f(__uint_as_float(rr[0]), __uint_as_float(rr[1]));
}
__device__ __forceinline__ void pv(f32x16* o, int vb, bf16x8 pa0, bf16x8 pa1, bf16x8 pa2, bf16x8 pa3) {
#pragma unroll
    for (int d0 = 0; d0 < 2; ++d0) { s16x4 lo[4], hi[4];
#pragma unroll
        for (int ks = 0; ks < 4; ++ks) {
            asm volatile("ds_read_b64_tr_b16 %0,%1 offset:%c2" : "=&v"(lo[ks]) : "v"(vb), "i"(d0 * 4096 + ks * 1024) : "memory");
            asm volatile("ds_read_b64_tr_b16 %0,%1 offset:%c2" : "=&v"(hi[ks]) : "v"(vb), "i"(d0 * 4096 + ks * 1024 + 512) : "memory"); }
        asm volatile("s_waitcnt lgkmcnt(0)" ::: "memory"); SBAR();
#define PK(k) (bf16x8){lo[k][0], lo[k][1], lo[k][2], lo[k][3], hi[k][0], hi[k][1], hi[k][2], hi[k][3]}
        o[d0] = __builtin_amdgcn_mfma_f32_32x32x16_bf16(pa0, PK(0), o[d0], 0, 0, 0);
        o[d0] = __builtin_amdgcn_mfma_f32_32x32x16_bf16(pa1, PK(1), o[d0], 0, 0, 0);
        o[d0] = __builtin_amdgcn_mfma_f32_32x32x16_bf16(pa2, PK(2), o[d0], 0, 0, 0);
        o[d0] = __builtin_amdgcn_mfma_f32_32x32x16_bf16(pa3, PK(3), o[d0], 0, 0, 0);
#undef PK
    }
}
template <int NK> struct Geo { static constexpr int SLOTB = NK * 2048, LDS_K = 0, LDS_V = 3 * SLOTB, LDS_WS = 6 * SLOTB, LDS_OST = LDS_WS + NWAVES * 256, LDS_BYTES = LDS_OST + NWAVES * 4096; };
template <int NK, bool AUG, int QP, int KP, int VP, int OP, int THRL>
__device__ __forceinline__ void attn_unit(const bf16* Qb, const bf16* Kf, const bf16* Km, const bf16* Vf, const bf16* Vm, bf16* Ob, int j, char* shm, int tid) {
    typedef Geo<NK> G; constexpr int SLOTB = G::SLOTB, LDS_K = G::LDS_K, LDS_V = G::LDS_V, LDS_WS = G::LDS_WS, LDS_OST = G::LDS_OST, NCH = 2 * NK, NKD = (NK > 4) ? 2 : 1, NSLOT = 3;
    const int lane = tid & 63, r32 = lane & 31, hi = lane >> 5; const int wid = __builtin_amdgcn_readfirstlane(tid >> 6);
    const int q0 = 256 * j;
    const bf16* Qw = Qb + (size_t)(q0 + wid * 32) * QP;
    const unsigned lds0 = (unsigned)(uintptr_t)shm;
    float* wsf = (float*)(shm + LDS_WS) + wid * 64;
    const int c2 = 8 + (wid % (NCH > 8 ? NCH - 8 : 1));
    const bf16* ksrc_f = Kf + (size_t)lane * KP + wid * 8; const bf16* ksrc_m = Km + (size_t)lane * KP + wid * 8;
    const bf16* vsrc_f = Vf + (size_t)(16 * (wid & 3) + (lane >> 2)) * VP + (wid >> 2) * 32 + (lane & 3) * 8; const bf16* vsrc_m = Vm + (size_t)(16 * (wid & 3) + (lane >> 2)) * VP + (wid >> 2) * 32 + (lane & 3) * 8;
    const unsigned kdst = lds0 + LDS_K + wid * 1024, kdst2 = lds0 + LDS_K + c2 * 1024, vdst = lds0 + LDS_V + wid * 1024;
#define RFL(x) ((unsigned)__builtin_amdgcn_readfirstlane(x))
#define DMA_KP(src, slot) do { glds16((src), RFL(kdst + (slot))); if (NKD == 2) glds16((src) + (c2 - wid) * 8, RFL(kdst2 + (slot))); } while (0)
#define DMA_K0(slot) DMA_KP(ksrc_f, slot)
#define DMA_KM(t, slot) DMA_KP(ksrc_m + (size_t)((t) - 1) * 64 * KP, slot)
#define DMA_V0(slot) glds16(vsrc_f, RFL(vdst + (slot)))
#define DMA_VM(t, slot) glds16(vsrc_m + (size_t)((t) - 1) * 64 * VP, RFL(vdst + (slot)))
#define WAIT_KV() do { if (NKD == 2) { WAIT_BAR(3); } else { WAIT_BAR(2); } } while (0)
    const int vb0 = (int)(lds0 + LDS_V) + ((lane >> 4) & 1) * 32 + (lane & 3) * 8 + (4 * hi + ((lane & 15) >> 2)) * 64;
    bf16x8 kf[2 * NK];
    const lds_cptr shm3 = (lds_cptr)shm; const lds_cptr kp0 = shm3 + LDS_K + hi * 1024 + r32 * 16; const lds_cptr vp0 = shm3 + LDS_V + ((lane >> 4) & 1) * 32 + (lane & 3) * 8 + (4 * hi + ((lane & 15) >> 2)) * 64;
    const int NT = 4 * j + 5;
    DMA_K0(0); DMA_V0(0); DMA_KM(1, SLOTB);
    bf16x8 qr[NK];
#pragma unroll
    for (int d0 = 0; d0 < NK; ++d0) { if (AUG && d0 == NK - 1) { const short one = (short)0x3F80; qr[d0] = hi ? (bf16x8){0, 0, 0, 0, 0, 0, 0, 0} : (bf16x8){one, one, one, 0, 0, 0, 0, 0}; }
        else qr[d0] = *reinterpret_cast<const bf16x8*>(&Qw[(size_t)r32 * QP + d0 * 16 + hi * 8]); }
    float mhat = 0.f, l_reg = 0.f; f32x16 o[2]; o[0] = f32x16{}; o[1] = f32x16{}; f32x16 negm = f32x16{}; if (!AUG) asm volatile("" : "+v"(negm));
#define SETREF() do { if (AUG) { bf16 h_, m_, l_; split3(-mhat, h_, m_, l_); if (hi == 0) { u32x4 w_ = {0x3F803F80u, 0x3F80u | ((unsigned)h_ << 16), (unsigned)m_ | ((unsigned)l_ << 16), 0u}; qr[NK - 1] = __builtin_bit_cast(bf16x8, w_); } } \
        else { _Pragma("unroll") for (int r = 0; r < 16; ++r) negm[r] = -mhat; asm volatile("" : "+v"(negm)); } } while (0)
#define CIN (AUG ? f32x16{} : negm)
    const int qrel = wid * 32 + r32;
#define CMASK(P0, P1, t) do { int jb_ = (t) - (NT - 4); if (jb_ >= 0) cmask(P0, P1, jb_, qrel, hi); } while (0)
    bool resc = false;
#define START(P0, P1) do { const float rm = rowmax(P0, P1); resc = false; \
    { const float dl = rm; mhat = fadd_s(mhat, dl); \
      _Pragma("unroll") for (int r = 0; r < 16; ++r) { P0[r] = fsub_s(P0[r], dl); P1[r] = fsub_s(P1[r], dl); } \
      SETREF(); } \
    _Pragma("unroll") for (int r = 0; r < 16; ++r) P0[r] = __builtin_amdgcn_exp2f(P0[r]); } while (0)
#define RESC() do { if (resc) { asm volatile("s_waitcnt lgkmcnt(0)" ::: "memory"); \
      _Pragma("unroll") for (int d_ = 0; d_ < 2; ++d_) _Pragma("unroll") for (int r = 0; r < 16; ++r) o[d_][r] *= wsf[crow(r, hi)]; } } while (0)
    f32x16 pA0, pA1, pB0, pB1;
    int sl_prev = 0, sl_cur = 0, sl_next = SLOTB;
#define ROT() do { sl_prev = sl_cur; sl_cur = sl_next; sl_next = (sl_next == (NSLOT - 1) * SLOTB) ? 0 : sl_next + SLOTB; } while (0)
    DMA_KM(2, 2 * SLOTB);
    if (NKD == 2) { WAIT_BAR(5); } else { WAIT_BAR(3); }
    { pA0 = CIN; pA1 = CIN; const char* kb = shm + LDS_K + hi * 1024 + r32 * 16;
#pragma unroll
      for (int d0 = 0; d0 < NK; ++d0) { const bf16x8 b0 = *reinterpret_cast<const bf16x8*>(kb + d0 * 2048), b1 = *reinterpret_cast<const bf16x8*>(kb + d0 * 2048 + 512);
          pA0 = __builtin_amdgcn_mfma_f32_32x32x16_bf16(b0, qr[d0], pA0, 0, 0, 0); pA1 = __builtin_amdgcn_mfma_f32_32x32x16_bf16(b1, qr[d0], pA1, 0, 0, 0); } }
    asm volatile("s_nop 15\n\ts_nop 7" : "+v"(pA0), "+v"(pA1));
#pragma unroll
    for (int r = 0; r < 16; ++r) { pA0[r] = -INFINITY; if (r < 8) pA1[r] = -INFINITY; }
    START(pA0, pA1);
#pragma unroll
    for (int r = 0; r < 16; ++r) pA1[r] = __builtin_amdgcn_exp2f(pA1[r]);
    WAIT_BAR(0);
    DMA_KM(3, 0); DMA_VM(1, SLOTB);
    ROT();
#pragma unroll
    for (int jj = 0; jj < NK; ++jj) kload2(kf, kp0 + sl_cur, jj);
    WAIT_KV();
    s16x4 vlo[8], vhi[8]; u32x4 pw0, pw1, pw2, pw3;
#define PKW(P, B) cvtpk(P[B], P[B + 1])
#define PAF(k) __builtin_bit_cast(bf16x8, pw##k)
#define VFR(i) (bf16x8){vlo[i][0], vlo[i][1], vlo[i][2], vlo[i][3], vhi[i][0], vhi[i][1], vhi[i][2], vhi[i][3]}
#define PIN(x) asm volatile("" : "+v"(x))
#define MX3(a, b, c) __builtin_fmaxf(__builtin_fmaxf((a), (b)), (c))
#define MF(c_, a_, b_) __builtin_amdgcn_mfma_f32_32x32x16_bf16(a_, b_, c_, 0, 0, 0)
#define GAPA(MFX, A0, A1, A2, A3, W0, W1, PW) do { MFX; sacc += A0; sacc += A1; sacc += A2; sacc += A3; PIN(sacc); W0; W1; PIN(PW); SBAR(); } while (0)
#define EX(v) __builtin_amdgcn_exp2f(v)
#define GAPB(MFX, X, B) do { MFX; X[B] = EX(X[B]); X[B + 1] = EX(X[B + 1]); X[B + 2] = EX(X[B + 2]); X[B + 3] = EX(X[B + 3]); PIN(X); SBAR(); } while (0)
#define VRD(i) do { vlo[i] = vtr(vp_ + (((i) >> 2) * 4096 + ((i) & 3) * 1024)); vhi[i] = vtr(vp_ + (((i) >> 2) * 4096 + ((i) & 3) * 1024 + 512)); } while (0)
#define KRD(Gf, jj) do { if (Gf) { kload2(kf, kp0 + sl_next, jj); SBAR(); } } while (0)
#define STEP(C0, C1, P0, P1, t, GK, GV, GL) do { SBAR(); \
    const lds_cptr vp_ = vp0 + sl_prev; \
    VRD(0); SBAR(); float sacc = (P0[0] + P0[1]); \
    GAPA(C0 = MF(CIN, kf[0], qr[0]), P0[2], P0[3], P0[4], P0[5],     pw0[0] = PKW(P0, 0), pw0[1] = PKW(P0, 2), pw0); \
    VRD(4); SBAR(); GAPA(C1 = MF(CIN, kf[1], qr[0]), P0[6], P0[7], P0[8], P0[9],     pw0[2] = PKW(P0, 4), pw0[3] = PKW(P0, 6), pw0); \
    VRD(1); SBAR(); GAPA(C0 = MF(C0, kf[2], qr[1]),   P0[10], P0[11], P0[12], P0[13], pw1[0] = PKW(P0, 8), pw1[1] = PKW(P0, 10), pw1); \
    VRD(5); SBAR(); GAPA(C1 = MF(C1, kf[3], qr[1]),   P0[14], P0[15], P1[0], P1[1],   pw1[2] = PKW(P0, 12), pw1[3] = PKW(P0, 14), pw1); \
    VRD(2); SBAR(); GAPA(C0 = MF(C0, kf[4], qr[2]),   P1[2], P1[3], P1[4], P1[5],     pw2[0] = PKW(P1, 0), pw2[1] = PKW(P1, 2), pw2); \
    VRD(6); SBAR(); GAPA(C1 = MF(C1, kf[5], qr[2]),   P1[6], P1[7], P1[8], P1[9],     pw2[2] = PKW(P1, 4), pw2[3] = PKW(P1, 6), pw2); \
    VRD(3); SBAR(); GAPA(C0 = MF(C0, kf[6], qr[3]),   P1[10], P1[11], P1[12], P1[13], pw3[0] = PKW(P1, 8), pw3[1] = PKW(P1, 10), pw3); \
    VRD(7); SBAR(); GAPA(C1 = MF(C1, kf[7], qr[3]),   P1[14], P1[15], 0.f, 0.f,       pw3[2] = PKW(P1, 12), pw3[3] = PKW(P1, 14), pw3); \
    if (NK > 4) { C0 = MF(C0, kf[8 % (2 * NK)], qr[4 % NK]); C1 = MF(C1, kf[9 % (2 * NK)], qr[4 % NK]); SBAR(); } \
    if (NK > 5) { C0 = MF(C0, kf[10 % (2 * NK)], qr[5 % NK]); C1 = MF(C1, kf[11 % (2 * NK)], qr[5 % NK]); SBAR(); } \
    l_reg += sacc; \
    if (GK) { DMA_KM((t) + 3, sl_cur); } if (GV) { DMA_VM((t) + 1, sl_next); } \
    CMASK(C0, C1, t); \
    { float a = MX3(C0[0], C0[1], C1[0]), b = MX3(C0[2], C0[3], C1[1]); a = MX3(a, C1[2], C1[3]); \
      _Pragma("unroll") for (int r = 4; r < 16; r += 4) { a = MX3(a, C0[r], C0[r + 1]); b = MX3(b, C0[r + 2], C0[r + 3]); a = MX3(a, C1[r], C1[r + 1]); b = MX3(b, C1[r + 2], C1[r + 3]); } \
      float rm = __builtin_fmaxf(a, b); { auto rr = __builtin_amdgcn_permlane32_swap(__float_as_uint(rm), __float_as_uint(rm), false, false); rm = __builtin_fmaxf(__uint_as_float(rr[0]), __uint_as_float(rr[1])); } \
      resc = false; \
      if (__builtin_expect(__any(rm > (float)THRL), 0)) { const float dl = __builtin_fmaxf(rm, 0.f); mhat += dl; \
        _Pragma("unroll") for (int r = 0; r < 16; ++r) { C0[r] -= dl; C1[r] -= dl; } \
        SETREF(); \
        const float f = __builtin_amdgcn_exp2f(-dl); l_reg *= f; if (hi == 0) wsf[r32] = f; resc = true; } } \
    SBAR(); \
    GAPB(o[0] = MF(o[0], PAF(0), VFR(0)), C0, 0); \
    GAPB(o[1] = MF(o[1], PAF(0), VFR(4)), C0, 4); \
    KRD(GL, 0); GAPB(o[0] = MF(o[0], PAF(1), VFR(1)), C0, 8); \
    KRD(GL, 1); GAPB(o[1] = MF(o[1], PAF(1), VFR(5)), C0, 12); \
    KRD(GL, 2); GAPB(o[0] = MF(o[0], PAF(2), VFR(2)), C1, 0); \
    KRD(GL, 3); GAPB(o[1] = MF(o[1], PAF(2), VFR(6)), C1, 4); \
    if (NK > 4) KRD(GL, 4 % NK); GAPB(o[0] = MF(o[0], PAF(3), VFR(3)), C1, 8); \
    if (NK > 5) KRD(GL, 5 % NK); GAPB(o[1] = MF(o[1], PAF(3), VFR(7)), C1, 12); \
    } while (0)
    int t = 1;
#undef CMASK
#define CMASK(P0, P1, t) do { } while (0)
    for (; t + 5 < NT; t += 2) {
        STEP(pB0, pB1, pA0, pA1, t, true, true, true);     WAIT_KV(); RESC(); ROT();
        STEP(pA0, pA1, pB0, pB1, t + 1, true, true, true); WAIT_KV(); RESC(); ROT();
    }
#undef CMASK
#define CMASK(P0, P1, t) do { int jb_ = (t) - (NT - 4); if (jb_ >= 0) cmask(P0, P1, jb_, qrel, hi); } while (0)
#define ENDW(tt) do { if ((tt) + 3 < NT) { WAIT_KV(); } else if ((tt) + 2 < NT) { WAIT_BAR(1); } else { WAIT_BAR(0); } } while (0)
    for (; t + 1 < NT; t += 2) {
        STEP(pB0, pB1, pA0, pA1, t, (t + 3 < NT), (t + 1 < NT), (t + 1 < NT));       ENDW(t);     RESC(); ROT();
        STEP(pA0, pA1, pB0, pB1, t + 1, (t + 4 < NT), (t + 2 < NT), (t + 2 < NT));   ENDW(t + 1); RESC(); ROT();
    }
    { float sacc = pA0[0] + pA0[1];
#pragma unroll
      for (int r = 2; r < 16; ++r) sacc += pA0[r];
#pragma unroll
      for (int r = 0; r < 16; ++r) sacc += pA1[r];
      l_reg += sacc;
      pw0 = (u32x4){PKW(pA0, 0), PKW(pA0, 2), PKW(pA0, 4), PKW(pA0, 6)}; pw1 = (u32x4){PKW(pA0, 8), PKW(pA0, 10), PKW(pA0, 12), PKW(pA0, 14)}; pw2 = (u32x4){PKW(pA1, 0), PKW(pA1, 2), PKW(pA1, 4), PKW(pA1, 6)}; pw3 = (u32x4){PKW(pA1, 8), PKW(pA1, 10), PKW(pA1, 12), PKW(pA1, 14)};
      SBAR(); pv(o, vb0 + sl_prev, PAF(0), PAF(1), PAF(2), PAF(3)); }
    { auto rr = __builtin_amdgcn_permlane32_swap(__float_as_uint(l_reg), __float_as_uint(l_reg), false, false); l_reg = __uint_as_float(rr[0]) + __uint_as_float(rr[1]); }
    if (hi == 0) wsf[32 + r32] = l_reg; asm volatile("s_waitcnt lgkmcnt(0)" ::: "memory");
    float rli[16];
#pragma unroll
    for (int r = 0; r < 16; ++r) rli[r] = __builtin_amdgcn_rcpf(wsf[32 + crow(r, hi)]);
    bf16* Ow = Ob + (size_t)(q0 + wid * 32) * OP;
    { bf16* stg = (bf16*)(shm + LDS_OST) + wid * 2048;
#pragma unroll
      for (int r = 0; r < 16; ++r) { const int orow = crow(r, hi);
#pragma unroll
          for (int d0 = 0; d0 < 2; ++d0) stg[orow * 64 + d0 * 32 + r32] = f2bf(o[d0][r] * rli[r]); }
      asm volatile("s_waitcnt lgkmcnt(0)" ::: "memory");
#pragma unroll
      for (int i = 0; i < 4; ++i) { const int row = i * 8 + (lane >> 3), ch = lane & 7; const u32x4 v = *(const u32x4*)(stg + row * 64 + ch * 8); *(u32x4*)(Ow + (size_t)row * OP + ch * 8) = v; } }
    asm volatile("s_waitcnt vmcnt(0) lgkmcnt(0)\n\ts_barrier" ::: "memory");
#undef SETREF
#undef CIN
#undef RFL
#undef DMA_KP
#undef DMA_K0
#undef DMA_KM
#undef DMA_V0
#undef DMA_VM
#undef WAIT_KV
#undef CMASK
#undef START
#undef RESC
#undef ROT
#undef PKW
#undef PAF
#undef VFR
#undef PIN
#undef MX3
#undef MF
#undef GAPA
#undef GAPB
#undef EX
#undef VRD
#undef KRD
#undef STEP
#undef ENDW
}
#undef SBAR
#undef WAIT_BAR
}
static_assert(fb::Geo<6>::LDS_BYTES <= 131072, "attention LDS");

#ifndef FB_THR
#define FB_THR 0
#endif
#ifndef USE_FB_A
#define USE_FB_A USE_FB
#endif
#ifndef USE_FB_B
#define USE_FB_B 0
#endif
__device__ __forceinline__ void attn_main_mfma(const Ctx& c0, int layer) {
#define LAUNDER() Ctx c = c0; asm volatile("" : "+v"(c.tid)); c.lane = c.tid & 63; c.wave = __builtin_amdgcn_readfirstlane(c.tid >> 6);
    const int vcu = (c0.G % 8 == 0) ? (c0.bid % 8) * (c0.G / 8) + c0.bid / 8 : c0.bid;
    char* shm = (char*)(__attribute__((address_space(0))) char*)c0.lds; (void)shm;
#ifndef REP_B
#define REP_B 1
#endif
#ifndef REP_C
#define REP_C 1
#endif
#pragma nounroll
    for (int rep = 0; rep < REP_B; ++rep)
    { LAUNDER()
#pragma nounroll
    for (int uu = 2 * vcu; uu < 512; uu += 2 * c.G) {
#pragma nounroll
        for (int k = 0; k < 2; ++k) {
            const int u = uu >> 1, bh = u >> 3, s8 = u & 7, b = bh >> 3, h = bh & 7, j = k ? s8 : 15 - s8; const size_t r0 = (size_t)b * SEQ;
#if USE_FB_B
            fb::attn_unit<6, false, PQB, PKB, PVB, PY, FB_THR>(WSP(bf16, WS_QB) + r0 * PQB + h * 96, WSP(bf16, WS_KB) + h * 96, WSP(bf16, WS_KB) + (FR + r0) * PKB + h * 96, WSP(bf16, WS_VB) + h * 64, WSP(bf16, WS_VB) + (FR + r0) * PVB + h * 64, WSP(bf16, WS_YB) + r0 * PY + h * 64, j, shm, c.tid);
#else
            const fa::Tensors TB{WSP(bf16, WS_QB) + r0 * PQB, PQB, h * 96, WSP(bf16, WS_KB), WSP(bf16, WS_KB) + (FR + r0) * PKB, PKB, h * 96, WSP(bf16, WS_VB), WSP(bf16, WS_VB) + (FR + r0) * PVB, PVB, h * 64, WSP(bf16, WS_YB) + r0 * PY, PY, h * 64};
            fa::attn_unit<6, 1>(c, TB, j, 0.f);
#endif
        }
    }
    }
    { LAUNDER()
#pragma nounroll
    for (int uu = 2 * vcu; uu < 512; uu += 2 * c.G) {
#pragma nounroll
        for (int k = 0; k < 2; ++k) {
            const int u = uu >> 1, bh = u >> 3, s8 = u & 7, b = bh >> 3, h = bh & 7, j = k ? s8 : 15 - s8; const size_t r0 = (size_t)b * SEQ;
#if USE_FB_A
            fb::attn_unit<5, true, PQA, PKA, PVA, PQA, FB_THR>(WSP(bf16, WS_QA) + r0 * PQA + h * 64, WSP(bf16, WS_KA) + h * 80, WSP(bf16, WS_KA) + (FR + r0) * PKA + h * 80, WSP(bf16, WS_VA) + h * 64, WSP(bf16, WS_VA) + (FR + r0) * PVA + h * 64, WSP(bf16, WS_QA) + r0 * PQA + h * 64, j, shm, c.tid);
#else
            const fa::Tensors TA{WSP(bf16, WS_QA) + r0 * PQA, PQA, h * 64, WSP(bf16, WS_KA), WSP(bf16, WS_KA) + (FR + r0) * PKA, PKA, h * 80, WSP(bf16, WS_VA), WSP(bf16, WS_VA) + (FR + r0) * PVA, PVA, h * 64, WSP(bf16, WS_QA) + r0 * PQA, PQA, h * 64};
            fa::attn_unit<5, 0>(c, TA, j, 0.f);
#endif
        }
    }
    }
    { LAUNDER()
#pragma nounroll
    for (int uu = 2 * vcu; uu < 512; uu += 2 * c.G) {
#pragma nounroll
        for (int k = 0; k < 2; ++k) {
            const int u = uu >> 1, bh = u >> 3, s8 = u & 7, b = bh >> 3, h = bh & 7, j = k ? s8 : 15 - s8; const size_t r0 = (size_t)b * SEQ;
            const fa::Tensors TC{WSP(bf16, WS_QC) + r0 * PQC, PQC, h * 64, WSP(bf16, WS_KC), WSP(bf16, WS_KC) + (FR + r0) * PKC, PKC, (h >> 2) * 64, WSP(bf16, WS_VC), WSP(bf16, WS_VC) + (FR + r0) * PVC, PVC, (h >> 2) * 64, WSP(bf16, WS_QC) + r0 * PQC, PQC, h * 64};
            fa::attn_unit<4, 2>(c, TC, j, c.sinks[layer * 8 + h] * LOG2E);
        }
    }
    }
#undef LAUNDER
}

__device__ __forceinline__ void attn_meta(const Ctx& c) {
    if (c.tid >= 384) return;
    const int br = c.tid / 128, h = (c.tid >> 4) & 7, r = c.tid & 15; bf16* ym = WSP(bf16, WS_YM) + (size_t)r * 1536 + br * 512 + h * 64;
    if (br == 0) attn_row<64, 0>(WSP(bf16, WS_QAM) + r * PQA + h * 64, WSP(bf16, WS_KA), WSP(bf16, WS_KA), PKA, h * 80, WSP(bf16, WS_VA), WSP(bf16, WS_VA), PVA, h * 64, r, 0.f, ym);
    else if (br == 1) attn_row<96, 1>(WSP(bf16, WS_QBM) + r * PQB + h * 96, WSP(bf16, WS_KB), WSP(bf16, WS_KB), PKB, h * 96, WSP(bf16, WS_VB), WSP(bf16, WS_VB), PVB, h * 64, r, 0.f, ym);
    else attn_row<64, 2>(WSP(bf16, WS_QCM) + r * PQC + h * 64, WSP(bf16, WS_KC), WSP(bf16, WS_KC), PKC, (h >> 2) * 64, WSP(bf16, WS_VC), WSP(bf16, WS_VC), PVC, (h >> 2) * 64, r, c.sinks[h] * LOG2E, ym);
}

struct Unit { int pm, pn, z; };
__device__ __forceinline__ int perm32(int rho) { const int n = rho >> 4, i = rho & 15; return 8 * (i >> 2) + 4 * n + (i & 3); }
template <class Prob, class Epi, class Sched>
__device__ __forceinline__ void gemm_naive(const Ctx& c, const Prob& P, const Sched& S, const Epi& E) {
    const int wr = c.wave >> 2, wc = c.wave & 3, fr = c.lane & 15, fq = c.lane >> 4;
    Unit u;
    for (int ui = 0; S.next(ui, u); ++ui) {
        const bf16* A; const bf16* Bt; P.operands(u, A, Bt);
        const int K = P.K, lda = P.K;
        f32x4 acc[2][2][4][2];
#pragma unroll
        for (int a = 0; a < 2; ++a)
#pragma unroll
            for (int b = 0; b < 2; ++b)
#pragma unroll
                for (int m = 0; m < 4; ++m)
#pragma unroll
                    for (int n = 0; n < 2; ++n) acc[a][b][m][n] = (f32x4){0.f, 0.f, 0.f, 0.f};
        for (int k0 = 0; k0 < K; k0 += 64) {
#pragma unroll
            for (int ai = 0; ai < 2; ++ai) {
#pragma unroll
                for (int bj = 0; bj < 2; ++bj) {
                    bf16x8 Bf[2][2];
#pragma unroll
                    for (int n = 0; n < 2; ++n)
#pragma unroll
                        for (int k = 0; k < 2; ++k) Bf[n][k] = *(const bf16x8*)(Bt + (size_t)(256 * u.pn + 128 * bj + 32 * wc + perm32(16 * n + fr)) * K + k0 + 32 * k + 8 * fq);
#pragma unroll
                    for (int m = 0; m < 4; ++m) {
                        bf16x8 At[2];
#pragma unroll
                        for (int k = 0; k < 2; ++k) At[k] = *(const bf16x8*)(A + (size_t)(256 * u.pm + 128 * ai + 64 * wr + 16 * m + fr) * lda + k0 + 32 * k + 8 * fq);
#pragma unroll
                        for (int n = 0; n < 2; ++n)
#pragma unroll
                            for (int k = 0; k < 2; ++k) acc[ai][bj][m][n] = __builtin_amdgcn_mfma_f32_16x16x32_bf16(Bf[n][k], At[k], acc[ai][bj][m][n], 0, 0, 0);
                    }
                }
            }
        }
        asm volatile("" ::: "memory");
        E(acc, u, wr, wc, fr, fq);
    }
}
struct ProbSimple { const bf16* A; const bf16* Bt; int K;
    __device__ __forceinline__ void operands(const Unit&, const bf16*& a, const bf16*& b) const { a = A; b = Bt; } };
struct ProbBranch { const bf16 *A0, *A1, *A2; const bf16* Bt; int K;
    __device__ __forceinline__ void operands(const Unit& u, const bf16*& a, const bf16*& b) const { a = (u.z == 0) ? A0 : (u.z == 1) ? A1 : A2; b = Bt + (size_t)u.z * DM * 512; } };

namespace pg8 {
constexpr int BM = 256, BK = 64, HALF = 128, HTB = HALF * BK * 2, STAGE_BYTES = 8 * HTB, NXCD = 8, WGM = 8;
__host__ __device__ __forceinline__ int lds_byte(int r, int c) { const int st = (r >> 4) * 2 + (c >> 5), rr = r & 15, cc = c & 31, ob = rr * 64 + cc * 2; return st * 1024 + (ob ^ (((ob >> 9) & 1) << 5)); }
__host__ __device__ __forceinline__ void stage_rc(int b, int& R, int& C) { const int st = b / 1024, sb = b % 1024, swz = sb ^ (((sb >> 9) & 1) << 5); R = (st >> 1) * 16 + swz / 64; C = (st & 1) * 32 + (swz % 64) / 2; }
template <int ZN>
struct StaticOrder {
    int nM, nN, nwg, G, c, pn0;
    __device__ __forceinline__ void init(int nM_, int nN_, int pn0_, int G_, int c_) { nM = nM_; nN = nN_; nwg = nM * nN; G = G_; c = c_; pn0 = pn0_; }
    __device__ __forceinline__ bool next(int i, Unit& u) const {
        const int it = i / ZN;
        const long L = (long)it * G + c; if (L >= nwg) return false;
        int wgid = (int)L; { const int q = nwg / NXCD, r = nwg % NXCD, xcd = wgid % NXCD, off = wgid / NXCD; wgid = (xcd < r ? xcd * (q + 1) : r * (q + 1) + (xcd - r) * q) + off; }
        const int nig = WGM * nN, gid = wgid / nig, fm = gid * WGM, gsz = (nM - fm) < WGM ? (nM - fm) : WGM;
        u.pm = fm + ((wgid % nig) % gsz); u.pn = pn0 + (wgid % nig) / gsz; u.z = i - it * ZN; return true;
    }
};
template <class Prob, class Epi, class Sched, bool ALIGN_EPI, bool SP2>
__device__ __forceinline__ void gemm_phase(LAS unsigned char* lds, const Prob& P, const Sched& S, const Epi& E) {
    const int tid = threadIdx.x, wid = __builtin_amdgcn_readfirstlane(tid >> 6), lane = tid & 63, wr = wid >> 2, wc = wid & 3, fr = lane & 15, fq = lane >> 4;
    const int K = P.K, nt = K / BK;
    unsigned voffA[2], voffB[2];
#pragma unroll
    for (int i = 0; i < 2; ++i) { int R, C; stage_rc(tid * 16 + i * 8192, R, C); const int Rb = (R & ~31) + perm32(R & 31);
        voffA[i] = (unsigned)(R * K + C) * 2u; voffB[i] = (unsigned)(Rb * K + C) * 2u; }
    const size_t kstep = (size_t)(BK * 2);
    const size_t hstep = (size_t)HALF * K * 2;
    const size_t tstep = 2 * hstep;
    const unsigned ldsw = (unsigned)wid * 1024u;
    const int aoff = lds_byte(wr * 64 + fr, fq * 8), boff = lds_byte(wc * 32 + fr, fq * 8);
#define PG8_SA(b, h) (((b) * 2 + (h)) * HTB)
#define PG8_SB(b, h) ((4 + (b) * 2 + (h)) * HTB)
#define PG8_STAGE(bufoff, gbase, voff) do { _Pragma("unroll") for (int _i = 0; _i < 2; ++_i) \
        __builtin_amdgcn_global_load_lds((const unsigned*)((const char*)(gbase) + (voff)[_i]), (LAS unsigned*)(lds + (bufoff) + ldsw + _i * 8192), 16, 0, 0); } while (0)
#define PG8_LDA(dst, b, h) do { _Pragma("unroll") for (int m = 0; m < 4; ++m) _Pragma("unroll") for (int k = 0; k < 2; ++k) dst[m][k] = *(const LAS bf16x8*)(lds + PG8_SA(b, h) + aoff + m * 2048 + k * 1024); } while (0)
#define PG8_LDB(dst, b, h) do { _Pragma("unroll") for (int n = 0; n < 2; ++n) _Pragma("unroll") for (int k = 0; k < 2; ++k) dst[n][k] = *(const LAS bf16x8*)(lds + PG8_SB(b, h) + boff + n * 2048 + k * 1024); } while (0)
#define PG8_MMA(ai, bj, At, Bt) do { __builtin_amdgcn_s_setprio(1); _Pragma("unroll") for (int m = 0; m < 4; ++m) _Pragma("unroll") for (int n = 0; n < 2; ++n) _Pragma("unroll") for (int k = 0; k < 2; ++k) \
        acc[ai][bj][m][n] = __builtin_amdgcn_mfma_f32_16x16x32_bf16(Bt[n][k], At[m][k], acc[ai][bj][m][n], 0, 0, 0); __builtin_amdgcn_s_setprio(0); } while (0)
#define PG8_WAIT_V(n) asm volatile("s_waitcnt vmcnt(" #n ")" ::: "memory")
#define PG8_WAIT_L(n) asm volatile("s_waitcnt lgkmcnt(" #n ")" ::: "memory")
#define PG8_BAR __builtin_amdgcn_s_barrier()
#define PG8_SCHED __builtin_amdgcn_sched_barrier(0)
    Unit cur, nxt; int ui = 0;
    if (!S.next(0, cur)) return;
    f32x4 acc[2][2][4][2];
#pragma unroll
    for (int a = 0; a < 2; ++a)
#pragma unroll
        for (int b = 0; b < 2; ++b)
#pragma unroll
            for (int m = 0; m < 4; ++m)
#pragma unroll
                for (int n = 0; n < 2; ++n) acc[a][b][m][n] = (f32x4){0.f, 0.f, 0.f, 0.f};
    bf16x8 At[4][2], B0[2][2], B1[2][2];
    const char* cA; const char* cB;
    { const bf16 *pa, *pb; P.operands(cur, pa, pb); cA = (const char*)pa + (size_t)cur.pm * tstep; cB = (const char*)pb + (size_t)cur.pn * tstep; }
    if constexpr (SP2) {
        PG8_STAGE(PG8_SB(0, 0), cB, voffB); PG8_STAGE(PG8_SB(0, 1), cB + hstep, voffB); PG8_STAGE(PG8_SA(0, 0), cA, voffA); PG8_STAGE(PG8_SA(0, 1), cA + hstep, voffA);
        if (wr == 1) PG8_BAR;
        PG8_WAIT_V(2); PG8_BAR;
        PG8_STAGE(PG8_SB(1, 0), cB + kstep, voffB); PG8_STAGE(PG8_SA(1, 0), cA + kstep, voffA); PG8_STAGE(PG8_SB(1, 1), cB + hstep + kstep, voffB);
        PG8_WAIT_V(6); PG8_BAR;
    } else {
        PG8_STAGE(PG8_SB(0, 0), cB, voffB); PG8_STAGE(PG8_SA(0, 0), cA, voffA); PG8_STAGE(PG8_SB(0, 1), cB + hstep, voffB); PG8_STAGE(PG8_SA(0, 1), cA + hstep, voffA);
        if (wr == 1) PG8_BAR;
        PG8_WAIT_V(4); PG8_BAR;
        PG8_STAGE(PG8_SB(1, 0), cB + kstep, voffB); PG8_STAGE(PG8_SA(1, 0), cA + kstep, voffA); PG8_STAGE(PG8_SB(1, 1), cB + hstep + kstep, voffB);
        PG8_WAIT_V(6); PG8_BAR;
    }
    for (;;) {
        const bool has_next = S.next(ui + 1, nxt);
        const char* nA = cA; const char* nB = cB;
        if (has_next) { const bf16 *pa, *pb; P.operands(nxt, pa, pb); nA = (const char*)pa + (size_t)nxt.pm * tstep; nB = (const char*)pb + (size_t)nxt.pn * tstep; }
        for (int t = 0; t < nt; t += 2) {
            const bool last = (t == nt - 2);
            const char* a1 = cA + (size_t)(t + 1) * kstep;
            const char* a2 = last ? nA : cA + (size_t)(t + 2) * kstep; const char* b2 = last ? nB : cB + (size_t)(t + 2) * kstep;
            const char* a3 = a2 + kstep; const char* b3 = b2 + kstep;
            if constexpr (SP2) {
            PG8_LDB(B0, 0, 0); PG8_LDB(B1, 0, 1); PG8_SCHED; PG8_LDA(At, 0, 0); PG8_STAGE(PG8_SA(1, 1), a1 + hstep, voffA);
            PG8_WAIT_V(8); PG8_WAIT_L(0); PG8_BAR; PG8_MMA(0, 0, At, B0); PG8_MMA(0, 1, At, B1); PG8_BAR; PG8_SCHED;
            PG8_LDA(At, 0, 1); PG8_STAGE(PG8_SB(0, 0), b2, voffB); PG8_STAGE(PG8_SB(0, 1), b2 + hstep, voffB); PG8_STAGE(PG8_SA(0, 0), a2, voffA);
            PG8_WAIT_V(8); PG8_WAIT_L(0); PG8_BAR; PG8_MMA(1, 0, At, B0); PG8_MMA(1, 1, At, B1); PG8_BAR; PG8_SCHED;
            PG8_LDB(B0, 1, 0); PG8_LDB(B1, 1, 1); PG8_SCHED; PG8_LDA(At, 1, 0); PG8_STAGE(PG8_SA(0, 1), a2 + hstep, voffA);
            PG8_WAIT_V(8); PG8_WAIT_L(0); PG8_BAR; PG8_MMA(0, 0, At, B0); PG8_MMA(0, 1, At, B1); PG8_BAR; PG8_SCHED;
            PG8_LDA(At, 1, 1); PG8_STAGE(PG8_SB(1, 0), b3, voffB); PG8_STAGE(PG8_SB(1, 1), b3 + hstep, voffB); PG8_STAGE(PG8_SA(1, 0), a3, voffA);
            PG8_WAIT_V(8); PG8_WAIT_L(0); PG8_BAR; PG8_MMA(1, 0, At, B0); PG8_MMA(1, 1, At, B1); PG8_BAR; PG8_SCHED;
            } else {
            PG8_LDB(B0, 0, 0); PG8_SCHED; PG8_LDA(At, 0, 0); PG8_STAGE(PG8_SA(1, 1), a1 + hstep, voffA);
            PG8_WAIT_L(8); PG8_BAR; PG8_WAIT_L(0); PG8_MMA(0, 0, At, B0); PG8_BAR; PG8_SCHED;
            PG8_LDB(B1, 0, 1); PG8_STAGE(PG8_SB(0, 0), b2, voffB);
            PG8_BAR; PG8_WAIT_L(0); PG8_MMA(0, 1, At, B1); PG8_BAR;
            PG8_LDA(At, 0, 1); PG8_STAGE(PG8_SA(0, 0), a2, voffA);
            PG8_BAR; PG8_WAIT_L(0); PG8_MMA(1, 0, At, B0); PG8_BAR; PG8_SCHED;
            PG8_STAGE(PG8_SB(0, 1), b2 + hstep, voffB);
            PG8_WAIT_V(6); PG8_BAR; PG8_MMA(1, 1, At, B1); PG8_BAR;
            PG8_LDB(B0, 1, 0); PG8_SCHED; PG8_LDA(At, 1, 0); PG8_STAGE(PG8_SA(0, 1), a2 + hstep, voffA);
            PG8_WAIT_L(8); PG8_BAR; PG8_WAIT_L(0); PG8_MMA(0, 0, At, B0); PG8_BAR; PG8_SCHED;
            PG8_LDB(B1, 1, 1); PG8_STAGE(PG8_SB(1, 0), b3, voffB);
            PG8_BAR; PG8_WAIT_L(0); PG8_MMA(0, 1, At, B1); PG8_BAR;
            PG8_LDA(At, 1, 1); PG8_STAGE(PG8_SA(1, 0), a3, voffA);
            PG8_BAR; PG8_WAIT_L(0); PG8_MMA(1, 0, At, B0); PG8_BAR; PG8_SCHED;
            PG8_STAGE(PG8_SB(1, 1), b3 + hstep, voffB);
            PG8_WAIT_V(6); PG8_BAR; PG8_MMA(1, 1, At, B1); PG8_BAR;
            }
        }
        if constexpr (ALIGN_EPI) { if (wr == 0) PG8_BAR; }
        E(acc, cur, wr, wc, fr, fq);
        if (!has_next) break;
#pragma unroll
        for (int a = 0; a < 2; ++a)
#pragma unroll
            for (int b = 0; b < 2; ++b)
#pragma unroll
                for (int m = 0; m < 4; ++m)
#pragma unroll
                    for (int n = 0; n < 2; ++n) acc[a][b][m][n] = (f32x4){0.f, 0.f, 0.f, 0.f};
        cur = nxt; cA = nA; cB = nB; ++ui;
        if constexpr (ALIGN_EPI) { if (wr == 1) PG8_BAR; }
    }
    PG8_WAIT_V(0);
    if constexpr (!ALIGN_EPI) { if (wr == 0) PG8_BAR; }
    PG8_BAR;
#undef PG8_SA
#undef PG8_SB
#undef PG8_STAGE
#undef PG8_LDA
#undef PG8_LDB
#undef PG8_MMA
#undef PG8_WAIT_V
#undef PG8_WAIT_L
#undef PG8_BAR
#undef PG8_SCHED
}
}
#ifndef USE_PG8
#define USE_PG8 1
#endif
template <int ZN, class Prob, class Epi>
__device__ __forceinline__ void gemm_run(const Ctx& c, const Prob& P, const Epi& E, int nM, int nN, int pn0) {
#if USE_PG8
    pg8::StaticOrder<ZN> S; S.init(nM, nN, pn0, c.G, c.bid);
    pg8::gemm_phase<Prob, Epi, pg8::StaticOrder<ZN>, true, true>(c.lds, P, S, E);
#else
    pg8::StaticOrder<ZN> S; S.init(nM, nN, pn0, c.G, c.bid);
    gemm_naive(c, P, S, E);
#endif
}

#define EPI_ROWS_BEGIN _Pragma("unroll") for (int ai = 0; ai < 2; ++ai) _Pragma("unroll") for (int m = 0; m < 4; ++m) { const int row = 256 * u.pm + 128 * ai + 64 * wr + 16 * m + fr; \
    const f32x4 l0 = acc[ai][0][m][0], l1 = acc[ai][0][m][1], h0 = acc[ai][1][m][0], h1 = acc[ai][1][m][1]; (void)l0; (void)l1; (void)h0; (void)h1;
#define EPI_ROWS_END asm volatile("" ::: "memory"); }
typedef f32x4 Acc_t[2][2][4][2];

__device__ __forceinline__ void rope8(const float* cs, const float* sn, f32x4 x1a, f32x4 x1b, f32x4 x2a, f32x4 x2b, float sc, f32x4& o1a, f32x4& o1b, f32x4& o2a, f32x4& o2b) {
    const f32x4 ca = *(const f32x4*)cs, cb = *(const f32x4*)(cs + 4), sa = *(const f32x4*)sn, sb = *(const f32x4*)(sn + 4);
    o1a = (x1a * ca - x2a * sa) * sc; o1b = (x1b * cb - x2b * sb) * sc; o2a = (x2a * ca + x1a * sa) * sc; o2b = (x2b * cb + x1b * sb) * sc;
}
struct EpiEarly {
    const Ctx& c; int layer;
    __device__ __forceinline__ void operator()(const Acc_t& acc, const Unit& u, int wr, int wc, int fr, int fq) const {
        const int c8 = 32 * wc + 8 * fq, t = u.pn;
        bf16 *QA = WSP(bf16, WS_QA), *KA = WSP(bf16, WS_KA) + (size_t)FR * PKA, *VA = WSP(bf16, WS_VA) + (size_t)FR * PVA, *QC = WSP(bf16, WS_QC), *KC = WSP(bf16, WS_KC) + (size_t)FR * PKC,
             *VC = WSP(bf16, WS_VC) + (size_t)FR * PVC, *CQ = WSP(bf16, WS_CQ), *CKV = WSP(bf16, WS_CKV), *KB = WSP(bf16, WS_KB) + (size_t)FR * PKB;
        const float *cos64 = WSP(float, WS_COS64), *sin64 = WSP(float, WS_SIN64), *cos32 = WSP(float, WS_COS32), *sin32 = WSP(float, WS_SIN32);
        if (t < 2) { EPI_ROWS_BEGIN st8(QA + (size_t)row * PQA + 256 * t + c8, l0 * C2A, l1 * C2A); st8(QA + (size_t)row * PQA + 256 * t + 128 + c8, h0 * C2A, h1 * C2A); EPI_ROWS_END }
        else if (t < 4) { const int L0 = 256 * (t - 2) + c8, L1 = L0 + 128;
            EPI_ROWS_BEGIN st8(KA + (size_t)row * PKA + (L0 >> 6) * 80 + (L0 & 63), l0, l1); st8(KA + (size_t)row * PKA + (L1 >> 6) * 80 + (L1 & 63), h0, h1); EPI_ROWS_END }
        else if (t < 6) { EPI_ROWS_BEGIN st8(VA + (size_t)row * PVA + 256 * (t - 4) + c8, l0, l1); st8(VA + (size_t)row * PVA + 256 * (t - 4) + 128 + c8, h0, h1); EPI_ROWS_END }
        else if (t < 8) { const int head = 4 * (t - 6) + wc, d = 8 * fq;
            EPI_ROWS_BEGIN const int pos = NMETA + (row & (SEQ - 1)); f32x4 o1a, o1b, o2a, o2b; rope8(cos64 + pos * 32 + d, sin64 + pos * 32 + d, l0, l1, h0, h1, C2C, o1a, o1b, o2a, o2b);
                st8(QC + (size_t)row * PQC + head * 64 + d, o1a, o1b); st8(QC + (size_t)row * PQC + head * 64 + 32 + d, o2a, o2b); EPI_ROWS_END }
        else if (t == 8) {
            if (wc < 2) { const int d = 8 * fq;
                EPI_ROWS_BEGIN const int pos = NMETA + (row & (SEQ - 1)); f32x4 o1a, o1b, o2a, o2b; rope8(cos64 + pos * 32 + d, sin64 + pos * 32 + d, l0, l1, h0, h1, 1.f, o1a, o1b, o2a, o2b);
                    st8(KC + (size_t)row * PKC + wc * 64 + d, o1a, o1b); st8(KC + (size_t)row * PKC + wc * 64 + 32 + d, o2a, o2b); EPI_ROWS_END }
            else { const int j = 32 * (wc - 2) + 8 * fq;
                EPI_ROWS_BEGIN st8(VC + (size_t)row * PVC + j, l0, l1); st8(VC + (size_t)row * PVC + 64 + j, h0, h1); EPI_ROWS_END } }
        else if (t == 9) { EPI_ROWS_BEGIN st8(CQ + (size_t)row * PCQ + c8, l0, l1); st8(CQ + (size_t)row * PCQ + 128 + c8, h0, h1); EPI_ROWS_END }
        else if (t == 10) {
            if (wc < 2) { EPI_ROWS_BEGIN st8(CQ + (size_t)row * PCQ + 256 + c8, l0, l1); st8(CQ + (size_t)row * PCQ + 256 + 64 + c8, h0, h1); EPI_ROWS_END }
            else if (wc == 2) {
                if (fq < 2) { const int d = 8 * fq;
                    EPI_ROWS_BEGIN const int pos = NMETA + (row & (SEQ - 1)); f32x4 o1a, o1b, o2a, o2b; rope8(cos32 + pos * 16 + d, sin32 + pos * 16 + d, l0, l1, h0, h1, 1.f, o1a, o1b, o2a, o2b);
                        const u32x4 w1 = pack8(o1a, o1b), w2 = pack8(o2a, o2b);
#pragma unroll
                        for (int h = 0; h < 8; ++h) { *(u32x4*)(KB + (size_t)row * PKB + h * 96 + 64 + d) = w1; *(u32x4*)(KB + (size_t)row * PKB + h * 96 + 80 + d) = w2; } EPI_ROWS_END }
                else if (fq == 2) { float* LF = WSP(float, WS_LF); const f32x4 b0 = *(const f32x4*)(c.b_f + layer * 8), b1 = *(const f32x4*)(c.b_f + layer * 8 + 4);
                    EPI_ROWS_BEGIN f32x4 a = l0 + b0, b = l1 + b1;
#pragma unroll
                        for (int j = 0; j < 4; ++j) { a[j] = logsigf_(a[j]); b[j] = logsigf_(b[j]); }
                        *(f32x4*)(LF + (size_t)row * 8) = a; *(f32x4*)(LF + (size_t)row * 8 + 4) = b; EPI_ROWS_END } } }
        else { EPI_ROWS_BEGIN st8(CKV + (size_t)row * PCKV + c8, l0, l1); st8(CKV + (size_t)row * PCKV + 128 + c8, h0, h1); EPI_ROWS_END }
    }
};
struct EpiUq {
    const Ctx& c;
    __device__ __forceinline__ void operator()(const Acc_t& acc, const Unit& u, int wr, int wc, int fr, int fq) const {
        bf16* QB = WSP(bf16, WS_QB); const float* RQ = WSP(float, WS_RQ); const float *cos32 = WSP(float, WS_COS32), *sin32 = WSP(float, WS_SIN32);
        const int c8 = 32 * wc + 8 * fq;
        if (u.pn < 2) { const int ha = 4 * u.pn + (c8 >> 6), hb = ha + 2, e = c8 & 63;
            EPI_ROWS_BEGIN const float sc = RQ[row] * C2B; st8(QB + (size_t)row * PQB + ha * 96 + e, l0 * sc, l1 * sc); st8(QB + (size_t)row * PQB + hb * 96 + e, h0 * sc, h1 * sc); EPI_ROWS_END }
        else { const int h = c8 >> 4, d = c8 & 15;
            EPI_ROWS_BEGIN const float sc = RQ[row] * C2B; const int pos = NMETA + (row & (SEQ - 1)); f32x4 o1a, o1b, o2a, o2b; rope8(cos32 + pos * 16 + d, sin32 + pos * 16 + d, l0, l1, h0, h1, sc, o1a, o1b, o2a, o2b);
                st8(QB + (size_t)row * PQB + h * 96 + 64 + d, o1a, o1b); st8(QB + (size_t)row * PQB + h * 96 + 80 + d, o2a, o2b); EPI_ROWS_END }
    }
};
struct EpiUkv {
    const Ctx& c;
    __device__ __forceinline__ void operator()(const Acc_t& acc, const Unit& u, int wr, int wc, int fr, int fq) const {
        bf16 *KB = WSP(bf16, WS_KB) + (size_t)FR * PKB, *VB = WSP(bf16, WS_VB) + (size_t)FR * PVB; const float* RKV = WSP(float, WS_RKV);
        const int c8 = 32 * wc + 8 * fq, ha = 2 * u.pn, hb = ha + 1;
        if (wc < 2) { EPI_ROWS_BEGIN const float sc = RKV[row]; st8(KB + (size_t)row * PKB + ha * 96 + c8, l0 * sc, l1 * sc); st8(KB + (size_t)row * PKB + hb * 96 + c8, h0 * sc, h1 * sc); EPI_ROWS_END }
        else { EPI_ROWS_BEGIN const float sc = RKV[row]; st8(VB + (size_t)row * PVB + ha * 64 + c8 - 64, l0 * sc, l1 * sc); st8(VB + (size_t)row * PVB + hb * 64 + c8 - 64, h0 * sc, h1 * sc); EPI_ROWS_END }
    }
};
struct EpiLateZ {
    const Ctx& c;
    __device__ __forceinline__ void operator()(const Acc_t& acc, const Unit& u, int wr, int wc, int fr, int fq) const {
        const int c8 = 32 * wc + 8 * fq, t = u.pn;
        bf16* Y = (t < 2) ? WSP(bf16, WS_QA) : (t < 4) ? WSP(bf16, WS_YB) : WSP(bf16, WS_QC); const int col = 256 * (t & 1) + c8;
        EPI_ROWS_BEGIN
            { bf16* p = Y + (size_t)row * PY + col; f32x4 ya, yb; ld8(p, ya, yb);
#pragma unroll
              for (int j = 0; j < 4; ++j) { ya[j] *= siluf_(l0[j]); yb[j] *= siluf_(l1[j]); }
              st8(p, ya, yb); }
            { bf16* p = Y + (size_t)row * PY + col + 128; f32x4 ya, yb; ld8(p, ya, yb);
#pragma unroll
              for (int j = 0; j < 4; ++j) { ya[j] *= siluf_(h0[j]); yb[j] *= siluf_(h1[j]); }
              st8(p, ya, yb); }
        EPI_ROWS_END
    }
};
struct EpiLateG {
    const Ctx& c;
    __device__ __forceinline__ void operator()(const Acc_t& acc, const Unit& u, int wr, int wc, int fr, int fq) const {
        bf16* Gp = WSP(bf16, WS_G); const int col = 256 * (u.pn - 6) + 32 * wc + 8 * fq;
        EPI_ROWS_BEGIN f32x4 a = l0, b = l1, cc = h0, d = h1;
#pragma unroll
            for (int j = 0; j < 4; ++j) { a[j] = sigmoidf_(a[j]); b[j] = sigmoidf_(b[j]); cc[j] = sigmoidf_(cc[j]); d[j] = sigmoidf_(d[j]); }
            st8(Gp + (size_t)row * PG + col, a, b); st8(Gp + (size_t)row * PG + col + 128, cc, d); EPI_ROWS_END
    }
};
struct EpiBranch {
    const Ctx& c;
    __device__ __forceinline__ void operator()(const Acc_t& acc, const Unit& u, int wr, int wc, int fr, int fq) const {
        const bf16* Gp = WSP(bf16, WS_G); bf16* MG = WSP(bf16, WS_HN); const int col = 256 * u.pn + 32 * wc + 8 * fq;
        EPI_ROWS_BEGIN
#pragma unroll
            for (int bj = 0; bj < 2; ++bj) { f32x4 ga, gb; ld8(Gp + (size_t)row * PG + u.z * DM + col + 128 * bj, ga, gb); f32x4 va = (bj ? h0 : l0) * ga, vb = (bj ? h1 : l1) * gb;
                bf16* p = MG + (size_t)row * DM + col + 128 * bj; if (u.z > 0) { f32x4 pa, pb; ld8(p, pa, pb); va += pa; vb += pb; } st8(p, va, vb); } EPI_ROWS_END
    }
};
struct EpiOut {
    const float* resid; float* out;
    __device__ __forceinline__ void operator()(const Acc_t& acc, const Unit& u, int wr, int wc, int fr, int fq) const {
        const int col = 256 * u.pn + 32 * wc + 8 * fq;
        EPI_ROWS_BEGIN const size_t off = (size_t)row * DM + col;
            const f32x4 r0 = *(const f32x4*)(resid + off), r1 = *(const f32x4*)(resid + off + 4), r2 = *(const f32x4*)(resid + off + 128), r3 = *(const f32x4*)(resid + off + 132);
            *(f32x4*)(out + off) = r0 + l0; *(f32x4*)(out + off + 4) = r1 + l1; *(f32x4*)(out + off + 128) = r2 + h0; *(f32x4*)(out + off + 132) = r3 + h1; EPI_ROWS_END
    }
};

__device__ __forceinline__ void stats_cumsum(const Ctx& c) {
    const int gw = c.bid * NWAVES + c.wave, NGW = c.G * NWAVES;
    for (int m = gw; m < M; m += NGW) {
        float sq = 0.f, sk = 0.f;
        if (c.lane < 48) { f32x4 a, b; ld8(WSP(bf16, WS_CQ) + (size_t)m * PCQ + 8 * c.lane, a, b); sq = (a[0] * a[0] + a[1] * a[1]) + (a[2] * a[2] + a[3] * a[3]) + (b[0] * b[0] + b[1] * b[1]) + (b[2] * b[2] + b[3] * b[3]); }
        if (c.lane < 32) { f32x4 a, b; ld8(WSP(bf16, WS_CKV) + (size_t)m * PCKV + 8 * c.lane, a, b); sk = (a[0] * a[0] + a[1] * a[1]) + (a[2] * a[2] + a[3] * a[3]) + (b[0] * b[0] + b[1] * b[1]) + (b[2] * b[2] + b[3] * b[3]); }
        sq = wave_sum(sq); sk = wave_sum(sk);
        if (c.lane == 0) { WSP(float, WS_RQ)[m] = 1.f / sqrtf(sq * (1.f / 384.f) + EPS); WSP(float, WS_RKV)[m] = 1.f / sqrtf(sk * (1.f / 256.f) + EPS); }
    }
    LAS double* wsum = (LAS double*)(c.lds);
    for (int task = c.bid; task < NBATCH * 8; task += c.G) {
        const int b = task >> 3, h = task & 7; const float* LF = WSP(float, WS_LF) + (size_t)b * SEQ * 8 + h;
        double v[8]; double s = 0.0;
#pragma unroll
        for (int j = 0; j < 8; ++j) { s += (double)LF[(size_t)(8 * c.tid + j) * 8]; v[j] = s; }
        double inc = s;
#pragma unroll
        for (int o = 1; o < 64; o <<= 1) { const double n = __shfl_up(inc, o); if (c.lane >= o) inc += n; }
        __syncthreads();
        if (c.lane == 63) wsum[c.wave] = inc;
        __syncthreads();
        double base = inc - s;
        for (int w = 0; w < c.wave; ++w) base += wsum[w];
        bf16* KA = WSP(bf16, WS_KA) + (size_t)(FR + b * SEQ) * PKA + h * 80 + 64;
#pragma unroll
        for (int j = 0; j < 8; ++j) { const float bias = (float)(-(base + v[j]) * 1.4426950408889634); bf16 bh, bm, bl; split3(bias, bh, bm, bl);
            u32x4 w0 = {(unsigned)bh | ((unsigned)bm << 16), (unsigned)bl | 0x3F800000u, 0x3F803F80u, 0u}, w1 = {0u, 0u, 0u, 0u};   bf16* kp = KA + (size_t)(8 * c.tid + j) * PKA; *(u32x4*)kp = w0; *(u32x4*)(kp + 8) = w1; }
    }
}
__device__ __forceinline__ void final_norm(const Ctx& c) {
    const int gw = c.bid * NWAVES + c.wave, NGW = c.G * NWAVES;
    for (int m = gw; m < M; m += NGW) {
        f32x4* xr = (f32x4*)(c.out + (size_t)m * DM) + c.lane; f32x4 v[4]; float s = 0.f;
#pragma unroll
        for (int j = 0; j < 4; ++j) { v[j] = xr[64 * j]; s += (v[j][0] * v[j][0] + v[j][1] * v[j][1]) + (v[j][2] * v[j][2] + v[j][3] * v[j][3]); }
        const float rstd = 1.f / sqrtf(wave_sum(s) * (1.f / DM) + EPS);
#pragma unroll
        for (int j = 0; j < 4; ++j) { const f32x4 g = ((const f32x4*)c.final_g + c.lane)[64 * j]; xr[64 * j] = v[j] * rstd * g; }
    }
}

#define XB_TMO      128
#define XB_XCNT(j)  (256  + 64 * (j))
#define XB_XSUB(j)  (1280 + 64 * (j))
#define XB_XGEN(j)  (2304 + 64 * (j))
#define XB_TOP      3328
#define XB_TOPGEN   3392
#define XCD_BAR_WORDS 3456
#define XB_SPIN_CAP (1u << 18)
__device__ __forceinline__ unsigned xb_ld(unsigned* p)              { return __hip_atomic_load(p, __ATOMIC_RELAXED, __HIP_MEMORY_SCOPE_AGENT); }
__device__ __forceinline__ unsigned xb_add(unsigned* p, unsigned v) { return __hip_atomic_fetch_add(p, v, __ATOMIC_RELAXED, __HIP_MEMORY_SCOPE_AGENT); }
__device__ __forceinline__ unsigned xb_xcc_id() { return (unsigned)__builtin_amdgcn_s_getreg((3 << 11) | 20) & 0xFu; }
#define XB_SPIN(cond, bar) do { unsigned _sp = 0; while (cond) { __builtin_amdgcn_s_sleep(1); \
    if ((++_sp & 255u) == 0u) { if (xb_ld(&(bar)[XB_TMO])) break; if (_sp > XB_SPIN_CAP) { atomicAdd(&(bar)[XB_TMO], 1u); break; } } } } while (0)
struct XcdBarrier { unsigned* bar; unsigned x; volatile LAS unsigned* st; };
__device__ __forceinline__ XcdBarrier xcd_barrier_post(unsigned* bar, volatile LAS unsigned* st) {
    XcdBarrier b; b.bar = bar; b.x = xb_xcc_id(); b.st = st;
    if (threadIdx.x == 0) (void)xb_add(&bar[XB_XCNT(b.x)], 1u);
    return b;
}
__device__ __forceinline__ void xcd_barrier_complete(unsigned* bar, unsigned x, unsigned& nloc, unsigned& nx) {
    const unsigned G = gridDim.x * gridDim.y * gridDim.z;
    unsigned sum, cnt, mine, sp = 0u;
    for (;;) {
        sum = 0u; cnt = 0u; mine = 0u;
#pragma unroll
        for (unsigned j = 0; j < 16; ++j) { const unsigned cc = xb_ld(&bar[XB_XCNT(j)]); sum += cc; cnt += (cc > 0u) ? 1u : 0u; mine = (j == x) ? cc : mine; }
        if (sum == G) break;
        __builtin_amdgcn_s_sleep(1);
        if ((++sp & 255u) == 0u) { if (xb_ld(&bar[XB_TMO])) break; if (sp > XB_SPIN_CAP) { atomicAdd(&bar[XB_TMO], 1u); break; } }
    }
    nloc = mine > 0u ? mine : 1u; nx = cnt > 0u ? cnt : 1u;
}
__device__ __forceinline__ void xcd_barrier(const XcdBarrier& b) {
    asm volatile("s_waitcnt vmcnt(0)" ::: "memory");
    __syncthreads();
    if (threadIdx.x == 0) {
        unsigned* bar = b.bar;
        __builtin_amdgcn_s_waitcnt(0);
        unsigned nloc = b.st[0], nx = b.st[1];
        if (nloc == 0u) { xcd_barrier_complete(bar, b.x, nloc, nx); b.st[0] = nloc; b.st[1] = nx; }
        const unsigned old = xb_add(&bar[XB_XSUB(b.x)], 1u);
        const unsigned gen = old / nloc;
        if (old + 1u == (gen + 1u) * nloc) {
            __builtin_amdgcn_fence(__ATOMIC_RELEASE, "agent");
            asm volatile("s_waitcnt vmcnt(0)" ::: "memory");
            const unsigned og = xb_add(&bar[XB_TOP], 1u);
            const unsigned tg = og / nx;
            if (og + 1u == (tg + 1u) * nx) xb_add(&bar[XB_TOPGEN], 1u);
            else XB_SPIN(xb_ld(&bar[XB_TOPGEN]) == tg, bar);
            __builtin_amdgcn_fence(__ATOMIC_ACQUIRE, "agent");
            xb_add(&bar[XB_XGEN(b.x)], 1u);
            asm volatile("s_waitcnt vmcnt(0)" ::: "memory");
        } else {
            XB_SPIN(xb_ld(&bar[XB_XGEN(b.x)]) == gen, bar);
            __builtin_amdgcn_fence(__ATOMIC_ACQUIRE, "agent");
            asm volatile("s_waitcnt vmcnt(0)" ::: "memory");
        }
    }
    __syncthreads();
}

constexpr int LDS_BYTES = 147456, MISC_OFF = 131072 + 320;
constexpr int NSLOTS = 18;
constexpr int CW_BAR = 4096;

struct Args { const float* in[13]; float* out; unsigned char* ws; int ph_lo, ph_hi, pad0, pad1; };
#define CAS __attribute__((address_space(4)))
__device__ __forceinline__ Ctx make_ctx() {
    const CAS char* kp = (const CAS char*)__builtin_amdgcn_kernarg_segment_ptr();
    asm volatile("" : "+s"(kp));
    const CAS Args* a = (const CAS Args*)kp;
    Ctx c;
    c.x = a->in[0]; c.meta = a->in[1]; c.norm_g = a->in[2]; c.w_in = a->in[3]; c.b_f = a->in[4]; c.g_cq = a->in[5]; c.g_ckv = a->in[6];
    c.w_uq = a->in[7]; c.w_ukv = a->in[8]; c.sinks = a->in[9]; c.w_branch = a->in[10]; c.w_out = a->in[11]; c.final_g = a->in[12];
    c.out = a->out; c.ws = a->ws;
    extern __shared__ __attribute__((aligned(16))) unsigned char lds_raw[];
    c.lds = (LAS unsigned char*)lds_raw;
    c.tid = threadIdx.x; c.lane = c.tid & 63; c.wave = __builtin_amdgcn_readfirstlane(c.tid >> 6); c.G = gridDim.x; c.bid = blockIdx.x;
    return c;
}

template <int SLOT>
__device__ __forceinline__ void run_slot() {
    const Ctx c = make_ctx();
    constexpr int slot = SLOT;
    constexpr int layer = (slot >= 9) ? 1 : 0;
    constexpr int ls = (slot >= 9) ? slot - 8 : slot;
        if constexpr (slot == 0) slot0(c);
        else if constexpr (slot == 17) final_norm(c);
        else if constexpr (ls == 1) {
            zero_fronts(c);
            norm_main(c, layer == 0 ? c.x : c.out);
            meta_blocks(c, AfPlain{WSP(bf16, WS_HNM), DM}, wl(c, layer, WL_EARLY), DM, NE / 16, WSP(float, WS_RAWE), NE, 0);
        } else if constexpr (ls == 2) {
            post_early(c, layer);
            ProbSimple P{WSP(bf16, WS_HN), wl(c, layer, WL_EARLY), DM};
            gemm_run<1>(c, P, EpiEarly{c, layer}, 64, NE / 256, 0);
        } else if constexpr (ls == 3) {
            { const AfPlain af{WSP(bf16, WS_CM), 640}; meta_blocks(c, af, wl(c, layer, WL_UQ), 384, NUQ / 16, WSP(float, WS_RAWU), NUQ + NUKV, 0);
              const AfPlain af2{WSP(bf16, WS_CM) + 384, 640}; meta_blocks(c, af2, wl(c, layer, WL_UKV), 256, NUKV / 16, WSP(float, WS_RAWU), NUQ + NUKV, NUQ); }
            if (c.bid == 0) post_early_reduce(c);
            stats_cumsum(c);
        } else if constexpr (ls == 4) {
            post_up(c);
            { ProbSimple P{WSP(bf16, WS_CQ), wl(c, layer, WL_UQ), 384}; gemm_run<1>(c, P, EpiUq{c}, 64, NUQ / 256, 0); }
            { ProbSimple P{WSP(bf16, WS_CKV), wl(c, layer, WL_UKV), 256}; gemm_run<1>(c, P, EpiUkv{c}, 64, NUKV / 256, 0); }
        } else if constexpr (ls == 5) {
            if (layer == 0) {
#ifndef NO_ATTNM
                if (c.bid == 0) attn_meta(c);
#endif
 meta_blocks(c, AfPlain{WSP(bf16, WS_HNM), DM}, wl(c, 0, WL_LATE), DM, NL / 16, WSP(float, WS_RAWL), NL, 0); }
#ifdef NAIVE_ATTN
            attn_main_naive(c, layer);
#else
            attn_main_mfma(c, layer);
#endif
        } else if constexpr (ls == 6) {
#ifndef NO_S67
            if (layer == 0) { for (int n = 0; n < 3; ++n) { const AfBranch af{WSP(bf16, WS_YM), WSP(float, WS_RAWL), n}; meta_blocks(c, af, wl(c, 0, WL_BR) + (size_t)n * DM * 512, 512, DM / 16, WSP(float, WS_RAWB) + (size_t)n * 16 * 1024, 1024, 0); } }
#endif
            { ProbSimple P{WSP(bf16, WS_HN), wl(c, layer, WL_LATE), DM}; gemm_run<1>(c, P, EpiLateZ{c}, 64, 6, 0); }
            { ProbSimple P{WSP(bf16, WS_HN), wl(c, layer, WL_LATE), DM}; gemm_run<1>(c, P, EpiLateG{c}, 64, 12, 6); }
        } else if constexpr (ls == 7) {
            if (layer == 0) { const AfMerged af{WSP(float, WS_RAWL), WSP(float, WS_RAWB)}; meta_blocks(c, af, wl(c, 0, WL_OUT), DM, DM / 16, WSP(float, WS_RAWO), DM, 0); }
            { ProbBranch P{WSP(bf16, WS_QA), WSP(bf16, WS_YB), WSP(bf16, WS_QC), wl(c, layer, WL_BR), 512}; gemm_run<3>(c, P, EpiBranch{c}, 64, 4, 0); }
        } else if constexpr (ls == 8) {
            if (layer == 0 && c.bid == 0) post_resid(c);
            ProbSimple P{WSP(bf16, WS_HN), wl(c, layer, WL_OUT), DM};
            gemm_run<1>(c, P, EpiOut{layer == 0 ? c.x : c.out, c.out}, 64, DM / 256, 0);
        }
}

__global__ void __launch_bounds__(NTHREADS, 2) skel_fwd(Args args) {
    const Ctx c = make_ctx();
    volatile LAS unsigned* MISC = (volatile LAS unsigned*)(c.lds + MISC_OFF);
    for (int u = c.tid; u < (LDS_BYTES - 131072) / 4; u += NTHREADS) ((LAS unsigned*)(c.lds + 131072))[u] = 0u;
    __syncthreads();
    XcdBarrier bar; bar.bar = (unsigned*)(c.ws + WS_CTL) + CW_BAR; bar.x = 0; bar.st = nullptr;
    const int lo = args.ph_lo, hi = args.ph_hi;
    if (hi - lo > 1) bar = xcd_barrier_post((unsigned*)(c.ws + WS_CTL) + CW_BAR, MISC + 8);

#ifndef SLOT_ON
#define SLOT_ON(k) true
#endif
#ifndef SLOT_REPS
#define SLOT_REPS(k) 1
#endif
#define RUN_SLOT(k) if (SLOT_ON(k) && lo <= (k) && (k) < hi) { _Pragma("nounroll") for (int rep_ = 0; rep_ < SLOT_REPS(k); ++rep_) { run_slot<k>(); if ((k) + 1 < hi) xcd_barrier(bar); } }
    RUN_SLOT(0) RUN_SLOT(1) RUN_SLOT(2) RUN_SLOT(3) RUN_SLOT(4) RUN_SLOT(5) RUN_SLOT(6) RUN_SLOT(7) RUN_SLOT(8)
    RUN_SLOT(9) RUN_SLOT(10) RUN_SLOT(11) RUN_SLOT(12) RUN_SLOT(13) RUN_SLOT(14) RUN_SLOT(15) RUN_SLOT(16) RUN_SLOT(17)
#undef RUN_SLOT
}

extern "C" void kernel_launch(void* const* d_in, const int* in_sizes, int n_in, void* d_out, int out_size, void* d_ws, size_t ws_size, hipStream_t stream) {
    static int grid = 0;
    if (grid == 0) {
        if (n_in != 13 || out_size != M * DM || ws_size < WS_END) { fprintf(stderr, "kernel_launch: unexpected shapes (n_in %d out %d ws %zu need %zu)\n", n_in, out_size, ws_size, (size_t)WS_END); grid = -1; return; }
        int dev = 0, cus = 0, per_cu = 0;
        if (hipGetDevice(&dev) != hipSuccess || hipDeviceGetAttribute(&cus, hipDeviceAttributeMultiprocessorCount, dev) != hipSuccess) { grid = -1; return; }
        if (hipFuncSetAttribute((const void*)skel_fwd, hipFuncAttributeMaxDynamicSharedMemorySize, LDS_BYTES) != hipSuccess) { fprintf(stderr, "kernel_launch: hipFuncSetAttribute failed\n"); grid = -1; return; }
        if (hipOccupancyMaxActiveBlocksPerMultiprocessor(&per_cu, (const void*)skel_fwd, NTHREADS, LDS_BYTES) != hipSuccess || per_cu < 1) fprintf(stderr, "kernel_launch: occupancy query says %d\n", per_cu);
        (void)hipGetLastError();
        grid = cus;
    }
    if (grid < 0) return;
    (void)hipMemsetAsync((char*)d_ws + WS_CTL, 0, CTL_BYTES, stream);
    Args a{};
    for (int i = 0; i < 13; ++i) a.in[i] = (const float*)d_in[i];
    a.out = (float*)d_out; a.ws = (unsigned char*)d_ws;
#if MK_SINGLE
    a.ph_lo = 0; a.ph_hi = NSLOTS;
    hipLaunchKernelGGL(skel_fwd, dim3(grid), dim3(NTHREADS), LDS_BYTES, stream, a);
#else
    for (int s = 0; s < NSLOTS; ++s) { a.ph_lo = s; a.ph_hi = s + 1; hipLaunchKernelGGL(skel_fwd, dim3(grid), dim3(NTHREADS), LDS_BYTES, stream, a); }
#endif
}
```

```cpp
#include <hip/hip_runtime.h>
#include <cstdio>
#include <cstdint>

#ifndef USE_FB
#define USE_FB 1
#endif
#ifndef MK_SINGLE
#define MK_SINGLE 1
#endif

#define GAS __attribute__((address_space(1)))
#define LAS __attribute__((address_space(3)))
typedef unsigned short bf16;
typedef short bf16x8 __attribute__((ext_vector_type(8)));
typedef float f32x4 __attribute__((ext_vector_type(4)));
typedef unsigned u32x4 __attribute__((ext_vector_type(4)));
typedef unsigned u32x2 __attribute__((ext_vector_type(2)));
typedef float f32x2_t __attribute__((ext_vector_type(2)));
typedef __bf16 bf16x2_t __attribute__((ext_vector_type(2)));
typedef GAS unsigned gu32;
#define RLX_AGENT __ATOMIC_RELAXED, __HIP_MEMORY_SCOPE_AGENT

constexpr int DM = 1024, NBATCH = 4, SEQ = 4096, M = NBATCH * SEQ, NMETA = 16, FR = 64, MOFF = 48, NPOS = SEQ + NMETA;
constexpr int NIN = 7592, NWAVES = 8, NTHREADS = NWAVES * 64;
constexpr float EPS = 1e-6f, LOG2E = 1.4426950408889634f, LN2 = 0.6931471805599453f;
constexpr float C2A = 0.125f * LOG2E, C2B = 0.10206207261596575f * LOG2E, C2C = 0.125f * LOG2E;
constexpr int LC_AQ = 0, LC_AK = 512, LC_AV = 1024, LC_AF = 1536, LC_AZ = 1544, LC_BCQ = 2056, LC_BCKV = 2440, LC_BKR = 2696, LC_BZ = 2728,
              LC_CQ = 3240, LC_CK = 3752, LC_CV = 3880, LC_CZ = 4008, LC_G = 4520;
constexpr int NE = 3072, NL = 4608, NUQ = 768, NUKV = 1024;
constexpr int PQA = 512, PKA = 640, PVA = 512, PQB = 768, PKB = 768, PVB = 512, PQC = 512, PKC = 128, PVC = 128, PCQ = 384, PCKV = 256, PY = 512, PG = 3072;

constexpr size_t MiB = 1u << 20;
constexpr size_t al(size_t x) { return (x + 255) & ~(size_t)255; }
constexpr size_t WS_CTL = 0, CTL_BYTES = 1 * MiB;
constexpr size_t WS_COS64 = CTL_BYTES, WS_SIN64 = WS_COS64 + al((size_t)NPOS * 32 * 4), WS_COS32 = WS_SIN64 + al((size_t)NPOS * 32 * 4), WS_SIN32 = WS_COS32 + al((size_t)NPOS * 16 * 4);
constexpr size_t WS_LF = WS_SIN32 + al((size_t)NPOS * 16 * 4), WS_RQ = WS_LF + al((size_t)M * 8 * 4), WS_RKV = WS_RQ + al((size_t)M * 4);
constexpr size_t WS_HM = WS_RKV + al((size_t)M * 4);
constexpr size_t WS_HNM = WS_HM + al(16 * 1024 * 4);
constexpr size_t WS_RAWE = WS_HNM + al(16 * 1024 * 2);
constexpr size_t WS_RAWU = WS_RAWE + al(16 * NE * 4);
constexpr size_t WS_RAWL = WS_RAWU + al(16 * (NUQ + NUKV) * 4);
constexpr size_t WS_RAWB = WS_RAWL + al(16 * NL * 4);
constexpr size_t WS_RAWO = WS_RAWB + al(3 * 16 * 1024 * 4);
constexpr size_t WS_YM = WS_RAWO + al(16 * 1024 * 4);
constexpr size_t WS_CM = WS_YM + al(16 * 1536 * 2);
constexpr size_t WS_RQM = WS_CM + al(16 * 640 * 2);
constexpr size_t WS_LFM = WS_RQM + al(32 * 4);
constexpr size_t WS_QAM = WS_LFM + al(16 * 8 * 4);
constexpr size_t WS_QBM = WS_QAM + al(16 * 512 * 2);
constexpr size_t WS_QCM = WS_QBM + al(16 * 768 * 2);
constexpr size_t WS_SMALL_END = WS_QCM + al(16 * 512 * 2);
constexpr size_t WL_EARLY = 0, WL_LATE = WL_EARLY + (size_t)NE * DM * 2, WL_UQ = WL_LATE + (size_t)NL * DM * 2, WL_UKV = WL_UQ + (size_t)NUQ * 384 * 2,
                 WL_BR = WL_UKV + (size_t)NUKV * 256 * 2, WL_OUT = WL_BR + (size_t)3 * DM * 512 * 2, WL_BYTES = WL_OUT + (size_t)DM * DM * 2;
constexpr size_t WS_W = 6 * MiB;
static_assert(WS_SMALL_END <= WS_W, "small region");
constexpr size_t WS_HN = WS_W + al(2 * WL_BYTES);
constexpr size_t WS_QA = WS_HN + (size_t)M * DM * 2;
constexpr size_t WS_QC = WS_QA + (size_t)M * PQA * 2;
constexpr size_t WS_CQ = WS_QC + (size_t)M * PQC * 2;
constexpr size_t WS_CKV = WS_CQ + (size_t)M * PCQ * 2;
constexpr size_t WS_YB = WS_CQ;
constexpr size_t WS_QB = WS_CKV + (size_t)M * PCKV * 2;
constexpr size_t WS_KB = WS_QB + (size_t)M * PQB * 2;
constexpr size_t WS_VB = WS_KB + (size_t)(FR + M) * PKB * 2;
constexpr size_t WS_KA = WS_VB + (size_t)(FR + M) * PVB * 2;
constexpr size_t WS_VA = WS_KA + (size_t)(FR + M) * PKA * 2;
constexpr size_t WS_KC = WS_VA + (size_t)(FR + M) * PVA * 2;
constexpr size_t WS_VC = WS_KC + (size_t)(FR + M) * PKC * 2;
constexpr size_t WS_END = WS_VC + (size_t)(FR + M) * PVC * 2;
constexpr size_t WS_G = WS_QB;
static_assert(WS_G + (size_t)M * PG * 2 <= WS_KC, "G overlay");
static_assert((size_t)M * PY * 2 <= (size_t)M * (PCQ + PCKV) * 2, "YB overlay");
static_assert(WS_END <= 256 * MiB, "workspace");

__device__ __forceinline__ unsigned cvtpk(float lo, float hi) { f32x2_t v = {lo, hi}; bf16x2_t b = __builtin_convertvector(v, bf16x2_t); return __builtin_bit_cast(unsigned, b); }
__device__ __forceinline__ bf16 f2bf(float f) { return (bf16)(cvtpk(f, 0.f) & 0xffffu); }
__device__ __forceinline__ float bf2f(bf16 v) { return __uint_as_float((unsigned)v << 16); }
__device__ __forceinline__ float bflo(unsigned w) { return __uint_as_float(w << 16); }
__device__ __forceinline__ float bfhi(unsigned w) { return __uint_as_float(w & 0xffff0000u); }
__device__ __forceinline__ float fexp2(float x) { return __builtin_amdgcn_exp2f(x); }
__device__ __forceinline__ float frcp(float x) { return __builtin_amdgcn_rcpf(x); }
__device__ __forceinline__ float sigmoidf_(float x) { return frcp(1.f + fexp2(-x * LOG2E)); }
__device__ __forceinline__ float siluf_(float x) { return x * sigmoidf_(x); }
__device__ __forceinline__ float logsigf_(float x) { return fminf(x, 0.f) - __builtin_amdgcn_logf(1.f + fexp2(-fabsf(x) * LOG2E)) * LN2; }
__device__ __forceinline__ float wave_sum(float v) {
#pragma unroll
    for (int o = 1; o < 64; o <<= 1) v += __shfl_xor(v, o);
    return v;
}
__device__ __forceinline__ u32x4 pack8(f32x4 a, f32x4 b) { u32x4 w; w.x = cvtpk(a[0], a[1]); w.y = cvtpk(a[2], a[3]); w.z = cvtpk(b[0], b[1]); w.w = cvtpk(b[2], b[3]); return w; }
__device__ __forceinline__ void st8(bf16* p, f32x4 a, f32x4 b) { *(u32x4*)p = pack8(a, b); }
__device__ __forceinline__ void ld8(const bf16* p, f32x4& a, f32x4& b) { const u32x4 w = *(const u32x4*)p; a = (f32x4){bflo(w.x), bfhi(w.x), bflo(w.y), bfhi(w.y)}; b = (f32x4){bflo(w.z), bfhi(w.z), bflo(w.w), bfhi(w.w)}; }
__device__ __forceinline__ void split3(float b, bf16& h, bf16& m, bf16& l) { h = f2bf(b); const float r1 = b - bf2f(h); m = f2bf(r1); const float r2 = r1 - bf2f(m); l = f2bf(r2); }

enum { MAP_EARLY = 0, MAP_LATE = 1, MAP_UQ = 2, MAP_ID = 3 };
__device__ __forceinline__ int map_col(int kind, int p) {
    const int t = p >> 8, c = p & 255, half = c >> 7, c7 = c & 127;
    if (kind == MAP_EARLY) {
        if (t < 2) return LC_AQ + p;
        if (t < 4) return LC_AK + (p - 512);
        if (t < 6) return LC_AV + (p - 1024);
        if (t < 8) return LC_CQ + 256 * (t - 6) + 64 * (c7 >> 5) + 32 * half + (c7 & 31);
        if (t == 8) { if (c7 < 64) return LC_CK + 64 * (c7 >> 5) + 32 * half + (c7 & 31); return LC_CV + 64 * half + (c7 - 64); }
        if (t == 9) return LC_BCQ + c;
        if (t == 10) { if (c7 < 64) return LC_BCQ + 256 + 64 * half + c7; if (c7 < 80) return LC_BKR + 16 * half + (c7 - 64); if (c7 < 88 && half == 0) return LC_AF + (c7 - 80); return -1; }
        return LC_BCKV + c;
    }
    if (kind == MAP_LATE) {
        if (t < 2) return LC_AZ + p;
        if (t < 4) return LC_BZ + (p - 512);
        if (t < 6) return LC_CZ + (p - 1024);
        return LC_G + (p - 1536);
    }
    if (kind == MAP_UQ) {
        if (t < 2) return (4 * t + (c >> 6)) * 96 + (c & 63);
        return (c7 >> 4) * 96 + 64 + 16 * half + (c7 & 15);
    }
    return p;
}

struct Ctx {
    const float *x, *meta, *norm_g, *w_in, *b_f, *g_cq, *g_ckv, *w_uq, *w_ukv, *sinks, *w_branch, *w_out, *final_g;
    float* out; unsigned char* ws;
    LAS unsigned char* lds;
    int tid, lane, wave, G, bid;
};
#define WSP(T, off) ((T*)(c.ws + (off)))
__device__ __forceinline__ bf16* wl(const Ctx& c, int layer, size_t off) { return (bf16*)(c.ws + WS_W + (size_t)layer * WL_BYTES + off); }

__device__ __forceinline__ void conv_item(const float* W, int N, const float* gv, bf16* Bt, int K, int kind, int nblk, int item, LAS float* scr, int lane) {
    const int kb = item / nblk, nb = item % nblk, k0 = 64 * kb, n0 = 32 * nb;
    const int lc = map_col(kind, n0 + (lane & 31));
#pragma unroll 8
    for (int i = 0; i < 32; ++i) { const int kk = 2 * i + (lane >> 5); float v = 0.f; if (lc >= 0) { v = W[(size_t)(k0 + kk) * N + lc]; if (gv) v *= gv[k0 + kk]; } scr[kk * 33 + (lane & 31)] = v; }
    asm volatile("s_waitcnt lgkmcnt(0)" ::: "memory");
    const int ch = lane & 7;
#pragma unroll
    for (int j = 0; j < 4; ++j) { const int n = (lane >> 3) + 8 * j; const LAS float* s = scr + (8 * ch) * 33 + n;
        u32x4 o; o.x = cvtpk(s[0 * 33], s[1 * 33]); o.y = cvtpk(s[2 * 33], s[3 * 33]); o.z = cvtpk(s[4 * 33], s[5 * 33]); o.w = cvtpk(s[6 * 33], s[7 * 33]);
        *(u32x4*)(Bt + (size_t)(n0 + n) * K + k0 + 8 * ch) = o; }
    asm volatile("s_waitcnt lgkmcnt(0)" ::: "memory");
}
__device__ __forceinline__ void zero_fronts(const Ctx& c) {
    const int g = c.bid * NTHREADS + c.tid, NG = c.G * NTHREADS;
    const u32x4 z = {0u, 0u, 0u, 0u};
    for (int e = g; e < MOFF * PKB / 8; e += NG) WSP(u32x4, WS_KB)[e] = z;
    for (int e = g; e < MOFF * PVB / 8; e += NG) WSP(u32x4, WS_VB)[e] = z;
    for (int e = g; e < MOFF * PKA / 8; e += NG) WSP(u32x4, WS_KA)[e] = z;
    for (int e = g; e < MOFF * PVA / 8; e += NG) WSP(u32x4, WS_VA)[e] = z;
    for (int e = g; e < MOFF * PKC / 8; e += NG) WSP(u32x4, WS_KC)[e] = z;
    for (int e = g; e < MOFF * PVC / 8; e += NG) WSP(u32x4, WS_VC)[e] = z;
}
__device__ __forceinline__ void sincos_d(float ang, float& s, float& co) {
    const double x = (double)ang, TWO_PI = 6.283185307179586476925, INV = 0.15915494309189533577;
    const double n = __builtin_rint(x * INV), r = __builtin_fma(-n, TWO_PI, x), y = 0.5 * r, y2 = y * y;
    double sp, cp;
    double ts = 1.0, tc = 1.0; sp = 1.0; cp = 1.0;
#pragma unroll
    for (int j = 1; j <= 12; ++j) { tc = -tc * y2 / (double)((2 * j - 1) * (2 * j)); ts = -ts * y2 / (double)((2 * j) * (2 * j + 1)); cp += tc; sp += ts; }
    const double sy = y * sp, cy = cp;
    s = (float)(2.0 * sy * cy); co = (float)(1.0 - 2.0 * sy * sy);
}
__device__ __forceinline__ void rope_tables(const Ctx& c) {
    const int g = c.bid * NTHREADS + c.tid, NG = c.G * NTHREADS;
    for (int e = g; e < NPOS * 48; e += NG) {
        const int pos = e / 48, i = e % 48;
        float inv; if (i < 32) inv = fexp2(-(float)i * (13.287712379549449f / 32.f)); else inv = fexp2(-(float)(i - 32) * (13.287712379549449f / 16.f));
        const float ang = (float)pos * inv; float s, co; sincos_d(ang, s, co);
        if (i < 32) { WSP(float, WS_COS64)[pos * 32 + i] = co; WSP(float, WS_SIN64)[pos * 32 + i] = s; }
        else { WSP(float, WS_COS32)[pos * 16 + i - 32] = co; WSP(float, WS_SIN32)[pos * 16 + i - 32] = s; }
    }
}
__device__ __forceinline__ void rms_row_to_bf16(const float* xrow, bf16* orow, float* copy, int lane) {
    const f32x4* xr = (const f32x4*)xrow + lane;
    f32x4 v[4]; float s = 0.f;
#pragma unroll
    for (int j = 0; j < 4; ++j) { v[j] = xr[64 * j]; s += (v[j][0] * v[j][0] + v[j][1] * v[j][1]) + (v[j][2] * v[j][2] + v[j][3] * v[j][3]); }
    const float rstd = 1.f / sqrtf(wave_sum(s) * (1.f / DM) + EPS);
    u32x2* o8 = (u32x2*)orow + lane;
#pragma unroll
    for (int j = 0; j < 4; ++j) { u32x2 w; w.x = cvtpk(v[j][0] * rstd, v[j][1] * rstd); w.y = cvtpk(v[j][2] * rstd, v[j][3] * rstd); o8[64 * j] = w; if (copy) ((f32x4*)copy + lane)[64 * j] = v[j]; }
}
__device__ __forceinline__ void slot0(const Ctx& c) {
    LAS float* scr = (LAS float*)(c.lds + c.wave * 16384);
    const int gw = c.bid * NWAVES + c.wave, NGW = c.G * NWAVES;
    for (int layer = 0; layer < 2; ++layer) {
        const float* w_in = c.w_in + (size_t)layer * DM * NIN;
        const int I_E = 16 * (NE / 32), I_L = 16 * (NL / 32), I_UQ = 6 * (NUQ / 32), I_UKV = 4 * (NUKV / 32), I_BR = 8 * (DM / 32), I_O = 16 * (DM / 32);
        const int tot = I_E + I_L + I_UQ + I_UKV + 3 * I_BR + I_O;
        for (int it = gw; it < tot; it += NGW) {
            int r = it;
            if (r < I_E) { conv_item(w_in, NIN, c.norm_g + layer * DM, wl(c, layer, WL_EARLY), DM, MAP_EARLY, NE / 32, r, scr, c.lane); continue; } r -= I_E;
            if (r < I_L) { conv_item(w_in, NIN, c.norm_g + layer * DM, wl(c, layer, WL_LATE), DM, MAP_LATE, NL / 32, r, scr, c.lane); continue; } r -= I_L;
            if (r < I_UQ) { conv_item(c.w_uq + (size_t)layer * 384 * 768, 768, c.g_cq + layer * 384, wl(c, layer, WL_UQ), 384, MAP_UQ, NUQ / 32, r, scr, c.lane); continue; } r -= I_UQ;
            if (r < I_UKV) { conv_item(c.w_ukv + (size_t)layer * 256 * 1024, 1024, c.g_ckv + layer * 256, wl(c, layer, WL_UKV), 256, MAP_ID, NUKV / 32, r, scr, c.lane); continue; } r -= I_UKV;
            if (r < 3 * I_BR) { const int n = r / I_BR; conv_item(c.w_branch + ((size_t)layer * 3 + n) * 512 * DM, DM, nullptr, wl(c, layer, WL_BR) + (size_t)n * DM * 512, 512, MAP_ID, DM / 32, r % I_BR, scr, c.lane); continue; } r -= 3 * I_BR;
            conv_item(c.w_out + (size_t)layer * DM * DM, DM, nullptr, wl(c, layer, WL_OUT), DM, MAP_ID, DM / 32, r, scr, c.lane);
        }
    }
    rope_tables(c);
    if (gw < 16) rms_row_to_bf16(c.meta + (size_t)gw * DM, WSP(bf16, WS_HNM) + (size_t)gw * DM, WSP(float, WS_HM) + (size_t)gw * DM, c.lane);
}

__device__ __forceinline__ void norm_main(const Ctx& c, const float* src) {
    const int gw = c.bid * NWAVES + c.wave, NGW = c.G * NWAVES;
    for (int m = gw; m < M; m += NGW) rms_row_to_bf16(src + (size_t)m * DM, WSP(bf16, WS_HN) + (size_t)m * DM, nullptr, c.lane);
}

template <class AF>
__device__ __forceinline__ void meta_block(const AF& af, const bf16* Bt, int K, int col0, float* raw, int ldraw, int rcol0, int lane) {
    f32x4 acc = {0.f, 0.f, 0.f, 0.f};
    const int r = lane & 15, kq = 8 * (lane >> 4);
    for (int k0 = 0; k0 < K; k0 += 32) {
        const bf16x8 a = af(r, k0 + kq);
        const bf16x8 b = *(const bf16x8*)(Bt + (size_t)(col0 + r) * K + k0 + kq);
        acc = __builtin_amdgcn_mfma_f32_16x16x32_bf16(a, b, acc, 0, 0, 0);
    }
#pragma unroll
    for (int x = 0; x < 4; ++x) raw[(size_t)(4 * (lane >> 4) + x) * ldraw + rcol0 + r] = acc[x];
}
struct AfPlain { const bf16* A; int lda; __device__ __forceinline__ bf16x8 operator()(int r, int k) const { return *(const bf16x8*)(A + (size_t)r * lda + k); } };
struct AfBranch {
    const bf16* ym; const float* rawl; int n;
    __device__ __forceinline__ bf16x8 operator()(int r, int k) const {
        f32x4 y0, y1; ld8(ym + (size_t)r * 1536 + n * 512 + k, y0, y1);
        const f32x4 z0 = *(const f32x4*)(rawl + (size_t)r * NL + 512 * n + k), z1 = *(const f32x4*)(rawl + (size_t)r * NL + 512 * n + k + 4);
#pragma unroll
        for (int j = 0; j < 4; ++j) { y0[j] *= siluf_(z0[j]); y1[j] *= siluf_(z1[j]); }
        return __builtin_bit_cast(bf16x8, pack8(y0, y1));
    }
};
struct AfMerged {
    const float* rawl; const float* rawb;
    __device__ __forceinline__ bf16x8 operator()(int r, int k) const {
        f32x4 s0 = {0.f, 0.f, 0.f, 0.f}, s1 = s0;
#pragma unroll
        for (int n = 0; n < 3; ++n) {
            const float* g = rawl + (size_t)r * NL + 1536 + n * 1024 + k; const float* p = rawb + ((size_t)n * 16 + r) * 1024 + k;
#pragma unroll
            for (int j = 0; j < 4; ++j) { s0[j] += sigmoidf_(g[j]) * p[j]; s1[j] += sigmoidf_(g[4 + j]) * p[4 + j]; }
        }
        return __builtin_bit_cast(bf16x8, pack8(s0, s1));
    }
};
template <class AF>
__device__ __forceinline__ void meta_blocks(const Ctx& c, const AF& af, const bf16* Bt, int K, int nblocks, float* raw, int ldraw, int rcol0) {
    LAS f32x4* red = (LAS f32x4*)(c.lds + 65536);
    const int r = c.lane & 15, kq = 8 * (c.lane >> 4), nks = K >> 5;
    for (int blk = c.bid; blk < nblocks; blk += c.G) {
        f32x4 acc = {0.f, 0.f, 0.f, 0.f};
#pragma unroll 4
        for (int ks = c.wave; ks < nks; ks += NWAVES) {
            const bf16x8 a = af(r, 32 * ks + kq);
            const bf16x8 bb = *(const bf16x8*)(Bt + (size_t)(16 * blk + r) * K + 32 * ks + kq);
            acc = __builtin_amdgcn_mfma_f32_16x16x32_bf16(a, bb, acc, 0, 0, 0);
        }
        asm volatile("s_nop 15\n\ts_nop 7" : "+v"(acc));
        red[c.wave * 64 + c.lane] = acc;
        __syncthreads();
        if (c.wave == 0) {
            f32x4 sm = red[c.lane];
#pragma unroll
            for (int w = 1; w < NWAVES; ++w) sm += red[w * 64 + c.lane];
#pragma unroll
            for (int x = 0; x < 4; ++x) raw[(size_t)(4 * (c.lane >> 4) + x) * ldraw + rcol0 + 16 * blk + r] = sm[x];
        }
        __syncthreads();
    }
}

__device__ __forceinline__ void post_early(const Ctx& c, int layer) {
    const float* raw = WSP(float, WS_RAWE);
    bf16 *QAm = WSP(bf16, WS_QAM), *QCm = WSP(bf16, WS_QCM), *cm = WSP(bf16, WS_CM);
    bf16 *KAf = WSP(bf16, WS_KA), *VAf = WSP(bf16, WS_VA), *KBf = WSP(bf16, WS_KB), *KCf = WSP(bf16, WS_KC), *VCf = WSP(bf16, WS_VC);
    float* LFm = WSP(float, WS_LFM);
    const float *cos64 = WSP(float, WS_COS64), *sin64 = WSP(float, WS_SIN64), *cos32 = WSP(float, WS_COS32), *sin32 = WSP(float, WS_SIN32);
    for (int e = c.bid * NTHREADS + c.tid; e < 16 * NE; e += c.G * NTHREADS) {
        const int r = e / NE, p = e % NE, t = p >> 8, cc = p & 255, half = cc >> 7, c7 = cc & 127; const float v = raw[e];
        if (t < 2) QAm[r * PQA + p] = f2bf(v * C2A);
        else if (t < 4) { const int L = p - 512; KAf[(size_t)(MOFF + r) * PKA + (L >> 6) * 80 + (L & 63)] = f2bf(v); }
        else if (t < 6) VAf[(size_t)(MOFF + r) * PVA + (p - 1024)] = f2bf(v);
        else if (t < 8) { if (half == 0) { const int hh = c7 >> 5, d = c7 & 31, head = 4 * (t - 6) + hh; const float x1 = v, x2 = raw[e + 128], cs = cos64[r * 32 + d], sn = sin64[r * 32 + d];
                QCm[r * PQC + head * 64 + d] = f2bf((x1 * cs - x2 * sn) * C2C); QCm[r * PQC + head * 64 + 32 + d] = f2bf((x2 * cs + x1 * sn) * C2C); } }
        else if (t == 8) { if (c7 < 64) { if (half == 0) { const int hh = c7 >> 5, d = c7 & 31; const float x1 = v, x2 = raw[e + 128], cs = cos64[r * 32 + d], sn = sin64[r * 32 + d];
                    KCf[(size_t)(MOFF + r) * PKC + hh * 64 + d] = f2bf(x1 * cs - x2 * sn); KCf[(size_t)(MOFF + r) * PKC + hh * 64 + 32 + d] = f2bf(x2 * cs + x1 * sn); } }
            else VCf[(size_t)(MOFF + r) * PVC + 64 * half + (c7 - 64)] = f2bf(v); }
        else if (t == 9) cm[r * 640 + cc] = f2bf(v);
        else if (t == 10) { if (c7 < 64) cm[r * 640 + 256 + 64 * half + c7] = f2bf(v);
            else if (c7 < 80) { if (half == 0) { const int d = c7 - 64; const float x1 = v, x2 = raw[e + 128], cs = cos32[r * 16 + d], sn = sin32[r * 16 + d]; const bf16 o1 = f2bf(x1 * cs - x2 * sn), o2 = f2bf(x2 * cs + x1 * sn);
                    for (int h = 0; h < 8; ++h) { KBf[(size_t)(MOFF + r) * PKB + h * 96 + 64 + d] = o1; KBf[(size_t)(MOFF + r) * PKB + h * 96 + 80 + d] = o2; } } }
            else if (c7 < 88 && half == 0) LFm[r * 8 + (c7 - 80)] = logsigf_(v + c.b_f[layer * 8 + (c7 - 80)]); }
        else cm[r * 640 + 384 + cc] = f2bf(v);
    }
}
__device__ __forceinline__ void post_early_reduce(const Ctx& c) {
    const bf16* cm = WSP(bf16, WS_CM); float* rqm = WSP(float, WS_RQM); const float* LFm = WSP(float, WS_LFM); bf16* KAf = WSP(bf16, WS_KA);
    for (int r = c.wave; r < 16; r += NWAVES) {
        float sq = 0.f, sk = 0.f;
        if (c.lane < 48) { f32x4 a, b; ld8(cm + r * 640 + 8 * c.lane, a, b); sq = (a[0] * a[0] + a[1] * a[1]) + (a[2] * a[2] + a[3] * a[3]) + (b[0] * b[0] + b[1] * b[1]) + (b[2] * b[2] + b[3] * b[3]); }
        if (c.lane < 32) { f32x4 a, b; ld8(cm + r * 640 + 384 + 8 * c.lane, a, b); sk = (a[0] * a[0] + a[1] * a[1]) + (a[2] * a[2] + a[3] * a[3]) + (b[0] * b[0] + b[1] * b[1]) + (b[2] * b[2] + b[3] * b[3]); }
        sq = wave_sum(sq); sk = wave_sum(sk);
        if (c.lane == 0) { rqm[r] = 1.f / sqrtf(sq * (1.f / 384.f) + EPS); rqm[16 + r] = 1.f / sqrtf(sk * (1.f / 256.f) + EPS); }
    }
    if (c.tid < 8) { const int h = c.tid; float lf[16];
#pragma unroll
        for (int r = 0; r < 16; ++r) lf[r] = LFm[r * 8 + h];
        float suf = 0.f;
#pragma unroll
        for (int r = 15; r >= 0; --r) { bf16 bh, bm, bl; split3(suf * LOG2E, bh, bm, bl); bf16* kp = KAf + (size_t)(MOFF + r) * PKA + h * 80 + 64;
            const u32x4 w0 = {(unsigned)bh | ((unsigned)bm << 16), (unsigned)bl | 0x3F800000u, 0x3F803F80u, 0u}, w1 = {0u, 0u, 0u, 0u}; *(u32x4*)kp = w0; *(u32x4*)(kp + 8) = w1; suf += lf[r]; } }
}
__device__ __forceinline__ void post_up(const Ctx& c) {
    const float* raw = WSP(float, WS_RAWU); const float* rqm = WSP(float, WS_RQM);
    bf16 *QBm = WSP(bf16, WS_QBM), *KBf = WSP(bf16, WS_KB), *VBf = WSP(bf16, WS_VB);
    const float *cos32 = WSP(float, WS_COS32), *sin32 = WSP(float, WS_SIN32);
    for (int e = c.bid * NTHREADS + c.tid; e < 16 * (NUQ + NUKV); e += c.G * NTHREADS) {
        const int r = e / (NUQ + NUKV), p = e % (NUQ + NUKV); const float v = raw[e];
        if (p < 512) { const int h = p >> 6, d = p & 63; QBm[r * PQB + h * 96 + d] = f2bf(v * rqm[r] * C2B); }
        else if (p < 768) { const int cc = p - 512, half = cc >> 7, c7 = cc & 127; if (half == 0) { const int h = c7 >> 4, d = c7 & 15; const float sc = rqm[r] * C2B, x1 = v * sc, x2 = raw[e + 128] * sc, cs = cos32[r * 16 + d], sn = sin32[r * 16 + d];
                QBm[r * PQB + h * 96 + 64 + d] = f2bf(x1 * cs - x2 * sn); QBm[r * PQB + h * 96 + 80 + d] = f2bf(x2 * cs + x1 * sn); } }
        else { const int q = p - 768, h = q >> 7, d = q & 127; const float w = v * rqm[16 + r];
            if (d < 64) KBf[(size_t)(MOFF + r) * PKB + h * 96 + d] = f2bf(w); else VBf[(size_t)(MOFF + r) * PVB + h * 64 + (d - 64)] = f2bf(w); }
    }
}
__device__ __forceinline__ void post_resid(const Ctx& c) {
    for (int r = c.wave; r < 16; r += NWAVES) {
        float* hm = WSP(float, WS_HM) + (size_t)r * DM; const float* ro = WSP(float, WS_RAWO) + (size_t)r * DM;
        f32x4 v[4]; float s = 0.f;
#pragma unroll
        for (int j = 0; j < 4; ++j) { v[j] = ((const f32x4*)hm + c.lane)[64 * j] + ((const f32x4*)ro + c.lane)[64 * j]; s += (v[j][0] * v[j][0] + v[j][1] * v[j][1]) + (v[j][2] * v[j][2] + v[j][3] * v[j][3]); }
        const float rstd = 1.f / sqrtf(wave_sum(s) * (1.f / DM) + EPS);
        u32x2* o8 = (u32x2*)(WSP(bf16, WS_HNM) + (size_t)r * DM) + c.lane;
#pragma unroll
        for (int j = 0; j < 4; ++j) { u32x2 w; w.x = cvtpk(v[j][0] * rstd, v[j][1] * rstd); w.y = cvtpk(v[j][2] * rstd, v[j][3] * rstd); o8[64 * j] = w; ((f32x4*)hm + c.lane)[64 * j] = v[j]; }
    }
}

template <int DK, int MODE>
__device__ __forceinline__ void attn_row(const bf16* qrow, const bf16* Kf, const bf16* Km, int kpitch, int koff, const bf16* Vf, const bf16* Vm, int vpitch, int voff, int t, float sink2, bf16* orow) {
    float q[DK];
#pragma unroll
    for (int d = 0; d < DK; d += 8) { f32x4 a, b; ld8(qrow + d, a, b);
#pragma unroll
        for (int j = 0; j < 4; ++j) { q[d + j] = a[j]; q[d + 4 + j] = b[j]; } }
    float o[64];
#pragma unroll
    for (int d = 0; d < 64; ++d) o[d] = 0.f;
    float m = -1e30f, l = 0.f; if (MODE == 2) { m = sink2; l = 1.f; }
    const int s0 = (MODE == 2) ? (t - 127 > 0 ? t - 127 : 0) : 0;
    for (int s = s0; s <= t; ++s) {
        const bf16* kp = (s < NMETA) ? Kf + (size_t)(MOFF + s) * kpitch + koff : Km + (size_t)(s - NMETA) * kpitch + koff;
        const bf16* vp = (s < NMETA) ? Vf + (size_t)(MOFF + s) * vpitch + voff : Vm + (size_t)(s - NMETA) * vpitch + voff;
        float x = 0.f;
#pragma unroll
        for (int d = 0; d < DK; d += 8) { f32x4 a, b; ld8(kp + d, a, b);
#pragma unroll
            for (int j = 0; j < 4; ++j) { x += q[d + j] * a[j]; x += q[d + 4 + j] * b[j]; } }
        if (MODE == 0) x += bf2f(kp[64]) + bf2f(kp[65]) + bf2f(kp[66]);
        if (x > m) { const float f = fexp2(m - x); l *= f;
#pragma unroll
            for (int d = 0; d < 64; ++d) o[d] *= f;
            m = x; }
        const float p = fexp2(x - m); l += p;
#pragma unroll
        for (int d = 0; d < 64; d += 8) { f32x4 a, b; ld8(vp + d, a, b);
#pragma unroll
            for (int j = 0; j < 4; ++j) { o[d + j] += p * a[j]; o[d + 4 + j] += p * b[j]; } }
    }
    const float il = 1.f / l;
#pragma unroll
    for (int d = 0; d < 64; d += 8) { f32x4 a = {o[d] * il, o[d + 1] * il, o[d + 2] * il, o[d + 3] * il}, b = {o[d + 4] * il, o[d + 5] * il, o[d + 6] * il, o[d + 7] * il}; st8(orow + d, a, b); }
}
__device__ __forceinline__ void attn_main_naive(const Ctx& c, int layer) {
    const int g = c.bid * NTHREADS + c.tid, NG = c.G * NTHREADS;
    for (int e = g; e < M * 8; e += NG) {
        const int i = e % SEQ, bh = e / SEQ, b = bh >> 3, h = bh & 7; const size_t row = (size_t)b * SEQ + i; const int t = NMETA + i;
        attn_row<64, 0>(WSP(bf16, WS_QA) + row * PQA + h * 64, WSP(bf16, WS_KA), WSP(bf16, WS_KA) + (size_t)(FR + b * SEQ) * PKA, PKA, h * 80,
                        WSP(bf16, WS_VA), WSP(bf16, WS_VA) + (size_t)(FR + b * SEQ) * PVA, PVA, h * 64, t, 0.f, WSP(bf16, WS_QA) + row * PQA + h * 64);
    }
    for (int e = g; e < M * 8; e += NG) {
        const int i = e % SEQ, bh = e / SEQ, b = bh >> 3, h = bh & 7; const size_t row = (size_t)b * SEQ + i; const int t = NMETA + i;
        attn_row<96, 1>(WSP(bf16, WS_QB) + row * PQB + h * 96, WSP(bf16, WS_KB), WSP(bf16, WS_KB) + (size_t)(FR + b * SEQ) * PKB, PKB, h * 96,
                        WSP(bf16, WS_VB), WSP(bf16, WS_VB) + (size_t)(FR + b * SEQ) * PVB, PVB, h * 64, t, 0.f, WSP(bf16, WS_YB) + row * PY + h * 64);
    }
    for (int e = g; e < M * 8; e += NG) {
        const int i = e % SEQ, bh = e / SEQ, b = bh >> 3, h = bh & 7; const size_t row = (size_t)b * SEQ + i; const int t = NMETA + i;
        attn_row<64, 2>(WSP(bf16, WS_QC) + row * PQC + h * 64, WSP(bf16, WS_KC), WSP(bf16, WS_KC) + (size_t)(FR + b * SEQ) * PKC, PKC, (h >> 2) * 64,
                        WSP(bf16, WS_VC), WSP(bf16, WS_VC) + (size_t)(FR + b * SEQ) * PVC, PVC, (h >> 2) * 64, t, c.sinks[layer * 8 + h] * LOG2E, WSP(bf16, WS_QC) + row * PQC + h * 64);
    }
}

namespace fa {
typedef float f32x16 __attribute__((ext_vector_type(16)));
typedef short s16x4 __attribute__((ext_vector_type(4)));
constexpr int KSLOT = 12288, VSLOT = 8192, OFF_K = 0, OFF_V = 2 * KSLOT, OFF_WS = OFF_V + 2 * VSLOT, OFF_OST = OFF_WS + NWAVES * 256, LDS_END = OFF_OST + NWAVES * 4096;
__device__ __forceinline__ int crow(int r, int hi) { return (r & 3) + 8 * (r >> 2) + 4 * hi; }
#define FA_SBAR() __builtin_amdgcn_sched_barrier(0)
__device__ __forceinline__ void pv(f32x16* o, int vb, bf16x8 pa0, bf16x8 pa1, bf16x8 pa2, bf16x8 pa3) {
#pragma unroll
    for (int d0 = 0; d0 < 2; ++d0) { s16x4 lo[4], hi[4];
#pragma unroll
        for (int ks = 0; ks < 4; ++ks) {
            asm volatile("ds_read_b64_tr_b16 %0,%1 offset:%c2" : "=&v"(lo[ks]) : "v"(vb), "i"(d0 * 4096 + ks * 1024) : "memory");
            asm volatile("ds_read_b64_tr_b16 %0,%1 offset:%c2" : "=&v"(hi[ks]) : "v"(vb), "i"(d0 * 4096 + ks * 1024 + 512) : "memory"); }
        asm volatile("s_waitcnt lgkmcnt(0)" ::: "memory"); FA_SBAR();
#define FA_PK(k) (bf16x8){lo[k][0], lo[k][1], lo[k][2], lo[k][3], hi[k][0], hi[k][1], hi[k][2], hi[k][3]}
        o[d0] = __builtin_amdgcn_mfma_f32_32x32x16_bf16(pa0, FA_PK(0), o[d0], 0, 0, 0);
        o[d0] = __builtin_amdgcn_mfma_f32_32x32x16_bf16(pa1, FA_PK(1), o[d0], 0, 0, 0);
        o[d0] = __builtin_amdgcn_mfma_f32_32x32x16_bf16(pa2, FA_PK(2), o[d0], 0, 0, 0);
        o[d0] = __builtin_amdgcn_mfma_f32_32x32x16_bf16(pa3, FA_PK(3), o[d0], 0, 0, 0);
#undef FA_PK
    }
}
struct Tensors { const bf16* Q; int qpitch, qoff; const bf16* Kf; const bf16* Km; int kpitch, koff; const bf16* Vf; const bf16* Vm; int vpitch, voff; bf16* O; int opitch, ooff; };
template <int NK, int MODE>
__device__ __forceinline__ void attn_unit(const Ctx& c, const Tensors& T, int j, float sink2) {
    constexpr int NCH = 2 * NK;
    LAS unsigned char* lds = c.lds;
    const int lane = c.lane, wid = c.wave, r32 = lane & 31, hi = lane >> 5;
    const unsigned lds0 = (unsigned)(size_t)lds;
    LAS float* wsf = (LAS float*)(lds + OFF_WS) + wid * 64;
    const int q0 = 256 * j;
    const int t_hi = 4 * j + 4, t_lo = (MODE == 2) ? (4 * j - 1 > 0 ? 4 * j - 1 : 0) : 0;
    bf16x8 qr[NK];
    { const bf16* qp = T.Q + (size_t)(q0 + wid * 32 + r32) * T.qpitch + T.qoff + hi * 8;
#pragma unroll
      for (int d0 = 0; d0 < NK; ++d0) { if (MODE == 0 && d0 == NK - 1) { const short one = (short)0x3F80; qr[d0] = hi ? (bf16x8){0, 0, 0, 0, 0, 0, 0, 0} : (bf16x8){one, one, one, 0, 0, 0, 0, 0}; } else qr[d0] = *(const bf16x8*)(qp + d0 * 16); } }
    u32x4 sk0, sk1 = {0u, 0u, 0u, 0u}, sv;
    const bool k2 = (wid + 8 < NCH);
#define FA_LOAD(t) do { const bf16* kt = ((t) == 0) ? T.Kf : T.Km + (size_t)(64 * ((t) - 1)) * T.kpitch; const bf16* vt = ((t) == 0) ? T.Vf : T.Vm + (size_t)(64 * ((t) - 1)) * T.vpitch; \
        sk0 = *(const u32x4*)(kt + (size_t)lane * T.kpitch + T.koff + wid * 8); if (k2) sk1 = *(const u32x4*)(kt + (size_t)lane * T.kpitch + T.koff + (wid + 8) * 8); \
        sv = *(const u32x4*)(vt + (size_t)(16 * (wid & 3) + (lane >> 2)) * T.vpitch + T.voff + (wid >> 2) * 32 + (lane & 3) * 8); } while (0)
#define FA_WRITE(b) do { *(LAS u32x4*)(lds + OFF_K + (b) * KSLOT + wid * 1024 + lane * 16) = sk0; if (k2) *(LAS u32x4*)(lds + OFF_K + (b) * KSLOT + (wid + 8) * 1024 + lane * 16) = sk1; \
        *(LAS u32x4*)(lds + OFF_V + (b) * VSLOT + wid * 1024 + lane * 16) = sv; } while (0)
    float m = (MODE == 2) ? sink2 : -INFINITY, l = (MODE == 2 && hi == 0) ? 1.f : 0.f;
    f32x16 o[2]; o[0] = f32x16{}; o[1] = f32x16{};
    const int qpos = NMETA + q0 + wid * 32 + r32;
    FA_LOAD(t_lo); FA_WRITE(0);
    int buf = 0;
    for (int t = t_lo; t <= t_hi; ++t) {
        __syncthreads();
        if (t < t_hi) FA_LOAD(t + 1);
        f32x16 p0 = f32x16{}, p1 = f32x16{};
        { const LAS unsigned char* kb = lds + OFF_K + buf * KSLOT + hi * 1024 + r32 * 16;
#pragma unroll
          for (int d0 = 0; d0 < NK; ++d0) { const bf16x8 b0 = *(const LAS bf16x8*)(kb + d0 * 2048), b1 = *(const LAS bf16x8*)(kb + d0 * 2048 + 512);
              p0 = __builtin_amdgcn_mfma_f32_32x32x16_bf16(b0, qr[d0], p0, 0, 0, 0); p1 = __builtin_amdgcn_mfma_f32_32x32x16_bf16(b1, qr[d0], p1, 0, 0, 0); } }
        const int kpos0 = (t == 0) ? -MOFF : NMETA + 64 * (t - 1);
        const bool need = (t == 0) || (t > t_hi - 4) || (MODE == 2);
        if (need) {
#pragma unroll
            for (int r = 0; r < 16; ++r) { const int ka = kpos0 + crow(r, hi), kb2 = ka + 32;
                bool ma = (ka > qpos) || (ka < 0), mb = (kb2 > qpos) || (kb2 < 0);
                if (MODE == 2) { ma = ma || (qpos - ka >= 128); mb = mb || (qpos - kb2 >= 128); }
                if (ma) p0[r] = -INFINITY; if (mb) p1[r] = -INFINITY; }
        }
        float rm = fmaxf(p0[0], p1[0]);
#pragma unroll
        for (int r = 1; r < 16; ++r) rm = fmaxf(rm, fmaxf(p0[r], p1[r]));
        { auto rr = __builtin_amdgcn_permlane32_swap(__float_as_uint(rm), __float_as_uint(rm), false, false); rm = fmaxf(__uint_as_float(rr[0]), __uint_as_float(rr[1])); }
        const float mn = fmaxf(m, rm);
        const bool grew = mn > m;
        const float alpha = (mn == -INFINITY) ? 1.f : fexp2(m - mn);
        const float msub = (mn == -INFINITY) ? 0.f : mn;
        float rs = 0.f;
#pragma unroll
        for (int r = 0; r < 16; ++r) { p0[r] = fexp2(p0[r] - msub); p1[r] = fexp2(p1[r] - msub); rs += p0[r] + p1[r]; }
        l = l * alpha + rs; m = mn;
        if (__any(grew)) {
            if (hi == 0) wsf[r32] = alpha;
            asm volatile("s_waitcnt lgkmcnt(0)" ::: "memory");
#pragma unroll
            for (int r = 0; r < 16; ++r) { const float f = wsf[crow(r, hi)]; o[0][r] *= f; o[1][r] *= f; }
        }
        u32x4 pw0, pw1, pw2, pw3;
        pw0 = (u32x4){cvtpk(p0[0], p0[1]), cvtpk(p0[2], p0[3]), cvtpk(p0[4], p0[5]), cvtpk(p0[6], p0[7])}; pw1 = (u32x4){cvtpk(p0[8], p0[9]), cvtpk(p0[10], p0[11]), cvtpk(p0[12], p0[13]), cvtpk(p0[14], p0[15])};
        pw2 = (u32x4){cvtpk(p1[0], p1[1]), cvtpk(p1[2], p1[3]), cvtpk(p1[4], p1[5]), cvtpk(p1[6], p1[7])}; pw3 = (u32x4){cvtpk(p1[8], p1[9]), cvtpk(p1[10], p1[11]), cvtpk(p1[12], p1[13]), cvtpk(p1[14], p1[15])};
        if (t < t_hi) FA_WRITE(buf ^ 1);
        const int vb = (int)(lds0 + OFF_V + buf * VSLOT) + ((lane >> 4) & 1) * 32 + (lane & 3) * 8 + (4 * hi + ((lane & 15) >> 2)) * 64;
        pv(o, vb, __builtin_bit_cast(bf16x8, pw0), __builtin_bit_cast(bf16x8, pw1), __builtin_bit_cast(bf16x8, pw2), __builtin_bit_cast(bf16x8, pw3));
        buf ^= 1;
    }
    { auto rr = __builtin_amdgcn_permlane32_swap(__float_as_uint(l), __float_as_uint(l), false, false); l = __uint_as_float(rr[0]) + __uint_as_float(rr[1]); }
    if (hi == 0) wsf[32 + r32] = l;
    asm volatile("s_waitcnt lgkmcnt(0)" ::: "memory");
    LAS bf16* stg = (LAS bf16*)(lds + OFF_OST) + wid * 2048;
#pragma unroll
    for (int r = 0; r < 16; ++r) { const int orow = crow(r, hi); const float rl = frcp(wsf[32 + orow]);
        stg[orow * 64 + r32] = f2bf(o[0][r] * rl); stg[orow * 64 + 32 + r32] = f2bf(o[1][r] * rl); }
    asm volatile("s_waitcnt lgkmcnt(0)" ::: "memory");
    bf16* Ow = T.O + (size_t)(q0 + wid * 32) * T.opitch + T.ooff;
#pragma unroll
    for (int i = 0; i < 4; ++i) { const int row = i * 8 + (lane >> 3), ch = lane & 7; const u32x4 v = *(const LAS u32x4*)(stg + row * 64 + ch * 8); *(u32x4*)(Ow + (size_t)row * T.opitch + ch * 8) = v; }
    __syncthreads();
#undef FA_LOAD
#undef FA_WRITE
}
#undef FA_SBAR
}
static_assert(fa::LDS_END <= 131072, "attention LDS");


namespace fb {
typedef float f32x16 __attribute__((ext_vector_type(16)));
typedef short s16x4 __attribute__((ext_vector_type(4)));
typedef short v4i16_t __attribute__((ext_vector_type(4)));
typedef __attribute__((address_space(3))) const char* lds_cptr;
__device__ __forceinline__ int crow(int r, int hi) { return (r & 3) + 8 * (r >> 2) + 4 * hi; }
#define SBAR() __builtin_amdgcn_sched_barrier(0)
__device__ __forceinline__ void cmask(f32x16& p0, f32x16& p1, int jb, int qrel, int hi) {
    const float NEG = -INFINITY; const int kb = 64 * jb + 4 * hi;
#pragma unroll
    for (int r = 0; r < 16; ++r) { const int kv = kb + (r & 3) + 8 * (r >> 2); if (kv > qrel) p0[r] = NEG; if (kv + 32 > qrel) p1[r] = NEG; }
}
__device__ __forceinline__ void glds16(const void* gsrc, unsigned lds_dst) { unsigned keep;
    asm volatile("s_mov_b32 %0, m0\n\ts_mov_b32 m0, %2\n\ts_nop 0\n\tglobal_load_lds_dwordx4 %1, off\n\ts_mov_b32 m0, %0" : "=&s"(keep) : "v"(gsrc), "s"(lds_dst) : "memory"); }
__device__ __forceinline__ float max3f(float a, float b, float c) { float r; asm("v_max3_f32 %0, %1, %2, %3" : "=v"(r) : "v"(a), "v"(b), "v"(c)); return r; }
__device__ __forceinline__ float max2f(float a, float b) { float r; asm("v_max_f32_e32 %0, %1, %2" : "=v"(r) : "v"(a), "v"(b)); return r; }
__device__ __forceinline__ float fadd_s(float a, float b) { float r; asm("v_add_f32_e32 %0, %1, %2" : "=v"(r) : "v"(a), "v"(b)); return r; }
__device__ __forceinline__ float fsub_s(float a, float b) { float r; asm("v_sub_f32_e32 %0, %1, %2" : "=v"(r) : "v"(a), "v"(b)); return r; }
#define WAIT_BAR(N) asm volatile("s_waitcnt vmcnt(" #N ") lgkmcnt(0)\n\ts_barrier" ::: "memory")
__device__ __forceinline__ void kload2(bf16x8* kf, lds_cptr kp, int j) { kf[2 * j] = *(const LAS bf16x8*)(kp + j * 2048); kf[2 * j + 1] = *(const LAS bf16x8*)(kp + j * 2048 + 512); }
__device__ __forceinline__ s16x4 vtr(lds_cptr p) { return __builtin_bit_cast(s16x4, __builtin_amdgcn_ds_read_tr16_b64_v4i16((LAS v4i16_t*)p)); }
__device__ __forceinline__ float rowmax(const f32x16& p0, const f32x16& p1) {
    float a = max3f(p0[0], p0[1], p1[0]), b = max3f(p0[2], p0[3], p1[1]); a = max3f(a, p1[2], p1[3]);
#pragma unroll
    for (int r = 4; r < 16; r += 4) { a = max3f(a, p0[r], p0[r + 1]); b = max3f(b, p0[r + 2], p0[r + 3]); a = max3f(a, p1[r], p1[r + 1]); b = max3f(b, p1[r + 2], p1[r + 3]); }
    const float m = max2f(a, b);
    auto rr = __builtin_amdgcn_permlane32_swap(__float_as_uint(m), __float_as_uint(m), false, false);
    return max2f(__uint_as_float(rr[0]), __uint_as_float(rr[1]));
}
__device__ __forceinline__ void pv(f32x16* o, int vb, bf16x8 pa0, bf16x8 pa1, bf16x8 pa2, bf16x8 pa3) {
#pragma unroll
    for (int d0 = 0; d0 < 2; ++d0) { s16x4 lo[4], hi[4];
#pragma unroll
        for (int ks = 0; ks < 4; ++ks) {
            asm volatile("ds_read_b64_tr_b16 %0,%1 offset:%c2" : "=&v"(lo[ks]) : "v"(vb), "i"(d0 * 4096 + ks * 1024) : "memory");
            asm volatile("ds_read_b64_tr_b16 %0,%1 offset:%c2" : "=&v"(hi[ks]) : "v"(vb), "i"(d0 * 4096 + ks * 1024 + 512) : "memory"); }
        asm volatile("s_waitcnt lgkmcnt(0)" ::: "memory"); SBAR();
#define PK(k) (bf16x8){lo[k][0], lo[k][1], lo[k][2], lo[k][3], hi[k][0], hi[k][1], hi[k][2], hi[k][3]}
        o[d0] = __builtin_amdgcn_mfma_f32_32x32x16_bf16(pa0, PK(0), o[d0], 0, 0, 0);
        o[d0] = __builtin_amdgcn_mfma_f32_32x32x16_bf16(pa1, PK(1), o[d0], 0, 0, 0);
        o[d0] = __builtin_amdgcn_mfma_f32_32x32x16_bf16(pa2, PK(2), o[d0], 0, 0, 0);
        o[d0] = __builtin_amdgcn_mfma_f32_32x32x16_bf16(pa3, PK(3), o[d0], 0, 0, 0);
#undef PK
    }
}
template <int NK> struct Geo { static constexpr int SLOTB = NK * 2048, LDS_K = 0, LDS_V = 3 * SLOTB, LDS_WS = 6 * SLOTB, LDS_OST = LDS_WS + NWAVES * 256, LDS_BYTES = LDS_OST + NWAVES * 4096; };
template <int NK, bool AUG, int QP, int KP, int VP, int OP, int THRL, bool XFIRST = false, int VLATE = 0, bool NONEGM = false>
__device__ __forceinline__ void attn_unit(const bf16* Qb, const bf16* Kf, const bf16* Km, const bf16* Vf, const bf16* Vm, bf16* Ob, int j, char* shm, int tid) {
    typedef Geo<NK> G; constexpr int SLOTB = G::SLOTB, LDS_K = G::LDS_K, LDS_V = G::LDS_V, LDS_WS = G::LDS_WS, LDS_OST = G::LDS_OST, NCH = 2 * NK, NKD = (NK > 4) ? 2 : 1, NSLOT = 3;
    const int lane = tid & 63, r32 = lane & 31, hi = lane >> 5; const int wid = __builtin_amdgcn_readfirstlane(tid >> 6);
    const int q0 = 256 * j;
    const bf16* Qw = Qb + (size_t)(q0 + wid * 32) * QP;
    const unsigned lds0 = (unsigned)(uintptr_t)shm;
    float* wsf = (float*)(shm + LDS_WS) + wid * 64;
    const int c2 = 8 + (wid % (NCH > 8 ? NCH - 8 : 1));
    const bf16* ksrc_f = Kf + (size_t)lane * KP + wid * 8; const bf16* ksrc_m = Km + (size_t)lane * KP + wid * 8;
    const bf16* vsrc_f = Vf + (size_t)(16 * (wid & 3) + (lane >> 2)) * VP + (wid >> 2) * 32 + (lane & 3) * 8; const bf16* vsrc_m = Vm + (size_t)(16 * (wid & 3) + (lane >> 2)) * VP + (wid >> 2) * 32 + (lane & 3) * 8;
    const unsigned kdst = lds0 + LDS_K + wid * 1024, kdst2 = lds0 + LDS_K + c2 * 1024, vdst = lds0 + LDS_V + wid * 1024;
#define RFL(x) ((unsigned)__builtin_amdgcn_readfirstlane(x))
#define DMA_KP(src, slot) do { glds16((src), RFL(kdst + (slot))); if (NKD == 2) glds16((src) + (c2 - wid) * 8, RFL(kdst2 + (slot))); } while (0)
#define DMA_K0(slot) DMA_KP(ksrc_f, slot)
#define DMA_KM(t, slot) DMA_KP(ksrc_m + (size_t)((t) - 1) * 64 * KP, slot)
#define DMA_V0(slot) glds16(vsrc_f, RFL(vdst + (slot)))
#define DMA_VM(t, slot) glds16(vsrc_m + (size_t)((t) - 1) * 64 * VP, RFL(vdst + (slot)))
#define WAIT_KV() do { if (NKD == 2) { WAIT_BAR(3); } else { WAIT_BAR(2); } } while (0)
    const int vb0 = (int)(lds0 + LDS_V) + ((lane >> 4) & 1) * 32 + (lane & 3) * 8 + (4 * hi + ((lane & 15) >> 2)) * 64;
    bf16x8 kf[2 * NK];
    const lds_cptr shm3 = (lds_cptr)shm; const lds_cptr kp0 = shm3 + LDS_K + hi * 1024 + r32 * 16; const lds_cptr vp0 = shm3 + LDS_V + ((lane >> 4) & 1) * 32 + (lane & 3) * 8 + (4 * hi + ((lane & 15) >> 2)) * 64;
    const int NT = 4 * j + 5;
    DMA_K0(0); DMA_V0(0); DMA_KM(1, SLOTB);
    bf16x8 qr[NK];
#pragma unroll
    for (int d0 = 0; d0 < NK; ++d0) { if (AUG && d0 == NK - 1) { const short one = (short)0x3F80; qr[d0] = hi ? (bf16x8){0, 0, 0, 0, 0, 0, 0, 0} : (bf16x8){one, one, one, 0, 0, 0, 0, 0}; }
        else qr[d0] = *reinterpret_cast<const bf16x8*>(&Qw[(size_t)r32 * QP + d0 * 16 + hi * 8]); }
    float mhat = 0.f, l_reg = 0.f; f32x16 o[2]; o[0] = f32x16{}; o[1] = f32x16{}; f32x16 negm = f32x16{}; if (!AUG && !NONEGM) asm volatile("" : "+v"(negm));
#define SETREF() do { if (AUG) { bf16 h_, m_, l_; split3(-mhat, h_, m_, l_); if (hi == 0) { u32x4 w_ = {0x3F803F80u, 0x3F80u | ((unsigned)h_ << 16), (unsigned)m_ | ((unsigned)l_ << 16), 0u}; qr[NK - 1] = __builtin_bit_cast(bf16x8, w_); } } \
        else if (!NONEGM) { _Pragma("unroll") for (int r = 0; r < 16; ++r) negm[r] = -mhat; asm volatile("" : "+v"(negm)); } } while (0)
#define CIN ((AUG || NONEGM) ? f32x16{} : negm)
    const int qrel = wid * 32 + r32;
#define CMASK(P0, P1, t) do { int jb_ = (t) - (NT - 4); if (jb_ >= 0) cmask(P0, P1, jb_, qrel, hi); } while (0)
    bool resc = false;
#define START(P0, P1) do { const float rm = rowmax(P0, P1); resc = false; \
    { const float dl = rm; mhat = fadd_s(mhat, dl); \
      _Pragma("unroll") for (int r = 0; r < 16; ++r) { P0[r] = fsub_s(P0[r], dl); P1[r] = fsub_s(P1[r], dl); } \
      SETREF(); } \
    _Pragma("unroll") for (int r = 0; r < 16; ++r) P0[r] = __builtin_amdgcn_exp2f(P0[r]); } while (0)
#define RESC() do { if (resc) { asm volatile("s_waitcnt lgkmcnt(0)" ::: "memory"); \
      _Pragma("unroll") for (int d_ = 0; d_ < 2; ++d_) _Pragma("unroll") for (int r = 0; r < 16; ++r) o[d_][r] *= wsf[crow(r, hi)]; } } while (0)
    f32x16 pA0, pA1, pB0, pB1;
    int sl_prev = 0, sl_cur = 0, sl_next = SLOTB;
#define ROT() do { sl_prev = sl_cur; sl_cur = sl_next; sl_next = (sl_next == (NSLOT - 1) * SLOTB) ? 0 : sl_next + SLOTB; } while (0)
    DMA_KM(2, 2 * SLOTB);
    if (NKD == 2) { WAIT_BAR(5); } else { WAIT_BAR(3); }
    { pA0 = CIN; pA1 = CIN; const char* kb = shm + LDS_K + hi * 1024 + r32 * 16;
#pragma unroll
      for (int d0 = 0; d0 < NK; ++d0) { const bf16x8 b0 = *reinterpret_cast<const bf16x8*>(kb + d0 * 2048), b1 = *reinterpret_cast<const bf16x8*>(kb + d0 * 2048 + 512);
          pA0 = __builtin_amdgcn_mfma_f32_32x32x16_bf16(b0, qr[d0], pA0, 0, 0, 0); pA1 = __builtin_amdgcn_mfma_f32_32x32x16_bf16(b1, qr[d0], pA1, 0, 0, 0); } }
    asm volatile("s_nop 15\n\ts_nop 7" : "+v"(pA0), "+v"(pA1));
#pragma unroll
    for (int r = 0; r < 16; ++r) { pA0[r] = -INFINITY; if (r < 8) pA1[r] = -INFINITY; }
    START(pA0, pA1);
#pragma unroll
    for (int r = 0; r < 16; ++r) pA1[r] = __builtin_amdgcn_exp2f(pA1[r]);
    WAIT_BAR(0);
    DMA_KM(3, 0); DMA_VM(1, SLOTB);
    ROT();
#pragma unroll
    for (int jj = 0; jj < NK; ++jj) kload2(kf, kp0 + sl_cur, jj);
    WAIT_KV();
    s16x4 vlo[8], vhi[8]; u32x4 pw0, pw1, pw2, pw3;
#define PKW(P, B) cvtpk(P[B], P[B + 1])
#define PAF(k) __builtin_bit_cast(bf16x8, pw##k)
#define VFR(i) (bf16x8){vlo[i][0], vlo[i][1], vlo[i][2], vlo[i][3], vhi[i][0], vhi[i][1], vhi[i][2], vhi[i][3]}
#define PIN(x) asm volatile("" : "+v"(x))
#define MX3(a, b, c) __builtin_fmaxf(__builtin_fmaxf((a), (b)), (c))
#define MF(c_, a_, b_) __builtin_amdgcn_mfma_f32_32x32x16_bf16(a_, b_, c_, 0, 0, 0)
#define GAPA(MFX, A0, A1, A2, A3, W0, W1, PW) do { MFX; sacc += A0; sacc += A1; sacc += A2; sacc += A3; PIN(sacc); W0; W1; PIN(PW); SBAR(); } while (0)
#define EX(v) __builtin_amdgcn_exp2f(v)
#define GAPB(MFX, X, B) do { MFX; X[B] = EX(X[B]); X[B + 1] = EX(X[B + 1]); X[B + 2] = EX(X[B + 2]); X[B + 3] = EX(X[B + 3]); PIN(X); SBAR(); } while (0)
#define VRD(i) do { vlo[i] = vtr(vp_ + (((i) >> 2) * 4096 + ((i) & 3) * 1024)); vhi[i] = vtr(vp_ + (((i) >> 2) * 4096 + ((i) & 3) * 1024 + 512)); } while (0)
#define KRD(Gf, jj) do { if (Gf) { kload2(kf, kp0 + sl_next, jj); SBAR(); } } while (0)
#define XF (XFIRST && NK > 4)
#define STEP(C0, C1, P0, P1, t, GK, GV, GL) do { SBAR(); \
    const lds_cptr vp_ = vp0 + sl_prev; \
    if (XF) { C0 = MF(CIN, kf[8 % (2 * NK)], qr[4 % NK]); C1 = MF(CIN, kf[9 % (2 * NK)], qr[4 % NK]); \
        if (NK > 5) { C0 = MF(C0, kf[10 % (2 * NK)], qr[5 % NK]); C1 = MF(C1, kf[11 % (2 * NK)], qr[5 % NK]); } SBAR(); } \
    if (VLATE < 2) { VRD(0); SBAR(); } float sacc = (P0[0] + P0[1]); \
    GAPA(C0 = MF((XF ? C0 : CIN), kf[0], qr[0]), P0[2], P0[3], P0[4], P0[5],     pw0[0] = PKW(P0, 0), pw0[1] = PKW(P0, 2), pw0); \
    if (VLATE < 2) { VRD(4); SBAR(); } GAPA(C1 = MF((XF ? C1 : CIN), kf[1], qr[0]), P0[6], P0[7], P0[8], P0[9],     pw0[2] = PKW(P0, 4), pw0[3] = PKW(P0, 6), pw0); \
    if (VLATE < 2) { VRD(1); SBAR(); } GAPA(C0 = MF(C0, kf[2], qr[1]),   P0[10], P0[11], P0[12], P0[13], pw1[0] = PKW(P0, 8), pw1[1] = PKW(P0, 10), pw1); \
    if (VLATE < 2) { VRD(5); SBAR(); } GAPA(C1 = MF(C1, kf[3], qr[1]),   P0[14], P0[15], P1[0], P1[1],   pw1[2] = PKW(P0, 12), pw1[3] = PKW(P0, 14), pw1); \
    if (VLATE == 0) { VRD(2); SBAR(); } GAPA(C0 = MF(C0, kf[4], qr[2]),   P1[2], P1[3], P1[4], P1[5],     pw2[0] = PKW(P1, 0), pw2[1] = PKW(P1, 2), pw2); \
    if (VLATE == 0) { VRD(6); SBAR(); } GAPA(C1 = MF(C1, kf[5], qr[2]),   P1[6], P1[7], P1[8], P1[9],     pw2[2] = PKW(P1, 4), pw2[3] = PKW(P1, 6), pw2); \
    if (VLATE == 0) { VRD(3); SBAR(); } if (VLATE == 2) { VRD(0); SBAR(); } GAPA(C0 = MF(C0, kf[6], qr[3]),   P1[10], P1[11], P1[12], P1[13], pw3[0] = PKW(P1, 8), pw3[1] = PKW(P1, 10), pw3); \
    if (VLATE == 0) { VRD(7); SBAR(); } if (VLATE == 2) { VRD(4); SBAR(); } GAPA(C1 = MF(C1, kf[7], qr[3]),   P1[14], P1[15], 0.f, 0.f,       pw3[2] = PKW(P1, 12), pw3[3] = PKW(P1, 14), pw3); \
    if (NK > 4 && !XF) { C0 = MF(C0, kf[8 % (2 * NK)], qr[4 % NK]); C1 = MF(C1, kf[9 % (2 * NK)], qr[4 % NK]); SBAR(); } \
    if (NK > 5 && !XF) { C0 = MF(C0, kf[10 % (2 * NK)], qr[5 % NK]); C1 = MF(C1, kf[11 % (2 * NK)], qr[5 % NK]); SBAR(); } \
    l_reg += sacc; \
    if (NONEGM) { _Pragma("unroll") for (int r = 0; r < 16; ++r) { C0[r] -= mhat; C1[r] -= mhat; } } \
    if (GK) { DMA_KM((t) + 3, sl_cur); } if (GV) { DMA_VM((t) + 1, sl_next); } \
    CMASK(C0, C1, t); \
    { float a = MX3(C0[0], C0[1], C1[0]), b = MX3(C0[2], C0[3], C1[1]); a = MX3(a, C1[2], C1[3]); \
      _Pragma("unroll") for (int r = 4; r < 16; r += 4) { a = MX3(a, C0[r], C0[r + 1]); b = MX3(b, C0[r + 2], C0[r + 3]); a = MX3(a, C1[r], C1[r + 1]); b = MX3(b, C1[r + 2], C1[r + 3]); } \
      float rm = __builtin_fmaxf(a, b); { auto rr = __builtin_amdgcn_permlane32_swap(__float_as_uint(rm), __float_as_uint(rm), false, false); rm = __builtin_fmaxf(__uint_as_float(rr[0]), __uint_as_float(rr[1])); } \
      resc = false; \
      if (__builtin_expect(__any(rm > (float)THRL), 0)) { const float dl = __builtin_fmaxf(rm, 0.f); mhat += dl; \
        _Pragma("unroll") for (int r = 0; r < 16; ++r) { C0[r] -= dl; C1[r] -= dl; } \
        SETREF(); \
        const float f = __builtin_amdgcn_exp2f(-dl); l_reg *= f; if (hi == 0) wsf[r32] = f; resc = true; } } \
    SBAR(); \
    if (VLATE == 1) { VRD(2); SBAR(); } if (VLATE == 2) { VRD(1); SBAR(); } GAPB(o[0] = MF(o[0], PAF(0), VFR(0)), C0, 0); \
    if (VLATE == 1) { VRD(6); SBAR(); } if (VLATE == 2) { VRD(5); SBAR(); } GAPB(o[1] = MF(o[1], PAF(0), VFR(4)), C0, 4); \
    if (VLATE == 1) { VRD(3); SBAR(); } if (VLATE == 2) { VRD(2); SBAR(); } KRD(GL, 0); GAPB(o[0] = MF(o[0], PAF(1), VFR(1)), C0, 8); \
    if (VLATE == 1) { VRD(7); SBAR(); } if (VLATE == 2) { VRD(6); SBAR(); } KRD(GL, 1); GAPB(o[1] = MF(o[1], PAF(1), VFR(5)), C0, 12); \
    if (VLATE == 2) { VRD(3); SBAR(); } KRD(GL, 2); GAPB(o[0] = MF(o[0], PAF(2), VFR(2)), C1, 0); \
    if (VLATE == 2) { VRD(7); SBAR(); } KRD(GL, 3); GAPB(o[1] = MF(o[1], PAF(2), VFR(6)), C1, 4); \
    if (NK > 4) KRD(GL, 4 % NK); GAPB(o[0] = MF(o[0], PAF(3), VFR(3)), C1, 8); \
    if (NK > 5) KRD(GL, 5 % NK); GAPB(o[1] = MF(o[1], PAF(3), VFR(7)), C1, 12); \
    } while (0)
    int t = 1;
#undef CMASK
#define CMASK(P0, P1, t) do { } while (0)
    for (; t + 5 < NT; t += 2) {
        STEP(pB0, pB1, pA0, pA1, t, true, true, true);     WAIT_KV(); RESC(); ROT();
        STEP(pA0, pA1, pB0, pB1, t + 1, true, true, true); WAIT_KV(); RESC(); ROT();
    }
#undef CMASK
#define CMASK(P0, P1, t) do { int jb_ = (t) - (NT - 4); if (jb_ >= 0) cmask(P0, P1, jb_, qrel, hi); } while (0)
#define ENDW(tt) do { if ((tt) + 3 < NT) { WAIT_KV(); } else if ((tt) + 2 < NT) { WAIT_BAR(1); } else { WAIT_BAR(0); } } while (0)
    for (; t + 1 < NT; t += 2) {
        STEP(pB0, pB1, pA0, pA1, t, (t + 3 < NT), (t + 1 < NT), (t + 1 < NT));       ENDW(t);     RESC(); ROT();
        STEP(pA0, pA1, pB0, pB1, t + 1, (t + 4 < NT), (t + 2 < NT), (t + 2 < NT));   ENDW(t + 1); RESC(); ROT();
    }
    { float sacc = pA0[0] + pA0[1];
#pragma unroll
      for (int r = 2; r < 16; ++r) sacc += pA0[r];
#pragma unroll
      for (int r = 0; r < 16; ++r) sacc += pA1[r];
      l_reg += sacc;
      pw0 = (u32x4){PKW(pA0, 0), PKW(pA0, 2), PKW(pA0, 4), PKW(pA0, 6)}; pw1 = (u32x4){PKW(pA0, 8), PKW(pA0, 10), PKW(pA0, 12), PKW(pA0, 14)}; pw2 = (u32x4){PKW(pA1, 0), PKW(pA1, 2), PKW(pA1, 4), PKW(pA1, 6)}; pw3 = (u32x4){PKW(pA1, 8), PKW(pA1, 10), PKW(pA1, 12), PKW(pA1, 14)};
      SBAR(); pv(o, vb0 + sl_prev, PAF(0), PAF(1), PAF(2), PAF(3)); }
    { auto rr = __builtin_amdgcn_permlane32_swap(__float_as_uint(l_reg), __float_as_uint(l_reg), false, false); l_reg = __uint_as_float(rr[0]) + __uint_as_float(rr[1]); }
    if (hi == 0) wsf[32 + r32] = l_reg; asm volatile("s_waitcnt lgkmcnt(0)" ::: "memory");
    float rli[16];
#pragma unroll
    for (int r = 0; r < 16; ++r) rli[r] = __builtin_amdgcn_rcpf(wsf[32 + crow(r, hi)]);
    bf16* Ow = Ob + (size_t)(q0 + wid * 32) * OP;
    { bf16* stg = (bf16*)(shm + LDS_OST) + wid * 2048;
#pragma unroll
      for (int r = 0; r < 16; ++r) { const int orow = crow(r, hi);
#pragma unroll
          for (int d0 = 0; d0 < 2; ++d0) stg[orow * 64 + d0 * 32 + r32] = f2bf(o[d0][r] * rli[r]); }
      asm volatile("s_waitcnt lgkmcnt(0)" ::: "memory");
#pragma unroll
      for (int i = 0; i < 4; ++i) { const int row = i * 8 + (lane >> 3), ch = lane & 7; const u32x4 v = *(const u32x4*)(stg + row * 64 + ch * 8); *(u32x4*)(Ow + (size_t)row * OP + ch * 8) = v; } }
    asm volatile("s_waitcnt vmcnt(0) lgkmcnt(0)\n\ts_barrier" ::: "memory");
#undef SETREF
#undef CIN
#undef RFL
#undef DMA_KP
#undef DMA_K0
#undef DMA_KM
#undef DMA_V0
#undef DMA_VM
#undef WAIT_KV
#undef CMASK
#undef START
#undef RESC
#undef ROT
#undef PKW
#undef PAF
#undef VFR
#undef PIN
#undef MX3
#undef MF
#undef GAPA
#undef GAPB
#undef EX
#undef VRD
#undef KRD
#undef STEP
#undef XF
#undef ENDW
}
#undef SBAR
#undef WAIT_BAR
}
static_assert(fb::Geo<6>::LDS_BYTES <= 131072, "attention LDS");

#ifndef FB_THR
#define FB_THR 0
#endif
#ifndef USE_FB_A
#define USE_FB_A USE_FB
#endif
#ifndef USE_FB_B
#define USE_FB_B 1
#endif
#ifndef FBB_XFIRST
#define FBB_XFIRST true
#endif
#ifndef FBB_VLATE
#define FBB_VLATE 2
#endif
#ifndef FBB_NONEGM
#define FBB_NONEGM true
#endif
__device__ __forceinline__ void attn_main_mfma(const Ctx& c0, int layer) {
#define LAUNDER() Ctx c = c0; asm volatile("" : "+v"(c.tid)); c.lane = c.tid & 63; c.wave = __builtin_amdgcn_readfirstlane(c.tid >> 6);
    const int vcu = (c0.G % 8 == 0) ? (c0.bid % 8) * (c0.G / 8) + c0.bid / 8 : c0.bid;
    char* shm = (char*)(__attribute__((address_space(0))) char*)c0.lds; (void)shm;
#ifndef REP_B
#define REP_B 1
#endif
#ifndef REP_C
#define REP_C 1
#endif
#pragma nounroll
    for (int rep = 0; rep < REP_B; ++rep)
    { LAUNDER()
#pragma nounroll
    for (int uu = 2 * vcu; uu < 512; uu += 2 * c.G) {
#pragma nounroll
        for (int k = 0; k < 2; ++k) {
            const int u = uu >> 1, bh = u >> 3, s8 = u & 7, b = bh >> 3, h = bh & 7, j = k ? s8 : 15 - s8; const size_t r0 = (size_t)b * SEQ;
#if USE_FB_B
            fb::attn_unit<6, false, PQB, PKB, PVB, PY, FB_THR, FBB_XFIRST, FBB_VLATE, FBB_NONEGM>(WSP(bf16, WS_QB) + r0 * PQB + h * 96, WSP(bf16, WS_KB) + h * 96, WSP(bf16, WS_KB) + (FR + r0) * PKB + h * 96, WSP(bf16, WS_VB) + h * 64, WSP(bf16, WS_VB) + (FR + r0) * PVB + h * 64, WSP(bf16, WS_YB) + r0 * PY + h * 64, j, shm, c.tid);
#else
            const fa::Tensors TB{WSP(bf16, WS_QB) + r0 * PQB, PQB, h * 96, WSP(bf16, WS_KB), WSP(bf16, WS_KB) + (FR + r0) * PKB, PKB, h * 96, WSP(bf16, WS_VB), WSP(bf16, WS_VB) + (FR + r0) * PVB, PVB, h * 64, WSP(bf16, WS_YB) + r0 * PY, PY, h * 64};
            fa::attn_unit<6, 1>(c, TB, j, 0.f);
#endif
        }
    }
    }
#ifndef NO_AC
    { LAUNDER()
#pragma nounroll
    for (int uu = 2 * vcu; uu < 512; uu += 2 * c.G) {
#pragma nounroll
        for (int k = 0; k < 2; ++k) {
            const int u = uu >> 1, bh = u >> 3, s8 = u & 7, b = bh >> 3, h = bh & 7, j = k ? s8 : 15 - s8; const size_t r0 = (size_t)b * SEQ;
#if USE_FB_A
            fb::attn_unit<5, true, PQA, PKA, PVA, PQA, FB_THR>(WSP(bf16, WS_QA) + r0 * PQA + h * 64, WSP(bf16, WS_KA) + h * 80, WSP(bf16, WS_KA) + (FR + r0) * PKA + h * 80, WSP(bf16, WS_VA) + h * 64, WSP(bf16, WS_VA) + (FR + r0) * PVA + h * 64, WSP(bf16, WS_QA) + r0 * PQA + h * 64, j, shm, c.tid);
#else
            const fa::Tensors TA{WSP(bf16, WS_QA) + r0 * PQA, PQA, h * 64, WSP(bf16, WS_KA), WSP(bf16, WS_KA) + (FR + r0) * PKA, PKA, h * 80, WSP(bf16, WS_VA), WSP(bf16, WS_VA) + (FR + r0) * PVA, PVA, h * 64, WSP(bf16, WS_QA) + r0 * PQA, PQA, h * 64};
            fa::attn_unit<5, 0>(c, TA, j, 0.f);
#endif
        }
    }
    }
    { LAUNDER()
#pragma nounroll
    for (int uu = 2 * vcu; uu < 512; uu += 2 * c.G) {
#pragma nounroll
        for (int k = 0; k < 2; ++k) {
            const int u = uu >> 1, bh = u >> 3, s8 = u & 7, b = bh >> 3, h = bh & 7, j = k ? s8 : 15 - s8; const size_t r0 = (size_t)b * SEQ;
            const fa::Tensors TC{WSP(bf16, WS_QC) + r0 * PQC, PQC, h * 64, WSP(bf16, WS_KC), WSP(bf16, WS_KC) + (FR + r0) * PKC, PKC, (h >> 2) * 64, WSP(bf16, WS_VC), WSP(bf16, WS_VC) + (FR + r0) * PVC, PVC, (h >> 2) * 64, WSP(bf16, WS_QC) + r0 * PQC, PQC, h * 64};
            fa::attn_unit<4, 2>(c, TC, j, c.sinks[layer * 8 + h] * LOG2E);
        }
    }
    }
#endif
#undef LAUNDER
}

__device__ __forceinline__ void attn_meta(const Ctx& c) {
    if (c.tid >= 384) return;
    const int br = c.tid / 128, h = (c.tid >> 4) & 7, r = c.tid & 15; bf16* ym = WSP(bf16, WS_YM) + (size_t)r * 1536 + br * 512 + h * 64;
    if (br == 0) attn_row<64, 0>(WSP(bf16, WS_QAM) + r * PQA + h * 64, WSP(bf16, WS_KA), WSP(bf16, WS_KA), PKA, h * 80, WSP(bf16, WS_VA), WSP(bf16, WS_VA), PVA, h * 64, r, 0.f, ym);
    else if (br == 1) attn_row<96, 1>(WSP(bf16, WS_QBM) + r * PQB + h * 96, WSP(bf16, WS_KB), WSP(bf16, WS_KB), PKB, h * 96, WSP(bf16, WS_VB), WSP(bf16, WS_VB), PVB, h * 64, r, 0.f, ym);
    else attn_row<64, 2>(WSP(bf16, WS_QCM) + r * PQC + h * 64, WSP(bf16, WS_KC), WSP(bf16, WS_KC), PKC, (h >> 2) * 64, WSP(bf16, WS_VC), WSP(bf16, WS_VC), PVC, (h >> 2) * 64, r, c.sinks[h] * LOG2E, ym);
}

struct Unit { int pm, pn, z; };
__device__ __forceinline__ int perm32(int rho) { const int n = rho >> 4, i = rho & 15; return 8 * (i >> 2) + 4 * n + (i & 3); }
template <class Prob, class Epi, class Sched>
__device__ __forceinline__ void gemm_naive(const Ctx& c, const Prob& P, const Sched& S, const Epi& E) {
    const int wr = c.wave >> 2, wc = c.wave & 3, fr = c.lane & 15, fq = c.lane >> 4;
    Unit u;
    for (int ui = 0; S.next(ui, u); ++ui) {
        const bf16* A; const bf16* Bt; P.operands(u, A, Bt);
        const int K = P.K, lda = P.K;
        f32x4 acc[2][2][4][2];
#pragma unroll
        for (int a = 0; a < 2; ++a)
#pragma unroll
            for (int b = 0; b < 2; ++b)
#pragma unroll
                for (int m = 0; m < 4; ++m)
#pragma unroll
                    for (int n = 0; n < 2; ++n) acc[a][b][m][n] = (f32x4){0.f, 0.f, 0.f, 0.f};
        for (int k0 = 0; k0 < K; k0 += 64) {
#pragma unroll
            for (int ai = 0; ai < 2; ++ai) {
#pragma unroll
                for (int bj = 0; bj < 2; ++bj) {
                    bf16x8 Bf[2][2];
#pragma unroll
                    for (int n = 0; n < 2; ++n)
#pragma unroll
                        for (int k = 0; k < 2; ++k) Bf[n][k] = *(const bf16x8*)(Bt + (size_t)(256 * u.pn + 128 * bj + 32 * wc + perm32(16 * n + fr)) * K + k0 + 32 * k + 8 * fq);
#pragma unroll
                    for (int m = 0; m < 4; ++m) {
                        bf16x8 At[2];
#pragma unroll
                        for (int k = 0; k < 2; ++k) At[k] = *(const bf16x8*)(A + (size_t)(256 * u.pm + 128 * ai + 64 * wr + 16 * m + fr) * lda + k0 + 32 * k + 8 * fq);
#pragma unroll
                        for (int n = 0; n < 2; ++n)
#pragma unroll
                            for (int k = 0; k < 2; ++k) acc[ai][bj][m][n] = __builtin_amdgcn_mfma_f32_16x16x32_bf16(Bf[n][k], At[k], acc[ai][bj][m][n], 0, 0, 0);
                    }
                }
            }
        }
        asm volatile("" ::: "memory");
        E(acc, u, wr, wc, fr, fq);
    }
}
struct ProbSimple { const bf16* A; const bf16* Bt; int K;
    __device__ __forceinline__ void operands(const Unit&, const bf16*& a, const bf16*& b) const { a = A; b = Bt; } };
struct ProbBranch { const bf16 *A0, *A1, *A2; const bf16* Bt; int K;
    __device__ __forceinline__ void operands(const Unit& u, const bf16*& a, const bf16*& b) const { a = (u.z == 0) ? A0 : (u.z == 1) ? A1 : A2; b = Bt + (size_t)u.z * DM * 512; } };

namespace pg8 {
constexpr int BM = 256, BK = 64, HALF = 128, HTB = HALF * BK * 2, STAGE_BYTES = 8 * HTB, NXCD = 8, WGM = 8;
__host__ __device__ __forceinline__ int lds_byte(int r, int c) { const int st = (r >> 4) * 2 + (c >> 5), rr = r & 15, cc = c & 31, ob = rr * 64 + cc * 2; return st * 1024 + (ob ^ (((ob >> 9) & 1) << 5)); }
__host__ __device__ __forceinline__ void stage_rc(int b, int& R, int& C) { const int st = b / 1024, sb = b % 1024, swz = sb ^ (((sb >> 9) & 1) << 5); R = (st >> 1) * 16 + swz / 64; C = (st & 1) * 32 + (swz % 64) / 2; }
template <int ZN>
struct StaticOrder {
    int nM, nN, nwg, G, c, pn0;
    __device__ __forceinline__ void init(int nM_, int nN_, int pn0_, int G_, int c_) { nM = nM_; nN = nN_; nwg = nM * nN; G = G_; c = c_; pn0 = pn0_; }
    __device__ __forceinline__ bool next(int i, Unit& u) const {
        const int it = i / ZN;
        const long L = (long)it * G + c; if (L >= nwg) return false;
        int wgid = (int)L; { const int q = nwg / NXCD, r = nwg % NXCD, xcd = wgid % NXCD, off = wgid / NXCD; wgid = (xcd < r ? xcd * (q + 1) : r * (q + 1) + (xcd - r) * q) + off; }
        const int nig = WGM * nN, gid = wgid / nig, fm = gid * WGM, gsz = (nM - fm) < WGM ? (nM - fm) : WGM;
        u.pm = fm + ((wgid % nig) % gsz); u.pn = pn0 + (wgid % nig) / gsz; u.z = i - it * ZN; return true;
    }
};
template <class Prob, class Epi, class Sched, bool ALIGN_EPI, bool SP2>
__device__ __forceinline__ void gemm_phase(LAS unsigned char* lds, const Prob& P, const Sched& S, const Epi& E) {
    const int tid = threadIdx.x, wid = __builtin_amdgcn_readfirstlane(tid >> 6), lane = tid & 63, wr = wid >> 2, wc = wid & 3, fr = lane & 15, fq = lane >> 4;
    const int K = P.K, nt = K / BK;
    unsigned voffA[2], voffB[2];
#pragma unroll
    for (int i = 0; i < 2; ++i) { int R, C; stage_rc(tid * 16 + i * 8192, R, C); const int Rb = (R & ~31) + perm32(R & 31);
        voffA[i] = (unsigned)(R * K + C) * 2u; voffB[i] = (unsigned)(Rb * K + C) * 2u; }
    const size_t kstep = (size_t)(BK * 2);
    const size_t hstep = (size_t)HALF * K * 2;
    const size_t tstep = 2 * hstep;
    const unsigned ldsw = (unsigned)wid * 1024u;
    const int aoff = lds_byte(wr * 64 + fr, fq * 8), boff = lds_byte(wc * 32 + fr, fq * 8);
#define PG8_SA(b, h) (((b) * 2 + (h)) * HTB)
#define PG8_SB(b, h) ((4 + (b) * 2 + (h)) * HTB)
#define PG8_STAGE(bufoff, gbase, voff) do { _Pragma("unroll") for (int _i = 0; _i < 2; ++_i) \
        __builtin_amdgcn_global_load_lds((const unsigned*)((const char*)(gbase) + (voff)[_i]), (LAS unsigned*)(lds + (bufoff) + ldsw + _i * 8192), 16, 0, 0); } while (0)
#define PG8_LDA(dst, b, h) do { _Pragma("unroll") for (int m = 0; m < 4; ++m) _Pragma("unroll") for (int k = 0; k < 2; ++k) dst[m][k] = *(const LAS bf16x8*)(lds + PG8_SA(b, h) + aoff + m * 2048 + k * 1024); } while (0)
#define PG8_LDB(dst, b, h) do { _Pragma("unroll") for (int n = 0; n < 2; ++n) _Pragma("unroll") for (int k = 0; k < 2; ++k) dst[n][k] = *(const LAS bf16x8*)(lds + PG8_SB(b, h) + boff + n * 2048 + k * 1024); } while (0)
#define PG8_MMA(ai, bj, At, Bt) do { __builtin_amdgcn_s_setprio(1); _Pragma("unroll") for (int m = 0; m < 4; ++m) _Pragma("unroll") for (int n = 0; n < 2; ++n) _Pragma("unroll") for (int k = 0; k < 2; ++k) \
        acc[ai][bj][m][n] = __builtin_amdgcn_mfma_f32_16x16x32_bf16(Bt[n][k], At[m][k], acc[ai][bj][m][n], 0, 0, 0); __builtin_amdgcn_s_setprio(0); } while (0)
#define PG8_WAIT_V(n) asm volatile("s_waitcnt vmcnt(" #n ")" ::: "memory")
#define PG8_WAIT_L(n) asm volatile("s_waitcnt lgkmcnt(" #n ")" ::: "memory")
#define PG8_BAR __builtin_amdgcn_s_barrier()
#define PG8_SCHED __builtin_amdgcn_sched_barrier(0)
    Unit cur, nxt; int ui = 0;
    if (!S.next(0, cur)) return;
    f32x4 acc[2][2][4][2];
#pragma unroll
    for (int a = 0; a < 2; ++a)
#pragma unroll
        for (int b = 0; b < 2; ++b)
#pragma unroll
            for (int m = 0; m < 4; ++m)
#pragma unroll
                for (int n = 0; n < 2; ++n) acc[a][b][m][n] = (f32x4){0.f, 0.f, 0.f, 0.f};
    bf16x8 At[4][2], B0[2][2], B1[2][2];
    const char* cA; const char* cB;
    { const bf16 *pa, *pb; P.operands(cur, pa, pb); cA = (const char*)pa + (size_t)cur.pm * tstep; cB = (const char*)pb + (size_t)cur.pn * tstep; }
    if constexpr (SP2) {
        PG8_STAGE(PG8_SB(0, 0), cB, voffB); PG8_STAGE(PG8_SB(0, 1), cB + hstep, voffB); PG8_STAGE(PG8_SA(0, 0), cA, voffA); PG8_STAGE(PG8_SA(0, 1), cA + hstep, voffA);
        if (wr == 1) PG8_BAR;
        PG8_WAIT_V(2); PG8_BAR;
        PG8_STAGE(PG8_SB(1, 0), cB + kstep, voffB); PG8_STAGE(PG8_SA(1, 0), cA + kstep, voffA); PG8_STAGE(PG8_SB(1, 1), cB + hstep + kstep, voffB);
        PG8_WAIT_V(6); PG8_BAR;
    } else {
        PG8_STAGE(PG8_SB(0, 0), cB, voffB); PG8_STAGE(PG8_SA(0, 0), cA, voffA); PG8_STAGE(PG8_SB(0, 1), cB + hstep, voffB); PG8_STAGE(PG8_SA(0, 1), cA + hstep, voffA);
        if (wr == 1) PG8_BAR;
        PG8_WAIT_V(4); PG8_BAR;
        PG8_STAGE(PG8_SB(1, 0), cB + kstep, voffB); PG8_STAGE(PG8_SA(1, 0), cA + kstep, voffA); PG8_STAGE(PG8_SB(1, 1), cB + hstep + kstep, voffB);
        PG8_WAIT_V(6); PG8_BAR;
    }
    for (;;) {
        const bool has_next = S.next(ui + 1, nxt);
        const char* nA = cA; const char* nB = cB;
        if (has_next) { const bf16 *pa, *pb; P.operands(nxt, pa, pb); nA = (const char*)pa + (size_t)nxt.pm * tstep; nB = (const char*)pb + (size_t)nxt.pn * tstep; }
        for (int t = 0; t < nt; t += 2) {
            const bool last = (t == nt - 2);
            const char* a1 = cA + (size_t)(t + 1) * kstep;
            const char* a2 = last ? nA : cA + (size_t)(t + 2) * kstep; const char* b2 = last ? nB : cB + (size_t)(t + 2) * kstep;
            const char* a3 = a2 + kstep; const char* b3 = b2 + kstep;
            if constexpr (SP2) {
            PG8_LDB(B0, 0, 0); PG8_LDB(B1, 0, 1); PG8_SCHED; PG8_LDA(At, 0, 0); PG8_STAGE(PG8_SA(1, 1), a1 + hstep, voffA);
            PG8_WAIT_V(8); PG8_WAIT_L(0); PG8_BAR; PG8_MMA(0, 0, At, B0); PG8_MMA(0, 1, At, B1); PG8_BAR; PG8_SCHED;
            PG8_LDA(At, 0, 1); PG8_STAGE(PG8_SB(0, 0), b2, voffB); PG8_STAGE(PG8_SB(0, 1), b2 + hstep, voffB); PG8_STAGE(PG8_SA(0, 0), a2, voffA);
            PG8_WAIT_V(8); PG8_WAIT_L(0); PG8_BAR; PG8_MMA(1, 0, At, B0); PG8_MMA(1, 1, At, B1); PG8_BAR; PG8_SCHED;
            PG8_LDB(B0, 1, 0); PG8_LDB(B1, 1, 1); PG8_SCHED; PG8_LDA(At, 1, 0); PG8_STAGE(PG8_SA(0, 1), a2 + hstep, voffA);
            PG8_WAIT_V(8); PG8_WAIT_L(0); PG8_BAR; PG8_MMA(0, 0, At, B0); PG8_MMA(0, 1, At, B1); PG8_BAR; PG8_SCHED;
            PG8_LDA(At, 1, 1); PG8_STAGE(PG8_SB(1, 0), b3, voffB); PG8_STAGE(PG8_SB(1, 1), b3 + hstep, voffB); PG8_STAGE(PG8_SA(1, 0), a3, voffA);
            PG8_WAIT_V(8); PG8_WAIT_L(0); PG8_BAR; PG8_MMA(1, 0, At, B0); PG8_MMA(1, 1, At, B1); PG8_BAR; PG8_SCHED;
            } else {
            PG8_LDB(B0, 0, 0); PG8_SCHED; PG8_LDA(At, 0, 0); PG8_STAGE(PG8_SA(1, 1), a1 + hstep, voffA);
            PG8_WAIT_L(8); PG8_BAR; PG8_WAIT_L(0); PG8_MMA(0, 0, At, B0); PG8_BAR; PG8_SCHED;
            PG8_LDB(B1, 0, 1); PG8_STAGE(PG8_SB(0, 0), b2, voffB);
            PG8_BAR; PG8_WAIT_L(0); PG8_MMA(0, 1, At, B1); PG8_BAR;
            PG8_LDA(At, 0, 1); PG8_STAGE(PG8_SA(0, 0), a2, voffA);
            PG8_BAR; PG8_WAIT_L(0); PG8_MMA(1, 0, At, B0); PG8_BAR; PG8_SCHED;
            PG8_STAGE(PG8_SB(0, 1), b2 + hstep, voffB);
            PG8_WAIT_V(6); PG8_BAR; PG8_MMA(1, 1, At, B1); PG8_BAR;
            PG8_LDB(B0, 1, 0); PG8_SCHED; PG8_LDA(At, 1, 0); PG8_STAGE(PG8_SA(0, 1), a2 + hstep, voffA);
            PG8_WAIT_L(8); PG8_BAR; PG8_WAIT_L(0); PG8_MMA(0, 0, At, B0); PG8_BAR; PG8_SCHED;
            PG8_LDB(B1, 1, 1); PG8_STAGE(PG8_SB(1, 0), b3, voffB);
            PG8_BAR; PG8_WAIT_L(0); PG8_MMA(0, 1, At, B1); PG8_BAR;
            PG8_LDA(At, 1, 1); PG8_STAGE(PG8_SA(1, 0), a3, voffA);
            PG8_BAR; PG8_WAIT_L(0); PG8_MMA(1, 0, At, B0); PG8_BAR; PG8_SCHED;
            PG8_STAGE(PG8_SB(1, 1), b3 + hstep, voffB);
            PG8_WAIT_V(6); PG8_BAR; PG8_MMA(1, 1, At, B1); PG8_BAR;
            }
        }
        if constexpr (ALIGN_EPI) { if (wr == 0) PG8_BAR; }
        E(acc, cur, wr, wc, fr, fq);
        if (!has_next) break;
#pragma unroll
        for (int a = 0; a < 2; ++a)
#pragma unroll
            for (int b = 0; b < 2; ++b)
#pragma unroll
                for (int m = 0; m < 4; ++m)
#pragma unroll
                    for (int n = 0; n < 2; ++n) acc[a][b][m][n] = (f32x4){0.f, 0.f, 0.f, 0.f};
        cur = nxt; cA = nA; cB = nB; ++ui;
        if constexpr (ALIGN_EPI) { if (wr == 1) PG8_BAR; }
    }
    PG8_WAIT_V(0);
    if constexpr (!ALIGN_EPI) { if (wr == 0) PG8_BAR; }
    PG8_BAR;
#undef PG8_SA
#undef PG8_SB
#undef PG8_STAGE
#undef PG8_LDA
#undef PG8_LDB
#undef PG8_MMA
#undef PG8_WAIT_V
#undef PG8_WAIT_L
#undef PG8_BAR
#undef PG8_SCHED
}
}
#ifndef USE_PG8
#define USE_PG8 1
#endif
template <int ZN, class Prob, class Epi>
__device__ __forceinline__ void gemm_run(const Ctx& c, const Prob& P, const Epi& E, int nM, int nN, int pn0) {
#if USE_PG8
    pg8::StaticOrder<ZN> S; S.init(nM, nN, pn0, c.G, c.bid);
    pg8::gemm_phase<Prob, Epi, pg8::StaticOrder<ZN>, true, true>(c.lds, P, S, E);
#else
    pg8::StaticOrder<ZN> S; S.init(nM, nN, pn0, c.G, c.bid);
    gemm_naive(c, P, S, E);
#endif
}

#define EPI_ROWS_BEGIN _Pragma("unroll") for (int ai = 0; ai < 2; ++ai) _Pragma("unroll") for (int m = 0; m < 4; ++m) { const int row = 256 * u.pm + 128 * ai + 64 * wr + 16 * m + fr; \
    const f32x4 l0 = acc[ai][0][m][0], l1 = acc[ai][0][m][1], h0 = acc[ai][1][m][0], h1 = acc[ai][1][m][1]; (void)l0; (void)l1; (void)h0; (void)h1;
#define EPI_ROWS_END if (m == 3) asm volatile("" ::: "memory"); }
typedef f32x4 Acc_t[2][2][4][2];

__device__ __forceinline__ void rope8(const float* cs, const float* sn, f32x4 x1a, f32x4 x1b, f32x4 x2a, f32x4 x2b, float sc, f32x4& o1a, f32x4& o1b, f32x4& o2a, f32x4& o2b) {
    const f32x4 ca = *(const f32x4*)cs, cb = *(const f32x4*)(cs + 4), sa = *(const f32x4*)sn, sb = *(const f32x4*)(sn + 4);
    o1a = (x1a * ca - x2a * sa) * sc; o1b = (x1b * cb - x2b * sb) * sc; o2a = (x2a * ca + x1a * sa) * sc; o2b = (x2b * cb + x1b * sb) * sc;
}
struct EpiEarly {
    const Ctx& c; int layer;
    __device__ __forceinline__ void operator()(const Acc_t& acc, const Unit& u, int wr, int wc, int fr, int fq) const {
        const int c8 = 32 * wc + 8 * fq, t = u.pn;
        bf16 *QA = WSP(bf16, WS_QA), *KA = WSP(bf16, WS_KA) + (size_t)FR * PKA, *VA = WSP(bf16, WS_VA) + (size_t)FR * PVA, *QC = WSP(bf16, WS_QC), *KC = WSP(bf16, WS_KC) + (size_t)FR * PKC,
             *VC = WSP(bf16, WS_VC) + (size_t)FR * PVC, *CQ = WSP(bf16, WS_CQ), *CKV = WSP(bf16, WS_CKV), *KB = WSP(bf16, WS_KB) + (size_t)FR * PKB;
        const float *cos64 = WSP(float, WS_COS64), *sin64 = WSP(float, WS_SIN64), *cos32 = WSP(float, WS_COS32), *sin32 = WSP(float, WS_SIN32);
        if (t < 2) { EPI_ROWS_BEGIN st8(QA + (size_t)row * PQA + 256 * t + c8, l0 * C2A, l1 * C2A); st8(QA + (size_t)row * PQA + 256 * t + 128 + c8, h0 * C2A, h1 * C2A); EPI_ROWS_END }
        else if (t < 4) { const int L0 = 256 * (t - 2) + c8, L1 = L0 + 128;
            EPI_ROWS_BEGIN st8(KA + (size_t)row * PKA + (L0 >> 6) * 80 + (L0 & 63), l0, l1); st8(KA + (size_t)row * PKA + (L1 >> 6) * 80 + (L1 & 63), h0, h1); EPI_ROWS_END }
        else if (t < 6) { EPI_ROWS_BEGIN st8(VA + (size_t)row * PVA + 256 * (t - 4) + c8, l0, l1); st8(VA + (size_t)row * PVA + 256 * (t - 4) + 128 + c8, h0, h1); EPI_ROWS_END }
        else if (t < 8) { const int head = 4 * (t - 6) + wc, d = 8 * fq;
            EPI_ROWS_BEGIN const int pos = NMETA + (row & (SEQ - 1)); f32x4 o1a, o1b, o2a, o2b; rope8(cos64 + pos * 32 + d, sin64 + pos * 32 + d, l0, l1, h0, h1, C2C, o1a, o1b, o2a, o2b);
                st8(QC + (size_t)row * PQC + head * 64 + d, o1a, o1b); st8(QC + (size_t)row * PQC + head * 64 + 32 + d, o2a, o2b); EPI_ROWS_END }
        else if (t == 8) {
            if (wc < 2) { const int d = 8 * fq;
                EPI_ROWS_BEGIN const int pos = NMETA + (row & (SEQ - 1)); f32x4 o1a, o1b, o2a, o2b; rope8(cos64 + pos * 32 + d, sin64 + pos * 32 + d, l0, l1, h0, h1, 1.f, o1a, o1b, o2a, o2b);
                    st8(KC + (size_t)row * PKC + wc * 64 + d, o1a, o1b); st8(KC + (size_t)row * PKC + wc * 64 + 32 + d, o2a, o2b); EPI_ROWS_END }
            else { const int j = 32 * (wc - 2) + 8 * fq;
                EPI_ROWS_BEGIN st8(VC + (size_t)row * PVC + j, l0, l1); st8(VC + (size_t)row * PVC + 64 + j, h0, h1); EPI_ROWS_END } }
        else if (t == 9) { EPI_ROWS_BEGIN st8(CQ + (size_t)row * PCQ + c8, l0, l1); st8(CQ + (size_t)row * PCQ + 128 + c8, h0, h1); EPI_ROWS_END }
        else if (t == 10) {
            if (wc < 2) { EPI_ROWS_BEGIN st8(CQ + (size_t)row * PCQ + 256 + c8, l0, l1); st8(CQ + (size_t)row * PCQ + 256 + 64 + c8, h0, h1); EPI_ROWS_END }
            else if (wc == 2) {
                if (fq < 2) { const int d = 8 * fq;
                    EPI_ROWS_BEGIN const int pos = NMETA + (row & (SEQ - 1)); f32x4 o1a, o1b, o2a, o2b; rope8(cos32 + pos * 16 + d, sin32 + pos * 16 + d, l0, l1, h0, h1, 1.f, o1a, o1b, o2a, o2b);
                        const u32x4 w1 = pack8(o1a, o1b), w2 = pack8(o2a, o2b);
#pragma unroll
                        for (int h = 0; h < 8; ++h) { *(u32x4*)(KB + (size_t)row * PKB + h * 96 + 64 + d) = w1; *(u32x4*)(KB + (size_t)row * PKB + h * 96 + 80 + d) = w2; } EPI_ROWS_END }
                else if (fq == 2) { float* LF = WSP(float, WS_LF); const f32x4 b0 = *(const f32x4*)(c.b_f + layer * 8), b1 = *(const f32x4*)(c.b_f + layer * 8 + 4);
                    EPI_ROWS_BEGIN f32x4 a = l0 + b0, b = l1 + b1;
#pragma unroll
                        for (int j = 0; j < 4; ++j) { a[j] = logsigf_(a[j]); b[j] = logsigf_(b[j]); }
                        *(f32x4*)(LF + (size_t)row * 8) = a; *(f32x4*)(LF + (size_t)row * 8 + 4) = b; EPI_ROWS_END } } }
        else { EPI_ROWS_BEGIN st8(CKV + (size_t)row * PCKV + c8, l0, l1); st8(CKV + (size_t)row * PCKV + 128 + c8, h0, h1); EPI_ROWS_END }
    }
};
struct EpiUq {
    const Ctx& c;
    __device__ __forceinline__ void operator()(const Acc_t& acc, const Unit& u, int wr, int wc, int fr, int fq) const {
        bf16* QB = WSP(bf16, WS_QB); const float* RQ = WSP(float, WS_RQ); const float *cos32 = WSP(float, WS_COS32), *sin32 = WSP(float, WS_SIN32);
        const int c8 = 32 * wc + 8 * fq;
        if (u.pn < 2) { const int ha = 4 * u.pn + (c8 >> 6), hb = ha + 2, e = c8 & 63;
            EPI_ROWS_BEGIN const float sc = RQ[row] * C2B; st8(QB + (size_t)row * PQB + ha * 96 + e, l0 * sc, l1 * sc); st8(QB + (size_t)row * PQB + hb * 96 + e, h0 * sc, h1 * sc); EPI_ROWS_END }
        else { const int h = c8 >> 4, d = c8 & 15;
            EPI_ROWS_BEGIN const float sc = RQ[row] * C2B; const int pos = NMETA + (row & (SEQ - 1)); f32x4 o1a, o1b, o2a, o2b; rope8(cos32 + pos * 16 + d, sin32 + pos * 16 + d, l0, l1, h0, h1, sc, o1a, o1b, o2a, o2b);
                st8(QB + (size_t)row * PQB + h * 96 + 64 + d, o1a, o1b); st8(QB + (size_t)row * PQB + h * 96 + 80 + d, o2a, o2b); EPI_ROWS_END }
    }
};
struct EpiUkv {
    const Ctx& c;
    __device__ __forceinline__ void operator()(const Acc_t& acc, const Unit& u, int wr, int wc, int fr, int fq) const {
        bf16 *KB = WSP(bf16, WS_KB) + (size_t)FR * PKB, *VB = WSP(bf16, WS_VB) + (size_t)FR * PVB; const float* RKV = WSP(float, WS_RKV);
        const int c8 = 32 * wc + 8 * fq, ha = 2 * u.pn, hb = ha + 1;
        if (wc < 2) { EPI_ROWS_BEGIN const float sc = RKV[row]; st8(KB + (size_t)row * PKB + ha * 96 + c8, l0 * sc, l1 * sc); st8(KB + (size_t)row * PKB + hb * 96 + c8, h0 * sc, h1 * sc); EPI_ROWS_END }
        else { EPI_ROWS_BEGIN const float sc = RKV[row]; st8(VB + (size_t)row * PVB + ha * 64 + c8 - 64, l0 * sc, l1 * sc); st8(VB + (size_t)row * PVB + hb * 64 + c8 - 64, h0 * sc, h1 * sc); EPI_ROWS_END }
    }
};
struct EpiLateZ {
    const Ctx& c;
    __device__ __forceinline__ void operator()(const Acc_t& acc, const Unit& u, int wr, int wc, int fr, int fq) const {
        const int c8 = 32 * wc + 8 * fq, t = u.pn;
        bf16* Y = (t < 2) ? WSP(bf16, WS_QA) : (t < 4) ? WSP(bf16, WS_YB) : WSP(bf16, WS_QC); const int col = 256 * (t & 1) + c8;
        EPI_ROWS_BEGIN
            { bf16* p = Y + (size_t)row * PY + col; f32x4 ya, yb; ld8(p, ya, yb);
#pragma unroll
              for (int j = 0; j < 4; ++j) { ya[j] *= siluf_(l0[j]); yb[j] *= siluf_(l1[j]); }
              st8(p, ya, yb); }
            { bf16* p = Y + (size_t)row * PY + col + 128; f32x4 ya, yb; ld8(p, ya, yb);
#pragma unroll
              for (int j = 0; j < 4; ++j) { ya[j] *= siluf_(h0[j]); yb[j] *= siluf_(h1[j]); }
              st8(p, ya, yb); }
        EPI_ROWS_END
    }
};
struct EpiLateG {
    const Ctx& c;
    __device__ __forceinline__ void operator()(const Acc_t& acc, const Unit& u, int wr, int wc, int fr, int fq) const {
        bf16* Gp = WSP(bf16, WS_G); const int col = 256 * (u.pn - 6) + 32 * wc + 8 * fq;
        EPI_ROWS_BEGIN f32x4 a = l0, b = l1, cc = h0, d = h1;
#pragma unroll
            for (int j = 0; j < 4; ++j) { a[j] = sigmoidf_(a[j]); b[j] = sigmoidf_(b[j]); cc[j] = sigmoidf_(cc[j]); d[j] = sigmoidf_(d[j]); }
            st8(Gp + (size_t)row * PG + col, a, b); st8(Gp + (size_t)row * PG + col + 128, cc, d); EPI_ROWS_END
    }
};
struct EpiBranch {
    const Ctx& c;
    __device__ __forceinline__ void operator()(const Acc_t& acc, const Unit& u, int wr, int wc, int fr, int fq) const {
        const bf16* Gp = WSP(bf16, WS_G); bf16* MG = WSP(bf16, WS_HN); const int col = 256 * u.pn + 32 * wc + 8 * fq;
        EPI_ROWS_BEGIN
#pragma unroll
            for (int bj = 0; bj < 2; ++bj) { f32x4 ga, gb; ld8(Gp + (size_t)row * PG + u.z * DM + col + 128 * bj, ga, gb); f32x4 va = (bj ? h0 : l0) * ga, vb = (bj ? h1 : l1) * gb;
                bf16* p = MG + (size_t)row * DM + col + 128 * bj; if (u.z > 0) { f32x4 pa, pb; ld8(p, pa, pb); va += pa; vb += pb; } st8(p, va, vb); } EPI_ROWS_END
    }
};
struct EpiOut {
    const float* resid; float* out;
    __device__ __forceinline__ void operator()(const Acc_t& acc, const Unit& u, int wr, int wc, int fr, int fq) const {
        const int col = 256 * u.pn + 32 * wc + 8 * fq;
        EPI_ROWS_BEGIN const size_t off = (size_t)row * DM + col;
            const f32x4 r0 = *(const f32x4*)(resid + off), r1 = *(const f32x4*)(resid + off + 4), r2 = *(const f32x4*)(resid + off + 128), r3 = *(const f32x4*)(resid + off + 132);
            *(f32x4*)(out + off) = r0 + l0; *(f32x4*)(out + off + 4) = r1 + l1; *(f32x4*)(out + off + 128) = r2 + h0; *(f32x4*)(out + off + 132) = r3 + h1; EPI_ROWS_END
    }
};

__device__ __forceinline__ void stats_cumsum(const Ctx& c) {
    const int gw = c.bid * NWAVES + c.wave, NGW = c.G * NWAVES;
    for (int m = gw; m < M; m += NGW) {
        float sq = 0.f, sk = 0.f;
        if (c.lane < 48) { f32x4 a, b; ld8(WSP(bf16, WS_CQ) + (size_t)m * PCQ + 8 * c.lane, a, b); sq = (a[0] * a[0] + a[1] * a[1]) + (a[2] * a[2] + a[3] * a[3]) + (b[0] * b[0] + b[1] * b[1]) + (b[2] * b[2] + b[3] * b[3]); }
        if (c.lane < 32) { f32x4 a, b; ld8(WSP(bf16, WS_CKV) + (size_t)m * PCKV + 8 * c.lane, a, b); sk = (a[0] * a[0] + a[1] * a[1]) + (a[2] * a[2] + a[3] * a[3]) + (b[0] * b[0] + b[1] * b[1]) + (b[2] * b[2] + b[3] * b[3]); }
        sq = wave_sum(sq); sk = wave_sum(sk);
        if (c.lane == 0) { WSP(float, WS_RQ)[m] = 1.f / sqrtf(sq * (1.f / 384.f) + EPS); WSP(float, WS_RKV)[m] = 1.f / sqrtf(sk * (1.f / 256.f) + EPS); }
    }
    LAS double* wsum = (LAS double*)(c.lds);
    for (int task = c.bid; task < NBATCH * 8; task += c.G) {
        const int b = task >> 3, h = task & 7; const float* LF = WSP(float, WS_LF) + (size_t)b * SEQ * 8 + h;
        double v[8]; double s = 0.0;
#pragma unroll
        for (int j = 0; j < 8; ++j) { s += (double)LF[(size_t)(8 * c.tid + j) * 8]; v[j] = s; }
        double inc = s;
#pragma unroll
        for (int o = 1; o < 64; o <<= 1) { const double n = __shfl_up(inc, o); if (c.lane >= o) inc += n; }
        __syncthreads();
        if (c.lane == 63) wsum[c.wave] = inc;
        __syncthreads();
        double base = inc - s;
        for (int w = 0; w < c.wave; ++w) base += wsum[w];
        bf16* KA = WSP(bf16, WS_KA) + (size_t)(FR + b * SEQ) * PKA + h * 80 + 64;
#pragma unroll
        for (int j = 0; j < 8; ++j) { const float bias = (float)(-(base + v[j]) * 1.4426950408889634); bf16 bh, bm, bl; split3(bias, bh, bm, bl);
            u32x4 w0 = {(unsigned)bh | ((unsigned)bm << 16), (unsigned)bl | 0x3F800000u, 0x3F803F80u, 0u}, w1 = {0u, 0u, 0u, 0u};   bf16* kp = KA + (size_t)(8 * c.tid + j) * PKA; *(u32x4*)kp = w0; *(u32x4*)(kp + 8) = w1; }
    }
}
__device__ __forceinline__ void final_norm(const Ctx& c) {
    const int gw = c.bid * NWAVES + c.wave, NGW = c.G * NWAVES;
    for (int m = gw; m < M; m += NGW) {
        f32x4* xr = (f32x4*)(c.out + (size_t)m * DM) + c.lane; f32x4 v[4]; float s = 0.f;
#pragma unroll
        for (int j = 0; j < 4; ++j) { v[j] = xr[64 * j]; s += (v[j][0] * v[j][0] + v[j][1] * v[j][1]) + (v[j][2] * v[j][2] + v[j][3] * v[j][3]); }
        const float rstd = 1.f / sqrtf(wave_sum(s) * (1.f / DM) + EPS);
#pragma unroll
        for (int j = 0; j < 4; ++j) { const f32x4 g = ((const f32x4*)c.final_g + c.lane)[64 * j]; xr[64 * j] = v[j] * rstd * g; }
    }
}

#define XB_TMO      128
#define XB_XCNT(j)  (256  + 64 * (j))
#define XB_XSUB(j)  (1280 + 64 * (j))
#define XB_XGEN(j)  (2304 + 64 * (j))
#define XB_TOP      3328
#define XB_TOPGEN   3392
#define XCD_BAR_WORDS 3456
#define XB_SPIN_CAP (1u << 18)
__device__ __forceinline__ unsigned xb_ld(unsigned* p)              { return __hip_atomic_load(p, __ATOMIC_RELAXED, __HIP_MEMORY_SCOPE_AGENT); }
__device__ __forceinline__ unsigned xb_add(unsigned* p, unsigned v) { return __hip_atomic_fetch_add(p, v, __ATOMIC_RELAXED, __HIP_MEMORY_SCOPE_AGENT); }
__device__ __forceinline__ unsigned xb_xcc_id() { return (unsigned)__builtin_amdgcn_s_getreg((3 << 11) | 20) & 0xFu; }
#define XB_SPIN(cond, bar) do { unsigned _sp = 0; while (cond) { __builtin_amdgcn_s_sleep(1); \
    if ((++_sp & 255u) == 0u) { if (xb_ld(&(bar)[XB_TMO])) break; if (_sp > XB_SPIN_CAP) { atomicAdd(&(bar)[XB_TMO], 1u); break; } } } } while (0)
struct XcdBarrier { unsigned* bar; unsigned x; volatile LAS unsigned* st; };
__device__ __forceinline__ XcdBarrier xcd_barrier_post(unsigned* bar, volatile LAS unsigned* st) {
    XcdBarrier b; b.bar = bar; b.x = xb_xcc_id(); b.st = st;
    if (threadIdx.x == 0) (void)xb_add(&bar[XB_XCNT(b.x)], 1u);
    return b;
}
__device__ __forceinline__ void xcd_barrier_complete(unsigned* bar, unsigned x, unsigned& nloc, unsigned& nx) {
    const unsigned G = gridDim.x * gridDim.y * gridDim.z;
    unsigned sum, cnt, mine, sp = 0u;
    for (;;) {
        sum = 0u; cnt = 0u; mine = 0u;
#pragma unroll
        for (unsigned j = 0; j < 16; ++j) { const unsigned cc = xb_ld(&bar[XB_XCNT(j)]); sum += cc; cnt += (cc > 0u) ? 1u : 0u; mine = (j == x) ? cc : mine; }
        if (sum == G) break;
        __builtin_amdgcn_s_sleep(1);
        if ((++sp & 255u) == 0u) { if (xb_ld(&bar[XB_TMO])) break; if (sp > XB_SPIN_CAP) { atomicAdd(&bar[XB_TMO], 1u); break; } }
    }
    nloc = mine > 0u ? mine : 1u; nx = cnt > 0u ? cnt : 1u;
}
__device__ __forceinline__ void xcd_barrier(const XcdBarrier& b) {
    asm volatile("s_waitcnt vmcnt(0)" ::: "memory");
    __syncthreads();
    if (threadIdx.x == 0) {
        unsigned* bar = b.bar;
        __builtin_amdgcn_s_waitcnt(0);
        unsigned nloc = b.st[0], nx = b.st[1];
        if (nloc == 0u) { xcd_barrier_complete(bar, b.x, nloc, nx); b.st[0] = nloc; b.st[1] = nx; }
        const unsigned old = xb_add(&bar[XB_XSUB(b.x)], 1u);
        const unsigned gen = old / nloc;
        if (old + 1u == (gen + 1u) * nloc) {
            __builtin_amdgcn_fence(__ATOMIC_RELEASE, "agent");
            asm volatile("s_waitcnt vmcnt(0)" ::: "memory");
            const unsigned og = xb_add(&bar[XB_TOP], 1u);
            const unsigned tg = og / nx;
            if (og + 1u == (tg + 1u) * nx) xb_add(&bar[XB_TOPGEN], 1u);
            else XB_SPIN(xb_ld(&bar[XB_TOPGEN]) == tg, bar);
            __builtin_amdgcn_fence(__ATOMIC_ACQUIRE, "agent");
            xb_add(&bar[XB_XGEN(b.x)], 1u);
            asm volatile("s_waitcnt vmcnt(0)" ::: "memory");
        } else {
            XB_SPIN(xb_ld(&bar[XB_XGEN(b.x)]) == gen, bar);
            __builtin_amdgcn_fence(__ATOMIC_ACQUIRE, "agent");
            asm volatile("s_waitcnt vmcnt(0)" ::: "memory");
        }
    }
    __syncthreads();
}

constexpr int LDS_BYTES = 147456, MISC_OFF = 131072 + 320;
constexpr int NSLOTS = 18;
constexpr int CW_BAR = 4096;

struct Args { const float* in[13]; float* out; unsigned char* ws; int ph_lo, ph_hi, pad0, pad1; };
#define CAS __attribute__((address_space(4)))
__device__ __forceinline__ Ctx make_ctx() {
    const CAS char* kp = (const CAS char*)__builtin_amdgcn_kernarg_segment_ptr();
    asm volatile("" : "+s"(kp));
    const CAS Args* a = (const CAS Args*)kp;
    Ctx c;
    c.x = a->in[0]; c.meta = a->in[1]; c.norm_g = a->in[2]; c.w_in = a->in[3]; c.b_f = a->in[4]; c.g_cq = a->in[5]; c.g_ckv = a->in[6];
    c.w_uq = a->in[7]; c.w_ukv = a->in[8]; c.sinks = a->in[9]; c.w_branch = a->in[10]; c.w_out = a->in[11]; c.final_g = a->in[12];
    c.out = a->out; c.ws = a->ws;
    extern __shared__ __attribute__((aligned(16))) unsigned char lds_raw[];
    c.lds = (LAS unsigned char*)lds_raw;
    c.tid = threadIdx.x; c.lane = c.tid & 63; c.wave = __builtin_amdgcn_readfirstlane(c.tid >> 6); c.G = gridDim.x; c.bid = blockIdx.x;
    return c;
}

template <int SLOT>
__device__ __forceinline__ void run_slot() {
    const Ctx c = make_ctx();
    constexpr int slot = SLOT;
    constexpr int layer = (slot >= 9) ? 1 : 0;
    constexpr int ls = (slot >= 9) ? slot - 8 : slot;
        if constexpr (slot == 0) slot0(c);
        else if constexpr (slot == 17) final_norm(c);
        else if constexpr (ls == 1) {
            zero_fronts(c);
            norm_main(c, layer == 0 ? c.x : c.out);
            meta_blocks(c, AfPlain{WSP(bf16, WS_HNM), DM}, wl(c, layer, WL_EARLY), DM, NE / 16, WSP(float, WS_RAWE), NE, 0);
        } else if constexpr (ls == 2) {
            post_early(c, layer);
            ProbSimple P{WSP(bf16, WS_HN), wl(c, layer, WL_EARLY), DM};
            gemm_run<1>(c, P, EpiEarly{c, layer}, 64, NE / 256, 0);
        } else if constexpr (ls == 3) {
            { const AfPlain af{WSP(bf16, WS_CM), 640}; meta_blocks(c, af, wl(c, layer, WL_UQ), 384, NUQ / 16, WSP(float, WS_RAWU), NUQ + NUKV, 0);
              const AfPlain af2{WSP(bf16, WS_CM) + 384, 640}; meta_blocks(c, af2, wl(c, layer, WL_UKV), 256, NUKV / 16, WSP(float, WS_RAWU), NUQ + NUKV, NUQ); }
            if (c.bid == 0) post_early_reduce(c);
            stats_cumsum(c);
        } else if constexpr (ls == 4) {
            post_up(c);
            { ProbSimple P{WSP(bf16, WS_CQ), wl(c, layer, WL_UQ), 384}; gemm_run<1>(c, P, EpiUq{c}, 64, NUQ / 256, 0); }
            { ProbSimple P{WSP(bf16, WS_CKV), wl(c, layer, WL_UKV), 256}; gemm_run<1>(c, P, EpiUkv{c}, 64, NUKV / 256, 0); }
        } else if constexpr (ls == 5) {
            if (layer == 0) {
#ifndef NO_ATTNM
                if (c.bid == 0) attn_meta(c);
#endif
 meta_blocks(c, AfPlain{WSP(bf16, WS_HNM), DM}, wl(c, 0, WL_LATE), DM, NL / 16, WSP(float, WS_RAWL), NL, 0); }
#ifdef NAIVE_ATTN
            attn_main_naive(c, layer);
#else
            attn_main_mfma(c, layer);
#endif
        } else if constexpr (ls == 6) {
#ifndef NO_S67
            if (layer == 0) { for (int n = 0; n < 3; ++n) { const AfBranch af{WSP(bf16, WS_YM), WSP(float, WS_RAWL), n}; meta_blocks(c, af, wl(c, 0, WL_BR) + (size_t)n * DM * 512, 512, DM / 16, WSP(float, WS_RAWB) + (size_t)n * 16 * 1024, 1024, 0); } }
#endif
            { ProbSimple P{WSP(bf16, WS_HN), wl(c, layer, WL_LATE), DM}; gemm_run<1>(c, P, EpiLateZ{c}, 64, 6, 0); }
            { ProbSimple P{WSP(bf16, WS_HN), wl(c, layer, WL_LATE), DM}; gemm_run<1>(c, P, EpiLateG{c}, 64, 12, 6); }
        } else if constexpr (ls == 7) {
            if (layer == 0) { const AfMerged af{WSP(float, WS_RAWL), WSP(float, WS_RAWB)}; meta_blocks(c, af, wl(c, 0, WL_OUT), DM, DM / 16, WSP(float, WS_RAWO), DM, 0); }
            { ProbBranch P{WSP(bf16, WS_QA), WSP(bf16, WS_YB), WSP(bf16, WS_QC), wl(c, layer, WL_BR), 512}; gemm_run<3>(c, P, EpiBranch{c}, 64, 4, 0); }
        } else if constexpr (ls == 8) {
            if (layer == 0 && c.bid == 0) post_resid(c);
            ProbSimple P{WSP(bf16, WS_HN), wl(c, layer, WL_OUT), DM};
            gemm_run<1>(c, P, EpiOut{layer == 0 ? c.x : c.out, c.out}, 64, DM / 256, 0);
        }
}

__global__ void __launch_bounds__(NTHREADS, 2) skel_fwd(Args args) {
    const Ctx c = make_ctx();
    volatile LAS unsigned* MISC = (volatile LAS unsigned*)(c.lds + MISC_OFF);
    for (int u = c.tid; u < (LDS_BYTES - 131072) / 4; u += NTHREADS) ((LAS unsigned*)(c.lds + 131072))[u] = 0u;
    __syncthreads();
    XcdBarrier bar; bar.bar = (unsigned*)(c.ws + WS_CTL) + CW_BAR; bar.x = 0; bar.st = nullptr;
    const int lo = args.ph_lo, hi = args.ph_hi;
    if (hi - lo > 1) bar = xcd_barrier_post((unsigned*)(c.ws + WS_CTL) + CW_BAR, MISC + 8);

#ifndef SLOT_ON
#define SLOT_ON(k) true
#endif
#ifndef SLOT_REPS
#define SLOT_REPS(k) 1
#endif
#define RUN_SLOT(k) if (SLOT_ON(k) && lo <= (k) && (k) < hi) { _Pragma("nounroll") for (int rep_ = 0; rep_ < SLOT_REPS(k); ++rep_) { run_slot<k>(); if ((k) + 1 < hi) xcd_barrier(bar); } }
    RUN_SLOT(0) RUN_SLOT(1) RUN_SLOT(2) RUN_SLOT(3) RUN_SLOT(4) RUN_SLOT(5) RUN_SLOT(6) RUN_SLOT(7) RUN_SLOT(8)
    RUN_SLOT(9) RUN_SLOT(10) RUN_SLOT(11) RUN_SLOT(12) RUN_SLOT(13) RUN_SLOT(14) RUN_SLOT(15) RUN_SLOT(16) RUN_SLOT(17)
#undef RUN_SLOT
}

extern "C" void kernel_launch(void* const* d_in, const int* in_sizes, int n_in, void* d_out, int out_size, void* d_ws, size_t ws_size, hipStream_t stream) {
    static int grid = 0;
    if (grid == 0) {
        if (n_in != 13 || out_size != M * DM || ws_size < WS_END) { fprintf(stderr, "kernel_launch: unexpected shapes (n_in %d out %d ws %zu need %zu)\n", n_in, out_size, ws_size, (size_t)WS_END); grid = -1; return; }
        int dev = 0, cus = 0, per_cu = 0;
        if (hipGetDevice(&dev) != hipSuccess || hipDeviceGetAttribute(&cus, hipDeviceAttributeMultiprocessorCount, dev) != hipSuccess) { grid = -1; return; }
        if (hipFuncSetAttribute((const void*)skel_fwd, hipFuncAttributeMaxDynamicSharedMemorySize, LDS_BYTES) != hipSuccess) { fprintf(stderr, "kernel_launch: hipFuncSetAttribute failed\n"); grid = -1; return; }
        if (hipOccupancyMaxActiveBlocksPerMultiprocessor(&per_cu, (const void*)skel_fwd, NTHREADS, LDS_BYTES) != hipSuccess || per_cu < 1) fprintf(stderr, "kernel_launch: occupancy query says %d\n", per_cu);
        (void)hipGetLastError();
        grid = cus;
    }
    if (grid < 0) return;
    (void)hipMemsetAsync((char*)d_ws + WS_CTL, 0, CTL_BYTES, stream);
    Args a{};
    for (int i = 0; i < 13; ++i) a.in[i] = (const float*)d_in[i];
    a.out = (float*)d_out; a.ws = (unsigned char*)d_ws;
#if MK_SINGLE
    a.ph_lo = 0; a.ph_hi = NSLOTS;
    hipLaunchKernelGGL(skel_fwd, dim3(grid), dim3(NTHREADS), LDS_BYTES, stream, a);
#else
#ifndef HOST_REPS
#define HOST_REPS(s) 1
#endif
    for (int s = 0; s < NSLOTS; ++s) for (int r = 0; r < HOST_REPS(s); ++r) { a.ph_lo = s; a.ph_hi = s + 1; hipLaunchKernelGGL(skel_fwd, dim3(grid), dim3(NTHREADS), LDS_BYTES, stream, a); }
#endif
}
```

```cpp
#include <hip/hip_runtime.h>
#include <cstdio>
#include <cstdint>

#ifndef USE_FB
#define USE_FB 1
#endif
#ifndef MK_SINGLE
#define MK_SINGLE 1
#endif

#define GAS __attribute__((address_space(1)))
#define LAS __attribute__((address_space(3)))
typedef unsigned short bf16;
typedef short bf16x8 __attribute__((ext_vector_type(8)));
typedef float f32x4 __attribute__((ext_vector_type(4)));
typedef unsigned u32x4 __attribute__((ext_vector_type(4)));
typedef unsigned u32x2 __attribute__((ext_vector_type(2)));
typedef float f32x2_t __attribute__((ext_vector_type(2)));
typedef __bf16 bf16x2_t __attribute__((ext_vector_type(2)));
typedef GAS unsigned gu32;
#define RLX_AGENT __ATOMIC_RELAXED, __HIP_MEMORY_SCOPE_AGENT

constexpr int DM = 1024, NBATCH = 4, SEQ = 4096, M = NBATCH * SEQ, NMETA = 16, FR = 64, MOFF = 48, NPOS = SEQ + NMETA;
constexpr int NIN = 7592, NWAVES = 8, NTHREADS = NWAVES * 64;
constexpr float EPS = 1e-6f, LOG2E = 1.4426950408889634f, LN2 = 0.6931471805599453f;
constexpr float C2A = 0.125f * LOG2E, C2B = 0.10206207261596575f * LOG2E, C2C = 0.125f * LOG2E;
constexpr int LC_AQ = 0, LC_AK = 512, LC_AV = 1024, LC_AF = 1536, LC_AZ = 1544, LC_BCQ = 2056, LC_BCKV = 2440, LC_BKR = 2696, LC_BZ = 2728,
              LC_CQ = 3240, LC_CK = 3752, LC_CV = 3880, LC_CZ = 4008, LC_G = 4520;
constexpr int NE = 3072, NL = 4608, NUQ = 768, NUKV = 1024;
constexpr int PQA = 512, PKA = 640, PVA = 512, PQB = 768, PKB = 768, PVB = 512, PQC = 512, PKC = 128, PVC = 128, PCQ = 384, PCKV = 256, PY = 512, PG = 3072;

constexpr size_t MiB = 1u << 20;
constexpr size_t al(size_t x) { return (x + 255) & ~(size_t)255; }
constexpr size_t WS_CTL = 0, CTL_BYTES = 1 * MiB;
constexpr size_t WS_COS64 = CTL_BYTES, WS_SIN64 = WS_COS64 + al((size_t)NPOS * 32 * 4), WS_COS32 = WS_SIN64 + al((size_t)NPOS * 32 * 4), WS_SIN32 = WS_COS32 + al((size_t)NPOS * 16 * 4);
constexpr size_t WS_LF = WS_SIN32 + al((size_t)NPOS * 16 * 4), WS_RQ = WS_LF + al((size_t)M * 8 * 4), WS_RKV = WS_RQ + al((size_t)M * 4);
constexpr size_t WS_HM = WS_RKV + al((size_t)M * 4);
constexpr size_t WS_HNM = WS_HM + al(16 * 1024 * 4);
constexpr size_t WS_RAWE = WS_HNM + al(16 * 1024 * 2);
constexpr size_t WS_RAWU = WS_RAWE + al(16 * NE * 4);
constexpr size_t WS_RAWL = WS_RAWU + al(16 * (NUQ + NUKV) * 4);
constexpr size_t WS_RAWB = WS_RAWL + al(16 * NL * 4);
constexpr size_t WS_RAWO = WS_RAWB + al(3 * 16 * 1024 * 4);
constexpr size_t WS_YM = WS_RAWO + al(16 * 1024 * 4);
constexpr size_t WS_CM = WS_YM + al(16 * 1536 * 2);
constexpr size_t WS_RQM = WS_CM + al(16 * 640 * 2);
constexpr size_t WS_LFM = WS_RQM + al(32 * 4);
constexpr size_t WS_QAM = WS_LFM + al(16 * 8 * 4);
constexpr size_t WS_QBM = WS_QAM + al(16 * 512 * 2);
constexpr size_t WS_QCM = WS_QBM + al(16 * 768 * 2);
constexpr size_t WS_SMALL_END = WS_QCM + al(16 * 512 * 2);
constexpr size_t WL_EARLY = 0, WL_LATE = WL_EARLY + (size_t)NE * DM * 2, WL_UQ = WL_LATE + (size_t)NL * DM * 2, WL_UKV = WL_UQ + (size_t)NUQ * 384 * 2,
                 WL_BR = WL_UKV + (size_t)NUKV * 256 * 2, WL_OUT = WL_BR + (size_t)3 * DM * 512 * 2, WL_BYTES = WL_OUT + (size_t)DM * DM * 2;
constexpr size_t WS_W = 6 * MiB;
static_assert(WS_SMALL_END <= WS_W, "small region");
constexpr size_t WS_HN = WS_W + al(2 * WL_BYTES);
constexpr size_t WS_QA = WS_HN + (size_t)M * DM * 2;
constexpr size_t WS_QC = WS_QA + (size_t)M * PQA * 2;
constexpr size_t WS_CQ = WS_QC + (size_t)M * PQC * 2;
constexpr size_t WS_CKV = WS_CQ + (size_t)M * PCQ * 2;
constexpr size_t WS_YB = WS_CQ;
constexpr size_t WS_QB = WS_CKV + (size_t)M * PCKV * 2;
constexpr size_t WS_KB = WS_QB + (size_t)M * PQB * 2;
constexpr size_t WS_VB = WS_KB + (size_t)(FR + M) * PKB * 2;
constexpr size_t WS_KA = WS_VB + (size_t)(FR + M) * PVB * 2;
constexpr size_t WS_VA = WS_KA + (size_t)(FR + M) * PKA * 2;
constexpr size_t WS_KC = WS_VA + (size_t)(FR + M) * PVA * 2;
constexpr size_t WS_VC = WS_KC + (size_t)(FR + M) * PKC * 2;
constexpr size_t WS_END = WS_VC + (size_t)(FR + M) * PVC * 2;
constexpr size_t WS_G = WS_QB;
static_assert(WS_G + (size_t)M * PG * 2 <= WS_KC, "G overlay");
static_assert((size_t)M * PY * 2 <= (size_t)M * (PCQ + PCKV) * 2, "YB overlay");
static_assert(WS_END <= 256 * MiB, "workspace");

__device__ __forceinline__ unsigned cvtpk(float lo, float hi) { f32x2_t v = {lo, hi}; bf16x2_t b = __builtin_convertvector(v, bf16x2_t); return __builtin_bit_cast(unsigned, b); }
__device__ __forceinline__ bf16 f2bf(float f) { return (bf16)(cvtpk(f, 0.f) & 0xffffu); }
__device__ __forceinline__ float bf2f(bf16 v) { return __uint_as_float((unsigned)v << 16); }
__device__ __forceinline__ float bflo(unsigned w) { return __uint_as_float(w << 16); }
__device__ __forceinline__ float bfhi(unsigned w) { return __uint_as_float(w & 0xffff0000u); }
__device__ __forceinline__ float fexp2(float x) { return __builtin_amdgcn_exp2f(x); }
__device__ __forceinline__ float frcp(float x) { return __builtin_amdgcn_rcpf(x); }
__device__ __forceinline__ float sigmoidf_(float x) { return frcp(1.f + fexp2(-x * LOG2E)); }
__device__ __forceinline__ float siluf_(float x) { return x * sigmoidf_(x); }
__device__ __forceinline__ float logsigf_(float x) { return fminf(x, 0.f) - __builtin_amdgcn_logf(1.f + fexp2(-fabsf(x) * LOG2E)) * LN2; }
__device__ __forceinline__ float wave_sum(float v) {
#pragma unroll
    for (int o = 1; o < 64; o <<= 1) v += __shfl_xor(v, o);
    return v;
}
__device__ __forceinline__ u32x4 pack8(f32x4 a, f32x4 b) { u32x4 w; w.x = cvtpk(a[0], a[1]); w.y = cvtpk(a[2], a[3]); w.z = cvtpk(b[0], b[1]); w.w = cvtpk(b[2], b[3]); return w; }
__device__ __forceinline__ void st8(bf16* p, f32x4 a, f32x4 b) { *(u32x4*)p = pack8(a, b); }
__device__ __forceinline__ void ld8(const bf16* p, f32x4& a, f32x4& b) { const u32x4 w = *(const u32x4*)p; a = (f32x4){bflo(w.x), bfhi(w.x), bflo(w.y), bfhi(w.y)}; b = (f32x4){bflo(w.z), bfhi(w.z), bflo(w.w), bfhi(w.w)}; }
__device__ __forceinline__ void split3(float b, bf16& h, bf16& m, bf16& l) { h = f2bf(b); const float r1 = b - bf2f(h); m = f2bf(r1); const float r2 = r1 - bf2f(m); l = f2bf(r2); }

enum { MAP_EARLY = 0, MAP_LATE = 1, MAP_UQ = 2, MAP_ID = 3 };
__device__ __forceinline__ int map_col(int kind, int p) {
    const int t = p >> 8, c = p & 255, half = c >> 7, c7 = c & 127;
    if (kind == MAP_EARLY) {
        if (t < 2) return LC_AQ + p;
        if (t < 4) return LC_AK + (p - 512);
        if (t < 6) return LC_AV + (p - 1024);
        if (t < 8) return LC_CQ + 256 * (t - 6) + 64 * (c7 >> 5) + 32 * half + (c7 & 31);
        if (t == 8) { if (c7 < 64) return LC_CK + 64 * (c7 >> 5) + 32 * half + (c7 & 31); return LC_CV + 64 * half + (c7 - 64); }
        if (t == 9) return LC_BCQ + c;
        if (t == 10) { if (c7 < 64) return LC_BCQ + 256 + 64 * half + c7; if (c7 < 80) return LC_BKR + 16 * half + (c7 - 64); if (c7 < 88 && half == 0) return LC_AF + (c7 - 80); return -1; }
        return LC_BCKV + c;
    }
    if (kind == MAP_LATE) {
        if (t < 2) return LC_AZ + p;
        if (t < 4) return LC_BZ + (p - 512);
        if (t < 6) return LC_CZ + (p - 1024);
        return LC_G + (p - 1536);
    }
    if (kind == MAP_UQ) {
        if (t < 2) return (4 * t + (c >> 6)) * 96 + (c & 63);
        return (c7 >> 4) * 96 + 64 + 16 * half + (c7 & 15);
    }
    return p;
}

struct Ctx {
    const float *x, *meta, *norm_g, *w_in, *b_f, *g_cq, *g_ckv, *w_uq, *w_ukv, *sinks, *w_branch, *w_out, *final_g;
    float* out; unsigned char* ws;
    LAS unsigned char* lds;
    int tid, lane, wave, G, bid;
};
#define WSP(T, off) ((T*)(c.ws + (off)))
__device__ __forceinline__ bf16* wl(const Ctx& c, int layer, size_t off) { return (bf16*)(c.ws + WS_W + (size_t)layer * WL_BYTES + off); }

__device__ __forceinline__ void conv_item(const float* W, int N, const float* gv, bf16* Bt, int K, int kind, int nblk, int item, LAS float* scr, int lane) {
    const int kb = item / nblk, nb = item % nblk, k0 = 64 * kb, n0 = 32 * nb;
    const int lc = map_col(kind, n0 + (lane & 31));
#pragma unroll 8
    for (int i = 0; i < 32; ++i) { const int kk = 2 * i + (lane >> 5); float v = 0.f; if (lc >= 0) { v = W[(size_t)(k0 + kk) * N + lc]; if (gv) v *= gv[k0 + kk]; } scr[kk * 33 + (lane & 31)] = v; }
    asm volatile("s_waitcnt lgkmcnt(0)" ::: "memory");
    const int ch = lane & 7;
#pragma unroll
    for (int j = 0; j < 4; ++j) { const int n = (lane >> 3) + 8 * j; const LAS float* s = scr + (8 * ch) * 33 + n;
        u32x4 o; o.x = cvtpk(s[0 * 33], s[1 * 33]); o.y = cvtpk(s[2 * 33], s[3 * 33]); o.z = cvtpk(s[4 * 33], s[5 * 33]); o.w = cvtpk(s[6 * 33], s[7 * 33]);
        *(u32x4*)(Bt + (size_t)(n0 + n) * K + k0 + 8 * ch) = o; }
    asm volatile("s_waitcnt lgkmcnt(0)" ::: "memory");
}
__device__ __forceinline__ void zero_fronts(const Ctx& c) {
    const int g = c.bid * NTHREADS + c.tid, NG = c.G * NTHREADS;
    const u32x4 z = {0u, 0u, 0u, 0u};
    for (int e = g; e < MOFF * PKB / 8; e += NG) WSP(u32x4, WS_KB)[e] = z;
    for (int e = g; e < MOFF * PVB / 8; e += NG) WSP(u32x4, WS_VB)[e] = z;
    for (int e = g; e < MOFF * PKA / 8; e += NG) WSP(u32x4, WS_KA)[e] = z;
    for (int e = g; e < MOFF * PVA / 8; e += NG) WSP(u32x4, WS_VA)[e] = z;
    for (int e = g; e < MOFF * PKC / 8; e += NG) WSP(u32x4, WS_KC)[e] = z;
    for (int e = g; e < MOFF * PVC / 8; e += NG) WSP(u32x4, WS_VC)[e] = z;
}
__device__ __forceinline__ void sincos_d(float ang, float& s, float& co) {
    const double x = (double)ang, TWO_PI = 6.283185307179586476925, INV = 0.15915494309189533577;
    const double n = __builtin_rint(x * INV), r = __builtin_fma(-n, TWO_PI, x), y = 0.5 * r, y2 = y * y;
    double sp, cp;
    double ts = 1.0, tc = 1.0; sp = 1.0; cp = 1.0;
#pragma unroll
    for (int j = 1; j <= 12; ++j) { tc = -tc * y2 / (double)((2 * j - 1) * (2 * j)); ts = -ts * y2 / (double)((2 * j) * (2 * j + 1)); cp += tc; sp += ts; }
    const double sy = y * sp, cy = cp;
    s = (float)(2.0 * sy * cy); co = (float)(1.0 - 2.0 * sy * sy);
}
__device__ __forceinline__ void rope_tables(const Ctx& c) {
    const int g = c.bid * NTHREADS + c.tid, NG = c.G * NTHREADS;
    for (int e = g; e < NPOS * 48; e += NG) {
        const int pos = e / 48, i = e % 48;
        float inv; if (i < 32) inv = fexp2(-(float)i * (13.287712379549449f / 32.f)); else inv = fexp2(-(float)(i - 32) * (13.287712379549449f / 16.f));
        const float ang = (float)pos * inv; float s, co; sincos_d(ang, s, co);
        if (i < 32) { WSP(float, WS_COS64)[pos * 32 + i] = co; WSP(float, WS_SIN64)[pos * 32 + i] = s; }
        else { WSP(float, WS_COS32)[pos * 16 + i - 32] = co; WSP(float, WS_SIN32)[pos * 16 + i - 32] = s; }
    }
}
__device__ __forceinline__ void rms_row_to_bf16(const float* xrow, bf16* orow, float* copy, int lane) {
    const f32x4* xr = (const f32x4*)xrow + lane;
    f32x4 v[4]; float s = 0.f;
#pragma unroll
    for (int j = 0; j < 4; ++j) { v[j] = xr[64 * j]; s += (v[j][0] * v[j][0] + v[j][1] * v[j][1]) + (v[j][2] * v[j][2] + v[j][3] * v[j][3]); }
    const float rstd = 1.f / sqrtf(wave_sum(s) * (1.f / DM) + EPS);
    u32x2* o8 = (u32x2*)orow + lane;
#pragma unroll
    for (int j = 0; j < 4; ++j) { u32x2 w; w.x = cvtpk(v[j][0] * rstd, v[j][1] * rstd); w.y = cvtpk(v[j][2] * rstd, v[j][3] * rstd); o8[64 * j] = w; if (copy) ((f32x4*)copy + lane)[64 * j] = v[j]; }
}
__device__ __forceinline__ void convert_weights(const Ctx& c, int layer);
__device__ __forceinline__ void slot0(const Ctx& c) {
    LAS float* scr = (LAS float*)(c.lds + c.wave * 16384);
    const int gw = c.bid * NWAVES + c.wave, NGW = c.G * NWAVES;
    convert_weights(c, 0);
    rope_tables(c);
    if (gw < 16) rms_row_to_bf16(c.meta + (size_t)gw * DM, WSP(bf16, WS_HNM) + (size_t)gw * DM, WSP(float, WS_HM) + (size_t)gw * DM, c.lane);
}
__device__ __forceinline__ void convert_weights(const Ctx& c, int layer) {
    LAS float* scr = (LAS float*)(c.lds + c.wave * 16384);
    const int gw = c.bid * NWAVES + c.wave, NGW = c.G * NWAVES;
    {
        const float* w_in = c.w_in + (size_t)layer * DM * NIN;
        const int I_E = 16 * (NE / 32), I_L = 16 * (NL / 32), I_UQ = 6 * (NUQ / 32), I_UKV = 4 * (NUKV / 32), I_BR = 8 * (DM / 32), I_O = 16 * (DM / 32);
        const int tot = I_E + I_L + I_UQ + I_UKV + 3 * I_BR + I_O;
        for (int it = gw; it < tot; it += NGW) {
            int r = it;
            if (r < I_E) { conv_item(w_in, NIN, c.norm_g + layer * DM, wl(c, layer, WL_EARLY), DM, MAP_EARLY, NE / 32, r, scr, c.lane); continue; } r -= I_E;
            if (r < I_L) { conv_item(w_in, NIN, c.norm_g + layer * DM, wl(c, layer, WL_LATE), DM, MAP_LATE, NL / 32, r, scr, c.lane); continue; } r -= I_L;
            if (r < I_UQ) { conv_item(c.w_uq + (size_t)layer * 384 * 768, 768, c.g_cq + layer * 384, wl(c, layer, WL_UQ), 384, MAP_UQ, NUQ / 32, r, scr, c.lane); continue; } r -= I_UQ;
            if (r < I_UKV) { conv_item(c.w_ukv + (size_t)layer * 256 * 1024, 1024, c.g_ckv + layer * 256, wl(c, layer, WL_UKV), 256, MAP_ID, NUKV / 32, r, scr, c.lane); continue; } r -= I_UKV;
            if (r < 3 * I_BR) { const int n = r / I_BR; conv_item(c.w_branch + ((size_t)layer * 3 + n) * 512 * DM, DM, nullptr, wl(c, layer, WL_BR) + (size_t)n * DM * 512, 512, MAP_ID, DM / 32, r % I_BR, scr, c.lane); continue; } r -= 3 * I_BR;
            conv_item(c.w_out + (size_t)layer * DM * DM, DM, nullptr, wl(c, layer, WL_OUT), DM, MAP_ID, DM / 32, r, scr, c.lane);
        }
    }
}

__device__ __forceinline__ void norm_main(const Ctx& c, const float* src) {
    const int gw = c.bid * NWAVES + c.wave, NGW = c.G * NWAVES;
    for (int m = gw; m < M; m += NGW) rms_row_to_bf16(src + (size_t)m * DM, WSP(bf16, WS_HN) + (size_t)m * DM, nullptr, c.lane);
}

template <class AF>
__device__ __forceinline__ void meta_block(const AF& af, const bf16* Bt, int K, int col0, float* raw, int ldraw, int rcol0, int lane) {
    f32x4 acc = {0.f, 0.f, 0.f, 0.f};
    const int r = lane & 15, kq = 8 * (lane >> 4);
    for (int k0 = 0; k0 < K; k0 += 32) {
        const bf16x8 a = af(r, k0 + kq);
        const bf16x8 b = *(const bf16x8*)(Bt + (size_t)(col0 + r) * K + k0 + kq);
        acc = __builtin_amdgcn_mfma_f32_16x16x32_bf16(a, b, acc, 0, 0, 0);
    }
#pragma unroll
    for (int x = 0; x < 4; ++x) raw[(size_t)(4 * (lane >> 4) + x) * ldraw + rcol0 + r] = acc[x];
}
struct AfPlain { const bf16* A; int lda; __device__ __forceinline__ bf16x8 operator()(int r, int k) const { return *(const bf16x8*)(A + (size_t)r * lda + k); } };
struct AfBranch {
    const bf16* ym; const float* rawl; int n;
    __device__ __forceinline__ bf16x8 operator()(int r, int k) const {
        f32x4 y0, y1; ld8(ym + (size_t)r * 1536 + n * 512 + k, y0, y1);
        const f32x4 z0 = *(const f32x4*)(rawl + (size_t)r * NL + 512 * n + k), z1 = *(const f32x4*)(rawl + (size_t)r * NL + 512 * n + k + 4);
#pragma unroll
        for (int j = 0; j < 4; ++j) { y0[j] *= siluf_(z0[j]); y1[j] *= siluf_(z1[j]); }
        return __builtin_bit_cast(bf16x8, pack8(y0, y1));
    }
};
struct AfMerged {
    const float* rawl; const float* rawb;
    __device__ __forceinline__ bf16x8 operator()(int r, int k) const {
        f32x4 s0 = {0.f, 0.f, 0.f, 0.f}, s1 = s0;
#pragma unroll
        for (int n = 0; n < 3; ++n) {
            const float* g = rawl + (size_t)r * NL + 1536 + n * 1024 + k; const float* p = rawb + ((size_t)n * 16 + r) * 1024 + k;
#pragma unroll
            for (int j = 0; j < 4; ++j) { s0[j] += sigmoidf_(g[j]) * p[j]; s1[j] += sigmoidf_(g[4 + j]) * p[4 + j]; }
        }
        return __builtin_bit_cast(bf16x8, pack8(s0, s1));
    }
};
template <class AF>
__device__ __forceinline__ void meta_blocks(const Ctx& c, const AF& af, const bf16* Bt, int K, int nblocks, float* raw, int ldraw, int rcol0) {
    LAS f32x4* red = (LAS f32x4*)(c.lds + 65536);
    const int r = c.lane & 15, kq = 8 * (c.lane >> 4), nks = K >> 5;
    for (int blk = c.bid; blk < nblocks; blk += c.G) {
        f32x4 acc = {0.f, 0.f, 0.f, 0.f};
#pragma unroll 4
        for (int ks = c.wave; ks < nks; ks += NWAVES) {
            const bf16x8 a = af(r, 32 * ks + kq);
            const bf16x8 bb = *(const bf16x8*)(Bt + (size_t)(16 * blk + r) * K + 32 * ks + kq);
            acc = __builtin_amdgcn_mfma_f32_16x16x32_bf16(a, bb, acc, 0, 0, 0);
        }
        asm volatile("s_nop 15\n\ts_nop 7" : "+v"(acc));
        red[c.wave * 64 + c.lane] = acc;
        __syncthreads();
        if (c.wave == 0) {
            f32x4 sm = red[c.lane];
#pragma unroll
            for (int w = 1; w < NWAVES; ++w) sm += red[w * 64 + c.lane];
#pragma unroll
            for (int x = 0; x < 4; ++x) raw[(size_t)(4 * (c.lane >> 4) + x) * ldraw + rcol0 + 16 * blk + r] = sm[x];
        }
        __syncthreads();
    }
}

__device__ __forceinline__ void post_early(const Ctx& c, int layer) {
    const float* raw = WSP(float, WS_RAWE);
    bf16 *QAm = WSP(bf16, WS_QAM), *QCm = WSP(bf16, WS_QCM), *cm = WSP(bf16, WS_CM);
    bf16 *KAf = WSP(bf16, WS_KA), *VAf = WSP(bf16, WS_VA), *KBf = WSP(bf16, WS_KB), *KCf = WSP(bf16, WS_KC), *VCf = WSP(bf16, WS_VC);
    float* LFm = WSP(float, WS_LFM);
    const float *cos64 = WSP(float, WS_COS64), *sin64 = WSP(float, WS_SIN64), *cos32 = WSP(float, WS_COS32), *sin32 = WSP(float, WS_SIN32);
    for (int e = c.bid * NTHREADS + c.tid; e < 16 * NE; e += c.G * NTHREADS) {
        const int r = e / NE, p = e % NE, t = p >> 8, cc = p & 255, half = cc >> 7, c7 = cc & 127; const float v = raw[e];
        if (t < 2) QAm[r * PQA + p] = f2bf(v * C2A);
        else if (t < 4) { const int L = p - 512; KAf[(size_t)(MOFF + r) * PKA + (L >> 6) * 80 + (L & 63)] = f2bf(v); }
        else if (t < 6) VAf[(size_t)(MOFF + r) * PVA + (p - 1024)] = f2bf(v);
        else if (t < 8) { if (half == 0) { const int hh = c7 >> 5, d = c7 & 31, head = 4 * (t - 6) + hh; const float x1 = v, x2 = raw[e + 128], cs = cos64[r * 32 + d], sn = sin64[r * 32 + d];
                QCm[r * PQC + head * 64 + d] = f2bf((x1 * cs - x2 * sn) * C2C); QCm[r * PQC + head * 64 + 32 + d] = f2bf((x2 * cs + x1 * sn) * C2C); } }
        else if (t == 8) { if (c7 < 64) { if (half == 0) { const int hh = c7 >> 5, d = c7 & 31; const float x1 = v, x2 = raw[e + 128], cs = cos64[r * 32 + d], sn = sin64[r * 32 + d];
                    KCf[(size_t)(MOFF + r) * PKC + hh * 64 + d] = f2bf(x1 * cs - x2 * sn); KCf[(size_t)(MOFF + r) * PKC + hh * 64 + 32 + d] = f2bf(x2 * cs + x1 * sn); } }
            else VCf[(size_t)(MOFF + r) * PVC + 64 * half + (c7 - 64)] = f2bf(v); }
        else if (t == 9) cm[r * 640 + cc] = f2bf(v);
        else if (t == 10) { if (c7 < 64) cm[r * 640 + 256 + 64 * half + c7] = f2bf(v);
            else if (c7 < 80) { if (half == 0) { const int d = c7 - 64; const float x1 = v, x2 = raw[e + 128], cs = cos32[r * 16 + d], sn = sin32[r * 16 + d]; const bf16 o1 = f2bf(x1 * cs - x2 * sn), o2 = f2bf(x2 * cs + x1 * sn);
                    for (int h = 0; h < 8; ++h) { KBf[(size_t)(MOFF + r) * PKB + h * 96 + 64 + d] = o1; KBf[(size_t)(MOFF + r) * PKB + h * 96 + 80 + d] = o2; } } }
            else if (c7 < 88 && half == 0) LFm[r * 8 + (c7 - 80)] = logsigf_(v + c.b_f[layer * 8 + (c7 - 80)]); }
        else cm[r * 640 + 384 + cc] = f2bf(v);
    }
}
__device__ __forceinline__ void post_early_reduce(const Ctx& c) {
    const bf16* cm = WSP(bf16, WS_CM); float* rqm = WSP(float, WS_RQM); const float* LFm = WSP(float, WS_LFM); bf16* KAf = WSP(bf16, WS_KA);
    for (int r = c.wave; r < 16; r += NWAVES) {
        float sq = 0.f, sk = 0.f;
        if (c.lane < 48) { f32x4 a, b; ld8(cm + r * 640 + 8 * c.lane, a, b); sq = (a[0] * a[0] + a[1] * a[1]) + (a[2] * a[2] + a[3] * a[3]) + (b[0] * b[0] + b[1] * b[1]) + (b[2] * b[2] + b[3] * b[3]); }
        if (c.lane < 32) { f32x4 a, b; ld8(cm + r * 640 + 384 + 8 * c.lane, a, b); sk = (a[0] * a[0] + a[1] * a[1]) + (a[2] * a[2] + a[3] * a[3]) + (b[0] * b[0] + b[1] * b[1]) + (b[2] * b[2] + b[3] * b[3]); }
        sq = wave_sum(sq); sk = wave_sum(sk);
        if (c.lane == 0) { rqm[r] = 1.f / sqrtf(sq * (1.f / 384.f) + EPS); rqm[16 + r] = 1.f / sqrtf(sk * (1.f / 256.f) + EPS); }
    }
    if (c.tid < 8) { const int h = c.tid; float lf[16];
#pragma unroll
        for (int r = 0; r < 16; ++r) lf[r] = LFm[r * 8 + h];
        float suf = 0.f;
#pragma unroll
        for (int r = 15; r >= 0; --r) { bf16 bh, bm, bl; split3(suf * LOG2E, bh, bm, bl); bf16* kp = KAf + (size_t)(MOFF + r) * PKA + h * 80 + 64;
            const u32x4 w0 = {(unsigned)bh | ((unsigned)bm << 16), (unsigned)bl | 0x3F800000u, 0x3F803F80u, 0u}, w1 = {0u, 0u, 0u, 0u}; *(u32x4*)kp = w0; *(u32x4*)(kp + 8) = w1; suf += lf[r]; } }
}
__device__ __forceinline__ void post_up(const Ctx& c) {
    const float* raw = WSP(float, WS_RAWU); const float* rqm = WSP(float, WS_RQM);
    bf16 *QBm = WSP(bf16, WS_QBM), *KBf = WSP(bf16, WS_KB), *VBf = WSP(bf16, WS_VB);
    const float *cos32 = WSP(float, WS_COS32), *sin32 = WSP(float, WS_SIN32);
    for (int e = c.bid * NTHREADS + c.tid; e < 16 * (NUQ + NUKV); e += c.G * NTHREADS) {
        const int r = e / (NUQ + NUKV), p = e % (NUQ + NUKV); const float v = raw[e];
        if (p < 512) { const int h = p >> 6, d = p & 63; QBm[r * PQB + h * 96 + d] = f2bf(v * rqm[r] * C2B); }
        else if (p < 768) { const int cc = p - 512, half = cc >> 7, c7 = cc & 127; if (half == 0) { const int h = c7 >> 4, d = c7 & 15; const float sc = rqm[r] * C2B, x1 = v * sc, x2 = raw[e + 128] * sc, cs = cos32[r * 16 + d], sn = sin32[r * 16 + d];
                QBm[r * PQB + h * 96 + 64 + d] = f2bf(x1 * cs - x2 * sn); QBm[r * PQB + h * 96 + 80 + d] = f2bf(x2 * cs + x1 * sn); } }
        else { const int q = p - 768, h = q >> 7, d = q & 127; const float w = v * rqm[16 + r];
            if (d < 64) KBf[(size_t)(MOFF + r) * PKB + h * 96 + d] = f2bf(w); else VBf[(size_t)(MOFF + r) * PVB + h * 64 + (d - 64)] = f2bf(w); }
    }
}
__device__ __forceinline__ void post_resid(const Ctx& c) {
    for (int r = c.wave; r < 16; r += NWAVES) {
        float* hm = WSP(float, WS_HM) + (size_t)r * DM; const float* ro = WSP(float, WS_RAWO) + (size_t)r * DM;
        f32x4 v[4]; float s = 0.f;
#pragma unroll
        for (int j = 0; j < 4; ++j) { v[j] = ((const f32x4*)hm + c.lane)[64 * j] + ((const f32x4*)ro + c.lane)[64 * j]; s += (v[j][0] * v[j][0] + v[j][1] * v[j][1]) + (v[j][2] * v[j][2] + v[j][3] * v[j][3]); }
        const float rstd = 1.f / sqrtf(wave_sum(s) * (1.f / DM) + EPS);
        u32x2* o8 = (u32x2*)(WSP(bf16, WS_HNM) + (size_t)r * DM) + c.lane;
#pragma unroll
        for (int j = 0; j < 4; ++j) { u32x2 w; w.x = cvtpk(v[j][0] * rstd, v[j][1] * rstd); w.y = cvtpk(v[j][2] * rstd, v[j][3] * rstd); o8[64 * j] = w; ((f32x4*)hm + c.lane)[64 * j] = v[j]; }
    }
}

template <int DK, int MODE>
__device__ __forceinline__ void attn_row(const bf16* qrow, const bf16* Kf, const bf16* Km, int kpitch, int koff, const bf16* Vf, const bf16* Vm, int vpitch, int voff, int t, float sink2, bf16* orow) {
    float q[DK];
#pragma unroll
    for (int d = 0; d < DK; d += 8) { f32x4 a, b; ld8(qrow + d, a, b);
#pragma unroll
        for (int j = 0; j < 4; ++j) { q[d + j] = a[j]; q[d + 4 + j] = b[j]; } }
    float o[64];
#pragma unroll
    for (int d = 0; d < 64; ++d) o[d] = 0.f;
    float m = -1e30f, l = 0.f; if (MODE == 2) { m = sink2; l = 1.f; }
    const int s0 = (MODE == 2) ? (t - 127 > 0 ? t - 127 : 0) : 0;
    for (int s = s0; s <= t; ++s) {
        const bf16* kp = (s < NMETA) ? Kf + (size_t)(MOFF + s) * kpitch + koff : Km + (size_t)(s - NMETA) * kpitch + koff;
        const bf16* vp = (s < NMETA) ? Vf + (size_t)(MOFF + s) * vpitch + voff : Vm + (size_t)(s - NMETA) * vpitch + voff;
        float x = 0.f;
#pragma unroll
        for (int d = 0; d < DK; d += 8) { f32x4 a, b; ld8(kp + d, a, b);
#pragma unroll
            for (int j = 0; j < 4; ++j) { x += q[d + j] * a[j]; x += q[d + 4 + j] * b[j]; } }
        if (MODE == 0) x += bf2f(kp[64]) + bf2f(kp[65]) + bf2f(kp[66]);
        if (x > m) { const float f = fexp2(m - x); l *= f;
#pragma unroll
            for (int d = 0; d < 64; ++d) o[d] *= f;
            m = x; }
        const float p = fexp2(x - m); l += p;
#pragma unroll
        for (int d = 0; d < 64; d += 8) { f32x4 a, b; ld8(vp + d, a, b);
#pragma unroll
            for (int j = 0; j < 4; ++j) { o[d + j] += p * a[j]; o[d + 4 + j] += p * b[j]; } }
    }
    const float il = 1.f / l;
#pragma unroll
    for (int d = 0; d < 64; d += 8) { f32x4 a = {o[d] * il, o[d + 1] * il, o[d + 2] * il, o[d + 3] * il}, b = {o[d + 4] * il, o[d + 5] * il, o[d + 6] * il, o[d + 7] * il}; st8(orow + d, a, b); }
}
__device__ __forceinline__ void attn_main_naive(const Ctx& c, int layer) {
    const int g = c.bid * NTHREADS + c.tid, NG = c.G * NTHREADS;
    for (int e = g; e < M * 8; e += NG) {
        const int i = e % SEQ, bh = e / SEQ, b = bh >> 3, h = bh & 7; const size_t row = (size_t)b * SEQ + i; const int t = NMETA + i;
        attn_row<64, 0>(WSP(bf16, WS_QA) + row * PQA + h * 64, WSP(bf16, WS_KA), WSP(bf16, WS_KA) + (size_t)(FR + b * SEQ) * PKA, PKA, h * 80,
                        WSP(bf16, WS_VA), WSP(bf16, WS_VA) + (size_t)(FR + b * SEQ) * PVA, PVA, h * 64, t, 0.f, WSP(bf16, WS_QA) + row * PQA + h * 64);
    }
    for (int e = g; e < M * 8; e += NG) {
        const int i = e % SEQ, bh = e / SEQ, b = bh >> 3, h = bh & 7; const size_t row = (size_t)b * SEQ + i; const int t = NMETA + i;
        attn_row<96, 1>(WSP(bf16, WS_QB) + row * PQB + h * 96, WSP(bf16, WS_KB), WSP(bf16, WS_KB) + (size_t)(FR + b * SEQ) * PKB, PKB, h * 96,
                        WSP(bf16, WS_VB), WSP(bf16, WS_VB) + (size_t)(FR + b * SEQ) * PVB, PVB, h * 64, t, 0.f, WSP(bf16, WS_YB) + row * PY + h * 64);
    }
    for (int e = g; e < M * 8; e += NG) {
        const int i = e % SEQ, bh = e / SEQ, b = bh >> 3, h = bh & 7; const size_t row = (size_t)b * SEQ + i; const int t = NMETA + i;
        attn_row<64, 2>(WSP(bf16, WS_QC) + row * PQC + h * 64, WSP(bf16, WS_KC), WSP(bf16, WS_KC) + (size_t)(FR + b * SEQ) * PKC, PKC, (h >> 2) * 64,
                        WSP(bf16, WS_VC), WSP(bf16, WS_VC) + (size_t)(FR + b * SEQ) * PVC, PVC, (h >> 2) * 64, t, c.sinks[layer * 8 + h] * LOG2E, WSP(bf16, WS_QC) + row * PQC + h * 64);
    }
}

namespace fa {
typedef float f32x16 __attribute__((ext_vector_type(16)));
typedef short s16x4 __attribute__((ext_vector_type(4)));
constexpr int KSLOT = 12288, VSLOT = 8192, OFF_K = 0, OFF_V = 2 * KSLOT, OFF_WS = OFF_V + 2 * VSLOT, OFF_OST = OFF_WS + NWAVES * 256, LDS_END = OFF_OST + NWAVES * 4096;
__device__ __forceinline__ int crow(int r, int hi) { return (r & 3) + 8 * (r >> 2) + 4 * hi; }
#define FA_SBAR() __builtin_amdgcn_sched_barrier(0)
__device__ __forceinline__ void pv(f32x16* o, int vb, bf16x8 pa0, bf16x8 pa1, bf16x8 pa2, bf16x8 pa3) {
#pragma unroll
    for (int d0 = 0; d0 < 2; ++d0) { s16x4 lo[4], hi[4];
#pragma unroll
        for (int ks = 0; ks < 4; ++ks) {
            asm volatile("ds_read_b64_tr_b16 %0,%1 offset:%c2" : "=&v"(lo[ks]) : "v"(vb), "i"(d0 * 4096 + ks * 1024) : "memory");
            asm volatile("ds_read_b64_tr_b16 %0,%1 offset:%c2" : "=&v"(hi[ks]) : "v"(vb), "i"(d0 * 4096 + ks * 1024 + 512) : "memory"); }
        asm volatile("s_waitcnt lgkmcnt(0)" ::: "memory"); FA_SBAR();
#define FA_PK(k) (bf16x8){lo[k][0], lo[k][1], lo[k][2], lo[k][3], hi[k][0], hi[k][1], hi[k][2], hi[k][3]}
        o[d0] = __builtin_amdgcn_mfma_f32_32x32x16_bf16(pa0, FA_PK(0), o[d0], 0, 0, 0);
        o[d0] = __builtin_amdgcn_mfma_f32_32x32x16_bf16(pa1, FA_PK(1), o[d0], 0, 0, 0);
        o[d0] = __builtin_amdgcn_mfma_f32_32x32x16_bf16(pa2, FA_PK(2), o[d0], 0, 0, 0);
        o[d0] = __builtin_amdgcn_mfma_f32_32x32x16_bf16(pa3, FA_PK(3), o[d0], 0, 0, 0);
#undef FA_PK
    }
}
struct Tensors { const bf16* Q; int qpitch, qoff; const bf16* Kf; const bf16* Km; int kpitch, koff; const bf16* Vf; const bf16* Vm; int vpitch, voff; bf16* O; int opitch, ooff; };
template <int NK, int MODE>
__device__ __forceinline__ void attn_unit(const Ctx& c, const Tensors& T, int j, float sink2) {
    constexpr int NCH = 2 * NK;
    LAS unsigned char* lds = c.lds;
    const int lane = c.lane, wid = c.wave, r32 = lane & 31, hi = lane >> 5;
    const unsigned lds0 = (unsigned)(size_t)lds;
    LAS float* wsf = (LAS float*)(lds + OFF_WS) + wid * 64;
    const int q0 = 256 * j;
    const int t_hi = 4 * j + 4, t_lo = (MODE == 2) ? (4 * j - 1 > 0 ? 4 * j - 1 : 0) : 0;
    bf16x8 qr[NK];
    { const bf16* qp = T.Q + (size_t)(q0 + wid * 32 + r32) * T.qpitch + T.qoff + hi * 8;
#pragma unroll
      for (int d0 = 0; d0 < NK; ++d0) { if (MODE == 0 && d0 == NK - 1) { const short one = (short)0x3F80; qr[d0] = hi ? (bf16x8){0, 0, 0, 0, 0, 0, 0, 0} : (bf16x8){one, one, one, 0, 0, 0, 0, 0}; } else qr[d0] = *(const bf16x8*)(qp + d0 * 16); } }
    u32x4 sk0, sk1 = {0u, 0u, 0u, 0u}, sv;
    const bool k2 = (wid + 8 < NCH);
#define FA_LOAD(t) do { const bf16* kt = ((t) == 0) ? T.Kf : T.Km + (size_t)(64 * ((t) - 1)) * T.kpitch; const bf16* vt = ((t) == 0) ? T.Vf : T.Vm + (size_t)(64 * ((t) - 1)) * T.vpitch; \
        sk0 = *(const u32x4*)(kt + (size_t)lane * T.kpitch + T.koff + wid * 8); if (k2) sk1 = *(const u32x4*)(kt + (size_t)lane * T.kpitch + T.koff + (wid + 8) * 8); \
        sv = *(const u32x4*)(vt + (size_t)(16 * (wid & 3) + (lane >> 2)) * T.vpitch + T.voff + (wid >> 2) * 32 + (lane & 3) * 8); } while (0)
#define FA_WRITE(b) do { *(LAS u32x4*)(lds + OFF_K + (b) * KSLOT + wid * 1024 + lane * 16) = sk0; if (k2) *(LAS u32x4*)(lds + OFF_K + (b) * KSLOT + (wid + 8) * 1024 + lane * 16) = sk1; \
        *(LAS u32x4*)(lds + OFF_V + (b) * VSLOT + wid * 1024 + lane * 16) = sv; } while (0)
    float m = (MODE == 2) ? sink2 : -INFINITY, l = (MODE == 2 && hi == 0) ? 1.f : 0.f;
    f32x16 o[2]; o[0] = f32x16{}; o[1] = f32x16{};
    const int qpos = NMETA + q0 + wid * 32 + r32;
    FA_LOAD(t_lo); FA_WRITE(0);
    int buf = 0;
    for (int t = t_lo; t <= t_hi; ++t) {
        __syncthreads();
        if (t < t_hi) FA_LOAD(t + 1);
        const int kpos0 = (t == 0) ? -MOFF : NMETA + 64 * (t - 1);
        const int qmin_w = NMETA + q0 + wid * 32;
        const bool active = (MODE != 2) || !(kpos0 > qmin_w + 31 || kpos0 + 63 < qmin_w - 127);
        if (active) {
        f32x16 p0 = f32x16{}, p1 = f32x16{};
        { const LAS unsigned char* kb = lds + OFF_K + buf * KSLOT + hi * 1024 + r32 * 16;
#pragma unroll
          for (int d0 = 0; d0 < NK; ++d0) { const bf16x8 b0 = *(const LAS bf16x8*)(kb + d0 * 2048), b1 = *(const LAS bf16x8*)(kb + d0 * 2048 + 512);
              p0 = __builtin_amdgcn_mfma_f32_32x32x16_bf16(b0, qr[d0], p0, 0, 0, 0); p1 = __builtin_amdgcn_mfma_f32_32x32x16_bf16(b1, qr[d0], p1, 0, 0, 0); } }
        const bool need = (t == 0) || (t > t_hi - 4) || (MODE == 2);
        if (need) {
#pragma unroll
            for (int r = 0; r < 16; ++r) { const int ka = kpos0 + crow(r, hi), kb2 = ka + 32;
                bool ma = (ka > qpos) || (ka < 0), mb = (kb2 > qpos) || (kb2 < 0);
                if (MODE == 2) { ma = ma || (qpos - ka >= 128); mb = mb || (qpos - kb2 >= 128); }
                if (ma) p0[r] = -INFINITY; if (mb) p1[r] = -INFINITY; }
        }
        float rm = fmaxf(p0[0], p1[0]);
#pragma unroll
        for (int r = 1; r < 16; ++r) rm = fmaxf(rm, fmaxf(p0[r], p1[r]));
        { auto rr = __builtin_amdgcn_permlane32_swap(__float_as_uint(rm), __float_as_uint(rm), false, false); rm = fmaxf(__uint_as_float(rr[0]), __uint_as_float(rr[1])); }
        const float mn = fmaxf(m, rm);
        const bool grew = mn > m;
        const float alpha = (mn == -INFINITY) ? 1.f : fexp2(m - mn);
        const float msub = (mn == -INFINITY) ? 0.f : mn;
        float rs = 0.f;
#pragma unroll
        for (int r = 0; r < 16; ++r) { p0[r] = fexp2(p0[r] - msub); p1[r] = fexp2(p1[r] - msub); rs += p0[r] + p1[r]; }
        l = l * alpha + rs; m = mn;
        if (__any(grew)) {
            if (hi == 0) wsf[r32] = alpha;
            asm volatile("s_waitcnt lgkmcnt(0)" ::: "memory");
#pragma unroll
            for (int r = 0; r < 16; ++r) { const float f = wsf[crow(r, hi)]; o[0][r] *= f; o[1][r] *= f; }
        }
        u32x4 pw0, pw1, pw2, pw3;
        pw0 = (u32x4){cvtpk(p0[0], p0[1]), cvtpk(p0[2], p0[3]), cvtpk(p0[4], p0[5]), cvtpk(p0[6], p0[7])}; pw1 = (u32x4){cvtpk(p0[8], p0[9]), cvtpk(p0[10], p0[11]), cvtpk(p0[12], p0[13]), cvtpk(p0[14], p0[15])};
        pw2 = (u32x4){cvtpk(p1[0], p1[1]), cvtpk(p1[2], p1[3]), cvtpk(p1[4], p1[5]), cvtpk(p1[6], p1[7])}; pw3 = (u32x4){cvtpk(p1[8], p1[9]), cvtpk(p1[10], p1[11]), cvtpk(p1[12], p1[13]), cvtpk(p1[14], p1[15])};
        if (t < t_hi) FA_WRITE(buf ^ 1);
        const int vb = (int)(lds0 + OFF_V + buf * VSLOT) + ((lane >> 4) & 1) * 32 + (lane & 3) * 8 + (4 * hi + ((lane & 15) >> 2)) * 64;
        pv(o, vb, __builtin_bit_cast(bf16x8, pw0), __builtin_bit_cast(bf16x8, pw1), __builtin_bit_cast(bf16x8, pw2), __builtin_bit_cast(bf16x8, pw3));
        } else { if (t < t_hi) FA_WRITE(buf ^ 1); }
        buf ^= 1;
    }
    { auto rr = __builtin_amdgcn_permlane32_swap(__float_as_uint(l), __float_as_uint(l), false, false); l = __uint_as_float(rr[0]) + __uint_as_float(rr[1]); }
    if (hi == 0) wsf[32 + r32] = l;
    asm volatile("s_waitcnt lgkmcnt(0)" ::: "memory");
    LAS bf16* stg = (LAS bf16*)(lds + OFF_OST) + wid * 2048;
#pragma unroll
    for (int r = 0; r < 16; ++r) { const int orow = crow(r, hi); const float rl = frcp(wsf[32 + orow]);
        stg[orow * 64 + r32] = f2bf(o[0][r] * rl); stg[orow * 64 + 32 + r32] = f2bf(o[1][r] * rl); }
    asm volatile("s_waitcnt lgkmcnt(0)" ::: "memory");
    bf16* Ow = T.O + (size_t)(q0 + wid * 32) * T.opitch + T.ooff;
#pragma unroll
    for (int i = 0; i < 4; ++i) { const int row = i * 8 + (lane >> 3), ch = lane & 7; const u32x4 v = *(const LAS u32x4*)(stg + row * 64 + ch * 8); *(u32x4*)(Ow + (size_t)row * T.opitch + ch * 8) = v; }
    __syncthreads();
#undef FA_LOAD
#undef FA_WRITE
}
#undef FA_SBAR
}
static_assert(fa::LDS_END <= 131072, "attention LDS");


namespace fb {
typedef float f32x16 __attribute__((ext_vector_type(16)));
typedef short s16x4 __attribute__((ext_vector_type(4)));
typedef short v4i16_t __attribute__((ext_vector_type(4)));
typedef __attribute__((address_space(3))) const char* lds_cptr;
__device__ __forceinline__ int crow(int r, int hi) { return (r & 3) + 8 * (r >> 2) + 4 * hi; }
#define SBAR() __builtin_amdgcn_sched_barrier(0)
__device__ __forceinline__ void cmask(f32x16& p0, f32x16& p1, int jb, int qrel, int hi) {
    const float NEG = -INFINITY; const int kb = 64 * jb + 4 * hi;
#pragma unroll
    for (int r = 0; r < 16; ++r) { const int kv = kb + (r & 3) + 8 * (r >> 2); if (kv > qrel) p0[r] = NEG; if (kv + 32 > qrel) p1[r] = NEG; }
}
__device__ __forceinline__ void glds16(const void* gsrc, unsigned lds_dst) { unsigned keep;
    asm volatile("s_mov_b32 %0, m0\n\ts_mov_b32 m0, %2\n\ts_nop 0\n\tglobal_load_lds_dwordx4 %1, off\n\ts_mov_b32 m0, %0" : "=&s"(keep) : "v"(gsrc), "s"(lds_dst) : "memory"); }
__device__ __forceinline__ float max3f(float a, float b, float c) { float r; asm("v_max3_f32 %0, %1, %2, %3" : "=v"(r) : "v"(a), "v"(b), "v"(c)); return r; }
__device__ __forceinline__ float max2f(float a, float b) { float r; asm("v_max_f32_e32 %0, %1, %2" : "=v"(r) : "v"(a), "v"(b)); return r; }
__device__ __forceinline__ float fadd_s(float a, float b) { float r; asm("v_add_f32_e32 %0, %1, %2" : "=v"(r) : "v"(a), "v"(b)); return r; }
__device__ __forceinline__ float fsub_s(float a, float b) { float r; asm("v_sub_f32_e32 %0, %1, %2" : "=v"(r) : "v"(a), "v"(b)); return r; }
#define WAIT_BAR(N) asm volatile("s_waitcnt vmcnt(" #N ") lgkmcnt(0)\n\ts_barrier" ::: "memory")
__device__ __forceinline__ void kload2(bf16x8* kf, lds_cptr kp, int j) { kf[2 * j] = *(const LAS bf16x8*)(kp + j * 2048); kf[2 * j + 1] = *(const LAS bf16x8*)(kp + j * 2048 + 512); }
__device__ __forceinline__ s16x4 vtr(lds_cptr p) { return __builtin_bit_cast(s16x4, __builtin_amdgcn_ds_read_tr16_b64_v4i16((LAS v4i16_t*)p)); }
__device__ __forceinline__ float rowmax(const f32x16& p0, const f32x16& p1) {
    float a = max3f(p0[0], p0[1], p1[0]), b = max3f(p0[2], p0[3], p1[1]); a = max3f(a, p1[2], p1[3]);
#pragma unroll
    for (int r = 4; r < 16; r += 4) { a = max3f(a, p0[r], p0[r + 1]); b = max3f(b, p0[r + 2], p0[r + 3]); a = max3f(a, p1[r], p1[r + 1]); b = max3f(b, p1[r + 2], p1[r + 3]); }
    const float m = max2f(a, b);
    auto rr = __builtin_amdgcn_permlane32_swap(__float_as_uint(m), __float_as_uint(m), false, false);
    return max2f(__uint_as_float(rr[0]), __uint_as_float(rr[1]));
}
__device__ __forceinline__ void pv(f32x16* o, int vb, bf16x8 pa0, bf16x8 pa1, bf16x8 pa2, bf16x8 pa3) {
#pragma unroll
    for (int d0 = 0; d0 < 2; ++d0) { s16x4 lo[4], hi[4];
#pragma unroll
        for (int ks = 0; ks < 4; ++ks) {
            asm volatile("ds_read_b64_tr_b16 %0,%1 offset:%c2" : "=&v"(lo[ks]) : "v"(vb), "i"(d0 * 4096 + ks * 1024) : "memory");
            asm volatile("ds_read_b64_tr_b16 %0,%1 offset:%c2" : "=&v"(hi[ks]) : "v"(vb), "i"(d0 * 4096 + ks * 1024 + 512) : "memory"); }
        asm volatile("s_waitcnt lgkmcnt(0)" ::: "memory"); SBAR();
#define PK(k) (bf16x8){lo[k][0], lo[k][1], lo[k][2], lo[k][3], hi[k][0], hi[k][1], hi[k][2], hi[k][3]}
        o[d0] = __builtin_amdgcn_mfma_f32_32x32x16_bf16(pa0, PK(0), o[d0], 0, 0, 0);
        o[d0] = __builtin_amdgcn_mfma_f32_32x32x16_bf16(pa1, PK(1), o[d0], 0, 0, 0);
        o[d0] = __builtin_amdgcn_mfma_f32_32x32x16_bf16(pa2, PK(2), o[d0], 0, 0, 0);
        o[d0] = __builtin_amdgcn_mfma_f32_32x32x16_bf16(pa3, PK(3), o[d0], 0, 0, 0);
#undef PK
    }
}
template <int NK> struct Geo { static constexpr int SLOTB = NK * 2048, LDS_K = 0, LDS_V = 3 * SLOTB, LDS_WS = 6 * SLOTB, LDS_OST = LDS_WS + NWAVES * 256, LDS_BYTES = LDS_OST + NWAVES * 4096; };
template <int NK, bool AUG, int QP, int KP, int VP, int OP, int THRL, bool XFIRST = false, int VLATE = 0, bool NONEGM = false>
__device__ __forceinline__ void attn_unit(const bf16* Qb, const bf16* Kf, const bf16* Km, const bf16* Vf, const bf16* Vm, bf16* Ob, int j, char* shm, int tid) {
    typedef Geo<NK> G; constexpr int SLOTB = G::SLOTB, LDS_K = G::LDS_K, LDS_V = G::LDS_V, LDS_WS = G::LDS_WS, LDS_OST = G::LDS_OST, NCH = 2 * NK, NKD = (NK > 4) ? 2 : 1, NSLOT = 3;
    const int lane = tid & 63, r32 = lane & 31, hi = lane >> 5; const int wid = __builtin_amdgcn_readfirstlane(tid >> 6);
    const int q0 = 256 * j;
    const bf16* Qw = Qb + (size_t)(q0 + wid * 32) * QP;
    const unsigned lds0 = (unsigned)(uintptr_t)shm;
    float* wsf = (float*)(shm + LDS_WS) + wid * 64;
    const int c2 = 8 + (wid % (NCH > 8 ? NCH - 8 : 1));
    const bf16* ksrc_f = Kf + (size_t)lane * KP + wid * 8; const bf16* ksrc_m = Km + (size_t)lane * KP + wid * 8;
    const bf16* vsrc_f = Vf + (size_t)(16 * (wid & 3) + (lane >> 2)) * VP + (wid >> 2) * 32 + (lane & 3) * 8; const bf16* vsrc_m = Vm + (size_t)(16 * (wid & 3) + (lane >> 2)) * VP + (wid >> 2) * 32 + (lane & 3) * 8;
    const unsigned kdst = lds0 + LDS_K + wid * 1024, kdst2 = lds0 + LDS_K + c2 * 1024, vdst = lds0 + LDS_V + wid * 1024;
#define RFL(x) ((unsigned)__builtin_amdgcn_readfirstlane(x))
#define DMA_KP(src, slot) do { glds16((src), RFL(kdst + (slot))); if (NKD == 2) glds16((src) + (c2 - wid) * 8, RFL(kdst2 + (slot))); } while (0)
#define DMA_K0(slot) DMA_KP(ksrc_f, slot)
#define DMA_KM(t, slot) DMA_KP(ksrc_m + (size_t)((t) - 1) * 64 * KP, slot)
#define DMA_V0(slot) glds16(vsrc_f, RFL(vdst + (slot)))
#define DMA_VM(t, slot) glds16(vsrc_m + (size_t)((t) - 1) * 64 * VP, RFL(vdst + (slot)))
#define WAIT_KV() do { if (NKD == 2) { WAIT_BAR(3); } else { WAIT_BAR(2); } } while (0)
    const int vb0 = (int)(lds0 + LDS_V) + ((lane >> 4) & 1) * 32 + (lane & 3) * 8 + (4 * hi + ((lane & 15) >> 2)) * 64;
    bf16x8 kf[2 * NK];
    const lds_cptr shm3 = (lds_cptr)shm; const lds_cptr kp0 = shm3 + LDS_K + hi * 1024 + r32 * 16; const lds_cptr vp0 = shm3 + LDS_V + ((lane >> 4) & 1) * 32 + (lane & 3) * 8 + (4 * hi + ((lane & 15) >> 2)) * 64;
    const int NT = 4 * j + 5;
    DMA_K0(0); DMA_V0(0); DMA_KM(1, SLOTB);
    bf16x8 qr[NK];
#pragma unroll
    for (int d0 = 0; d0 < NK; ++d0) { if (AUG && d0 == NK - 1) { const short one = (short)0x3F80; qr[d0] = hi ? (bf16x8){0, 0, 0, 0, 0, 0, 0, 0} : (bf16x8){one, one, one, 0, 0, 0, 0, 0}; }
        else qr[d0] = *reinterpret_cast<const bf16x8*>(&Qw[(size_t)r32 * QP + d0 * 16 + hi * 8]); }
    float mhat = 0.f, l_reg = 0.f; f32x16 o[2]; o[0] = f32x16{}; o[1] = f32x16{}; f32x16 negm = f32x16{}; if (!AUG && !NONEGM) asm volatile("" : "+v"(negm));
#define SETREF() do { if (AUG) { bf16 h_, m_, l_; split3(-mhat, h_, m_, l_); if (hi == 0) { u32x4 w_ = {0x3F803F80u, 0x3F80u | ((unsigned)h_ << 16), (unsigned)m_ | ((unsigned)l_ << 16), 0u}; qr[NK - 1] = __builtin_bit_cast(bf16x8, w_); } } \
        else if (!NONEGM) { _Pragma("unroll") for (int r = 0; r < 16; ++r) negm[r] = -mhat; asm volatile("" : "+v"(negm)); } } while (0)
#define CIN ((AUG || NONEGM) ? f32x16{} : negm)
    const int qrel = wid * 32 + r32;
#define CMASK(P0, P1, t) do { int jb_ = (t) - (NT - 4); if (jb_ >= 0) cmask(P0, P1, jb_, qrel, hi); } while (0)
    bool resc = false;
#define START(P0, P1) do { const float rm = rowmax(P0, P1); resc = false; \
    { const float dl = rm; mhat = fadd_s(mhat, dl); \
      _Pragma("unroll") for (int r = 0; r < 16; ++r) { P0[r] = fsub_s(P0[r], dl); P1[r] = fsub_s(P1[r], dl); } \
      SETREF(); } \
    _Pragma("unroll") for (int r = 0; r < 16; ++r) P0[r] = __builtin_amdgcn_exp2f(P0[r]); } while (0)
#define RESC() do { if (resc) { asm volatile("s_waitcnt lgkmcnt(0)" ::: "memory"); \
      _Pragma("unroll") for (int d_ = 0; d_ < 2; ++d_) _Pragma("unroll") for (int r = 0; r < 16; ++r) o[d_][r] *= wsf[crow(r, hi)]; } } while (0)
    f32x16 pA0, pA1, pB0, pB1;
    int sl_prev = 0, sl_cur = 0, sl_next = SLOTB;
#define ROT() do { sl_prev = sl_cur; sl_cur = sl_next; sl_next = (sl_next == (NSLOT - 1) * SLOTB) ? 0 : sl_next + SLOTB; } while (0)
    DMA_KM(2, 2 * SLOTB);
    if (NKD == 2) { WAIT_BAR(5); } else { WAIT_BAR(3); }
    { pA0 = CIN; pA1 = CIN; const char* kb = shm + LDS_K + hi * 1024 + r32 * 16;
#pragma unroll
      for (int d0 = 0; d0 < NK; ++d0) { const bf16x8 b0 = *reinterpret_cast<const bf16x8*>(kb + d0 * 2048), b1 = *reinterpret_cast<const bf16x8*>(kb + d0 * 2048 + 512);
          pA0 = __builtin_amdgcn_mfma_f32_32x32x16_bf16(b0, qr[d0], pA0, 0, 0, 0); pA1 = __builtin_amdgcn_mfma_f32_32x32x16_bf16(b1, qr[d0], pA1, 0, 0, 0); } }
    asm volatile("s_nop 15\n\ts_nop 7" : "+v"(pA0), "+v"(pA1));
#pragma unroll
    for (int r = 0; r < 16; ++r) { pA0[r] = -INFINITY; if (r < 8) pA1[r] = -INFINITY; }
    START(pA0, pA1);
#pragma unroll
    for (int r = 0; r < 16; ++r) pA1[r] = __builtin_amdgcn_exp2f(pA1[r]);
    WAIT_BAR(0);
    DMA_KM(3, 0); DMA_VM(1, SLOTB);
    ROT();
#pragma unroll
    for (int jj = 0; jj < NK; ++jj) kload2(kf, kp0 + sl_cur, jj);
    WAIT_KV();
    s16x4 vlo[8], vhi[8]; u32x4 pw0, pw1, pw2, pw3;
#define PKW(P, B) cvtpk(P[B], P[B + 1])
#define PAF(k) __builtin_bit_cast(bf16x8, pw##k)
#define VFR(i) (bf16x8){vlo[i][0], vlo[i][1], vlo[i][2], vlo[i][3], vhi[i][0], vhi[i][1], vhi[i][2], vhi[i][3]}
#define PIN(x) asm volatile("" : "+v"(x))
#define MX3(a, b, c) __builtin_fmaxf(__builtin_fmaxf((a), (b)), (c))
#define MF(c_, a_, b_) __builtin_amdgcn_mfma_f32_32x32x16_bf16(a_, b_, c_, 0, 0, 0)
#define GAPA(MFX, A0, A1, A2, A3, W0, W1, PW) do { MFX; sacc += A0; sacc += A1; sacc += A2; sacc += A3; PIN(sacc); W0; W1; PIN(PW); SBAR(); } while (0)
#define EX(v) __builtin_amdgcn_exp2f(v)
#define GAPB(MFX, X, B) do { MFX; X[B] = EX(X[B]); X[B + 1] = EX(X[B + 1]); X[B + 2] = EX(X[B + 2]); X[B + 3] = EX(X[B + 3]); PIN(X); SBAR(); } while (0)
#define VRD(i) do { vlo[i] = vtr(vp_ + (((i) >> 2) * 4096 + ((i) & 3) * 1024)); vhi[i] = vtr(vp_ + (((i) >> 2) * 4096 + ((i) & 3) * 1024 + 512)); } while (0)
#define KRD(Gf, jj) do { if (Gf) { kload2(kf, kp0 + sl_next, jj); SBAR(); } } while (0)
#define XF (XFIRST && NK > 4)
#define STEP(C0, C1, P0, P1, t, GK, GV, GL) do { SBAR(); \
    const lds_cptr vp_ = vp0 + sl_prev; \
    if (XF) { C0 = MF(CIN, kf[8 % (2 * NK)], qr[4 % NK]); C1 = MF(CIN, kf[9 % (2 * NK)], qr[4 % NK]); \
        if (NK > 5) { C0 = MF(C0, kf[10 % (2 * NK)], qr[5 % NK]); C1 = MF(C1, kf[11 % (2 * NK)], qr[5 % NK]); } SBAR(); } \
    if (VLATE < 2) { VRD(0); SBAR(); } float sacc = (P0[0] + P0[1]); \
    GAPA(C0 = MF((XF ? C0 : CIN), kf[0], qr[0]), P0[2], P0[3], P0[4], P0[5],     pw0[0] = PKW(P0, 0), pw0[1] = PKW(P0, 2), pw0); \
    if (VLATE < 2) { VRD(4); SBAR(); } GAPA(C1 = MF((XF ? C1 : CIN), kf[1], qr[0]), P0[6], P0[7], P0[8], P0[9],     pw0[2] = PKW(P0, 4), pw0[3] = PKW(P0, 6), pw0); \
    if (VLATE < 2) { VRD(1); SBAR(); } GAPA(C0 = MF(C0, kf[2], qr[1]),   P0[10], P0[11], P0[12], P0[13], pw1[0] = PKW(P0, 8), pw1[1] = PKW(P0, 10), pw1); \
    if (VLATE < 2) { VRD(5); SBAR(); } GAPA(C1 = MF(C1, kf[3], qr[1]),   P0[14], P0[15], P1[0], P1[1],   pw1[2] = PKW(P0, 12), pw1[3] = PKW(P0, 14), pw1); \
    if (VLATE == 0) { VRD(2); SBAR(); } GAPA(C0 = MF(C0, kf[4], qr[2]),   P1[2], P1[3], P1[4], P1[5],     pw2[0] = PKW(P1, 0), pw2[1] = PKW(P1, 2), pw2); \
    if (VLATE == 0) { VRD(6); SBAR(); } GAPA(C1 = MF(C1, kf[5], qr[2]),   P1[6], P1[7], P1[8], P1[9],     pw2[2] = PKW(P1, 4), pw2[3] = PKW(P1, 6), pw2); \
    if (VLATE == 0) { VRD(3); SBAR(); } if (VLATE == 2) { VRD(0); SBAR(); } GAPA(C0 = MF(C0, kf[6], qr[3]),   P1[10], P1[11], P1[12], P1[13], pw3[0] = PKW(P1, 8), pw3[1] = PKW(P1, 10), pw3); \
    if (VLATE == 0) { VRD(7); SBAR(); } if (VLATE == 2) { VRD(4); SBAR(); } GAPA(C1 = MF(C1, kf[7], qr[3]),   P1[14], P1[15], 0.f, 0.f,       pw3[2] = PKW(P1, 12), pw3[3] = PKW(P1, 14), pw3); \
    if (NK > 4 && !XF) { C0 = MF(C0, kf[8 % (2 * NK)], qr[4 % NK]); C1 = MF(C1, kf[9 % (2 * NK)], qr[4 % NK]); SBAR(); } \
    if (NK > 5 && !XF) { C0 = MF(C0, kf[10 % (2 * NK)], qr[5 % NK]); C1 = MF(C1, kf[11 % (2 * NK)], qr[5 % NK]); SBAR(); } \
    l_reg += sacc; \
    if (NONEGM) { _Pragma("unroll") for (int r = 0; r < 16; ++r) { C0[r] -= mhat; C1[r] -= mhat; } } \
    if (GK) { DMA_KM((t) + 3, sl_cur); } if (GV) { DMA_VM((t) + 1, sl_next); } \
    CMASK(C0, C1, t); \
    { float a = MX3(C0[0], C0[1], C1[0]), b = MX3(C0[2], C0[3], C1[1]); a = MX3(a, C1[2], C1[3]); \
      _Pragma("unroll") for (int r = 4; r < 16; r += 4) { a = MX3(a, C0[r], C0[r + 1]); b = MX3(b, C0[r + 2], C0[r + 3]); a = MX3(a, C1[r], C1[r + 1]); b = MX3(b, C1[r + 2], C1[r + 3]); } \
      float rm = __builtin_fmaxf(a, b); { auto rr = __builtin_amdgcn_permlane32_swap(__float_as_uint(rm), __float_as_uint(rm), false, false); rm = __builtin_fmaxf(__uint_as_float(rr[0]), __uint_as_float(rr[1])); } \
      resc = false; \
      if (__builtin_expect(__any(rm > (float)THRL), 0)) { const float dl = __builtin_fmaxf(rm, 0.f); mhat += dl; \
        _Pragma("unroll") for (int r = 0; r < 16; ++r) { C0[r] -= dl; C1[r] -= dl; } \
        SETREF(); \
        const float f = __builtin_amdgcn_exp2f(-dl); l_reg *= f; if (hi == 0) wsf[r32] = f; resc = true; } } \
    SBAR(); \
    if (VLATE == 1) { VRD(2); SBAR(); } if (VLATE == 2) { VRD(1); SBAR(); } GAPB(o[0] = MF(o[0], PAF(0), VFR(0)), C0, 0); \
    if (VLATE == 1) { VRD(6); SBAR(); } if (VLATE == 2) { VRD(5); SBAR(); } GAPB(o[1] = MF(o[1], PAF(0), VFR(4)), C0, 4); \
    if (VLATE == 1) { VRD(3); SBAR(); } if (VLATE == 2) { VRD(2); SBAR(); } KRD(GL, 0); GAPB(o[0] = MF(o[0], PAF(1), VFR(1)), C0, 8); \
    if (VLATE == 1) { VRD(7); SBAR(); } if (VLATE == 2) { VRD(6); SBAR(); } KRD(GL, 1); GAPB(o[1] = MF(o[1], PAF(1), VFR(5)), C0, 12); \
    if (VLATE == 2) { VRD(3); SBAR(); } KRD(GL, 2); GAPB(o[0] = MF(o[0], PAF(2), VFR(2)), C1, 0); \
    if (VLATE == 2) { VRD(7); SBAR(); } KRD(GL, 3); GAPB(o[1] = MF(o[1], PAF(2), VFR(6)), C1, 4); \
    if (NK > 4) KRD(GL, 4 % NK); GAPB(o[0] = MF(o[0], PAF(3), VFR(3)), C1, 8); \
    if (NK > 5) KRD(GL, 5 % NK); GAPB(o[1] = MF(o[1], PAF(3), VFR(7)), C1, 12); \
    } while (0)
    int t = 1;
#undef CMASK
#define CMASK(P0, P1, t) do { } while (0)
    for (; t + 5 < NT; t += 2) {
        STEP(pB0, pB1, pA0, pA1, t, true, true, true);     WAIT_KV(); RESC(); ROT();
        STEP(pA0, pA1, pB0, pB1, t + 1, true, true, true); WAIT_KV(); RESC(); ROT();
    }
#undef CMASK
#define CMASK(P0, P1, t) do { int jb_ = (t) - (NT - 4); if (jb_ >= 0) cmask(P0, P1, jb_, qrel, hi); } while (0)
#define ENDW(tt) do { if ((tt) + 3 < NT) { WAIT_KV(); } else if ((tt) + 2 < NT) { WAIT_BAR(1); } else { WAIT_BAR(0); } } while (0)
    for (; t + 1 < NT; t += 2) {
        STEP(pB0, pB1, pA0, pA1, t, (t + 3 < NT), (t + 1 < NT), (t + 1 < NT));       ENDW(t);     RESC(); ROT();
        STEP(pA0, pA1, pB0, pB1, t + 1, (t + 4 < NT), (t + 2 < NT), (t + 2 < NT));   ENDW(t + 1); RESC(); ROT();
    }
    { float sacc = pA0[0] + pA0[1];
#pragma unroll
      for (int r = 2; r < 16; ++r) sacc += pA0[r];
#pragma unroll
      for (int r = 0; r < 16; ++r) sacc += pA1[r];
      l_reg += sacc;
      pw0 = (u32x4){PKW(pA0, 0), PKW(pA0, 2), PKW(pA0, 4), PKW(pA0, 6)}; pw1 = (u32x4){PKW(pA0, 8), PKW(pA0, 10), PKW(pA0, 12), PKW(pA0, 14)}; pw2 = (u32x4){PKW(pA1, 0), PKW(pA1, 2), PKW(pA1, 4), PKW(pA1, 6)}; pw3 = (u32x4){PKW(pA1, 8), PKW(pA1, 10), PKW(pA1, 12), PKW(pA1, 14)};
      SBAR(); pv(o, vb0 + sl_prev, PAF(0), PAF(1), PAF(2), PAF(3)); }
    { auto rr = __builtin_amdgcn_permlane32_swap(__float_as_uint(l_reg), __float_as_uint(l_reg), false, false); l_reg = __uint_as_float(rr[0]) + __uint_as_float(rr[1]); }
    if (hi == 0) wsf[32 + r32] = l_reg; asm volatile("s_waitcnt lgkmcnt(0)" ::: "memory");
    float rli[16];
#pragma unroll
    for (int r = 0; r < 16; ++r) rli[r] = __builtin_amdgcn_rcpf(wsf[32 + crow(r, hi)]);
    bf16* Ow = Ob + (size_t)(q0 + wid * 32) * OP;
    { bf16* stg = (bf16*)(shm + LDS_OST) + wid * 2048;
#pragma unroll
      for (int r = 0; r < 16; ++r) { const int orow = crow(r, hi);
#pragma unroll
          for (int d0 = 0; d0 < 2; ++d0) stg[orow * 64 + d0 * 32 + r32] = f2bf(o[d0][r] * rli[r]); }
      asm volatile("s_waitcnt lgkmcnt(0)" ::: "memory");
#pragma unroll
      for (int i = 0; i < 4; ++i) { const int row = i * 8 + (lane >> 3), ch = lane & 7; const u32x4 v = *(const u32x4*)(stg + row * 64 + ch * 8); *(u32x4*)(Ow + (size_t)row * OP + ch * 8) = v; } }
    asm volatile("s_waitcnt vmcnt(0) lgkmcnt(0)\n\ts_barrier" ::: "memory");
#undef SETREF
#undef CIN
#undef RFL
#undef DMA_KP
#undef DMA_K0
#undef DMA_KM
#undef DMA_V0
#undef DMA_VM
#undef WAIT_KV
#undef CMASK
#undef START
#undef RESC
#undef ROT
#undef PKW
#undef PAF
#undef VFR
#undef PIN
#undef MX3
#undef MF
#undef GAPA
#undef GAPB
#undef EX
#undef VRD
#undef KRD
#undef STEP
#undef XF
#undef ENDW
}
#undef SBAR
#undef WAIT_BAR
}
static_assert(fb::Geo<6>::LDS_BYTES <= 131072, "attention LDS");

#ifndef FB_THR
#define FB_THR 8
#endif
#ifndef USE_FB_A
#define USE_FB_A USE_FB
#endif
#ifndef USE_FB_B
#define USE_FB_B 1
#endif
#ifndef FBB_XFIRST
#define FBB_XFIRST true
#endif
#ifndef FBB_VLATE
#define FBB_VLATE 2
#endif
#ifndef FBB_NONEGM
#define FBB_NONEGM true
#endif
__device__ __forceinline__ void attn_main_mfma(const Ctx& c0, int layer) {
#define LAUNDER() Ctx c = c0; asm volatile("" : "+v"(c.tid)); c.lane = c.tid & 63; c.wave = __builtin_amdgcn_readfirstlane(c.tid >> 6);
    const int vcu = (c0.G % 8 == 0) ? (c0.bid % 8) * (c0.G / 8) + c0.bid / 8 : c0.bid;
    char* shm = (char*)(__attribute__((address_space(0))) char*)c0.lds; (void)shm;
#ifdef PROBE_DUP_A
    { LAUNDER()
#pragma nounroll
    for (int uu = 2 * vcu; uu < 512; uu += 2 * c.G) {
#pragma nounroll
        for (int k = 0; k < 2; ++k) {
            const int u = uu >> 1, bh = u >> 3, s8 = u & 7, b = bh >> 3, h = bh & 7, j = k ? s8 : 15 - s8; const size_t r0 = (size_t)b * SEQ;
            fb::attn_unit<5, true, PQA, PKA, PVA, PY, FB_THR>(WSP(bf16, WS_QA) + r0 * PQA + h * 64, WSP(bf16, WS_KA) + h * 80, WSP(bf16, WS_KA) + (FR + r0) * PKA + h * 80, WSP(bf16, WS_VA) + h * 64, WSP(bf16, WS_VA) + (FR + r0) * PVA + h * 64, WSP(bf16, WS_YB) + r0 * PY + h * 64, j, shm, c.tid);
        }
    }
    }
#endif
#ifdef PROBE_DUP_C
    { LAUNDER()
#pragma nounroll
    for (int uu = 2 * vcu; uu < 512; uu += 2 * c.G) {
#pragma nounroll
        for (int k = 0; k < 2; ++k) {
            const int u = uu >> 1, bh = u >> 3, s8 = u & 7, b = bh >> 3, h = bh & 7, j = k ? s8 : 15 - s8; const size_t r0 = (size_t)b * SEQ;
            const fa::Tensors TC{WSP(bf16, WS_QC) + r0 * PQC, PQC, h * 64, WSP(bf16, WS_KC), WSP(bf16, WS_KC) + (FR + r0) * PKC, PKC, (h >> 2) * 64, WSP(bf16, WS_VC), WSP(bf16, WS_VC) + (FR + r0) * PVC, PVC, (h >> 2) * 64, WSP(bf16, WS_YB) + r0 * PY, PY, h * 64};
            fa::attn_unit<4, 2>(c, TC, j, c.sinks[layer * 8 + h] * LOG2E);
        }
    }
    }
#endif
#ifndef REP_B
#define REP_B 1
#endif
#ifndef REP_C
#define REP_C 1
#endif
#pragma nounroll
    for (int rep = 0; rep < REP_B; ++rep)
    { LAUNDER()
#pragma nounroll
    for (int uu = 2 * vcu; uu < 512; uu += 2 * c.G) {
#pragma nounroll
        for (int k = 0; k < 2; ++k) {
            const int u = uu >> 1, bh = u >> 3, s8 = u & 7, b = bh >> 3, h = bh & 7, j = k ? s8 : 15 - s8; const size_t r0 = (size_t)b * SEQ;
#if USE_FB_B
            fb::attn_unit<6, false, PQB, PKB, PVB, PY, FB_THR, FBB_XFIRST, FBB_VLATE, FBB_NONEGM>(WSP(bf16, WS_QB) + r0 * PQB + h * 96, WSP(bf16, WS_KB) + h * 96, WSP(bf16, WS_KB) + (FR + r0) * PKB + h * 96, WSP(bf16, WS_VB) + h * 64, WSP(bf16, WS_VB) + (FR + r0) * PVB + h * 64, WSP(bf16, WS_YB) + r0 * PY + h * 64, j, shm, c.tid);
#else
            const fa::Tensors TB{WSP(bf16, WS_QB) + r0 * PQB, PQB, h * 96, WSP(bf16, WS_KB), WSP(bf16, WS_KB) + (FR + r0) * PKB, PKB, h * 96, WSP(bf16, WS_VB), WSP(bf16, WS_VB) + (FR + r0) * PVB, PVB, h * 64, WSP(bf16, WS_YB) + r0 * PY, PY, h * 64};
            fa::attn_unit<6, 1>(c, TB, j, 0.f);
#endif
        }
    }
    }
#ifndef NO_AC
    { LAUNDER()
#pragma nounroll
    for (int uu = 2 * vcu; uu < 512; uu += 2 * c.G) {
#pragma nounroll
        for (int k = 0; k < 2; ++k) {
            const int u = uu >> 1, bh = u >> 3, s8 = u & 7, b = bh >> 3, h = bh & 7, j = k ? s8 : 15 - s8; const size_t r0 = (size_t)b * SEQ;
#if USE_FB_A
            fb::attn_unit<5, true, PQA, PKA, PVA, PQA, FB_THR>(WSP(bf16, WS_QA) + r0 * PQA + h * 64, WSP(bf16, WS_KA) + h * 80, WSP(bf16, WS_KA) + (FR + r0) * PKA + h * 80, WSP(bf16, WS_VA) + h * 64, WSP(bf16, WS_VA) + (FR + r0) * PVA + h * 64, WSP(bf16, WS_QA) + r0 * PQA + h * 64, j, shm, c.tid);
#else
            const fa::Tensors TA{WSP(bf16, WS_QA) + r0 * PQA, PQA, h * 64, WSP(bf16, WS_KA), WSP(bf16, WS_KA) + (FR + r0) * PKA, PKA, h * 80, WSP(bf16, WS_VA), WSP(bf16, WS_VA) + (FR + r0) * PVA, PVA, h * 64, WSP(bf16, WS_QA) + r0 * PQA, PQA, h * 64};
            fa::attn_unit<5, 0>(c, TA, j, 0.f);
#endif
        }
    }
    }
    { LAUNDER()
#pragma nounroll
    for (int uu = 2 * vcu; uu < 512; uu += 2 * c.G) {
#pragma nounroll
        for (int k = 0; k < 2; ++k) {
            const int u = uu >> 1, bh = u >> 3, s8 = u & 7, b = bh >> 3, h = bh & 7, j = k ? s8 : 15 - s8; const size_t r0 = (size_t)b * SEQ;
            const fa::Tensors TC{WSP(bf16, WS_QC) + r0 * PQC, PQC, h * 64, WSP(bf16, WS_KC), WSP(bf16, WS_KC) + (FR + r0) * PKC, PKC, (h >> 2) * 64, WSP(bf16, WS_VC), WSP(bf16, WS_VC) + (FR + r0) * PVC, PVC, (h >> 2) * 64, WSP(bf16, WS_QC) + r0 * PQC, PQC, h * 64};
            fa::attn_unit<4, 2>(c, TC, j, c.sinks[layer * 8 + h] * LOG2E);
        }
    }
    }
#endif
#undef LAUNDER
}

__device__ __forceinline__ void attn_meta(const Ctx& c) {
    if (c.tid >= 384) return;
    const int br = c.tid / 128, h = (c.tid >> 4) & 7, r = c.tid & 15; bf16* ym = WSP(bf16, WS_YM) + (size_t)r * 1536 + br * 512 + h * 64;
    if (br == 0) attn_row<64, 0>(WSP(bf16, WS_QAM) + r * PQA + h * 64, WSP(bf16, WS_KA), WSP(bf16, WS_KA), PKA, h * 80, WSP(bf16, WS_VA), WSP(bf16, WS_VA), PVA, h * 64, r, 0.f, ym);
    else if (br == 1) attn_row<96, 1>(WSP(bf16, WS_QBM) + r * PQB + h * 96, WSP(bf16, WS_KB), WSP(bf16, WS_KB), PKB, h * 96, WSP(bf16, WS_VB), WSP(bf16, WS_VB), PVB, h * 64, r, 0.f, ym);
    else attn_row<64, 2>(WSP(bf16, WS_QCM) + r * PQC + h * 64, WSP(bf16, WS_KC), WSP(bf16, WS_KC), PKC, (h >> 2) * 64, WSP(bf16, WS_VC), WSP(bf16, WS_VC), PVC, (h >> 2) * 64, r, c.sinks[h] * LOG2E, ym);
}

struct Unit { int pm, pn, z; };
__device__ __forceinline__ int perm32(int rho) { const int n = rho >> 4, i = rho & 15; return 8 * (i >> 2) + 4 * n + (i & 3); }
template <class Prob, class Epi, class Sched>
__device__ __forceinline__ void gemm_naive(const Ctx& c, const Prob& P, const Sched& S, const Epi& E) {
    const int wr = c.wave >> 2, wc = c.wave & 3, fr = c.lane & 15, fq = c.lane >> 4;
    Unit u;
    for (int ui = 0; S.next(ui, u); ++ui) {
        const bf16* A; const bf16* Bt; P.operands(u, A, Bt);
        const int K = P.K, lda = P.K;
        f32x4 acc[2][2][4][2];
#pragma unroll
        for (int a = 0; a < 2; ++a)
#pragma unroll
            for (int b = 0; b < 2; ++b)
#pragma unroll
                for (int m = 0; m < 4; ++m)
#pragma unroll
                    for (int n = 0; n < 2; ++n) acc[a][b][m][n] = (f32x4){0.f, 0.f, 0.f, 0.f};
        for (int k0 = 0; k0 < K; k0 += 64) {
#pragma unroll
            for (int ai = 0; ai < 2; ++ai) {
#pragma unroll
                for (int bj = 0; bj < 2; ++bj) {
                    bf16x8 Bf[2][2];
#pragma unroll
                    for (int n = 0; n < 2; ++n)
#pragma unroll
                        for (int k = 0; k < 2; ++k) Bf[n][k] = *(const bf16x8*)(Bt + (size_t)(256 * u.pn + 128 * bj + 32 * wc + perm32(16 * n + fr)) * K + k0 + 32 * k + 8 * fq);
#pragma unroll
                    for (int m = 0; m < 4; ++m) {
                        bf16x8 At[2];
#pragma unroll
                        for (int k = 0; k < 2; ++k) At[k] = *(const bf16x8*)(A + (size_t)(256 * u.pm + 128 * ai + 64 * wr + 16 * m + fr) * lda + k0 + 32 * k + 8 * fq);
#pragma unroll
                        for (int n = 0; n < 2; ++n)
#pragma unroll
                            for (int k = 0; k < 2; ++k) acc[ai][bj][m][n] = __builtin_amdgcn_mfma_f32_16x16x32_bf16(Bf[n][k], At[k], acc[ai][bj][m][n], 0, 0, 0);
                    }
                }
            }
        }
        asm volatile("" ::: "memory");
        E(acc, u, wr, wc, fr, fq);
    }
}
struct ProbSimple { const bf16* A; const bf16* Bt; int K;
    __device__ __forceinline__ void operands(const Unit&, const bf16*& a, const bf16*& b) const { a = A; b = Bt; } };
struct ProbBranch { const bf16 *A0, *A1, *A2; const bf16* Bt; int K;
    __device__ __forceinline__ void operands(const Unit& u, const bf16*& a, const bf16*& b) const { a = (u.z == 0) ? A0 : (u.z == 1) ? A1 : A2; b = Bt + (size_t)u.z * DM * 512; } };

namespace pg8 {
constexpr int BM = 256, BK = 64, HALF = 128, HTB = HALF * BK * 2, STAGE_BYTES = 8 * HTB, NXCD = 8, WGM = 8;
__host__ __device__ __forceinline__ int lds_byte(int r, int c) { const int st = (r >> 4) * 2 + (c >> 5), rr = r & 15, cc = c & 31, ob = rr * 64 + cc * 2; return st * 1024 + (ob ^ (((ob >> 9) & 1) << 5)); }
__host__ __device__ __forceinline__ void stage_rc(int b, int& R, int& C) { const int st = b / 1024, sb = b % 1024, swz = sb ^ (((sb >> 9) & 1) << 5); R = (st >> 1) * 16 + swz / 64; C = (st & 1) * 32 + (swz % 64) / 2; }
template <int ZN>
struct StaticOrder {
    int nM, nN, nwg, G, c, pn0;
    __device__ __forceinline__ void init(int nM_, int nN_, int pn0_, int G_, int c_) { nM = nM_; nN = nN_; nwg = nM * nN; G = G_; c = c_; pn0 = pn0_; }
    __device__ __forceinline__ bool next(int i, Unit& u) const {
        const int it = i / ZN;
        const long L = (long)it * G + c; if (L >= nwg) return false;
        int wgid = (int)L; { const int q = nwg / NXCD, r = nwg % NXCD, xcd = wgid % NXCD, off = wgid / NXCD; wgid = (xcd < r ? xcd * (q + 1) : r * (q + 1) + (xcd - r) * q) + off; }
        const int nig = WGM * nN, gid = wgid / nig, fm = gid * WGM, gsz = (nM - fm) < WGM ? (nM - fm) : WGM;
        u.pm = fm + ((wgid % nig) % gsz); u.pn = pn0 + (wgid % nig) / gsz; u.z = i - it * ZN; return true;
    }
};
template <class Prob, class Epi, class Sched, bool ALIGN_EPI, bool SP2>
__device__ __forceinline__ void gemm_phase(LAS unsigned char* lds, const Prob& P, const Sched& S, const Epi& E) {
    const int tid = threadIdx.x, wid = __builtin_amdgcn_readfirstlane(tid >> 6), lane = tid & 63, wr = wid >> 2, wc = wid & 3, fr = lane & 15, fq = lane >> 4;
    const int K = P.K, nt = K / BK;
    unsigned voffA[2], voffB[2];
#pragma unroll
    for (int i = 0; i < 2; ++i) { int R, C; stage_rc(tid * 16 + i * 8192, R, C); const int Rb = (R & ~31) + perm32(R & 31);
        voffA[i] = (unsigned)(R * K + C) * 2u; voffB[i] = (unsigned)(Rb * K + C) * 2u; }
    const size_t kstep = (size_t)(BK * 2);
    const size_t hstep = (size_t)HALF * K * 2;
    const size_t tstep = 2 * hstep;
    const unsigned ldsw = (unsigned)wid * 1024u;
    const int aoff = lds_byte(wr * 64 + fr, fq * 8), boff = lds_byte(wc * 32 + fr, fq * 8);
#define PG8_SA(b, h) (((b) * 2 + (h)) * HTB)
#define PG8_SB(b, h) ((4 + (b) * 2 + (h)) * HTB)
#define PG8_STAGE(bufoff, gbase, voff) do { _Pragma("unroll") for (int _i = 0; _i < 2; ++_i) \
        __builtin_amdgcn_global_load_lds((const unsigned*)((const char*)(gbase) + (voff)[_i]), (LAS unsigned*)(lds + (bufoff) + ldsw + _i * 8192), 16, 0, 0); } while (0)
#define PG8_LDA(dst, b, h) do { _Pragma("unroll") for (int m = 0; m < 4; ++m) _Pragma("unroll") for (int k = 0; k < 2; ++k) dst[m][k] = *(const LAS bf16x8*)(lds + PG8_SA(b, h) + aoff + m * 2048 + k * 1024); } while (0)
#define PG8_LDB(dst, b, h) do { _Pragma("unroll") for (int n = 0; n < 2; ++n) _Pragma("unroll") for (int k = 0; k < 2; ++k) dst[n][k] = *(const LAS bf16x8*)(lds + PG8_SB(b, h) + boff + n * 2048 + k * 1024); } while (0)
#define PG8_MMA(ai, bj, At, Bt) do { __builtin_amdgcn_s_setprio(1); _Pragma("unroll") for (int m = 0; m < 4; ++m) _Pragma("unroll") for (int n = 0; n < 2; ++n) _Pragma("unroll") for (int k = 0; k < 2; ++k) \
        acc[ai][bj][m][n] = __builtin_amdgcn_mfma_f32_16x16x32_bf16(Bt[n][k], At[m][k], acc[ai][bj][m][n], 0, 0, 0); __builtin_amdgcn_s_setprio(0); } while (0)
#define PG8_WAIT_V(n) asm volatile("s_waitcnt vmcnt(" #n ")" ::: "memory")
#define PG8_WAIT_L(n) asm volatile("s_waitcnt lgkmcnt(" #n ")" ::: "memory")
#define PG8_BAR __builtin_amdgcn_s_barrier()
#define PG8_SCHED __builtin_amdgcn_sched_barrier(0)
    Unit cur, nxt; int ui = 0;
    if (!S.next(0, cur)) return;
    f32x4 acc[2][2][4][2];
#pragma unroll
    for (int a = 0; a < 2; ++a)
#pragma unroll
        for (int b = 0; b < 2; ++b)
#pragma unroll
            for (int m = 0; m < 4; ++m)
#pragma unroll
                for (int n = 0; n < 2; ++n) acc[a][b][m][n] = (f32x4){0.f, 0.f, 0.f, 0.f};
    bf16x8 At[4][2], B0[2][2], B1[2][2];
    const char* cA; const char* cB;
    { const bf16 *pa, *pb; P.operands(cur, pa, pb); cA = (const char*)pa + (size_t)cur.pm * tstep; cB = (const char*)pb + (size_t)cur.pn * tstep; }
    if constexpr (SP2) {
        PG8_STAGE(PG8_SB(0, 0), cB, voffB); PG8_STAGE(PG8_SB(0, 1), cB + hstep, voffB); PG8_STAGE(PG8_SA(0, 0), cA, voffA); PG8_STAGE(PG8_SA(0, 1), cA + hstep, voffA);
        if (wr == 1) PG8_BAR;
        PG8_WAIT_V(2); PG8_BAR;
        PG8_STAGE(PG8_SB(1, 0), cB + kstep, voffB); PG8_STAGE(PG8_SA(1, 0), cA + kstep, voffA); PG8_STAGE(PG8_SB(1, 1), cB + hstep + kstep, voffB);
        PG8_WAIT_V(6); PG8_BAR;
    } else {
        PG8_STAGE(PG8_SB(0, 0), cB, voffB); PG8_STAGE(PG8_SA(0, 0), cA, voffA); PG8_STAGE(PG8_SB(0, 1), cB + hstep, voffB); PG8_STAGE(PG8_SA(0, 1), cA + hstep, voffA);
        if (wr == 1) PG8_BAR;
        PG8_WAIT_V(4); PG8_BAR;
        PG8_STAGE(PG8_SB(1, 0), cB + kstep, voffB); PG8_STAGE(PG8_SA(1, 0), cA + kstep, voffA); PG8_STAGE(PG8_SB(1, 1), cB + hstep + kstep, voffB);
        PG8_WAIT_V(6); PG8_BAR;
    }
    for (;;) {
        const bool has_next = S.next(ui + 1, nxt);
        const char* nA = cA; const char* nB = cB;
        if (has_next) { const bf16 *pa, *pb; P.operands(nxt, pa, pb); nA = (const char*)pa + (size_t)nxt.pm * tstep; nB = (const char*)pb + (size_t)nxt.pn * tstep; }
        for (int t = 0; t < nt; t += 2) {
            const bool last = (t == nt - 2);
            const char* a1 = cA + (size_t)(t + 1) * kstep;
            const char* a2 = last ? nA : cA + (size_t)(t + 2) * kstep; const char* b2 = last ? nB : cB + (size_t)(t + 2) * kstep;
            const char* a3 = a2 + kstep; const char* b3 = b2 + kstep;
            if constexpr (SP2) {
            PG8_LDB(B0, 0, 0); PG8_LDB(B1, 0, 1); PG8_SCHED; PG8_LDA(At, 0, 0); PG8_STAGE(PG8_SA(1, 1), a1 + hstep, voffA);
            PG8_WAIT_V(8); PG8_WAIT_L(0); PG8_BAR; PG8_MMA(0, 0, At, B0); PG8_MMA(0, 1, At, B1); PG8_BAR; PG8_SCHED;
            PG8_LDA(At, 0, 1); PG8_STAGE(PG8_SB(0, 0), b2, voffB); PG8_STAGE(PG8_SB(0, 1), b2 + hstep, voffB); PG8_STAGE(PG8_SA(0, 0), a2, voffA);
            PG8_WAIT_V(8); PG8_WAIT_L(0); PG8_BAR; PG8_MMA(1, 0, At, B0); PG8_MMA(1, 1, At, B1); PG8_BAR; PG8_SCHED;
            PG8_LDB(B0, 1, 0); PG8_LDB(B1, 1, 1); PG8_SCHED; PG8_LDA(At, 1, 0); PG8_STAGE(PG8_SA(0, 1), a2 + hstep, voffA);
            PG8_WAIT_V(8); PG8_WAIT_L(0); PG8_BAR; PG8_MMA(0, 0, At, B0); PG8_MMA(0, 1, At, B1); PG8_BAR; PG8_SCHED;
            PG8_LDA(At, 1, 1); PG8_STAGE(PG8_SB(1, 0), b3, voffB); PG8_STAGE(PG8_SB(1, 1), b3 + hstep, voffB); PG8_STAGE(PG8_SA(1, 0), a3, voffA);
            PG8_WAIT_V(8); PG8_WAIT_L(0); PG8_BAR; PG8_MMA(1, 0, At, B0); PG8_MMA(1, 1, At, B1); PG8_BAR; PG8_SCHED;
            } else {
            PG8_LDB(B0, 0, 0); PG8_SCHED; PG8_LDA(At, 0, 0); PG8_STAGE(PG8_SA(1, 1), a1 + hstep, voffA);
            PG8_WAIT_L(8); PG8_BAR; PG8_WAIT_L(0); PG8_MMA(0, 0, At, B0); PG8_BAR; PG8_SCHED;
            PG8_LDB(B1, 0, 1); PG8_STAGE(PG8_SB(0, 0), b2, voffB);
            PG8_BAR; PG8_WAIT_L(0); PG8_MMA(0, 1, At, B1); PG8_BAR;
            PG8_LDA(At, 0, 1); PG8_STAGE(PG8_SA(0, 0), a2, voffA);
            PG8_BAR; PG8_WAIT_L(0); PG8_MMA(1, 0, At, B0); PG8_BAR; PG8_SCHED;
            PG8_STAGE(PG8_SB(0, 1), b2 + hstep, voffB);
            PG8_WAIT_V(6); PG8_BAR; PG8_MMA(1, 1, At, B1); PG8_BAR;
            PG8_LDB(B0, 1, 0); PG8_SCHED; PG8_LDA(At, 1, 0); PG8_STAGE(PG8_SA(0, 1), a2 + hstep, voffA);
            PG8_WAIT_L(8); PG8_BAR; PG8_WAIT_L(0); PG8_MMA(0, 0, At, B0); PG8_BAR; PG8_SCHED;
            PG8_LDB(B1, 1, 1); PG8_STAGE(PG8_SB(1, 0), b3, voffB);
            PG8_BAR; PG8_WAIT_L(0); PG8_MMA(0, 1, At, B1); PG8_BAR;
            PG8_LDA(At, 1, 1); PG8_STAGE(PG8_SA(1, 0), a3, voffA);
            PG8_BAR; PG8_WAIT_L(0); PG8_MMA(1, 0, At, B0); PG8_BAR; PG8_SCHED;
            PG8_STAGE(PG8_SB(1, 1), b3 + hstep, voffB);
            PG8_WAIT_V(6); PG8_BAR; PG8_MMA(1, 1, At, B1); PG8_BAR;
            }
        }
        if constexpr (ALIGN_EPI) { if (wr == 0) PG8_BAR; }
        E(acc, cur, wr, wc, fr, fq);
        if (!has_next) break;
#pragma unroll
        for (int a = 0; a < 2; ++a)
#pragma unroll
            for (int b = 0; b < 2; ++b)
#pragma unroll
                for (int m = 0; m < 4; ++m)
#pragma unroll
                    for (int n = 0; n < 2; ++n) acc[a][b][m][n] = (f32x4){0.f, 0.f, 0.f, 0.f};
        cur = nxt; cA = nA; cB = nB; ++ui;
        if constexpr (ALIGN_EPI) { if (wr == 1) PG8_BAR; }
    }
    PG8_WAIT_V(0);
    if constexpr (!ALIGN_EPI) { if (wr == 0) PG8_BAR; }
    PG8_BAR;
#undef PG8_SA
#undef PG8_SB
#undef PG8_STAGE
#undef PG8_LDA
#undef PG8_LDB
#undef PG8_MMA
#undef PG8_WAIT_V
#undef PG8_WAIT_L
#undef PG8_BAR
#undef PG8_SCHED
}
}
#ifndef USE_PG8
#define USE_PG8 1
#endif
template <int ZN, class Prob, class Epi>
__device__ __forceinline__ void gemm_run(const Ctx& c, const Prob& P, const Epi& E, int nM, int nN, int pn0) {
#if USE_PG8
    pg8::StaticOrder<ZN> S; S.init(nM, nN, pn0, c.G, c.bid);
    pg8::gemm_phase<Prob, Epi, pg8::StaticOrder<ZN>, true, true>(c.lds, P, S, E);
#else
    pg8::StaticOrder<ZN> S; S.init(nM, nN, pn0, c.G, c.bid);
    gemm_naive(c, P, S, E);
#endif
}

#define EPI_ROWS_BEGIN _Pragma("unroll") for (int ai = 0; ai < 2; ++ai) _Pragma("unroll") for (int m = 0; m < 4; ++m) { const int row = 256 * u.pm + 128 * ai + 64 * wr + 16 * m + fr; \
    const f32x4 l0 = acc[ai][0][m][0], l1 = acc[ai][0][m][1], h0 = acc[ai][1][m][0], h1 = acc[ai][1][m][1]; (void)l0; (void)l1; (void)h0; (void)h1;
#define EPI_ROWS_END if (m == 3) asm volatile("" ::: "memory"); }
typedef f32x4 Acc_t[2][2][4][2];

__device__ __forceinline__ void rope8(const float* cs, const float* sn, f32x4 x1a, f32x4 x1b, f32x4 x2a, f32x4 x2b, float sc, f32x4& o1a, f32x4& o1b, f32x4& o2a, f32x4& o2b) {
    const f32x4 ca = *(const f32x4*)cs, cb = *(const f32x4*)(cs + 4), sa = *(const f32x4*)sn, sb = *(const f32x4*)(sn + 4);
    o1a = (x1a * ca - x2a * sa) * sc; o1b = (x1b * cb - x2b * sb) * sc; o2a = (x2a * ca + x1a * sa) * sc; o2b = (x2b * cb + x1b * sb) * sc;
}
struct EpiEarly {
    const Ctx& c; int layer;
    __device__ __forceinline__ void operator()(const Acc_t& acc, const Unit& u, int wr, int wc, int fr, int fq) const {
        const int c8 = 32 * wc + 8 * fq, t = u.pn;
        bf16 *QA = WSP(bf16, WS_QA), *KA = WSP(bf16, WS_KA) + (size_t)FR * PKA, *VA = WSP(bf16, WS_VA) + (size_t)FR * PVA, *QC = WSP(bf16, WS_QC), *KC = WSP(bf16, WS_KC) + (size_t)FR * PKC,
             *VC = WSP(bf16, WS_VC) + (size_t)FR * PVC, *CQ = WSP(bf16, WS_CQ), *CKV = WSP(bf16, WS_CKV), *KB = WSP(bf16, WS_KB) + (size_t)FR * PKB;
        const float *cos64 = WSP(float, WS_COS64), *sin64 = WSP(float, WS_SIN64), *cos32 = WSP(float, WS_COS32), *sin32 = WSP(float, WS_SIN32);
        if (t < 2) { EPI_ROWS_BEGIN st8(QA + (size_t)row * PQA + 256 * t + c8, l0 * C2A, l1 * C2A); st8(QA + (size_t)row * PQA + 256 * t + 128 + c8, h0 * C2A, h1 * C2A); EPI_ROWS_END }
        else if (t < 4) { const int L0 = 256 * (t - 2) + c8, L1 = L0 + 128;
            EPI_ROWS_BEGIN st8(KA + (size_t)row * PKA + (L0 >> 6) * 80 + (L0 & 63), l0, l1); st8(KA + (size_t)row * PKA + (L1 >> 6) * 80 + (L1 & 63), h0, h1); EPI_ROWS_END }
        else if (t < 6) { EPI_ROWS_BEGIN st8(VA + (size_t)row * PVA + 256 * (t - 4) + c8, l0, l1); st8(VA + (size_t)row * PVA + 256 * (t - 4) + 128 + c8, h0, h1); EPI_ROWS_END }
        else if (t < 8) { const int head = 4 * (t - 6) + wc, d = 8 * fq;
            EPI_ROWS_BEGIN const int pos = NMETA + (row & (SEQ - 1)); f32x4 o1a, o1b, o2a, o2b; rope8(cos64 + pos * 32 + d, sin64 + pos * 32 + d, l0, l1, h0, h1, C2C, o1a, o1b, o2a, o2b);
                st8(QC + (size_t)row * PQC + head * 64 + d, o1a, o1b); st8(QC + (size_t)row * PQC + head * 64 + 32 + d, o2a, o2b); EPI_ROWS_END }
        else if (t == 8) {
            if (wc < 2) { const int d = 8 * fq;
                EPI_ROWS_BEGIN const int pos = NMETA + (row & (SEQ - 1)); f32x4 o1a, o1b, o2a, o2b; rope8(cos64 + pos * 32 + d, sin64 + pos * 32 + d, l0, l1, h0, h1, 1.f, o1a, o1b, o2a, o2b);
                    st8(KC + (size_t)row * PKC + wc * 64 + d, o1a, o1b); st8(KC + (size_t)row * PKC + wc * 64 + 32 + d, o2a, o2b); EPI_ROWS_END }
            else { const int j = 32 * (wc - 2) + 8 * fq;
                EPI_ROWS_BEGIN st8(VC + (size_t)row * PVC + j, l0, l1); st8(VC + (size_t)row * PVC + 64 + j, h0, h1); EPI_ROWS_END } }
        else if (t == 9) { EPI_ROWS_BEGIN st8(CQ + (size_t)row * PCQ + c8, l0, l1); st8(CQ + (size_t)row * PCQ + 128 + c8, h0, h1); EPI_ROWS_END }
        else if (t == 10) {
            if (wc < 2) { EPI_ROWS_BEGIN st8(CQ + (size_t)row * PCQ + 256 + c8, l0, l1); st8(CQ + (size_t)row * PCQ + 256 + 64 + c8, h0, h1); EPI_ROWS_END }
            else if (wc == 2) {
                if (fq < 2) { const int d = 8 * fq;
                    EPI_ROWS_BEGIN const int pos = NMETA + (row & (SEQ - 1)); f32x4 o1a, o1b, o2a, o2b; rope8(cos32 + pos * 16 + d, sin32 + pos * 16 + d, l0, l1, h0, h1, 1.f, o1a, o1b, o2a, o2b);
                        const u32x4 w1 = pack8(o1a, o1b), w2 = pack8(o2a, o2b);
#pragma unroll
                        for (int h = 0; h < 8; ++h) { *(u32x4*)(KB + (size_t)row * PKB + h * 96 + 64 + d) = w1; *(u32x4*)(KB + (size_t)row * PKB + h * 96 + 80 + d) = w2; } EPI_ROWS_END }
                else if (fq == 2) { float* LF = WSP(float, WS_LF); const f32x4 b0 = *(const f32x4*)(c.b_f + layer * 8), b1 = *(const f32x4*)(c.b_f + layer * 8 + 4);
                    EPI_ROWS_BEGIN f32x4 a = l0 + b0, b = l1 + b1;
#pragma unroll
                        for (int j = 0; j < 4; ++j) { a[j] = logsigf_(a[j]); b[j] = logsigf_(b[j]); }
                        *(f32x4*)(LF + (size_t)row * 8) = a; *(f32x4*)(LF + (size_t)row * 8 + 4) = b; EPI_ROWS_END } } }
        else { EPI_ROWS_BEGIN st8(CKV + (size_t)row * PCKV + c8, l0, l1); st8(CKV + (size_t)row * PCKV + 128 + c8, h0, h1); EPI_ROWS_END }
    }
};
struct EpiUq {
    const Ctx& c;
    __device__ __forceinline__ void operator()(const Acc_t& acc, const Unit& u, int wr, int wc, int fr, int fq) const {
        bf16* QB = WSP(bf16, WS_QB); const float* RQ = WSP(float, WS_RQ); const float *cos32 = WSP(float, WS_COS32), *sin32 = WSP(float, WS_SIN32);
        const int c8 = 32 * wc + 8 * fq;
        if (u.pn < 2) { const int ha = 4 * u.pn + (c8 >> 6), hb = ha + 2, e = c8 & 63;
            EPI_ROWS_BEGIN const float sc = RQ[row] * C2B; st8(QB + (size_t)row * PQB + ha * 96 + e, l0 * sc, l1 * sc); st8(QB + (size_t)row * PQB + hb * 96 + e, h0 * sc, h1 * sc); EPI_ROWS_END }
        else { const int h = c8 >> 4, d = c8 & 15;
            EPI_ROWS_BEGIN const float sc = RQ[row] * C2B; const int pos = NMETA + (row & (SEQ - 1)); f32x4 o1a, o1b, o2a, o2b; rope8(cos32 + pos * 16 + d, sin32 + pos * 16 + d, l0, l1, h0, h1, sc, o1a, o1b, o2a, o2b);
                st8(QB + (size_t)row * PQB + h * 96 + 64 + d, o1a, o1b); st8(QB + (size_t)row * PQB + h * 96 + 80 + d, o2a, o2b); EPI_ROWS_END }
    }
};
struct EpiUkv {
    const Ctx& c;
    __device__ __forceinline__ void operator()(const Acc_t& acc, const Unit& u, int wr, int wc, int fr, int fq) const {
        bf16 *KB = WSP(bf16, WS_KB) + (size_t)FR * PKB, *VB = WSP(bf16, WS_VB) + (size_t)FR * PVB; const float* RKV = WSP(float, WS_RKV);
        const int c8 = 32 * wc + 8 * fq, ha = 2 * u.pn, hb = ha + 1;
        if (wc < 2) { EPI_ROWS_BEGIN const float sc = RKV[row]; st8(KB + (size_t)row * PKB + ha * 96 + c8, l0 * sc, l1 * sc); st8(KB + (size_t)row * PKB + hb * 96 + c8, h0 * sc, h1 * sc); EPI_ROWS_END }
        else { EPI_ROWS_BEGIN const float sc = RKV[row]; st8(VB + (size_t)row * PVB + ha * 64 + c8 - 64, l0 * sc, l1 * sc); st8(VB + (size_t)row * PVB + hb * 64 + c8 - 64, h0 * sc, h1 * sc); EPI_ROWS_END }
    }
};
struct EpiLateZ {
    const Ctx& c;
    __device__ __forceinline__ void operator()(const Acc_t& acc, const Unit& u, int wr, int wc, int fr, int fq) const {
        const int c8 = 32 * wc + 8 * fq, t = u.pn;
        bf16* Y = (t < 2) ? WSP(bf16, WS_QA) : (t < 4) ? WSP(bf16, WS_YB) : WSP(bf16, WS_QC); const int col = 256 * (t & 1) + c8;
        EPI_ROWS_BEGIN
            { bf16* p = Y + (size_t)row * PY + col; f32x4 ya, yb; ld8(p, ya, yb);
#pragma unroll
              for (int j = 0; j < 4; ++j) { ya[j] *= siluf_(l0[j]); yb[j] *= siluf_(l1[j]); }
              st8(p, ya, yb); }
            { bf16* p = Y + (size_t)row * PY + col + 128; f32x4 ya, yb; ld8(p, ya, yb);
#pragma unroll
              for (int j = 0; j < 4; ++j) { ya[j] *= siluf_(h0[j]); yb[j] *= siluf_(h1[j]); }
              st8(p, ya, yb); }
        EPI_ROWS_END
    }
};
struct EpiLateG {
    const Ctx& c;
    __device__ __forceinline__ void operator()(const Acc_t& acc, const Unit& u, int wr, int wc, int fr, int fq) const {
        bf16* Gp = WSP(bf16, WS_G); const int col = 256 * (u.pn - 6) + 32 * wc + 8 * fq;
        EPI_ROWS_BEGIN f32x4 a = l0, b = l1, cc = h0, d = h1;
#pragma unroll
            for (int j = 0; j < 4; ++j) { a[j] = sigmoidf_(a[j]); b[j] = sigmoidf_(b[j]); cc[j] = sigmoidf_(cc[j]); d[j] = sigmoidf_(d[j]); }
            st8(Gp + (size_t)row * PG + col, a, b); st8(Gp + (size_t)row * PG + col + 128, cc, d); EPI_ROWS_END
    }
};
struct EpiBranch {
    const Ctx& c;
    __device__ __forceinline__ void operator()(const Acc_t& acc, const Unit& u, int wr, int wc, int fr, int fq) const {
        const bf16* Gp = WSP(bf16, WS_G); bf16* MG = WSP(bf16, WS_HN); const int col = 256 * u.pn + 32 * wc + 8 * fq;
        EPI_ROWS_BEGIN
#pragma unroll
            for (int bj = 0; bj < 2; ++bj) { f32x4 ga, gb; ld8(Gp + (size_t)row * PG + u.z * DM + col + 128 * bj, ga, gb); f32x4 va = (bj ? h0 : l0) * ga, vb = (bj ? h1 : l1) * gb;
                bf16* p = MG + (size_t)row * DM + col + 128 * bj; if (u.z > 0) { f32x4 pa, pb; ld8(p, pa, pb); va += pa; vb += pb; } st8(p, va, vb); } EPI_ROWS_END
    }
};
struct EpiOut {
    const float* resid; float* out;
    __device__ __forceinline__ void operator()(const Acc_t& acc, const Unit& u, int wr, int wc, int fr, int fq) const {
        const int col = 256 * u.pn + 32 * wc + 8 * fq;
        EPI_ROWS_BEGIN const size_t off = (size_t)row * DM + col;
            const f32x4 r0 = *(const f32x4*)(resid + off), r1 = *(const f32x4*)(resid + off + 4), r2 = *(const f32x4*)(resid + off + 128), r3 = *(const f32x4*)(resid + off + 132);
            *(f32x4*)(out + off) = r0 + l0; *(f32x4*)(out + off + 4) = r1 + l1; *(f32x4*)(out + off + 128) = r2 + h0; *(f32x4*)(out + off + 132) = r3 + h1; EPI_ROWS_END
    }
};

__device__ __forceinline__ void stats_cumsum(const Ctx& c) {
    const int gw = c.bid * NWAVES + c.wave, NGW = c.G * NWAVES;
    for (int m = gw; m < M; m += NGW) {
        float sq = 0.f, sk = 0.f;
        if (c.lane < 48) { f32x4 a, b; ld8(WSP(bf16, WS_CQ) + (size_t)m * PCQ + 8 * c.lane, a, b); sq = (a[0] * a[0] + a[1] * a[1]) + (a[2] * a[2] + a[3] * a[3]) + (b[0] * b[0] + b[1] * b[1]) + (b[2] * b[2] + b[3] * b[3]); }
        if (c.lane < 32) { f32x4 a, b; ld8(WSP(bf16, WS_CKV) + (size_t)m * PCKV + 8 * c.lane, a, b); sk = (a[0] * a[0] + a[1] * a[1]) + (a[2] * a[2] + a[3] * a[3]) + (b[0] * b[0] + b[1] * b[1]) + (b[2] * b[2] + b[3] * b[3]); }
        sq = wave_sum(sq); sk = wave_sum(sk);
        if (c.lane == 0) { WSP(float, WS_RQ)[m] = 1.f / sqrtf(sq * (1.f / 384.f) + EPS); WSP(float, WS_RKV)[m] = 1.f / sqrtf(sk * (1.f / 256.f) + EPS); }
    }
    LAS double* wsum = (LAS double*)(c.lds);
    for (int task = c.bid; task < NBATCH * 8; task += c.G) {
        const int b = task >> 3, h = task & 7; const float* LF = WSP(float, WS_LF) + (size_t)b * SEQ * 8 + h;
        double v[8]; double s = 0.0;
#pragma unroll
        for (int j = 0; j < 8; ++j) { s += (double)LF[(size_t)(8 * c.tid + j) * 8]; v[j] = s; }
        double inc = s;
#pragma unroll
        for (int o = 1; o < 64; o <<= 1) { const double n = __shfl_up(inc, o); if (c.lane >= o) inc += n; }
        __syncthreads();
        if (c.lane == 63) wsum[c.wave] = inc;
        __syncthreads();
        double base = inc - s;
        for (int w = 0; w < c.wave; ++w) base += wsum[w];
        bf16* KA = WSP(bf16, WS_KA) + (size_t)(FR + b * SEQ) * PKA + h * 80 + 64;
#pragma unroll
        for (int j = 0; j < 8; ++j) { const float bias = (float)(-(base + v[j]) * 1.4426950408889634); bf16 bh, bm, bl; split3(bias, bh, bm, bl);
            u32x4 w0 = {(unsigned)bh | ((unsigned)bm << 16), (unsigned)bl | 0x3F800000u, 0x3F803F80u, 0u}, w1 = {0u, 0u, 0u, 0u};   bf16* kp = KA + (size_t)(8 * c.tid + j) * PKA; *(u32x4*)kp = w0; *(u32x4*)(kp + 8) = w1; }
    }
}
__device__ __forceinline__ void final_norm(const Ctx& c) {
    const int gw = c.bid * NWAVES + c.wave, NGW = c.G * NWAVES;
    for (int m = gw; m < M; m += NGW) {
        f32x4* xr = (f32x4*)(c.out + (size_t)m * DM) + c.lane; f32x4 v[4]; float s = 0.f;
#pragma unroll
        for (int j = 0; j < 4; ++j) { v[j] = xr[64 * j]; s += (v[j][0] * v[j][0] + v[j][1] * v[j][1]) + (v[j][2] * v[j][2] + v[j][3] * v[j][3]); }
        const float rstd = 1.f / sqrtf(wave_sum(s) * (1.f / DM) + EPS);
#pragma unroll
        for (int j = 0; j < 4; ++j) { const f32x4 g = ((const f32x4*)c.final_g + c.lane)[64 * j]; xr[64 * j] = v[j] * rstd * g; }
    }
}

#define XB_TMO      128
#define XB_XCNT(j)  (256  + 64 * (j))
#define XB_XSUB(j)  (1280 + 64 * (j))
#define XB_XGEN(j)  (2304 + 64 * (j))
#define XB_TOP      3328
#define XB_TOPGEN   3392
#define XCD_BAR_WORDS 3456
#define XB_SPIN_CAP (1u << 18)
__device__ __forceinline__ unsigned xb_ld(unsigned* p)              { return __hip_atomic_load(p, __ATOMIC_RELAXED, __HIP_MEMORY_SCOPE_AGENT); }
__device__ __forceinline__ unsigned xb_add(unsigned* p, unsigned v) { return __hip_atomic_fetch_add(p, v, __ATOMIC_RELAXED, __HIP_MEMORY_SCOPE_AGENT); }
__device__ __forceinline__ unsigned xb_xcc_id() { return (unsigned)__builtin_amdgcn_s_getreg((3 << 11) | 20) & 0xFu; }
#define XB_SPIN(cond, bar) do { unsigned _sp = 0; while (cond) { __builtin_amdgcn_s_sleep(1); \
    if ((++_sp & 255u) == 0u) { if (xb_ld(&(bar)[XB_TMO])) break; if (_sp > XB_SPIN_CAP) { atomicAdd(&(bar)[XB_TMO], 1u); break; } } } } while (0)
struct XcdBarrier { unsigned* bar; unsigned x; volatile LAS unsigned* st; };
__device__ __forceinline__ XcdBarrier xcd_barrier_post(unsigned* bar, volatile LAS unsigned* st) {
    XcdBarrier b; b.bar = bar; b.x = xb_xcc_id(); b.st = st;
    if (threadIdx.x == 0) (void)xb_add(&bar[XB_XCNT(b.x)], 1u);
    return b;
}
__device__ __forceinline__ void xcd_barrier_complete(unsigned* bar, unsigned x, unsigned& nloc, unsigned& nx) {
    const unsigned G = gridDim.x * gridDim.y * gridDim.z;
    unsigned sum, cnt, mine, sp = 0u;
    for (;;) {
        sum = 0u; cnt = 0u; mine = 0u;
#pragma unroll
        for (unsigned j = 0; j < 16; ++j) { const unsigned cc = xb_ld(&bar[XB_XCNT(j)]); sum += cc; cnt += (cc > 0u) ? 1u : 0u; mine = (j == x) ? cc : mine; }
        if (sum == G) break;
        __builtin_amdgcn_s_sleep(1);
        if ((++sp & 255u) == 0u) { if (xb_ld(&bar[XB_TMO])) break; if (sp > XB_SPIN_CAP) { atomicAdd(&bar[XB_TMO], 1u); break; } }
    }
    nloc = mine > 0u ? mine : 1u; nx = cnt > 0u ? cnt : 1u;
}
__device__ __forceinline__ void xcd_barrier(const XcdBarrier& b) {
    asm volatile("s_waitcnt vmcnt(0)" ::: "memory");
    __syncthreads();
    if (threadIdx.x == 0) {
        unsigned* bar = b.bar;
        __builtin_amdgcn_s_waitcnt(0);
        unsigned nloc = b.st[0], nx = b.st[1];
        if (nloc == 0u) { xcd_barrier_complete(bar, b.x, nloc, nx); b.st[0] = nloc; b.st[1] = nx; }
        const unsigned old = xb_add(&bar[XB_XSUB(b.x)], 1u);
        const unsigned gen = old / nloc;
        if (old + 1u == (gen + 1u) * nloc) {
            __builtin_amdgcn_fence(__ATOMIC_RELEASE, "agent");
            asm volatile("s_waitcnt vmcnt(0)" ::: "memory");
            const unsigned og = xb_add(&bar[XB_TOP], 1u);
            const unsigned tg = og / nx;
            if (og + 1u == (tg + 1u) * nx) xb_add(&bar[XB_TOPGEN], 1u);
            else XB_SPIN(xb_ld(&bar[XB_TOPGEN]) == tg, bar);
            __builtin_amdgcn_fence(__ATOMIC_ACQUIRE, "agent");
            xb_add(&bar[XB_XGEN(b.x)], 1u);
            asm volatile("s_waitcnt vmcnt(0)" ::: "memory");
        } else {
            XB_SPIN(xb_ld(&bar[XB_XGEN(b.x)]) == gen, bar);
            __builtin_amdgcn_fence(__ATOMIC_ACQUIRE, "agent");
            asm volatile("s_waitcnt vmcnt(0)" ::: "memory");
        }
    }
    __syncthreads();
}

constexpr int LDS_BYTES = 147456, MISC_OFF = 131072 + 320;
constexpr int NSLOTS = 18;
constexpr int CW_BAR = 4096;

struct Args { const float* in[13]; float* out; unsigned char* ws; int ph_lo, ph_hi, pad0, pad1; };
#define CAS __attribute__((address_space(4)))
__device__ __forceinline__ Ctx make_ctx() {
    const CAS char* kp = (const CAS char*)__builtin_amdgcn_kernarg_segment_ptr();
    asm volatile("" : "+s"(kp));
    const CAS Args* a = (const CAS Args*)kp;
    Ctx c;
    c.x = a->in[0]; c.meta = a->in[1]; c.norm_g = a->in[2]; c.w_in = a->in[3]; c.b_f = a->in[4]; c.g_cq = a->in[5]; c.g_ckv = a->in[6];
    c.w_uq = a->in[7]; c.w_ukv = a->in[8]; c.sinks = a->in[9]; c.w_branch = a->in[10]; c.w_out = a->in[11]; c.final_g = a->in[12];
    c.out = a->out; c.ws = a->ws;
    extern __shared__ __attribute__((aligned(16))) unsigned char lds_raw[];
    c.lds = (LAS unsigned char*)lds_raw;
    c.tid = threadIdx.x; c.lane = c.tid & 63; c.wave = __builtin_amdgcn_readfirstlane(c.tid >> 6); c.G = gridDim.x; c.bid = blockIdx.x;
    return c;
}

template <int SLOT>
__device__ __forceinline__ void run_slot() {
    const Ctx c = make_ctx();
    constexpr int slot = SLOT;
    constexpr int layer = (slot >= 9) ? 1 : 0;
    constexpr int ls = (slot >= 9) ? slot - 8 : slot;
        if constexpr (slot == 0) slot0(c);
        else if constexpr (slot == 17) final_norm(c);
        else if constexpr (ls == 1) {
            zero_fronts(c);
            norm_main(c, layer == 0 ? c.x : c.out);
            meta_blocks(c, AfPlain{WSP(bf16, WS_HNM), DM}, wl(c, layer, WL_EARLY), DM, NE / 16, WSP(float, WS_RAWE), NE, 0);
        } else if constexpr (ls == 2) {
            post_early(c, layer);
            ProbSimple P{WSP(bf16, WS_HN), wl(c, layer, WL_EARLY), DM};
            gemm_run<1>(c, P, EpiEarly{c, layer}, 64, NE / 256, 0);
        } else if constexpr (ls == 3) {
            { const AfPlain af{WSP(bf16, WS_CM), 640}; meta_blocks(c, af, wl(c, layer, WL_UQ), 384, NUQ / 16, WSP(float, WS_RAWU), NUQ + NUKV, 0);
              const AfPlain af2{WSP(bf16, WS_CM) + 384, 640}; meta_blocks(c, af2, wl(c, layer, WL_UKV), 256, NUKV / 16, WSP(float, WS_RAWU), NUQ + NUKV, NUQ); }
            if (c.bid == 0) post_early_reduce(c);
            if (layer == 0) { convert_weights(c, 1); __syncthreads(); }
            stats_cumsum(c);
        } else if constexpr (ls == 4) {
            post_up(c);
            { ProbSimple P{WSP(bf16, WS_CQ), wl(c, layer, WL_UQ), 384}; gemm_run<1>(c, P, EpiUq{c}, 64, NUQ / 256, 0); }
            { ProbSimple P{WSP(bf16, WS_CKV), wl(c, layer, WL_UKV), 256}; gemm_run<1>(c, P, EpiUkv{c}, 64, NUKV / 256, 0); }
        } else if constexpr (ls == 5) {
            if (layer == 0) {
#ifndef NO_ATTNM
                if (c.bid == 0) attn_meta(c);
#endif
 meta_blocks(c, AfPlain{WSP(bf16, WS_HNM), DM}, wl(c, 0, WL_LATE), DM, NL / 16, WSP(float, WS_RAWL), NL, 0); }
#ifdef NAIVE_ATTN
            attn_main_naive(c, layer);
#else
            attn_main_mfma(c, layer);
#endif
        } else if constexpr (ls == 6) {
#ifndef NO_S67
            if (layer == 0) { for (int n = 0; n < 3; ++n) { const AfBranch af{WSP(bf16, WS_YM), WSP(float, WS_RAWL), n}; meta_blocks(c, af, wl(c, 0, WL_BR) + (size_t)n * DM * 512, 512, DM / 16, WSP(float, WS_RAWB) + (size_t)n * 16 * 1024, 1024, 0); } }
#endif
            { ProbSimple P{WSP(bf16, WS_HN), wl(c, layer, WL_LATE), DM}; gemm_run<1>(c, P, EpiLateZ{c}, 64, 6, 0); }
            { ProbSimple P{WSP(bf16, WS_HN), wl(c, layer, WL_LATE), DM}; gemm_run<1>(c, P, EpiLateG{c}, 64, 12, 6); }
        } else if constexpr (ls == 7) {
            if (layer == 0) { const AfMerged af{WSP(float, WS_RAWL), WSP(float, WS_RAWB)}; meta_blocks(c, af, wl(c, 0, WL_OUT), DM, DM / 16, WSP(float, WS_RAWO), DM, 0); }
            { ProbBranch P{WSP(bf16, WS_QA), WSP(bf16, WS_YB), WSP(bf16, WS_QC), wl(c, layer, WL_BR), 512}; gemm_run<3>(c, P, EpiBranch{c}, 64, 4, 0); }
        } else if constexpr (ls == 8) {
            if (layer == 0 && c.bid == 0) post_resid(c);
            ProbSimple P{WSP(bf16, WS_HN), wl(c, layer, WL_OUT), DM};
            gemm_run<1>(c, P, EpiOut{layer == 0 ? c.x : c.out, c.out}, 64, DM / 256, 0);
        }
}

__global__ void __launch_bounds__(NTHREADS, 2) skel_fwd(Args args) {
    const Ctx c = make_ctx();
    volatile LAS unsigned* MISC = (volatile LAS unsigned*)(c.lds + MISC_OFF);
    for (int u = c.tid; u < (LDS_BYTES - 131072) / 4; u += NTHREADS) ((LAS unsigned*)(c.lds + 131072))[u] = 0u;
    __syncthreads();
    XcdBarrier bar; bar.bar = (unsigned*)(c.ws + WS_CTL) + CW_BAR; bar.x = 0; bar.st = nullptr;
    const int lo = args.ph_lo, hi = args.ph_hi;
    if (hi - lo > 1) bar = xcd_barrier_post((unsigned*)(c.ws + WS_CTL) + CW_BAR, MISC + 8);

#ifndef SLOT_ON
#define SLOT_ON(k) true
#endif
#ifndef SLOT_REPS
#define SLOT_REPS(k) 1
#endif
#define RUN_SLOT(k) if (SLOT_ON(k) && lo <= (k) && (k) < hi) { _Pragma("nounroll") for (int rep_ = 0; rep_ < SLOT_REPS(k); ++rep_) { run_slot<k>(); if ((k) + 1 < hi) xcd_barrier(bar); } }
    RUN_SLOT(0) RUN_SLOT(1) RUN_SLOT(2) RUN_SLOT(3) RUN_SLOT(4) RUN_SLOT(5) RUN_SLOT(6) RUN_SLOT(7) RUN_SLOT(8)
    RUN_SLOT(9) RUN_SLOT(10) RUN_SLOT(11) RUN_SLOT(12) RUN_SLOT(13) RUN_SLOT(14) RUN_SLOT(15) RUN_SLOT(16) RUN_SLOT(17)
#undef RUN_SLOT
}

extern "C" void kernel_launch(void* const* d_in, const int* in_sizes, int n_in, void* d_out, int out_size, void* d_ws, size_t ws_size, hipStream_t stream) {
    static int grid = 0;
    if (grid == 0) {
        if (n_in != 13 || out_size != M * DM || ws_size < WS_END) { fprintf(stderr, "kernel_launch: unexpected shapes (n_in %d out %d ws %zu need %zu)\n", n_in, out_size, ws_size, (size_t)WS_END); grid = -1; return; }
        int dev = 0, cus = 0, per_cu = 0;
        if (hipGetDevice(&dev) != hipSuccess || hipDeviceGetAttribute(&cus, hipDeviceAttributeMultiprocessorCount, dev) != hipSuccess) { grid = -1; return; }
        if (hipFuncSetAttribute((const void*)skel_fwd, hipFuncAttributeMaxDynamicSharedMemorySize, LDS_BYTES) != hipSuccess) { fprintf(stderr, "kernel_launch: hipFuncSetAttribute failed\n"); grid = -1; return; }
        if (hipOccupancyMaxActiveBlocksPerMultiprocessor(&per_cu, (const void*)skel_fwd, NTHREADS, LDS_BYTES) != hipSuccess || per_cu < 1) fprintf(stderr, "kernel_launch: occupancy query says %d\n", per_cu);
        (void)hipGetLastError();
        grid = cus;
    }
    if (grid < 0) return;
    (void)hipMemsetAsync((char*)d_ws + WS_CTL, 0, CTL_BYTES, stream);
    Args a{};
    for (int i = 0; i < 13; ++i) a.in[i] = (const float*)d_in[i];
    a.out = (float*)d_out; a.ws = (unsigned char*)d_ws;
#if MK_SINGLE
    a.ph_lo = 0; a.ph_hi = NSLOTS;
    hipLaunchKernelGGL(skel_fwd, dim3(grid), dim3(NTHREADS), LDS_BYTES, stream, a);
#else
#ifndef HOST_REPS
#define HOST_REPS(s) 1
#endif
    for (int s = 0; s < NSLOTS; ++s) for (int r = 0; r < HOST_REPS(s); ++r) { a.ph_lo = s; a.ph_hi = s + 1; hipLaunchKernelGGL(skel_fwd, dim3(grid), dim3(NTHREADS), LDS_BYTES, stream, a); }
#endif
}
```

```cpp
#include <hip/hip_runtime.h>
#include <cstdio>
#include <cstdint>

#ifndef USE_FB
#define USE_FB 1
#endif
#ifndef MK_SINGLE
#define MK_SINGLE 1
#endif

#define GAS __attribute__((address_space(1)))
#define LAS __attribute__((address_space(3)))
typedef unsigned short bf16;
typedef short bf16x8 __attribute__((ext_vector_type(8)));
typedef float f32x4 __attribute__((ext_vector_type(4)));
typedef unsigned u32x4 __attribute__((ext_vector_type(4)));
typedef unsigned u32x2 __attribute__((ext_vector_type(2)));
typedef float f32x2_t __attribute__((ext_vector_type(2)));
typedef __bf16 bf16x2_t __attribute__((ext_vector_type(2)));
typedef GAS unsigned gu32;
#define RLX_AGENT __ATOMIC_RELAXED, __HIP_MEMORY_SCOPE_AGENT

constexpr int DM = 1024, NBATCH = 4, SEQ = 4096, M = NBATCH * SEQ, NMETA = 16, FR = 64, MOFF = 48, NPOS = SEQ + NMETA;
constexpr int NIN = 7592, NWAVES = 8, NTHREADS = NWAVES * 64;
constexpr float EPS = 1e-6f, LOG2E = 1.4426950408889634f, LN2 = 0.6931471805599453f;
constexpr float C2A = 0.125f * LOG2E, C2B = 0.10206207261596575f * LOG2E, C2C = 0.125f * LOG2E;
constexpr int LC_AQ = 0, LC_AK = 512, LC_AV = 1024, LC_AF = 1536, LC_AZ = 1544, LC_BCQ = 2056, LC_BCKV = 2440, LC_BKR = 2696, LC_BZ = 2728,
              LC_CQ = 3240, LC_CK = 3752, LC_CV = 3880, LC_CZ = 4008, LC_G = 4520;
constexpr int NE = 3072, NL = 4608, NUQ = 768, NUKV = 1024;
constexpr int PQA = 512, PKA = 640, PVA = 512, PQB = 768, PKB = 768, PVB = 512, PQC = 512, PKC = 128, PVC = 128, PCQ = 384, PCKV = 256, PY = 512, PG = 3072;

constexpr size_t MiB = 1u << 20;
constexpr size_t al(size_t x) { return (x + 255) & ~(size_t)255; }
constexpr size_t WS_CTL = 0, CTL_BYTES = 1 * MiB;
constexpr size_t WS_COS64 = CTL_BYTES, WS_SIN64 = WS_COS64 + al((size_t)NPOS * 32 * 4), WS_COS32 = WS_SIN64 + al((size_t)NPOS * 32 * 4), WS_SIN32 = WS_COS32 + al((size_t)NPOS * 16 * 4);
constexpr size_t WS_LF = WS_SIN32 + al((size_t)NPOS * 16 * 4), WS_RQ = WS_LF + al((size_t)M * 8 * 4), WS_RKV = WS_RQ + al((size_t)M * 4);
constexpr size_t WS_HM = WS_RKV + al((size_t)M * 4);
constexpr size_t WS_HNM = WS_HM + al(16 * 1024 * 4);
constexpr size_t WS_RAWE = WS_HNM + al(16 * 1024 * 2);
constexpr size_t WS_RAWU = WS_RAWE + al(16 * NE * 4);
constexpr size_t WS_RAWL = WS_RAWU + al(16 * (NUQ + NUKV) * 4);
constexpr size_t WS_RAWB = WS_RAWL + al(16 * NL * 4);
constexpr size_t WS_RAWO = WS_RAWB + al(3 * 16 * 1024 * 4);
constexpr size_t WS_YM = WS_RAWO + al(16 * 1024 * 4);
constexpr size_t WS_CM = WS_YM + al(16 * 1536 * 2);
constexpr size_t WS_RQM = WS_CM + al(16 * 640 * 2);
constexpr size_t WS_LFM = WS_RQM + al(32 * 4);
constexpr size_t WS_QAM = WS_LFM + al(16 * 8 * 4);
constexpr size_t WS_QBM = WS_QAM + al(16 * 512 * 2);
constexpr size_t WS_QCM = WS_QBM + al(16 * 768 * 2);
constexpr size_t WS_CUMB = WS_QCM + al(16 * 512 * 2);
constexpr size_t WS_SMALL_END = WS_CUMB + al((size_t)NBATCH * 8 * SEQ * 4);
constexpr size_t WL_EARLY = 0, WL_LATE = WL_EARLY + (size_t)NE * DM * 2, WL_UQ = WL_LATE + (size_t)NL * DM * 2, WL_UKV = WL_UQ + (size_t)NUQ * 384 * 2,
                 WL_BR = WL_UKV + (size_t)NUKV * 256 * 2, WL_OUT = WL_BR + (size_t)3 * DM * 512 * 2, WL_BYTES = WL_OUT + (size_t)DM * DM * 2;
constexpr size_t WS_W = 6 * MiB;
static_assert(WS_SMALL_END <= WS_W, "small region");
constexpr size_t WS_HN = WS_W + al(2 * WL_BYTES);
constexpr size_t WS_QA = WS_HN + (size_t)M * DM * 2;
constexpr size_t WS_QC = WS_QA + (size_t)M * PQA * 2;
constexpr size_t WS_CQ = WS_QC + (size_t)M * PQC * 2;
constexpr size_t WS_CKV = WS_CQ + (size_t)M * PCQ * 2;
constexpr size_t WS_YB = WS_CQ;
constexpr size_t WS_QB = WS_CKV + (size_t)M * PCKV * 2;
constexpr size_t WS_KB = WS_QB + (size_t)M * PQB * 2;
constexpr size_t WS_VB = WS_KB + (size_t)(FR + M) * PKB * 2;
constexpr size_t WS_KA = WS_VB + (size_t)(FR + M) * PVB * 2;
constexpr size_t WS_VA = WS_KA + (size_t)(FR + M) * PKA * 2;
constexpr size_t WS_KC = WS_VA + (size_t)(FR + M) * PVA * 2;
constexpr size_t WS_VC = WS_KC + (size_t)(FR + M) * PKC * 2;
constexpr size_t WS_END = WS_VC + (size_t)(FR + M) * PVC * 2;
constexpr size_t WS_G = WS_QB;
static_assert(WS_G + (size_t)M * PG * 2 <= WS_KC, "G overlay");
static_assert((size_t)M * PY * 2 <= (size_t)M * (PCQ + PCKV) * 2, "YB overlay");
static_assert(WS_END <= 256 * MiB, "workspace");

constexpr int LDS_BYTES = 147456, MISC_OFF = 131072 + 320;
constexpr int CW_QN = 8192, CW_KN = 8192 + 128, CW_QUE = 8192 + 256;
__device__ __forceinline__ unsigned cvtpk(float lo, float hi) { f32x2_t v = {lo, hi}; bf16x2_t b = __builtin_convertvector(v, bf16x2_t); return __builtin_bit_cast(unsigned, b); }
__device__ __forceinline__ bf16 f2bf(float f) { return (bf16)(cvtpk(f, 0.f) & 0xffffu); }
__device__ __forceinline__ float bf2f(bf16 v) { return __uint_as_float((unsigned)v << 16); }
__device__ __forceinline__ float bflo(unsigned w) { return __uint_as_float(w << 16); }
__device__ __forceinline__ float bfhi(unsigned w) { return __uint_as_float(w & 0xffff0000u); }
__device__ __forceinline__ float fexp2(float x) { return __builtin_amdgcn_exp2f(x); }
__device__ __forceinline__ float frcp(float x) { return __builtin_amdgcn_rcpf(x); }
__device__ __forceinline__ float sigmoidf_(float x) { return frcp(1.f + fexp2(-x * LOG2E)); }
__device__ __forceinline__ float siluf_(float x) { return x * sigmoidf_(x); }
__device__ __forceinline__ float logsigf_(float x) { return fminf(x, 0.f) - __builtin_amdgcn_logf(1.f + fexp2(-fabsf(x) * LOG2E)) * LN2; }
__device__ __forceinline__ float wave_sum(float v) {
#pragma unroll
    for (int o = 1; o < 64; o <<= 1) v += __shfl_xor(v, o);
    return v;
}
__device__ __forceinline__ u32x4 pack8(f32x4 a, f32x4 b) { u32x4 w; w.x = cvtpk(a[0], a[1]); w.y = cvtpk(a[2], a[3]); w.z = cvtpk(b[0], b[1]); w.w = cvtpk(b[2], b[3]); return w; }
__device__ __forceinline__ void st8(bf16* p, f32x4 a, f32x4 b) { *(u32x4*)p = pack8(a, b); }
__device__ __forceinline__ void ld8(const bf16* p, f32x4& a, f32x4& b) { const u32x4 w = *(const u32x4*)p; a = (f32x4){bflo(w.x), bfhi(w.x), bflo(w.y), bfhi(w.y)}; b = (f32x4){bflo(w.z), bfhi(w.z), bflo(w.w), bfhi(w.w)}; }
__device__ __forceinline__ void split3(float b, bf16& h, bf16& m, bf16& l) { h = f2bf(b); const float r1 = b - bf2f(h); m = f2bf(r1); const float r2 = r1 - bf2f(m); l = f2bf(r2); }

enum { MAP_EARLY = 0, MAP_LATE = 1, MAP_UQ = 2, MAP_ID = 3 };
__device__ __forceinline__ int map_col(int kind, int p) {
    const int t = p >> 8, c = p & 255, half = c >> 7, c7 = c & 127;
    if (kind == MAP_EARLY) {
        if (t < 2) return LC_AQ + p;
        if (t < 4) return LC_AK + (p - 512);
        if (t < 6) return LC_AV + (p - 1024);
        if (t < 8) return LC_CQ + 256 * (t - 6) + 64 * (c7 >> 5) + 32 * half + (c7 & 31);
        if (t == 8) { if (c7 < 64) return LC_CK + 64 * (c7 >> 5) + 32 * half + (c7 & 31); return LC_CV + 64 * half + (c7 - 64); }
        if (t == 9) return LC_BCQ + c;
        if (t == 10) { if (c7 < 64) return LC_BCQ + 256 + 64 * half + c7; if (c7 < 80) return LC_BKR + 16 * half + (c7 - 64); if (c7 < 88 && half == 0) return LC_AF + (c7 - 80); return -1; }
        return LC_BCKV + c;
    }
    if (kind == MAP_LATE) {
        if (t < 2) return LC_AZ + p;
        if (t < 4) return LC_BZ + (p - 512);
        if (t < 6) return LC_CZ + (p - 1024);
        return LC_G + (p - 1536);
    }
    if (kind == MAP_UQ) {
        if (t < 2) return (4 * t + (c >> 6)) * 96 + (c & 63);
        return (c7 >> 4) * 96 + 64 + 16 * half + (c7 & 15);
    }
    return p;
}

struct Ctx {
    const float *x, *meta, *norm_g, *w_in, *b_f, *g_cq, *g_ckv, *w_uq, *w_ukv, *sinks, *w_branch, *w_out, *final_g;
    float* out; unsigned char* ws;
    LAS unsigned char* lds;
    int tid, lane, wave, G, bid;
};
#define WSP(T, off) ((T*)(c.ws + (off)))
__device__ __forceinline__ bf16* wl(const Ctx& c, int layer, size_t off) { return (bf16*)(c.ws + WS_W + (size_t)layer * WL_BYTES + off); }

__device__ __forceinline__ void conv_item(const float* W, int N, const float* gv, bf16* Bt, int K, int kind, int nblk, int item, LAS float* scr, int lane) {
    const int kb = item / nblk, nb = item % nblk, k0 = 64 * kb, n0 = 32 * nb;
    const int lc = map_col(kind, n0 + (lane & 31));
#pragma unroll 8
    for (int i = 0; i < 32; ++i) { const int kk = 2 * i + (lane >> 5); float v = 0.f; if (lc >= 0) { v = W[(size_t)(k0 + kk) * N + lc]; if (gv) v *= gv[k0 + kk]; } scr[kk * 33 + (lane & 31)] = v; }
    asm volatile("s_waitcnt lgkmcnt(0)" ::: "memory");
    const int ch = lane & 7;
#pragma unroll
    for (int j = 0; j < 4; ++j) { const int n = (lane >> 3) + 8 * j; const LAS float* s = scr + (8 * ch) * 33 + n;
        u32x4 o; o.x = cvtpk(s[0 * 33], s[1 * 33]); o.y = cvtpk(s[2 * 33], s[3 * 33]); o.z = cvtpk(s[4 * 33], s[5 * 33]); o.w = cvtpk(s[6 * 33], s[7 * 33]);
        *(u32x4*)(Bt + (size_t)(n0 + n) * K + k0 + 8 * ch) = o; }
    asm volatile("s_waitcnt lgkmcnt(0)" ::: "memory");
}
__device__ __forceinline__ void zero_fronts(const Ctx& c) {
    const int g = c.bid * NTHREADS + c.tid, NG = c.G * NTHREADS;
    const u32x4 z = {0u, 0u, 0u, 0u};
    for (int e = g; e < MOFF * PKB / 8; e += NG) WSP(u32x4, WS_KB)[e] = z;
    for (int e = g; e < MOFF * PVB / 8; e += NG) WSP(u32x4, WS_VB)[e] = z;
    for (int e = g; e < MOFF * PKA / 8; e += NG) WSP(u32x4, WS_KA)[e] = z;
    for (int e = g; e < MOFF * PVA / 8; e += NG) WSP(u32x4, WS_VA)[e] = z;
    for (int e = g; e < MOFF * PKC / 8; e += NG) WSP(u32x4, WS_KC)[e] = z;
    for (int e = g; e < MOFF * PVC / 8; e += NG) WSP(u32x4, WS_VC)[e] = z;
}
__device__ __forceinline__ void sincos_d(float ang, float& s, float& co) {
    const double x = (double)ang, TWO_PI = 6.283185307179586476925, INV = 0.15915494309189533577;
    const double n = __builtin_rint(x * INV), r = __builtin_fma(-n, TWO_PI, x), y = 0.5 * r, y2 = y * y;
    double sp, cp;
    double ts = 1.0, tc = 1.0; sp = 1.0; cp = 1.0;
#pragma unroll
    for (int j = 1; j <= 12; ++j) { tc = -tc * y2 / (double)((2 * j - 1) * (2 * j)); ts = -ts * y2 / (double)((2 * j) * (2 * j + 1)); cp += tc; sp += ts; }
    const double sy = y * sp, cy = cp;
    s = (float)(2.0 * sy * cy); co = (float)(1.0 - 2.0 * sy * sy);
}
__device__ __forceinline__ void rope_tables(const Ctx& c) {
    const int g = c.bid * NTHREADS + c.tid, NG = c.G * NTHREADS;
    for (int e = g; e < NPOS * 48; e += NG) {
        const int pos = e / 48, i = e % 48;
        float inv; if (i < 32) inv = fexp2(-(float)i * (13.287712379549449f / 32.f)); else inv = fexp2(-(float)(i - 32) * (13.287712379549449f / 16.f));
        const float ang = (float)pos * inv; float s, co; sincos_d(ang, s, co);
        if (i < 32) { WSP(float, WS_COS64)[pos * 32 + i] = co; WSP(float, WS_SIN64)[pos * 32 + i] = s; }
        else { WSP(float, WS_COS32)[pos * 16 + i - 32] = co; WSP(float, WS_SIN32)[pos * 16 + i - 32] = s; }
    }
}
__device__ __forceinline__ void rms_row_to_bf16(const float* xrow, bf16* orow, float* copy, int lane) {
    const f32x4* xr = (const f32x4*)xrow + lane;
    f32x4 v[4]; float s = 0.f;
#pragma unroll
    for (int j = 0; j < 4; ++j) { v[j] = xr[64 * j]; s += (v[j][0] * v[j][0] + v[j][1] * v[j][1]) + (v[j][2] * v[j][2] + v[j][3] * v[j][3]); }
    const float rstd = 1.f / sqrtf(wave_sum(s) * (1.f / DM) + EPS);
    u32x2* o8 = (u32x2*)orow + lane;
#pragma unroll
    for (int j = 0; j < 4; ++j) { u32x2 w; w.x = cvtpk(v[j][0] * rstd, v[j][1] * rstd); w.y = cvtpk(v[j][2] * rstd, v[j][3] * rstd); o8[64 * j] = w; if (copy) ((f32x4*)copy + lane)[64 * j] = v[j]; }
}
__device__ __forceinline__ void convert_weights(const Ctx& c, int layer);
__device__ __forceinline__ void slot0(const Ctx& c) {
    LAS float* scr = (LAS float*)(c.lds + c.wave * 16384);
    const int gw = c.bid * NWAVES + c.wave, NGW = c.G * NWAVES;
    convert_weights(c, 0);
    rope_tables(c);
    if (gw < 16) rms_row_to_bf16(c.meta + (size_t)gw * DM, WSP(bf16, WS_HNM) + (size_t)gw * DM, WSP(float, WS_HM) + (size_t)gw * DM, c.lane);
}
__device__ __forceinline__ void convert_weights(const Ctx& c, int layer) {
    LAS float* scr = (LAS float*)(c.lds + c.wave * 16384);
    const int gw = c.bid * NWAVES + c.wave, NGW = c.G * NWAVES;
    {
        const float* w_in = c.w_in + (size_t)layer * DM * NIN;
        const int I_E = 16 * (NE / 32), I_L = 16 * (NL / 32), I_UQ = 6 * (NUQ / 32), I_UKV = 4 * (NUKV / 32), I_BR = 8 * (DM / 32), I_O = 16 * (DM / 32);
        const int tot = I_E + I_L + I_UQ + I_UKV + 3 * I_BR + I_O;
        for (int it = gw; it < tot; it += NGW) {
            int r = it;
            if (r < I_E) { conv_item(w_in, NIN, c.norm_g + layer * DM, wl(c, layer, WL_EARLY), DM, MAP_EARLY, NE / 32, r, scr, c.lane); continue; } r -= I_E;
            if (r < I_L) { conv_item(w_in, NIN, c.norm_g + layer * DM, wl(c, layer, WL_LATE), DM, MAP_LATE, NL / 32, r, scr, c.lane); continue; } r -= I_L;
            if (r < I_UQ) { conv_item(c.w_uq + (size_t)layer * 384 * 768, 768, c.g_cq + layer * 384, wl(c, layer, WL_UQ), 384, MAP_UQ, NUQ / 32, r, scr, c.lane); continue; } r -= I_UQ;
            if (r < I_UKV) { conv_item(c.w_ukv + (size_t)layer * 256 * 1024, 1024, c.g_ckv + layer * 256, wl(c, layer, WL_UKV), 256, MAP_ID, NUKV / 32, r, scr, c.lane); continue; } r -= I_UKV;
            if (r < 3 * I_BR) { const int n = r / I_BR; conv_item(c.w_branch + ((size_t)layer * 3 + n) * 512 * DM, DM, nullptr, wl(c, layer, WL_BR) + (size_t)n * DM * 512, 512, MAP_ID, DM / 32, r % I_BR, scr, c.lane); continue; } r -= 3 * I_BR;
            conv_item(c.w_out + (size_t)layer * DM * DM, DM, nullptr, wl(c, layer, WL_OUT), DM, MAP_ID, DM / 32, r, scr, c.lane);
        }
    }
}

__device__ __forceinline__ void norm_main(const Ctx& c, const float* src) {
    const int gw = c.bid * NWAVES + c.wave, NGW = c.G * NWAVES;
    for (int m = gw; m < M; m += NGW) rms_row_to_bf16(src + (size_t)m * DM, WSP(bf16, WS_HN) + (size_t)m * DM, nullptr, c.lane);
}

template <class AF>
__device__ __forceinline__ void meta_block(const AF& af, const bf16* Bt, int K, int col0, float* raw, int ldraw, int rcol0, int lane) {
    f32x4 acc = {0.f, 0.f, 0.f, 0.f};
    const int r = lane & 15, kq = 8 * (lane >> 4);
    for (int k0 = 0; k0 < K; k0 += 32) {
        const bf16x8 a = af(r, k0 + kq);
        const bf16x8 b = *(const bf16x8*)(Bt + (size_t)(col0 + r) * K + k0 + kq);
        acc = __builtin_amdgcn_mfma_f32_16x16x32_bf16(a, b, acc, 0, 0, 0);
    }
#pragma unroll
    for (int x = 0; x < 4; ++x) raw[(size_t)(4 * (lane >> 4) + x) * ldraw + rcol0 + r] = acc[x];
}
struct AfPlain { const bf16* A; int lda; __device__ __forceinline__ bf16x8 operator()(int r, int k) const { return *(const bf16x8*)(A + (size_t)r * lda + k); } };
struct AfBranch {
    const bf16* ym; const float* rawl; int n;
    __device__ __forceinline__ bf16x8 operator()(int r, int k) const {
        f32x4 y0, y1; ld8(ym + (size_t)r * 1536 + n * 512 + k, y0, y1);
        const f32x4 z0 = *(const f32x4*)(rawl + (size_t)r * NL + 512 * n + k), z1 = *(const f32x4*)(rawl + (size_t)r * NL + 512 * n + k + 4);
#pragma unroll
        for (int j = 0; j < 4; ++j) { y0[j] *= siluf_(z0[j]); y1[j] *= siluf_(z1[j]); }
        return __builtin_bit_cast(bf16x8, pack8(y0, y1));
    }
};
struct AfMerged {
    const float* rawl; const float* rawb;
    __device__ __forceinline__ bf16x8 operator()(int r, int k) const {
        f32x4 s0 = {0.f, 0.f, 0.f, 0.f}, s1 = s0;
#pragma unroll
        for (int n = 0; n < 3; ++n) {
            const float* g = rawl + (size_t)r * NL + 1536 + n * 1024 + k; const float* p = rawb + ((size_t)n * 16 + r) * 1024 + k;
#pragma unroll
            for (int j = 0; j < 4; ++j) { s0[j] += sigmoidf_(g[j]) * p[j]; s1[j] += sigmoidf_(g[4 + j]) * p[4 + j]; }
        }
        return __builtin_bit_cast(bf16x8, pack8(s0, s1));
    }
};
template <class AF>
__device__ __forceinline__ void meta_blocks(const Ctx& c, const AF& af, const bf16* Bt, int K, int nblocks, float* raw, int ldraw, int rcol0) {
    LAS f32x4* red = (LAS f32x4*)(c.lds + 65536);
    const int r = c.lane & 15, kq = 8 * (c.lane >> 4), nks = K >> 5;
    for (int blk = c.bid; blk < nblocks; blk += c.G) {
        f32x4 acc = {0.f, 0.f, 0.f, 0.f};
#pragma unroll 4
        for (int ks = c.wave; ks < nks; ks += NWAVES) {
            const bf16x8 a = af(r, 32 * ks + kq);
            const bf16x8 bb = *(const bf16x8*)(Bt + (size_t)(16 * blk + r) * K + 32 * ks + kq);
            acc = __builtin_amdgcn_mfma_f32_16x16x32_bf16(a, bb, acc, 0, 0, 0);
        }
        asm volatile("s_nop 15\n\ts_nop 7" : "+v"(acc));
        red[c.wave * 64 + c.lane] = acc;
        __syncthreads();
        if (c.wave == 0) {
            f32x4 sm = red[c.lane];
#pragma unroll
            for (int w = 1; w < NWAVES; ++w) sm += red[w * 64 + c.lane];
#pragma unroll
            for (int x = 0; x < 4; ++x) raw[(size_t)(4 * (c.lane >> 4) + x) * ldraw + rcol0 + 16 * blk + r] = sm[x];
        }
        __syncthreads();
    }
}

__device__ __forceinline__ void post_early(const Ctx& c, int layer) {
    const float* raw = WSP(float, WS_RAWE);
    bf16 *QAm = WSP(bf16, WS_QAM), *QCm = WSP(bf16, WS_QCM), *cm = WSP(bf16, WS_CM);
    bf16 *KAf = WSP(bf16, WS_KA), *VAf = WSP(bf16, WS_VA), *KBf = WSP(bf16, WS_KB), *KCf = WSP(bf16, WS_KC), *VCf = WSP(bf16, WS_VC);
    float* LFm = WSP(float, WS_LFM);
    const float *cos64 = WSP(float, WS_COS64), *sin64 = WSP(float, WS_SIN64), *cos32 = WSP(float, WS_COS32), *sin32 = WSP(float, WS_SIN32);
    for (int e = c.bid * NTHREADS + c.tid; e < 16 * NE; e += c.G * NTHREADS) {
        const int r = e / NE, p = e % NE, t = p >> 8, cc = p & 255, half = cc >> 7, c7 = cc & 127; const float v = raw[e];
        if (t < 2) QAm[r * PQA + p] = f2bf(v * C2A);
        else if (t < 4) { const int L = p - 512; KAf[(size_t)(MOFF + r) * PKA + (L >> 6) * 80 + (L & 63)] = f2bf(v); }
        else if (t < 6) VAf[(size_t)(MOFF + r) * PVA + (p - 1024)] = f2bf(v);
        else if (t < 8) { if (half == 0) { const int hh = c7 >> 5, d = c7 & 31, head = 4 * (t - 6) + hh; const float x1 = v, x2 = raw[e + 128], cs = cos64[r * 32 + d], sn = sin64[r * 32 + d];
                QCm[r * PQC + head * 64 + d] = f2bf((x1 * cs - x2 * sn) * C2C); QCm[r * PQC + head * 64 + 32 + d] = f2bf((x2 * cs + x1 * sn) * C2C); } }
        else if (t == 8) { if (c7 < 64) { if (half == 0) { const int hh = c7 >> 5, d = c7 & 31; const float x1 = v, x2 = raw[e + 128], cs = cos64[r * 32 + d], sn = sin64[r * 32 + d];
                    KCf[(size_t)(MOFF + r) * PKC + hh * 64 + d] = f2bf(x1 * cs - x2 * sn); KCf[(size_t)(MOFF + r) * PKC + hh * 64 + 32 + d] = f2bf(x2 * cs + x1 * sn); } }
            else VCf[(size_t)(MOFF + r) * PVC + 64 * half + (c7 - 64)] = f2bf(v); }
        else if (t == 9) cm[r * 640 + cc] = f2bf(v);
        else if (t == 10) { if (c7 < 64) cm[r * 640 + 256 + 64 * half + c7] = f2bf(v);
            else if (c7 < 80) { if (half == 0) { const int d = c7 - 64; const float x1 = v, x2 = raw[e + 128], cs = cos32[r * 16 + d], sn = sin32[r * 16 + d]; const bf16 o1 = f2bf(x1 * cs - x2 * sn), o2 = f2bf(x2 * cs + x1 * sn);
                    for (int h = 0; h < 8; ++h) { KBf[(size_t)(MOFF + r) * PKB + h * 96 + 64 + d] = o1; KBf[(size_t)(MOFF + r) * PKB + h * 96 + 80 + d] = o2; } } }
            else if (c7 < 88 && half == 0) LFm[r * 8 + (c7 - 80)] = logsigf_(v + c.b_f[layer * 8 + (c7 - 80)]); }
        else cm[r * 640 + 384 + cc] = f2bf(v);
    }
}
__device__ __forceinline__ void post_early_reduce(const Ctx& c, int layer) {
    const bf16* cm = WSP(bf16, WS_CM); float* rqm = WSP(float, WS_RQM); const float* LFm = WSP(float, WS_LFM); bf16* KAf = WSP(bf16, WS_KA);
    for (int r = c.wave; r < 16; r += NWAVES) {
        float sq = 0.f, sk = 0.f;
        if (c.lane < 48) { f32x4 a, b; ld8(cm + r * 640 + 8 * c.lane, a, b); sq = (a[0] * a[0] + a[1] * a[1]) + (a[2] * a[2] + a[3] * a[3]) + (b[0] * b[0] + b[1] * b[1]) + (b[2] * b[2] + b[3] * b[3]); }
        if (c.lane < 32) { f32x4 a, b; ld8(cm + r * 640 + 384 + 8 * c.lane, a, b); sk = (a[0] * a[0] + a[1] * a[1]) + (a[2] * a[2] + a[3] * a[3]) + (b[0] * b[0] + b[1] * b[1]) + (b[2] * b[2] + b[3] * b[3]); }
        sq = wave_sum(sq); sk = wave_sum(sk);
        if (c.lane == 0) { rqm[r] = 1.f / sqrtf(sq * (1.f / 384.f) + EPS); rqm[16 + r] = 1.f / sqrtf(sk * (1.f / 256.f) + EPS); }
    }
    if (c.tid >= 64 && c.tid < 72) {
        const int h = c.tid - 64; float mk = 0.f;
        for (int r = 0; r < 16; ++r) { float sk = 0.f;
            for (int d = 0; d < 64; d += 8) { f32x4 a, b; ld8(KAf + (size_t)(MOFF + r) * PKA + h * 80 + d, a, b); sk += (a[0] * a[0] + a[1] * a[1]) + (a[2] * a[2] + a[3] * a[3]) + (b[0] * b[0] + b[1] * b[1]) + (b[2] * b[2] + b[3] * b[3]); }
            mk = fmaxf(mk, sk); }
        for (int b = 0; b < NBATCH; ++b) __hip_atomic_fetch_max((gu32*)(c.ws + WS_CTL) + CW_KN + layer * 64 + b * 8 + h, __float_as_uint(mk), RLX_AGENT);
    }
    if (c.tid < 8) { const int h = c.tid; float lf[16];
#pragma unroll
        for (int r = 0; r < 16; ++r) lf[r] = LFm[r * 8 + h];
        float suf = 0.f;
#pragma unroll
        for (int r = 15; r >= 0; --r) { bf16 bh, bm, bl; split3(suf * LOG2E, bh, bm, bl); bf16* kp = KAf + (size_t)(MOFF + r) * PKA + h * 80 + 64;
            const u32x4 w0 = {(unsigned)bh | ((unsigned)bm << 16), (unsigned)bl | 0x3F800000u, 0x3F803F80u, 0u}, w1 = {0u, 0u, 0u, 0u}; *(u32x4*)kp = w0; *(u32x4*)(kp + 8) = w1; suf += lf[r]; } }
}
__device__ __forceinline__ void post_up(const Ctx& c) {
    const float* raw = WSP(float, WS_RAWU); const float* rqm = WSP(float, WS_RQM);
    bf16 *QBm = WSP(bf16, WS_QBM), *KBf = WSP(bf16, WS_KB), *VBf = WSP(bf16, WS_VB);
    const float *cos32 = WSP(float, WS_COS32), *sin32 = WSP(float, WS_SIN32);
    for (int e = c.bid * NTHREADS + c.tid; e < 16 * (NUQ + NUKV); e += c.G * NTHREADS) {
        const int r = e / (NUQ + NUKV), p = e % (NUQ + NUKV); const float v = raw[e];
        if (p < 512) { const int h = p >> 6, d = p & 63; QBm[r * PQB + h * 96 + d] = f2bf(v * rqm[r] * C2B); }
        else if (p < 768) { const int cc = p - 512, half = cc >> 7, c7 = cc & 127; if (half == 0) { const int h = c7 >> 4, d = c7 & 15; const float sc = rqm[r] * C2B, x1 = v * sc, x2 = raw[e + 128] * sc, cs = cos32[r * 16 + d], sn = sin32[r * 16 + d];
                QBm[r * PQB + h * 96 + 64 + d] = f2bf(x1 * cs - x2 * sn); QBm[r * PQB + h * 96 + 80 + d] = f2bf(x2 * cs + x1 * sn); } }
        else { const int q = p - 768, h = q >> 7, d = q & 127; const float w = v * rqm[16 + r];
            if (d < 64) KBf[(size_t)(MOFF + r) * PKB + h * 96 + d] = f2bf(w); else VBf[(size_t)(MOFF + r) * PVB + h * 64 + (d - 64)] = f2bf(w); }
    }
}
__device__ __forceinline__ void post_resid(const Ctx& c) {
    for (int r = c.wave; r < 16; r += NWAVES) {
        float* hm = WSP(float, WS_HM) + (size_t)r * DM; const float* ro = WSP(float, WS_RAWO) + (size_t)r * DM;
        f32x4 v[4]; float s = 0.f;
#pragma unroll
        for (int j = 0; j < 4; ++j) { v[j] = ((const f32x4*)hm + c.lane)[64 * j] + ((const f32x4*)ro + c.lane)[64 * j]; s += (v[j][0] * v[j][0] + v[j][1] * v[j][1]) + (v[j][2] * v[j][2] + v[j][3] * v[j][3]); }
        const float rstd = 1.f / sqrtf(wave_sum(s) * (1.f / DM) + EPS);
        u32x2* o8 = (u32x2*)(WSP(bf16, WS_HNM) + (size_t)r * DM) + c.lane;
#pragma unroll
        for (int j = 0; j < 4; ++j) { u32x2 w; w.x = cvtpk(v[j][0] * rstd, v[j][1] * rstd); w.y = cvtpk(v[j][2] * rstd, v[j][3] * rstd); o8[64 * j] = w; ((f32x4*)hm + c.lane)[64 * j] = v[j]; }
    }
}

template <int DK, int MODE>
__device__ __forceinline__ void attn_row(const bf16* qrow, const bf16* Kf, const bf16* Km, int kpitch, int koff, const bf16* Vf, const bf16* Vm, int vpitch, int voff, int t, float sink2, bf16* orow) {
    float q[DK];
#pragma unroll
    for (int d = 0; d < DK; d += 8) { f32x4 a, b; ld8(qrow + d, a, b);
#pragma unroll
        for (int j = 0; j < 4; ++j) { q[d + j] = a[j]; q[d + 4 + j] = b[j]; } }
    float o[64];
#pragma unroll
    for (int d = 0; d < 64; ++d) o[d] = 0.f;
    float m = -1e30f, l = 0.f; if (MODE == 2) { m = sink2; l = 1.f; }
    const int s0 = (MODE == 2) ? (t - 127 > 0 ? t - 127 : 0) : 0;
    for (int s = s0; s <= t; ++s) {
        const bf16* kp = (s < NMETA) ? Kf + (size_t)(MOFF + s) * kpitch + koff : Km + (size_t)(s - NMETA) * kpitch + koff;
        const bf16* vp = (s < NMETA) ? Vf + (size_t)(MOFF + s) * vpitch + voff : Vm + (size_t)(s - NMETA) * vpitch + voff;
        float x = 0.f;
#pragma unroll
        for (int d = 0; d < DK; d += 8) { f32x4 a, b; ld8(kp + d, a, b);
#pragma unroll
            for (int j = 0; j < 4; ++j) { x += q[d + j] * a[j]; x += q[d + 4 + j] * b[j]; } }
        if (MODE == 0) x += bf2f(kp[64]) + bf2f(kp[65]) + bf2f(kp[66]);
        if (x > m) { const float f = fexp2(m - x); l *= f;
#pragma unroll
            for (int d = 0; d < 64; ++d) o[d] *= f;
            m = x; }
        const float p = fexp2(x - m); l += p;
#pragma unroll
        for (int d = 0; d < 64; d += 8) { f32x4 a, b; ld8(vp + d, a, b);
#pragma unroll
            for (int j = 0; j < 4; ++j) { o[d + j] += p * a[j]; o[d + 4 + j] += p * b[j]; } }
    }
    const float il = 1.f / l;
#pragma unroll
    for (int d = 0; d < 64; d += 8) { f32x4 a = {o[d] * il, o[d + 1] * il, o[d + 2] * il, o[d + 3] * il}, b = {o[d + 4] * il, o[d + 5] * il, o[d + 6] * il, o[d + 7] * il}; st8(orow + d, a, b); }
}
__device__ __forceinline__ void attn_main_naive(const Ctx& c, int layer) {
    const int g = c.bid * NTHREADS + c.tid, NG = c.G * NTHREADS;
    for (int e = g; e < M * 8; e += NG) {
        const int i = e % SEQ, bh = e / SEQ, b = bh >> 3, h = bh & 7; const size_t row = (size_t)b * SEQ + i; const int t = NMETA + i;
        attn_row<64, 0>(WSP(bf16, WS_QA) + row * PQA + h * 64, WSP(bf16, WS_KA), WSP(bf16, WS_KA) + (size_t)(FR + b * SEQ) * PKA, PKA, h * 80,
                        WSP(bf16, WS_VA), WSP(bf16, WS_VA) + (size_t)(FR + b * SEQ) * PVA, PVA, h * 64, t, 0.f, WSP(bf16, WS_QA) + row * PQA + h * 64);
    }
    for (int e = g; e < M * 8; e += NG) {
        const int i = e % SEQ, bh = e / SEQ, b = bh >> 3, h = bh & 7; const size_t row = (size_t)b * SEQ + i; const int t = NMETA + i;
        attn_row<96, 1>(WSP(bf16, WS_QB) + row * PQB + h * 96, WSP(bf16, WS_KB), WSP(bf16, WS_KB) + (size_t)(FR + b * SEQ) * PKB, PKB, h * 96,
                        WSP(bf16, WS_VB), WSP(bf16, WS_VB) + (size_t)(FR + b * SEQ) * PVB, PVB, h * 64, t, 0.f, WSP(bf16, WS_YB) + row * PY + h * 64);
    }
    for (int e = g; e < M * 8; e += NG) {
        const int i = e % SEQ, bh = e / SEQ, b = bh >> 3, h = bh & 7; const size_t row = (size_t)b * SEQ + i; const int t = NMETA + i;
        attn_row<64, 2>(WSP(bf16, WS_QC) + row * PQC + h * 64, WSP(bf16, WS_KC), WSP(bf16, WS_KC) + (size_t)(FR + b * SEQ) * PKC, PKC, (h >> 2) * 64,
                        WSP(bf16, WS_VC), WSP(bf16, WS_VC) + (size_t)(FR + b * SEQ) * PVC, PVC, (h >> 2) * 64, t, c.sinks[layer * 8 + h] * LOG2E, WSP(bf16, WS_QC) + row * PQC + h * 64);
    }
}

namespace fa {
typedef float f32x16 __attribute__((ext_vector_type(16)));
typedef short s16x4 __attribute__((ext_vector_type(4)));
constexpr int KSLOT = 12288, VSLOT = 8192, OFF_K = 0, OFF_V = 2 * KSLOT, OFF_WS = OFF_V + 2 * VSLOT, OFF_OST = OFF_WS + NWAVES * 256, LDS_END = OFF_OST + NWAVES * 4096;
__device__ __forceinline__ int crow(int r, int hi) { return (r & 3) + 8 * (r >> 2) + 4 * hi; }
#define FA_SBAR() __builtin_amdgcn_sched_barrier(0)
__device__ __forceinline__ void pv(f32x16* o, int vb, bf16x8 pa0, bf16x8 pa1, bf16x8 pa2, bf16x8 pa3) {
#pragma unroll
    for (int d0 = 0; d0 < 2; ++d0) { s16x4 lo[4], hi[4];
#pragma unroll
        for (int ks = 0; ks < 4; ++ks) {
            asm volatile("ds_read_b64_tr_b16 %0,%1 offset:%c2" : "=&v"(lo[ks]) : "v"(vb), "i"(d0 * 4096 + ks * 1024) : "memory");
            asm volatile("ds_read_b64_tr_b16 %0,%1 offset:%c2" : "=&v"(hi[ks]) : "v"(vb), "i"(d0 * 4096 + ks * 1024 + 512) : "memory"); }
        asm volatile("s_waitcnt lgkmcnt(0)" ::: "memory"); FA_SBAR();
#define FA_PK(k) (bf16x8){lo[k][0], lo[k][1], lo[k][2], lo[k][3], hi[k][0], hi[k][1], hi[k][2], hi[k][3]}
        o[d0] = __builtin_amdgcn_mfma_f32_32x32x16_bf16(pa0, FA_PK(0), o[d0], 0, 0, 0);
        o[d0] = __builtin_amdgcn_mfma_f32_32x32x16_bf16(pa1, FA_PK(1), o[d0], 0, 0, 0);
        o[d0] = __builtin_amdgcn_mfma_f32_32x32x16_bf16(pa2, FA_PK(2), o[d0], 0, 0, 0);
        o[d0] = __builtin_amdgcn_mfma_f32_32x32x16_bf16(pa3, FA_PK(3), o[d0], 0, 0, 0);
#undef FA_PK
    }
}
struct Tensors { const bf16* Q; int qpitch, qoff; const bf16* Kf; const bf16* Km; int kpitch, koff; const bf16* Vf; const bf16* Vm; int vpitch, voff; bf16* O; int opitch, ooff; };
template <int NK, int MODE>
__device__ __forceinline__ void attn_unit(const Ctx& c, const Tensors& T, int j, float sink2) {
    constexpr int NCH = 2 * NK;
    LAS unsigned char* lds = c.lds;
    const int lane = c.lane, wid = c.wave, r32 = lane & 31, hi = lane >> 5;
    const unsigned lds0 = (unsigned)(size_t)lds;
    LAS float* wsf = (LAS float*)(lds + OFF_WS) + wid * 64;
    const int q0 = 256 * j;
    const int t_hi = 4 * j + 4, t_lo = (MODE == 2) ? (4 * j - 1 > 0 ? 4 * j - 1 : 0) : 0;
    bf16x8 qr[NK];
    { const bf16* qp = T.Q + (size_t)(q0 + wid * 32 + r32) * T.qpitch + T.qoff + hi * 8;
#pragma unroll
      for (int d0 = 0; d0 < NK; ++d0) { if (MODE == 0 && d0 == NK - 1) { const short one = (short)0x3F80; qr[d0] = hi ? (bf16x8){0, 0, 0, 0, 0, 0, 0, 0} : (bf16x8){one, one, one, 0, 0, 0, 0, 0}; } else qr[d0] = *(const bf16x8*)(qp + d0 * 16); } }
    u32x4 sk0, sk1 = {0u, 0u, 0u, 0u}, sv;
    const bool k2 = (wid + 8 < NCH);
#define FA_LOAD(t) do { const bf16* kt = ((t) == 0) ? T.Kf : T.Km + (size_t)(64 * ((t) - 1)) * T.kpitch; const bf16* vt = ((t) == 0) ? T.Vf : T.Vm + (size_t)(64 * ((t) - 1)) * T.vpitch; \
        sk0 = *(const u32x4*)(kt + (size_t)lane * T.kpitch + T.koff + wid * 8); if (k2) sk1 = *(const u32x4*)(kt + (size_t)lane * T.kpitch + T.koff + (wid + 8) * 8); \
        sv = *(const u32x4*)(vt + (size_t)(16 * (wid & 3) + (lane >> 2)) * T.vpitch + T.voff + (wid >> 2) * 32 + (lane & 3) * 8); } while (0)
#define FA_WRITE(b) do { *(LAS u32x4*)(lds + OFF_K + (b) * KSLOT + wid * 1024 + lane * 16) = sk0; if (k2) *(LAS u32x4*)(lds + OFF_K + (b) * KSLOT + (wid + 8) * 1024 + lane * 16) = sk1; \
        *(LAS u32x4*)(lds + OFF_V + (b) * VSLOT + wid * 1024 + lane * 16) = sv; } while (0)
    float m = (MODE == 2) ? sink2 : -INFINITY, l = (MODE == 2 && hi == 0) ? 1.f : 0.f;
    f32x16 o[2]; o[0] = f32x16{}; o[1] = f32x16{};
    const int qpos = NMETA + q0 + wid * 32 + r32;
    FA_LOAD(t_lo); FA_WRITE(0);
    int buf = 0;
    for (int t = t_lo; t <= t_hi; ++t) {
        __syncthreads();
        if (t < t_hi) FA_LOAD(t + 1);
        const int kpos0 = (t == 0) ? -MOFF : NMETA + 64 * (t - 1);
        const int qmin_w = NMETA + q0 + wid * 32;
        const bool active = (MODE != 2) || !(kpos0 > qmin_w + 31 || kpos0 + 63 < qmin_w - 127);
        if (active) {
        f32x16 p0 = f32x16{}, p1 = f32x16{};
        { const LAS unsigned char* kb = lds + OFF_K + buf * KSLOT + hi * 1024 + r32 * 16;
#pragma unroll
          for (int d0 = 0; d0 < NK; ++d0) { const bf16x8 b0 = *(const LAS bf16x8*)(kb + d0 * 2048), b1 = *(const LAS bf16x8*)(kb + d0 * 2048 + 512);
              p0 = __builtin_amdgcn_mfma_f32_32x32x16_bf16(b0, qr[d0], p0, 0, 0, 0); p1 = __builtin_amdgcn_mfma_f32_32x32x16_bf16(b1, qr[d0], p1, 0, 0, 0); } }
        const bool need = (t == 0) || (t > t_hi - 4) || (MODE == 2);
        if (need) {
#pragma unroll
            for (int r = 0; r < 16; ++r) { const int ka = kpos0 + crow(r, hi), kb2 = ka + 32;
                bool ma = (ka > qpos) || (ka < 0), mb = (kb2 > qpos) || (kb2 < 0);
                if (MODE == 2) { ma = ma || (qpos - ka >= 128); mb = mb || (qpos - kb2 >= 128); }
                if (ma) p0[r] = -INFINITY; if (mb) p1[r] = -INFINITY; }
        }
        float rm = fmaxf(p0[0], p1[0]);
#pragma unroll
        for (int r = 1; r < 16; ++r) rm = fmaxf(rm, fmaxf(p0[r], p1[r]));
        { auto rr = __builtin_amdgcn_permlane32_swap(__float_as_uint(rm), __float_as_uint(rm), false, false); rm = fmaxf(__uint_as_float(rr[0]), __uint_as_float(rr[1])); }
        const float mn = fmaxf(m, rm);
        const bool grew = mn > m;
        const float alpha = (mn == -INFINITY) ? 1.f : fexp2(m - mn);
        const float msub = (mn == -INFINITY) ? 0.f : mn;
        float rs = 0.f;
#pragma unroll
        for (int r = 0; r < 16; ++r) { p0[r] = fexp2(p0[r] - msub); p1[r] = fexp2(p1[r] - msub); rs += p0[r] + p1[r]; }
        l = l * alpha + rs; m = mn;
        if (__any(grew)) {
            if (hi == 0) wsf[r32] = alpha;
            asm volatile("s_waitcnt lgkmcnt(0)" ::: "memory");
#pragma unroll
            for (int r = 0; r < 16; ++r) { const float f = wsf[crow(r, hi)]; o[0][r] *= f; o[1][r] *= f; }
        }
        u32x4 pw0, pw1, pw2, pw3;
        pw0 = (u32x4){cvtpk(p0[0], p0[1]), cvtpk(p0[2], p0[3]), cvtpk(p0[4], p0[5]), cvtpk(p0[6], p0[7])}; pw1 = (u32x4){cvtpk(p0[8], p0[9]), cvtpk(p0[10], p0[11]), cvtpk(p0[12], p0[13]), cvtpk(p0[14], p0[15])};
        pw2 = (u32x4){cvtpk(p1[0], p1[1]), cvtpk(p1[2], p1[3]), cvtpk(p1[4], p1[5]), cvtpk(p1[6], p1[7])}; pw3 = (u32x4){cvtpk(p1[8], p1[9]), cvtpk(p1[10], p1[11]), cvtpk(p1[12], p1[13]), cvtpk(p1[14], p1[15])};
        if (t < t_hi) FA_WRITE(buf ^ 1);
        const int vb = (int)(lds0 + OFF_V + buf * VSLOT) + ((lane >> 4) & 1) * 32 + (lane & 3) * 8 + (4 * hi + ((lane & 15) >> 2)) * 64;
        pv(o, vb, __builtin_bit_cast(bf16x8, pw0), __builtin_bit_cast(bf16x8, pw1), __builtin_bit_cast(bf16x8, pw2), __builtin_bit_cast(bf16x8, pw3));
        } else { if (t < t_hi) FA_WRITE(buf ^ 1); }
        buf ^= 1;
    }
    { auto rr = __builtin_amdgcn_permlane32_swap(__float_as_uint(l), __float_as_uint(l), false, false); l = __uint_as_float(rr[0]) + __uint_as_float(rr[1]); }
    if (hi == 0) wsf[32 + r32] = l;
    asm volatile("s_waitcnt lgkmcnt(0)" ::: "memory");
    LAS bf16* stg = (LAS bf16*)(lds + OFF_OST) + wid * 2048;
#pragma unroll
    for (int r = 0; r < 16; ++r) { const int orow = crow(r, hi); const float rl = frcp(wsf[32 + orow]);
        stg[orow * 64 + r32] = f2bf(o[0][r] * rl); stg[orow * 64 + 32 + r32] = f2bf(o[1][r] * rl); }
    asm volatile("s_waitcnt lgkmcnt(0)" ::: "memory");
    bf16* Ow = T.O + (size_t)(q0 + wid * 32) * T.opitch + T.ooff;
#pragma unroll
    for (int i = 0; i < 4; ++i) { const int row = i * 8 + (lane >> 3), ch = lane & 7; const u32x4 v = *(const LAS u32x4*)(stg + row * 64 + ch * 8); *(u32x4*)(Ow + (size_t)row * T.opitch + ch * 8) = v; }
    __syncthreads();
#undef FA_LOAD
#undef FA_WRITE
}
#undef FA_SBAR
}
static_assert(fa::LDS_END <= 131072, "attention LDS");


namespace fb {
typedef float f32x16 __attribute__((ext_vector_type(16)));
typedef short s16x4 __attribute__((ext_vector_type(4)));
typedef short v4i16_t __attribute__((ext_vector_type(4)));
typedef __attribute__((address_space(3))) const char* lds_cptr;
__device__ __forceinline__ int crow(int r, int hi) { return (r & 3) + 8 * (r >> 2) + 4 * hi; }
#define SBAR() __builtin_amdgcn_sched_barrier(0)
__device__ __forceinline__ void cmask(f32x16& p0, f32x16& p1, int jb, int qrel, int hi) {
    const float NEG = -INFINITY; const int kb = 64 * jb + 4 * hi;
#pragma unroll
    for (int r = 0; r < 16; ++r) { const int kv = kb + (r & 3) + 8 * (r >> 2); if (kv > qrel) p0[r] = NEG; if (kv + 32 > qrel) p1[r] = NEG; }
}
__device__ __forceinline__ void glds16(const void* gsrc, unsigned lds_dst) { unsigned keep;
    asm volatile("s_mov_b32 %0, m0\n\ts_mov_b32 m0, %2\n\ts_nop 0\n\tglobal_load_lds_dwordx4 %1, off\n\ts_mov_b32 m0, %0" : "=&s"(keep) : "v"(gsrc), "s"(lds_dst) : "memory"); }
__device__ __forceinline__ float max3f(float a, float b, float c) { float r; asm("v_max3_f32 %0, %1, %2, %3" : "=v"(r) : "v"(a), "v"(b), "v"(c)); return r; }
__device__ __forceinline__ float max2f(float a, float b) { float r; asm("v_max_f32_e32 %0, %1, %2" : "=v"(r) : "v"(a), "v"(b)); return r; }
__device__ __forceinline__ float fadd_s(float a, float b) { float r; asm("v_add_f32_e32 %0, %1, %2" : "=v"(r) : "v"(a), "v"(b)); return r; }
__device__ __forceinline__ float fsub_s(float a, float b) { float r; asm("v_sub_f32_e32 %0, %1, %2" : "=v"(r) : "v"(a), "v"(b)); return r; }
#define WAIT_BAR(N) asm volatile("s_waitcnt vmcnt(" #N ") lgkmcnt(0)\n\ts_barrier" ::: "memory")
__device__ __forceinline__ void kload2(bf16x8* kf, lds_cptr kp, int j) { kf[2 * j] = *(const LAS bf16x8*)(kp + j * 2048); kf[2 * j + 1] = *(const LAS bf16x8*)(kp + j * 2048 + 512); }
__device__ __forceinline__ s16x4 vtr(lds_cptr p) { return __builtin_bit_cast(s16x4, __builtin_amdgcn_ds_read_tr16_b64_v4i16((LAS v4i16_t*)p)); }
__device__ __forceinline__ float rowmax(const f32x16& p0, const f32x16& p1) {
    float a = max3f(p0[0], p0[1], p1[0]), b = max3f(p0[2], p0[3], p1[1]); a = max3f(a, p1[2], p1[3]);
#pragma unroll
    for (int r = 4; r < 16; r += 4) { a = max3f(a, p0[r], p0[r + 1]); b = max3f(b, p0[r + 2], p0[r + 3]); a = max3f(a, p1[r], p1[r + 1]); b = max3f(b, p1[r + 2], p1[r + 3]); }
    const float m = max2f(a, b);
    auto rr = __builtin_amdgcn_permlane32_swap(__float_as_uint(m), __float_as_uint(m), false, false);
    return max2f(__uint_as_float(rr[0]), __uint_as_float(rr[1]));
}
__device__ __forceinline__ void pv(f32x16* o, int vb, bf16x8 pa0, bf16x8 pa1, bf16x8 pa2, bf16x8 pa3) {
#pragma unroll
    for (int d0 = 0; d0 < 2; ++d0) { s16x4 lo[4], hi[4];
#pragma unroll
        for (int ks = 0; ks < 4; ++ks) {
            asm volatile("ds_read_b64_tr_b16 %0,%1 offset:%c2" : "=&v"(lo[ks]) : "v"(vb), "i"(d0 * 4096 + ks * 1024) : "memory");
            asm volatile("ds_read_b64_tr_b16 %0,%1 offset:%c2" : "=&v"(hi[ks]) : "v"(vb), "i"(d0 * 4096 + ks * 1024 + 512) : "memory"); }
        asm volatile("s_waitcnt lgkmcnt(0)" ::: "memory"); SBAR();
#define PK(k) (bf16x8){lo[k][0], lo[k][1], lo[k][2], lo[k][3], hi[k][0], hi[k][1], hi[k][2], hi[k][3]}
        o[d0] = __builtin_amdgcn_mfma_f32_32x32x16_bf16(pa0, PK(0), o[d0], 0, 0, 0);
        o[d0] = __builtin_amdgcn_mfma_f32_32x32x16_bf16(pa1, PK(1), o[d0], 0, 0, 0);
        o[d0] = __builtin_amdgcn_mfma_f32_32x32x16_bf16(pa2, PK(2), o[d0], 0, 0, 0);
        o[d0] = __builtin_amdgcn_mfma_f32_32x32x16_bf16(pa3, PK(3), o[d0], 0, 0, 0);
#undef PK
    }
}
template <int NK> struct Geo { static constexpr int SLOTB = NK * 2048, LDS_K = 0, LDS_V = 3 * SLOTB, LDS_WS = 6 * SLOTB, LDS_OST = LDS_WS + NWAVES * 256, LDS_BYTES = LDS_OST + NWAVES * 4096; };
template <int NK, bool AUG, int QP, int KP, int VP, int OP, int THRL, bool XFIRST = false, int VLATE = 0, bool NONEGM = false>
__device__ __forceinline__ void attn_unit(const bf16* Qb, const bf16* Kf, const bf16* Km, const bf16* Vf, const bf16* Vm, bf16* Ob, int j, char* shm, int tid, int t0 = 0) {
    typedef Geo<NK> G; constexpr int SLOTB = G::SLOTB, LDS_K = G::LDS_K, LDS_V = G::LDS_V, LDS_WS = G::LDS_WS, LDS_OST = G::LDS_OST, NCH = 2 * NK, NKD = (NK > 4) ? 2 : 1, NSLOT = 3;
    const int lane = tid & 63, r32 = lane & 31, hi = lane >> 5; const int wid = __builtin_amdgcn_readfirstlane(tid >> 6);
    const int q0 = 256 * j;
    const bf16* Qw = Qb + (size_t)(q0 + wid * 32) * QP;
    const unsigned lds0 = (unsigned)(uintptr_t)shm;
    float* wsf = (float*)(shm + LDS_WS) + wid * 64;
    const int c2 = 8 + (wid % (NCH > 8 ? NCH - 8 : 1));
    const bf16* ksrc_f = Kf + (size_t)lane * KP + wid * 8; const bf16* ksrc_m = Km + (size_t)lane * KP + wid * 8;
    const bf16* vsrc_f = Vf + (size_t)(16 * (wid & 3) + (lane >> 2)) * VP + (wid >> 2) * 32 + (lane & 3) * 8; const bf16* vsrc_m = Vm + (size_t)(16 * (wid & 3) + (lane >> 2)) * VP + (wid >> 2) * 32 + (lane & 3) * 8;
    const unsigned kdst = lds0 + LDS_K + wid * 1024, kdst2 = lds0 + LDS_K + c2 * 1024, vdst = lds0 + LDS_V + wid * 1024;
#define RFL(x) ((unsigned)__builtin_amdgcn_readfirstlane(x))
#define DMA_KP(src, slot) do { glds16((src), RFL(kdst + (slot))); if (NKD == 2) glds16((src) + (c2 - wid) * 8, RFL(kdst2 + (slot))); } while (0)
#define DMA_K0(slot) DMA_KP(ksrc_f, slot)
#define DMA_KM(t, slot) DMA_KP(ksrc_m + (size_t)((t) - 1) * 64 * KP, slot)
#define DMA_V0(slot) glds16(vsrc_f, RFL(vdst + (slot)))
#define DMA_VM(t, slot) glds16(vsrc_m + (size_t)((t) - 1) * 64 * VP, RFL(vdst + (slot)))
#define WAIT_KV() do { if (NKD == 2) { WAIT_BAR(3); } else { WAIT_BAR(2); } } while (0)
    const int vb0 = (int)(lds0 + LDS_V) + ((lane >> 4) & 1) * 32 + (lane & 3) * 8 + (4 * hi + ((lane & 15) >> 2)) * 64;
    bf16x8 kf[2 * NK];
    const lds_cptr shm3 = (lds_cptr)shm; const lds_cptr kp0 = shm3 + LDS_K + hi * 1024 + r32 * 16; const lds_cptr vp0 = shm3 + LDS_V + ((lane >> 4) & 1) * 32 + (lane & 3) * 8 + (4 * hi + ((lane & 15) >> 2)) * 64;
    const int NT = 4 * j + 5;
    if (t0 == 0) { DMA_K0(0); DMA_V0(0); } else { DMA_KM(t0, 0); DMA_VM(t0, 0); }
    DMA_KM(t0 + 1, SLOTB);
    bf16x8 qr[NK];
#pragma unroll
    for (int d0 = 0; d0 < NK; ++d0) { if (AUG && d0 == NK - 1) { const short one = (short)0x3F80; qr[d0] = hi ? (bf16x8){0, 0, 0, 0, 0, 0, 0, 0} : (bf16x8){one, one, one, 0, 0, 0, 0, 0}; }
        else qr[d0] = *reinterpret_cast<const bf16x8*>(&Qw[(size_t)r32 * QP + d0 * 16 + hi * 8]); }
    float mhat = 0.f, l_reg = 0.f; f32x16 o[2]; o[0] = f32x16{}; o[1] = f32x16{}; f32x16 negm = f32x16{}; if (!AUG && !NONEGM) asm volatile("" : "+v"(negm));
#define SETREF() do { if (AUG) { bf16 h_, m_, l_; split3(-mhat, h_, m_, l_); if (hi == 0) { u32x4 w_ = {0x3F803F80u, 0x3F80u | ((unsigned)h_ << 16), (unsigned)m_ | ((unsigned)l_ << 16), 0u}; qr[NK - 1] = __builtin_bit_cast(bf16x8, w_); } } \
        else if (!NONEGM) { _Pragma("unroll") for (int r = 0; r < 16; ++r) negm[r] = -mhat; asm volatile("" : "+v"(negm)); } } while (0)
#define CIN ((AUG || NONEGM) ? f32x16{} : negm)
    const int qrel = wid * 32 + r32;
#define CMASK(P0, P1, t) do { int jb_ = (t) - (NT - 4); if (jb_ >= 0) cmask(P0, P1, jb_, qrel, hi); } while (0)
    bool resc = false;
#define START(P0, P1) do { const float rm = rowmax(P0, P1); resc = false; \
    { const float dl = rm; mhat = fadd_s(mhat, dl); \
      _Pragma("unroll") for (int r = 0; r < 16; ++r) { P0[r] = fsub_s(P0[r], dl); P1[r] = fsub_s(P1[r], dl); } \
      SETREF(); } \
    _Pragma("unroll") for (int r = 0; r < 16; ++r) P0[r] = __builtin_amdgcn_exp2f(P0[r]); } while (0)
#define RESC() do { if (resc) { asm volatile("s_waitcnt lgkmcnt(0)" ::: "memory"); \
      _Pragma("unroll") for (int d_ = 0; d_ < 2; ++d_) _Pragma("unroll") for (int r = 0; r < 16; ++r) o[d_][r] *= wsf[crow(r, hi)]; } } while (0)
    f32x16 pA0, pA1, pB0, pB1;
    int sl_prev = 0, sl_cur = 0, sl_next = SLOTB;
#define ROT() do { sl_prev = sl_cur; sl_cur = sl_next; sl_next = (sl_next == (NSLOT - 1) * SLOTB) ? 0 : sl_next + SLOTB; } while (0)
    DMA_KM(t0 + 2, 2 * SLOTB);
    if (NKD == 2) { WAIT_BAR(5); } else { WAIT_BAR(3); }
    { pA0 = CIN; pA1 = CIN; const char* kb = shm + LDS_K + hi * 1024 + r32 * 16;
#pragma unroll
      for (int d0 = 0; d0 < NK; ++d0) { const bf16x8 b0 = *reinterpret_cast<const bf16x8*>(kb + d0 * 2048), b1 = *reinterpret_cast<const bf16x8*>(kb + d0 * 2048 + 512);
          pA0 = __builtin_amdgcn_mfma_f32_32x32x16_bf16(b0, qr[d0], pA0, 0, 0, 0); pA1 = __builtin_amdgcn_mfma_f32_32x32x16_bf16(b1, qr[d0], pA1, 0, 0, 0); } }
    asm volatile("s_nop 15\n\ts_nop 7" : "+v"(pA0), "+v"(pA1));
    if (t0 == 0) {
#pragma unroll
        for (int r = 0; r < 16; ++r) { pA0[r] = -INFINITY; if (r < 8) pA1[r] = -INFINITY; } }
    START(pA0, pA1);
#pragma unroll
    for (int r = 0; r < 16; ++r) pA1[r] = __builtin_amdgcn_exp2f(pA1[r]);
    WAIT_BAR(0);
    DMA_KM(t0 + 3, 0); DMA_VM(t0 + 1, SLOTB);
    ROT();
#pragma unroll
    for (int jj = 0; jj < NK; ++jj) kload2(kf, kp0 + sl_cur, jj);
    WAIT_KV();
    s16x4 vlo[8], vhi[8]; u32x4 pw0, pw1, pw2, pw3;
#define PKW(P, B) cvtpk(P[B], P[B + 1])
#define PAF(k) __builtin_bit_cast(bf16x8, pw##k)
#define VFR(i) (bf16x8){vlo[i][0], vlo[i][1], vlo[i][2], vlo[i][3], vhi[i][0], vhi[i][1], vhi[i][2], vhi[i][3]}
#define PIN(x) asm volatile("" : "+v"(x))
#define MX3(a, b, c) __builtin_fmaxf(__builtin_fmaxf((a), (b)), (c))
#define MF(c_, a_, b_) __builtin_amdgcn_mfma_f32_32x32x16_bf16(a_, b_, c_, 0, 0, 0)
#define GAPA(MFX, A0, A1, A2, A3, W0, W1, PW) do { MFX; sacc += A0; sacc += A1; sacc += A2; sacc += A3; PIN(sacc); W0; W1; PIN(PW); SBAR(); } while (0)
#define EX(v) __builtin_amdgcn_exp2f(v)
#define GAPB(MFX, X, B) do { MFX; X[B] = EX(X[B]); X[B + 1] = EX(X[B + 1]); X[B + 2] = EX(X[B + 2]); X[B + 3] = EX(X[B + 3]); PIN(X); SBAR(); } while (0)
#define VRD(i) do { vlo[i] = vtr(vp_ + (((i) >> 2) * 4096 + ((i) & 3) * 1024)); vhi[i] = vtr(vp_ + (((i) >> 2) * 4096 + ((i) & 3) * 1024 + 512)); } while (0)
#define KRD(Gf, jj) do { if (Gf) { kload2(kf, kp0 + sl_next, jj); SBAR(); } } while (0)
#define XF (XFIRST && NK > 4)
#define STEP(C0, C1, P0, P1, t, GK, GV, GL) do { SBAR(); \
    const lds_cptr vp_ = vp0 + sl_prev; \
    if (XF) { C0 = MF(CIN, kf[8 % (2 * NK)], qr[4 % NK]); C1 = MF(CIN, kf[9 % (2 * NK)], qr[4 % NK]); \
        if (NK > 5) { C0 = MF(C0, kf[10 % (2 * NK)], qr[5 % NK]); C1 = MF(C1, kf[11 % (2 * NK)], qr[5 % NK]); } SBAR(); } \
    if (VLATE < 2) { VRD(0); SBAR(); } float sacc = (P0[0] + P0[1]); \
    GAPA(C0 = MF((XF ? C0 : CIN), kf[0], qr[0]), P0[2], P0[3], P0[4], P0[5],     pw0[0] = PKW(P0, 0), pw0[1] = PKW(P0, 2), pw0); \
    if (VLATE < 2) { VRD(4); SBAR(); } GAPA(C1 = MF((XF ? C1 : CIN), kf[1], qr[0]), P0[6], P0[7], P0[8], P0[9],     pw0[2] = PKW(P0, 4), pw0[3] = PKW(P0, 6), pw0); \
    if (VLATE < 2) { VRD(1); SBAR(); } GAPA(C0 = MF(C0, kf[2], qr[1]),   P0[10], P0[11], P0[12], P0[13], pw1[0] = PKW(P0, 8), pw1[1] = PKW(P0, 10), pw1); \
    if (VLATE < 2) { VRD(5); SBAR(); } GAPA(C1 = MF(C1, kf[3], qr[1]),   P0[14], P0[15], P1[0], P1[1],   pw1[2] = PKW(P0, 12), pw1[3] = PKW(P0, 14), pw1); \
    if (VLATE == 0) { VRD(2); SBAR(); } GAPA(C0 = MF(C0, kf[4], qr[2]),   P1[2], P1[3], P1[4], P1[5],     pw2[0] = PKW(P1, 0), pw2[1] = PKW(P1, 2), pw2); \
    if (VLATE == 0) { VRD(6); SBAR(); } GAPA(C1 = MF(C1, kf[5], qr[2]),   P1[6], P1[7], P1[8], P1[9],     pw2[2] = PKW(P1, 4), pw2[3] = PKW(P1, 6), pw2); \
    if (VLATE == 0) { VRD(3); SBAR(); } if (VLATE == 2) { VRD(0); SBAR(); } GAPA(C0 = MF(C0, kf[6], qr[3]),   P1[10], P1[11], P1[12], P1[13], pw3[0] = PKW(P1, 8), pw3[1] = PKW(P1, 10), pw3); \
    if (VLATE == 0) { VRD(7); SBAR(); } if (VLATE == 2) { VRD(4); SBAR(); } GAPA(C1 = MF(C1, kf[7], qr[3]),   P1[14], P1[15], 0.f, 0.f,       pw3[2] = PKW(P1, 12), pw3[3] = PKW(P1, 14), pw3); \
    if (NK > 4 && !XF) { C0 = MF(C0, kf[8 % (2 * NK)], qr[4 % NK]); C1 = MF(C1, kf[9 % (2 * NK)], qr[4 % NK]); SBAR(); } \
    if (NK > 5 && !XF) { C0 = MF(C0, kf[10 % (2 * NK)], qr[5 % NK]); C1 = MF(C1, kf[11 % (2 * NK)], qr[5 % NK]); SBAR(); } \
    l_reg += sacc; \
    if (NONEGM) { _Pragma("unroll") for (int r = 0; r < 16; ++r) { C0[r] -= mhat; C1[r] -= mhat; } } \
    if (GK) { DMA_KM((t) + 3, sl_cur); } if (GV) { DMA_VM((t) + 1, sl_next); } \
    CMASK(C0, C1, t); \
    { float a = MX3(C0[0], C0[1], C1[0]), b = MX3(C0[2], C0[3], C1[1]); a = MX3(a, C1[2], C1[3]); \
      _Pragma("unroll") for (int r = 4; r < 16; r += 4) { a = MX3(a, C0[r], C0[r + 1]); b = MX3(b, C0[r + 2], C0[r + 3]); a = MX3(a, C1[r], C1[r + 1]); b = MX3(b, C1[r + 2], C1[r + 3]); } \
      float rm = __builtin_fmaxf(a, b); { auto rr = __builtin_amdgcn_permlane32_swap(__float_as_uint(rm), __float_as_uint(rm), false, false); rm = __builtin_fmaxf(__uint_as_float(rr[0]), __uint_as_float(rr[1])); } \
      resc = false; \
      if (__builtin_expect(__any(rm > (float)THRL), 0)) { const float dl = __builtin_fmaxf(rm, 0.f); mhat += dl; \
        _Pragma("unroll") for (int r = 0; r < 16; ++r) { C0[r] -= dl; C1[r] -= dl; } \
        SETREF(); \
        const float f = __builtin_amdgcn_exp2f(-dl); l_reg *= f; if (hi == 0) wsf[r32] = f; resc = true; } } \
    SBAR(); \
    if (VLATE == 1) { VRD(2); SBAR(); } if (VLATE == 2) { VRD(1); SBAR(); } GAPB(o[0] = MF(o[0], PAF(0), VFR(0)), C0, 0); \
    if (VLATE == 1) { VRD(6); SBAR(); } if (VLATE == 2) { VRD(5); SBAR(); } GAPB(o[1] = MF(o[1], PAF(0), VFR(4)), C0, 4); \
    if (VLATE == 1) { VRD(3); SBAR(); } if (VLATE == 2) { VRD(2); SBAR(); } KRD(GL, 0); GAPB(o[0] = MF(o[0], PAF(1), VFR(1)), C0, 8); \
    if (VLATE == 1) { VRD(7); SBAR(); } if (VLATE == 2) { VRD(6); SBAR(); } KRD(GL, 1); GAPB(o[1] = MF(o[1], PAF(1), VFR(5)), C0, 12); \
    if (VLATE == 2) { VRD(3); SBAR(); } KRD(GL, 2); GAPB(o[0] = MF(o[0], PAF(2), VFR(2)), C1, 0); \
    if (VLATE == 2) { VRD(7); SBAR(); } KRD(GL, 3); GAPB(o[1] = MF(o[1], PAF(2), VFR(6)), C1, 4); \
    if (NK > 4) KRD(GL, 4 % NK); GAPB(o[0] = MF(o[0], PAF(3), VFR(3)), C1, 8); \
    if (NK > 5) KRD(GL, 5 % NK); GAPB(o[1] = MF(o[1], PAF(3), VFR(7)), C1, 12); \
    } while (0)
    int t = t0 + 1;
#undef CMASK
#define CMASK(P0, P1, t) do { } while (0)
    for (; t + 5 < NT; t += 2) {
        STEP(pB0, pB1, pA0, pA1, t, true, true, true);     WAIT_KV(); RESC(); ROT();
        STEP(pA0, pA1, pB0, pB1, t + 1, true, true, true); WAIT_KV(); RESC(); ROT();
    }
#undef CMASK
#define CMASK(P0, P1, t) do { int jb_ = (t) - (NT - 4); if (jb_ >= 0) cmask(P0, P1, jb_, qrel, hi); } while (0)
#define ENDW(tt) do { if ((tt) + 3 < NT) { WAIT_KV(); } else if ((tt) + 2 < NT) { WAIT_BAR(1); } else { WAIT_BAR(0); } } while (0)
    for (; t + 1 < NT; t += 2) {
        STEP(pB0, pB1, pA0, pA1, t, (t + 3 < NT), (t + 1 < NT), (t + 1 < NT));       ENDW(t);     RESC(); ROT();
        STEP(pA0, pA1, pB0, pB1, t + 1, (t + 4 < NT), (t + 2 < NT), (t + 2 < NT));   ENDW(t + 1); RESC(); ROT();
    }
    { float sacc = pA0[0] + pA0[1];
#pragma unroll
      for (int r = 2; r < 16; ++r) sacc += pA0[r];
#pragma unroll
      for (int r = 0; r < 16; ++r) sacc += pA1[r];
      l_reg += sacc;
      pw0 = (u32x4){PKW(pA0, 0), PKW(pA0, 2), PKW(pA0, 4), PKW(pA0, 6)}; pw1 = (u32x4){PKW(pA0, 8), PKW(pA0, 10), PKW(pA0, 12), PKW(pA0, 14)}; pw2 = (u32x4){PKW(pA1, 0), PKW(pA1, 2), PKW(pA1, 4), PKW(pA1, 6)}; pw3 = (u32x4){PKW(pA1, 8), PKW(pA1, 10), PKW(pA1, 12), PKW(pA1, 14)};
      SBAR(); pv(o, vb0 + sl_prev, PAF(0), PAF(1), PAF(2), PAF(3)); }
    { auto rr = __builtin_amdgcn_permlane32_swap(__float_as_uint(l_reg), __float_as_uint(l_reg), false, false); l_reg = __uint_as_float(rr[0]) + __uint_as_float(rr[1]); }
    if (hi == 0) wsf[32 + r32] = l_reg; asm volatile("s_waitcnt lgkmcnt(0)" ::: "memory");
    float rli[16];
#pragma unroll
    for (int r = 0; r < 16; ++r) rli[r] = __builtin_amdgcn_rcpf(wsf[32 + crow(r, hi)]);
    bf16* Ow = Ob + (size_t)(q0 + wid * 32) * OP;
    { bf16* stg = (bf16*)(shm + LDS_OST) + wid * 2048;
#pragma unroll
      for (int r = 0; r < 16; ++r) { const int orow = crow(r, hi);
#pragma unroll
          for (int d0 = 0; d0 < 2; ++d0) stg[orow * 64 + d0 * 32 + r32] = f2bf(o[d0][r] * rli[r]); }
      asm volatile("s_waitcnt lgkmcnt(0)" ::: "memory");
#pragma unroll
      for (int i = 0; i < 4; ++i) { const int row = i * 8 + (lane >> 3), ch = lane & 7; const u32x4 v = *(const u32x4*)(stg + row * 64 + ch * 8); *(u32x4*)(Ow + (size_t)row * OP + ch * 8) = v; } }
    asm volatile("s_waitcnt vmcnt(0) lgkmcnt(0)\n\ts_barrier" ::: "memory");
#undef SETREF
#undef CIN
#undef RFL
#undef DMA_KP
#undef DMA_K0
#undef DMA_KM
#undef DMA_V0
#undef DMA_VM
#undef WAIT_KV
#undef CMASK
#undef START
#undef RESC
#undef ROT
#undef PKW
#undef PAF
#undef VFR
#undef PIN
#undef MX3
#undef MF
#undef GAPA
#undef GAPB
#undef EX
#undef VRD
#undef KRD
#undef STEP
#undef XF
#undef ENDW
}
#undef SBAR
#undef WAIT_BAR
}
static_assert(fb::Geo<6>::LDS_BYTES <= 131072, "attention LDS");

#ifndef FB_THR
#define FB_THR 8
#endif
#ifndef USE_FB_A
#define USE_FB_A USE_FB
#endif
#ifndef USE_FB_B
#define USE_FB_B 1
#endif
#ifndef FBB_XFIRST
#define FBB_XFIRST true
#endif
#ifndef FBB_VLATE
#define FBB_VLATE 2
#endif
#ifndef FBB_NONEGM
#define FBB_NONEGM true
#endif
#ifndef FOX_T
#define FOX_T 40.f
#endif
__device__ __forceinline__ void attn_main_mfma(const Ctx& c0, int layer) {
#define LAUNDER() Ctx c = c0; asm volatile("" : "+v"(c.tid)); c.lane = c.tid & 63; c.wave = __builtin_amdgcn_readfirstlane(c.tid >> 6);
    char* shm = (char*)(__attribute__((address_space(0))) char*)c0.lds; (void)shm;
    volatile LAS unsigned* MISC = (volatile LAS unsigned*)(c0.lds + MISC_OFF);
    const int nq = (c0.G % 8 == 0) ? 8 : 1, q = c0.bid % nq, heads = 32 / nq, nbig = 32 * heads, nall = nbig + 16 * heads;
    gu32* head = (gu32*)(c0.ws + WS_CTL) + CW_QUE + (layer * 8 + q) * 64;
    for (;;) {
        if (c0.tid == 0) MISC[12] = __hip_atomic_fetch_add(head, 1u, RLX_AGENT);
        __syncthreads();
        const int idx = __builtin_amdgcn_readfirstlane((int)MISC[12]);
        if (idx >= nall) break;
        int type, j, bh;
        if (idx < nbig) { const int jj = idx / (2 * heads), rem = idx - jj * 2 * heads; type = rem / heads; bh = q * heads + rem % heads; j = 15 - jj; }
        else { const int cc = idx - nbig; type = 2; j = 15 - cc / heads; bh = q * heads + cc % heads; }
        const int b = bh >> 3, h = bh & 7; const size_t r0 = (size_t)b * SEQ;
        if (type == 0) { LAUNDER()
            fb::attn_unit<6, false, PQB, PKB, PVB, PY, FB_THR, FBB_XFIRST, FBB_VLATE, FBB_NONEGM>(WSP(bf16, WS_QB) + r0 * PQB + h * 96, WSP(bf16, WS_KB) + h * 96, WSP(bf16, WS_KB) + (FR + r0) * PKB + h * 96, WSP(bf16, WS_VB) + h * 64, WSP(bf16, WS_VB) + (FR + r0) * PVB + h * 64, WSP(bf16, WS_YB) + r0 * PY + h * 64, j, shm, c.tid);
        } else if (type == 1) { LAUNDER()
            int t0 = 0;
            { const gu32* ctl = (const gu32*)(c.ws + WS_CTL);
              const float qn = sqrtf(__uint_as_float(__hip_atomic_load(ctl + CW_QN + layer * 64 + bh, RLX_AGENT))), kn = sqrtf(__uint_as_float(__hip_atomic_load(ctl + CW_KN + layer * 64 + bh, RLX_AGENT)));
              const float* cumb = WSP(float, WS_CUMB) + (size_t)bh * SEQ;
              const float thresh = cumb[256 * j] - FOX_T - 2.f * qn * kn;
              const int i = c.lane;
              const bool sk = (i >= 1) && (i <= 4 * j) && (cumb[64 * (i > 0 ? i : 1) - 1] < thresh);
              const int imax = __builtin_popcountll(__ballot(sk));
              t0 = (imax >= 1) ? ((imax + 1) & ~1) : 0; if (t0 > 4 * j) t0 = 4 * j; t0 = __builtin_amdgcn_readfirstlane(t0); }
            fb::attn_unit<5, true, PQA, PKA, PVA, PQA, FB_THR>(WSP(bf16, WS_QA) + r0 * PQA + h * 64, WSP(bf16, WS_KA) + h * 80, WSP(bf16, WS_KA) + (FR + r0) * PKA + h * 80, WSP(bf16, WS_VA) + h * 64, WSP(bf16, WS_VA) + (FR + r0) * PVA + h * 64, WSP(bf16, WS_QA) + r0 * PQA + h * 64, j, shm, c.tid, t0);
        } else { LAUNDER()
            const fa::Tensors TC{WSP(bf16, WS_QC) + r0 * PQC, PQC, h * 64, WSP(bf16, WS_KC), WSP(bf16, WS_KC) + (FR + r0) * PKC, PKC, (h >> 2) * 64, WSP(bf16, WS_VC), WSP(bf16, WS_VC) + (FR + r0) * PVC, PVC, (h >> 2) * 64, WSP(bf16, WS_QC) + r0 * PQC, PQC, h * 64};
            fa::attn_unit<4, 2>(c, TC, j, c.sinks[layer * 8 + h] * LOG2E);
        }
    }
#undef LAUNDER
}

__device__ __forceinline__ void attn_meta(const Ctx& c) {
    if (c.tid >= 384) return;
    const int br = c.tid / 128, h = (c.tid >> 4) & 7, r = c.tid & 15; bf16* ym = WSP(bf16, WS_YM) + (size_t)r * 1536 + br * 512 + h * 64;
    if (br == 0) attn_row<64, 0>(WSP(bf16, WS_QAM) + r * PQA + h * 64, WSP(bf16, WS_KA), WSP(bf16, WS_KA), PKA, h * 80, WSP(bf16, WS_VA), WSP(bf16, WS_VA), PVA, h * 64, r, 0.f, ym);
    else if (br == 1) attn_row<96, 1>(WSP(bf16, WS_QBM) + r * PQB + h * 96, WSP(bf16, WS_KB), WSP(bf16, WS_KB), PKB, h * 96, WSP(bf16, WS_VB), WSP(bf16, WS_VB), PVB, h * 64, r, 0.f, ym);
    else attn_row<64, 2>(WSP(bf16, WS_QCM) + r * PQC + h * 64, WSP(bf16, WS_KC), WSP(bf16, WS_KC), PKC, (h >> 2) * 64, WSP(bf16, WS_VC), WSP(bf16, WS_VC), PVC, (h >> 2) * 64, r, c.sinks[h] * LOG2E, ym);
}

struct Unit { int pm, pn, z; };
__device__ __forceinline__ int perm32(int rho) { const int n = rho >> 4, i = rho & 15; return 8 * (i >> 2) + 4 * n + (i & 3); }
template <class Prob, class Epi, class Sched>
__device__ __forceinline__ void gemm_naive(const Ctx& c, const Prob& P, const Sched& S, const Epi& E) {
    const int wr = c.wave >> 2, wc = c.wave & 3, fr = c.lane & 15, fq = c.lane >> 4;
    Unit u;
    for (int ui = 0; S.next(ui, u); ++ui) {
        const bf16* A; const bf16* Bt; P.operands(u, A, Bt);
        const int K = P.K, lda = P.K;
        f32x4 acc[2][2][4][2];
#pragma unroll
        for (int a = 0; a < 2; ++a)
#pragma unroll
            for (int b = 0; b < 2; ++b)
#pragma unroll
                for (int m = 0; m < 4; ++m)
#pragma unroll
                    for (int n = 0; n < 2; ++n) acc[a][b][m][n] = (f32x4){0.f, 0.f, 0.f, 0.f};
        for (int k0 = 0; k0 < K; k0 += 64) {
#pragma unroll
            for (int ai = 0; ai < 2; ++ai) {
#pragma unroll
                for (int bj = 0; bj < 2; ++bj) {
                    bf16x8 Bf[2][2];
#pragma unroll
                    for (int n = 0; n < 2; ++n)
#pragma unroll
                        for (int k = 0; k < 2; ++k) Bf[n][k] = *(const bf16x8*)(Bt + (size_t)(256 * u.pn + 128 * bj + 32 * wc + perm32(16 * n + fr)) * K + k0 + 32 * k + 8 * fq);
#pragma unroll
                    for (int m = 0; m < 4; ++m) {
                        bf16x8 At[2];
#pragma unroll
                        for (int k = 0; k < 2; ++k) At[k] = *(const bf16x8*)(A + (size_t)(256 * u.pm + 128 * ai + 64 * wr + 16 * m + fr) * lda + k0 + 32 * k + 8 * fq);
#pragma unroll
                        for (int n = 0; n < 2; ++n)
#pragma unroll
                            for (int k = 0; k < 2; ++k) acc[ai][bj][m][n] = __builtin_amdgcn_mfma_f32_16x16x32_bf16(Bf[n][k], At[k], acc[ai][bj][m][n], 0, 0, 0);
                    }
                }
            }
        }
        asm volatile("" ::: "memory");
        E(acc, u, wr, wc, fr, fq);
    }
}
struct ProbSimple { const bf16* A; const bf16* Bt; int K;
    __device__ __forceinline__ void operands(const Unit&, const bf16*& a, const bf16*& b) const { a = A; b = Bt; } };
struct ProbBranch { const bf16 *A0, *A1, *A2; const bf16* Bt; int K;
    __device__ __forceinline__ void operands(const Unit& u, const bf16*& a, const bf16*& b) const { a = (u.z == 0) ? A0 : (u.z == 1) ? A1 : A2; b = Bt + (size_t)u.z * DM * 512; } };

namespace pg8 {
constexpr int BM = 256, BK = 64, HALF = 128, HTB = HALF * BK * 2, STAGE_BYTES = 8 * HTB, NXCD = 8, WGM = 8;
__host__ __device__ __forceinline__ int lds_byte(int r, int c) { const int st = (r >> 4) * 2 + (c >> 5), rr = r & 15, cc = c & 31, ob = rr * 64 + cc * 2; return st * 1024 + (ob ^ (((ob >> 9) & 1) << 5)); }
__host__ __device__ __forceinline__ void stage_rc(int b, int& R, int& C) { const int st = b / 1024, sb = b % 1024, swz = sb ^ (((sb >> 9) & 1) << 5); R = (st >> 1) * 16 + swz / 64; C = (st & 1) * 32 + (swz % 64) / 2; }
template <int ZN>
struct StaticOrder {
    int nM, nN, nwg, G, c, pn0;
    __device__ __forceinline__ void init(int nM_, int nN_, int pn0_, int G_, int c_) { nM = nM_; nN = nN_; nwg = nM * nN; G = G_; c = c_; pn0 = pn0_; }
    __device__ __forceinline__ bool next(int i, Unit& u) const {
        const int it = i / ZN;
        const long L = (long)it * G + c; if (L >= nwg) return false;
        int wgid = (int)L; { const int q = nwg / NXCD, r = nwg % NXCD, xcd = wgid % NXCD, off = wgid / NXCD; wgid = (xcd < r ? xcd * (q + 1) : r * (q + 1) + (xcd - r) * q) + off; }
        const int nig = WGM * nN, gid = wgid / nig, fm = gid * WGM, gsz = (nM - fm) < WGM ? (nM - fm) : WGM;
        u.pm = fm + ((wgid % nig) % gsz); u.pn = pn0 + (wgid % nig) / gsz; u.z = i - it * ZN; return true;
    }
};
template <class Prob, class Epi, class Sched, bool ALIGN_EPI, bool SP2>
__device__ __forceinline__ void gemm_phase(LAS unsigned char* lds, const Prob& P, const Sched& S, const Epi& E) {
    const int tid = threadIdx.x, wid = __builtin_amdgcn_readfirstlane(tid >> 6), lane = tid & 63, wr = wid >> 2, wc = wid & 3, fr = lane & 15, fq = lane >> 4;
    const int K = P.K, nt = K / BK;
    unsigned voffA[2], voffB[2];
#pragma unroll
    for (int i = 0; i < 2; ++i) { int R, C; stage_rc(tid * 16 + i * 8192, R, C); const int Rb = (R & ~31) + perm32(R & 31);
        voffA[i] = (unsigned)(R * K + C) * 2u; voffB[i] = (unsigned)(Rb * K + C) * 2u; }
    const size_t kstep = (size_t)(BK * 2);
    const size_t hstep = (size_t)HALF * K * 2;
    const size_t tstep = 2 * hstep;
    const unsigned ldsw = (unsigned)wid * 1024u;
    const int aoff = lds_byte(wr * 64 + fr, fq * 8), boff = lds_byte(wc * 32 + fr, fq * 8);
#define PG8_SA(b, h) (((b) * 2 + (h)) * HTB)
#define PG8_SB(b, h) ((4 + (b) * 2 + (h)) * HTB)
#define PG8_STAGE(bufoff, gbase, voff) do { _Pragma("unroll") for (int _i = 0; _i < 2; ++_i) \
        __builtin_amdgcn_global_load_lds((const unsigned*)((const char*)(gbase) + (voff)[_i]), (LAS unsigned*)(lds + (bufoff) + ldsw + _i * 8192), 16, 0, 0); } while (0)
#define PG8_LDA(dst, b, h) do { _Pragma("unroll") for (int m = 0; m < 4; ++m) _Pragma("unroll") for (int k = 0; k < 2; ++k) dst[m][k] = *(const LAS bf16x8*)(lds + PG8_SA(b, h) + aoff + m * 2048 + k * 1024); } while (0)
#define PG8_LDB(dst, b, h) do { _Pragma("unroll") for (int n = 0; n < 2; ++n) _Pragma("unroll") for (int k = 0; k < 2; ++k) dst[n][k] = *(const LAS bf16x8*)(lds + PG8_SB(b, h) + boff + n * 2048 + k * 1024); } while (0)
#define PG8_MMA(ai, bj, At, Bt) do { __builtin_amdgcn_s_setprio(1); _Pragma("unroll") for (int m = 0; m < 4; ++m) _Pragma("unroll") for (int n = 0; n < 2; ++n) _Pragma("unroll") for (int k = 0; k < 2; ++k) \
        acc[ai][bj][m][n] = __builtin_amdgcn_mfma_f32_16x16x32_bf16(Bt[n][k], At[m][k], acc[ai][bj][m][n], 0, 0, 0); __builtin_amdgcn_s_setprio(0); } while (0)
#define PG8_WAIT_V(n) asm volatile("s_waitcnt vmcnt(" #n ")" ::: "memory")
#define PG8_WAIT_L(n) asm volatile("s_waitcnt lgkmcnt(" #n ")" ::: "memory")
#define PG8_BAR __builtin_amdgcn_s_barrier()
#define PG8_SCHED __builtin_amdgcn_sched_barrier(0)
    Unit cur, nxt; int ui = 0;
    if (!S.next(0, cur)) return;
    f32x4 acc[2][2][4][2];
#pragma unroll
    for (int a = 0; a < 2; ++a)
#pragma unroll
        for (int b = 0; b < 2; ++b)
#pragma unroll
            for (int m = 0; m < 4; ++m)
#pragma unroll
                for (int n = 0; n < 2; ++n) acc[a][b][m][n] = (f32x4){0.f, 0.f, 0.f, 0.f};
    bf16x8 At[4][2], B0[2][2], B1[2][2];
    const char* cA; const char* cB;
    { const bf16 *pa, *pb; P.operands(cur, pa, pb); cA = (const char*)pa + (size_t)cur.pm * tstep; cB = (const char*)pb + (size_t)cur.pn * tstep; }
    if constexpr (SP2) {
        PG8_STAGE(PG8_SB(0, 0), cB, voffB); PG8_STAGE(PG8_SB(0, 1), cB + hstep, voffB); PG8_STAGE(PG8_SA(0, 0), cA, voffA); PG8_STAGE(PG8_SA(0, 1), cA + hstep, voffA);
        if (wr == 1) PG8_BAR;
        PG8_WAIT_V(2); PG8_BAR;
        PG8_STAGE(PG8_SB(1, 0), cB + kstep, voffB); PG8_STAGE(PG8_SA(1, 0), cA + kstep, voffA); PG8_STAGE(PG8_SB(1, 1), cB + hstep + kstep, voffB);
        PG8_WAIT_V(6); PG8_BAR;
    } else {
        PG8_STAGE(PG8_SB(0, 0), cB, voffB); PG8_STAGE(PG8_SA(0, 0), cA, voffA); PG8_STAGE(PG8_SB(0, 1), cB + hstep, voffB); PG8_STAGE(PG8_SA(0, 1), cA + hstep, voffA);
        if (wr == 1) PG8_BAR;
        PG8_WAIT_V(4); PG8_BAR;
        PG8_STAGE(PG8_SB(1, 0), cB + kstep, voffB); PG8_STAGE(PG8_SA(1, 0), cA + kstep, voffA); PG8_STAGE(PG8_SB(1, 1), cB + hstep + kstep, voffB);
        PG8_WAIT_V(6); PG8_BAR;
    }
    for (;;) {
        const bool has_next = S.next(ui + 1, nxt);
        const char* nA = cA; const char* nB = cB;
        if (has_next) { const bf16 *pa, *pb; P.operands(nxt, pa, pb); nA = (const char*)pa + (size_t)nxt.pm * tstep; nB = (const char*)pb + (size_t)nxt.pn * tstep; }
        for (int t = 0; t < nt; t += 2) {
            const bool last = (t == nt - 2);
            const char* a1 = cA + (size_t)(t + 1) * kstep;
            const char* a2 = last ? nA : cA + (size_t)(t + 2) * kstep; const char* b2 = last ? nB : cB + (size_t)(t + 2) * kstep;
            const char* a3 = a2 + kstep; const char* b3 = b2 + kstep;
            if constexpr (SP2) {
            PG8_LDB(B0, 0, 0); PG8_LDB(B1, 0, 1); PG8_SCHED; PG8_LDA(At, 0, 0); PG8_STAGE(PG8_SA(1, 1), a1 + hstep, voffA);
            PG8_WAIT_V(8); PG8_WAIT_L(0); PG8_BAR; PG8_MMA(0, 0, At, B0); PG8_MMA(0, 1, At, B1); PG8_BAR; PG8_SCHED;
            PG8_LDA(At, 0, 1); PG8_STAGE(PG8_SB(0, 0), b2, voffB); PG8_STAGE(PG8_SB(0, 1), b2 + hstep, voffB); PG8_STAGE(PG8_SA(0, 0), a2, voffA);
            PG8_WAIT_V(8); PG8_WAIT_L(0); PG8_BAR; PG8_MMA(1, 0, At, B0); PG8_MMA(1, 1, At, B1); PG8_BAR; PG8_SCHED;
            PG8_LDB(B0, 1, 0); PG8_LDB(B1, 1, 1); PG8_SCHED; PG8_LDA(At, 1, 0); PG8_STAGE(PG8_SA(0, 1), a2 + hstep, voffA);
            PG8_WAIT_V(8); PG8_WAIT_L(0); PG8_BAR; PG8_MMA(0, 0, At, B0); PG8_MMA(0, 1, At, B1); PG8_BAR; PG8_SCHED;
            PG8_LDA(At, 1, 1); PG8_STAGE(PG8_SB(1, 0), b3, voffB); PG8_STAGE(PG8_SB(1, 1), b3 + hstep, voffB); PG8_STAGE(PG8_SA(1, 0), a3, voffA);
            PG8_WAIT_V(8); PG8_WAIT_L(0); PG8_BAR; PG8_MMA(1, 0, At, B0); PG8_MMA(1, 1, At, B1); PG8_BAR; PG8_SCHED;
            } else {
            PG8_LDB(B0, 0, 0); PG8_SCHED; PG8_LDA(At, 0, 0); PG8_STAGE(PG8_SA(1, 1), a1 + hstep, voffA);
            PG8_WAIT_L(8); PG8_BAR; PG8_WAIT_L(0); PG8_MMA(0, 0, At, B0); PG8_BAR; PG8_SCHED;
            PG8_LDB(B1, 0, 1); PG8_STAGE(PG8_SB(0, 0), b2, voffB);
            PG8_BAR; PG8_WAIT_L(0); PG8_MMA(0, 1, At, B1); PG8_BAR;
            PG8_LDA(At, 0, 1); PG8_STAGE(PG8_SA(0, 0), a2, voffA);
            PG8_BAR; PG8_WAIT_L(0); PG8_MMA(1, 0, At, B0); PG8_BAR; PG8_SCHED;
            PG8_STAGE(PG8_SB(0, 1), b2 + hstep, voffB);
            PG8_WAIT_V(6); PG8_BAR; PG8_MMA(1, 1, At, B1); PG8_BAR;
            PG8_LDB(B0, 1, 0); PG8_SCHED; PG8_LDA(At, 1, 0); PG8_STAGE(PG8_SA(0, 1), a2 + hstep, voffA);
            PG8_WAIT_L(8); PG8_BAR; PG8_WAIT_L(0); PG8_MMA(0, 0, At, B0); PG8_BAR; PG8_SCHED;
            PG8_LDB(B1, 1, 1); PG8_STAGE(PG8_SB(1, 0), b3, voffB);
            PG8_BAR; PG8_WAIT_L(0); PG8_MMA(0, 1, At, B1); PG8_BAR;
            PG8_LDA(At, 1, 1); PG8_STAGE(PG8_SA(1, 0), a3, voffA);
            PG8_BAR; PG8_WAIT_L(0); PG8_MMA(1, 0, At, B0); PG8_BAR; PG8_SCHED;
            PG8_STAGE(PG8_SB(1, 1), b3 + hstep, voffB);
            PG8_WAIT_V(6); PG8_BAR; PG8_MMA(1, 1, At, B1); PG8_BAR;
            }
        }
        if constexpr (ALIGN_EPI) { if (wr == 0) PG8_BAR; }
        E(acc, cur, wr, wc, fr, fq);
        if (!has_next) break;
#pragma unroll
        for (int a = 0; a < 2; ++a)
#pragma unroll
            for (int b = 0; b < 2; ++b)
#pragma unroll
                for (int m = 0; m < 4; ++m)
#pragma unroll
                    for (int n = 0; n < 2; ++n) acc[a][b][m][n] = (f32x4){0.f, 0.f, 0.f, 0.f};
        cur = nxt; cA = nA; cB = nB; ++ui;
        if constexpr (ALIGN_EPI) { if (wr == 1) PG8_BAR; }
    }
    PG8_WAIT_V(0);
    if constexpr (!ALIGN_EPI) { if (wr == 0) PG8_BAR; }
    PG8_BAR;
#undef PG8_SA
#undef PG8_SB
#undef PG8_STAGE
#undef PG8_LDA
#undef PG8_LDB
#undef PG8_MMA
#undef PG8_WAIT_V
#undef PG8_WAIT_L
#undef PG8_BAR
#undef PG8_SCHED
}
}
#ifndef USE_PG8
#define USE_PG8 1
#endif
template <int ZN, class Prob, class Epi>
__device__ __forceinline__ void gemm_run(const Ctx& c, const Prob& P, const Epi& E, int nM, int nN, int pn0) {
#if USE_PG8
    pg8::StaticOrder<ZN> S; S.init(nM, nN, pn0, c.G, c.bid);
    pg8::gemm_phase<Prob, Epi, pg8::StaticOrder<ZN>, true, true>(c.lds, P, S, E);
#else
    pg8::StaticOrder<ZN> S; S.init(nM, nN, pn0, c.G, c.bid);
    gemm_naive(c, P, S, E);
#endif
}

#define EPI_ROWS_BEGIN _Pragma("unroll") for (int ai = 0; ai < 2; ++ai) _Pragma("unroll") for (int m = 0; m < 4; ++m) { const int row = 256 * u.pm + 128 * ai + 64 * wr + 16 * m + fr; \
    const f32x4 l0 = acc[ai][0][m][0], l1 = acc[ai][0][m][1], h0 = acc[ai][1][m][0], h1 = acc[ai][1][m][1]; (void)l0; (void)l1; (void)h0; (void)h1;
#define EPI_ROWS_END if (m == 3) asm volatile("" ::: "memory"); }
typedef f32x4 Acc_t[2][2][4][2];

__device__ __forceinline__ void rope8(const float* cs, const float* sn, f32x4 x1a, f32x4 x1b, f32x4 x2a, f32x4 x2b, float sc, f32x4& o1a, f32x4& o1b, f32x4& o2a, f32x4& o2b) {
    const f32x4 ca = *(const f32x4*)cs, cb = *(const f32x4*)(cs + 4), sa = *(const f32x4*)sn, sb = *(const f32x4*)(sn + 4);
    o1a = (x1a * ca - x2a * sa) * sc; o1b = (x1b * cb - x2b * sb) * sc; o2a = (x2a * ca + x1a * sa) * sc; o2b = (x2b * cb + x1b * sb) * sc;
}
struct EpiEarly {
    const Ctx& c; int layer;
    __device__ __forceinline__ void operator()(const Acc_t& acc, const Unit& u, int wr, int wc, int fr, int fq) const {
        const int c8 = 32 * wc + 8 * fq, t = u.pn;
        bf16 *QA = WSP(bf16, WS_QA), *KA = WSP(bf16, WS_KA) + (size_t)FR * PKA, *VA = WSP(bf16, WS_VA) + (size_t)FR * PVA, *QC = WSP(bf16, WS_QC), *KC = WSP(bf16, WS_KC) + (size_t)FR * PKC,
             *VC = WSP(bf16, WS_VC) + (size_t)FR * PVC, *CQ = WSP(bf16, WS_CQ), *CKV = WSP(bf16, WS_CKV), *KB = WSP(bf16, WS_KB) + (size_t)FR * PKB;
        const float *cos64 = WSP(float, WS_COS64), *sin64 = WSP(float, WS_SIN64), *cos32 = WSP(float, WS_COS32), *sin32 = WSP(float, WS_SIN32);
        if (t < 2) { EPI_ROWS_BEGIN st8(QA + (size_t)row * PQA + 256 * t + c8, l0 * C2A, l1 * C2A); st8(QA + (size_t)row * PQA + 256 * t + 128 + c8, h0 * C2A, h1 * C2A); EPI_ROWS_END }
        else if (t < 4) { const int L0 = 256 * (t - 2) + c8, L1 = L0 + 128;
            EPI_ROWS_BEGIN st8(KA + (size_t)row * PKA + (L0 >> 6) * 80 + (L0 & 63), l0, l1); st8(KA + (size_t)row * PKA + (L1 >> 6) * 80 + (L1 & 63), h0, h1); EPI_ROWS_END }
        else if (t < 6) { EPI_ROWS_BEGIN st8(VA + (size_t)row * PVA + 256 * (t - 4) + c8, l0, l1); st8(VA + (size_t)row * PVA + 256 * (t - 4) + 128 + c8, h0, h1); EPI_ROWS_END }
        else if (t < 8) { const int head = 4 * (t - 6) + wc, d = 8 * fq;
            EPI_ROWS_BEGIN const int pos = NMETA + (row & (SEQ - 1)); f32x4 o1a, o1b, o2a, o2b; rope8(cos64 + pos * 32 + d, sin64 + pos * 32 + d, l0, l1, h0, h1, C2C, o1a, o1b, o2a, o2b);
                st8(QC + (size_t)row * PQC + head * 64 + d, o1a, o1b); st8(QC + (size_t)row * PQC + head * 64 + 32 + d, o2a, o2b); EPI_ROWS_END }
        else if (t == 8) {
            if (wc < 2) { const int d = 8 * fq;
                EPI_ROWS_BEGIN const int pos = NMETA + (row & (SEQ - 1)); f32x4 o1a, o1b, o2a, o2b; rope8(cos64 + pos * 32 + d, sin64 + pos * 32 + d, l0, l1, h0, h1, 1.f, o1a, o1b, o2a, o2b);
                    st8(KC + (size_t)row * PKC + wc * 64 + d, o1a, o1b); st8(KC + (size_t)row * PKC + wc * 64 + 32 + d, o2a, o2b); EPI_ROWS_END }
            else { const int j = 32 * (wc - 2) + 8 * fq;
                EPI_ROWS_BEGIN st8(VC + (size_t)row * PVC + j, l0, l1); st8(VC + (size_t)row * PVC + 64 + j, h0, h1); EPI_ROWS_END } }
        else if (t == 9) { EPI_ROWS_BEGIN st8(CQ + (size_t)row * PCQ + c8, l0, l1); st8(CQ + (size_t)row * PCQ + 128 + c8, h0, h1); EPI_ROWS_END }
        else if (t == 10) {
            if (wc < 2) { EPI_ROWS_BEGIN st8(CQ + (size_t)row * PCQ + 256 + c8, l0, l1); st8(CQ + (size_t)row * PCQ + 256 + 64 + c8, h0, h1); EPI_ROWS_END }
            else if (wc == 2) {
                if (fq < 2) { const int d = 8 * fq;
                    EPI_ROWS_BEGIN const int pos = NMETA + (row & (SEQ - 1)); f32x4 o1a, o1b, o2a, o2b; rope8(cos32 + pos * 16 + d, sin32 + pos * 16 + d, l0, l1, h0, h1, 1.f, o1a, o1b, o2a, o2b);
                        const u32x4 w1 = pack8(o1a, o1b), w2 = pack8(o2a, o2b);
#pragma unroll
                        for (int h = 0; h < 8; ++h) { *(u32x4*)(KB + (size_t)row * PKB + h * 96 + 64 + d) = w1; *(u32x4*)(KB + (size_t)row * PKB + h * 96 + 80 + d) = w2; } EPI_ROWS_END }
                else if (fq == 2) { float* LF = WSP(float, WS_LF); const f32x4 b0 = *(const f32x4*)(c.b_f + layer * 8), b1 = *(const f32x4*)(c.b_f + layer * 8 + 4);
                    EPI_ROWS_BEGIN f32x4 a = l0 + b0, b = l1 + b1;
#pragma unroll
                        for (int j = 0; j < 4; ++j) { a[j] = logsigf_(a[j]); b[j] = logsigf_(b[j]); }
                        *(f32x4*)(LF + (size_t)row * 8) = a; *(f32x4*)(LF + (size_t)row * 8 + 4) = b; EPI_ROWS_END } } }
        else { EPI_ROWS_BEGIN st8(CKV + (size_t)row * PCKV + c8, l0, l1); st8(CKV + (size_t)row * PCKV + 128 + c8, h0, h1); EPI_ROWS_END }
    }
};
struct EpiUq {
    const Ctx& c;
    __device__ __forceinline__ void operator()(const Acc_t& acc, const Unit& u, int wr, int wc, int fr, int fq) const {
        bf16* QB = WSP(bf16, WS_QB); const float* RQ = WSP(float, WS_RQ); const float *cos32 = WSP(float, WS_COS32), *sin32 = WSP(float, WS_SIN32);
        const int c8 = 32 * wc + 8 * fq;
        if (u.pn < 2) { const int ha = 4 * u.pn + (c8 >> 6), hb = ha + 2, e = c8 & 63;
            EPI_ROWS_BEGIN const float sc = RQ[row] * C2B; st8(QB + (size_t)row * PQB + ha * 96 + e, l0 * sc, l1 * sc); st8(QB + (size_t)row * PQB + hb * 96 + e, h0 * sc, h1 * sc); EPI_ROWS_END }
        else { const int h = c8 >> 4, d = c8 & 15;
            EPI_ROWS_BEGIN const float sc = RQ[row] * C2B; const int pos = NMETA + (row & (SEQ - 1)); f32x4 o1a, o1b, o2a, o2b; rope8(cos32 + pos * 16 + d, sin32 + pos * 16 + d, l0, l1, h0, h1, sc, o1a, o1b, o2a, o2b);
                st8(QB + (size_t)row * PQB + h * 96 + 64 + d, o1a, o1b); st8(QB + (size_t)row * PQB + h * 96 + 80 + d, o2a, o2b); EPI_ROWS_END }
    }
};
struct EpiUkv {
    const Ctx& c;
    __device__ __forceinline__ void operator()(const Acc_t& acc, const Unit& u, int wr, int wc, int fr, int fq) const {
        bf16 *KB = WSP(bf16, WS_KB) + (size_t)FR * PKB, *VB = WSP(bf16, WS_VB) + (size_t)FR * PVB; const float* RKV = WSP(float, WS_RKV);
        const int c8 = 32 * wc + 8 * fq, ha = 2 * u.pn, hb = ha + 1;
        if (wc < 2) { EPI_ROWS_BEGIN const float sc = RKV[row]; st8(KB + (size_t)row * PKB + ha * 96 + c8, l0 * sc, l1 * sc); st8(KB + (size_t)row * PKB + hb * 96 + c8, h0 * sc, h1 * sc); EPI_ROWS_END }
        else { EPI_ROWS_BEGIN const float sc = RKV[row]; st8(VB + (size_t)row * PVB + ha * 64 + c8 - 64, l0 * sc, l1 * sc); st8(VB + (size_t)row * PVB + hb * 64 + c8 - 64, h0 * sc, h1 * sc); EPI_ROWS_END }
    }
};
struct EpiLateZ {
    const Ctx& c;
    __device__ __forceinline__ void operator()(const Acc_t& acc, const Unit& u, int wr, int wc, int fr, int fq) const {
        const int c8 = 32 * wc + 8 * fq, t = u.pn;
        bf16* Y = (t < 2) ? WSP(bf16, WS_QA) : (t < 4) ? WSP(bf16, WS_YB) : WSP(bf16, WS_QC); const int col = 256 * (t & 1) + c8;
        EPI_ROWS_BEGIN
            { bf16* p = Y + (size_t)row * PY + col; f32x4 ya, yb; ld8(p, ya, yb);
#pragma unroll
              for (int j = 0; j < 4; ++j) { ya[j] *= siluf_(l0[j]); yb[j] *= siluf_(l1[j]); }
              st8(p, ya, yb); }
            { bf16* p = Y + (size_t)row * PY + col + 128; f32x4 ya, yb; ld8(p, ya, yb);
#pragma unroll
              for (int j = 0; j < 4; ++j) { ya[j] *= siluf_(h0[j]); yb[j] *= siluf_(h1[j]); }
              st8(p, ya, yb); }
        EPI_ROWS_END
    }
};
struct EpiLateG {
    const Ctx& c;
    __device__ __forceinline__ void operator()(const Acc_t& acc, const Unit& u, int wr, int wc, int fr, int fq) const {
        bf16* Gp = WSP(bf16, WS_G); const int col = 256 * (u.pn - 6) + 32 * wc + 8 * fq;
        EPI_ROWS_BEGIN f32x4 a = l0, b = l1, cc = h0, d = h1;
#pragma unroll
            for (int j = 0; j < 4; ++j) { a[j] = sigmoidf_(a[j]); b[j] = sigmoidf_(b[j]); cc[j] = sigmoidf_(cc[j]); d[j] = sigmoidf_(d[j]); }
            st8(Gp + (size_t)row * PG + col, a, b); st8(Gp + (size_t)row * PG + col + 128, cc, d); EPI_ROWS_END
    }
};
struct EpiBranch {
    const Ctx& c;
    __device__ __forceinline__ void operator()(const Acc_t& acc, const Unit& u, int wr, int wc, int fr, int fq) const {
        const bf16* Gp = WSP(bf16, WS_G); bf16* MG = WSP(bf16, WS_HN); const int col = 256 * u.pn + 32 * wc + 8 * fq;
        EPI_ROWS_BEGIN
#pragma unroll
            for (int bj = 0; bj < 2; ++bj) { f32x4 ga, gb; ld8(Gp + (size_t)row * PG + u.z * DM + col + 128 * bj, ga, gb); f32x4 va = (bj ? h0 : l0) * ga, vb = (bj ? h1 : l1) * gb;
                bf16* p = MG + (size_t)row * DM + col + 128 * bj; if (u.z > 0) { f32x4 pa, pb; ld8(p, pa, pb); va += pa; vb += pb; } st8(p, va, vb); } EPI_ROWS_END
    }
};
struct EpiOut {
    const float* resid; float* out;
    __device__ __forceinline__ void operator()(const Acc_t& acc, const Unit& u, int wr, int wc, int fr, int fq) const {
        const int col = 256 * u.pn + 32 * wc + 8 * fq;
        EPI_ROWS_BEGIN const size_t off = (size_t)row * DM + col;
            const f32x4 r0 = *(const f32x4*)(resid + off), r1 = *(const f32x4*)(resid + off + 4), r2 = *(const f32x4*)(resid + off + 128), r3 = *(const f32x4*)(resid + off + 132);
            *(f32x4*)(out + off) = r0 + l0; *(f32x4*)(out + off + 4) = r1 + l1; *(f32x4*)(out + off + 128) = r2 + h0; *(f32x4*)(out + off + 132) = r3 + h1; EPI_ROWS_END
    }
};

__device__ __forceinline__ void stats_cumsum(const Ctx& c, int layer) {
    const int gw = c.bid * NWAVES + c.wave, NGW = c.G * NWAVES;
    for (int m = gw; m < M; m += NGW) {
        float sq = 0.f, sk = 0.f;
        if (c.lane < 48) { f32x4 a, b; ld8(WSP(bf16, WS_CQ) + (size_t)m * PCQ + 8 * c.lane, a, b); sq = (a[0] * a[0] + a[1] * a[1]) + (a[2] * a[2] + a[3] * a[3]) + (b[0] * b[0] + b[1] * b[1]) + (b[2] * b[2] + b[3] * b[3]); }
        if (c.lane < 32) { f32x4 a, b; ld8(WSP(bf16, WS_CKV) + (size_t)m * PCKV + 8 * c.lane, a, b); sk = (a[0] * a[0] + a[1] * a[1]) + (a[2] * a[2] + a[3] * a[3]) + (b[0] * b[0] + b[1] * b[1]) + (b[2] * b[2] + b[3] * b[3]); }
        sq = wave_sum(sq); sk = wave_sum(sk);
        if (c.lane == 0) { WSP(float, WS_RQ)[m] = 1.f / sqrtf(sq * (1.f / 384.f) + EPS); WSP(float, WS_RKV)[m] = 1.f / sqrtf(sk * (1.f / 256.f) + EPS); }
    }
    { LAS float* wmax = (LAS float*)(c.lds + 4096);
      const int hh = c.lane >> 3, sub = c.lane & 7;
      for (int r0 = 8 * gw; r0 < M; r0 += 8 * NGW) {
          float mq = 0.f, mk = 0.f;
#pragma unroll
          for (int i = 0; i < 8; ++i) { const size_t m = (size_t)r0 + i; f32x4 a, b;
              ld8(WSP(bf16, WS_QA) + m * PQA + hh * 64 + sub * 8, a, b); float sq = (a[0] * a[0] + a[1] * a[1]) + (a[2] * a[2] + a[3] * a[3]) + (b[0] * b[0] + b[1] * b[1]) + (b[2] * b[2] + b[3] * b[3]);
              ld8(WSP(bf16, WS_KA) + (FR + m) * PKA + hh * 80 + sub * 8, a, b); float sk = (a[0] * a[0] + a[1] * a[1]) + (a[2] * a[2] + a[3] * a[3]) + (b[0] * b[0] + b[1] * b[1]) + (b[2] * b[2] + b[3] * b[3]);
              sq += __shfl_xor(sq, 1); sq += __shfl_xor(sq, 2); sq += __shfl_xor(sq, 4); sk += __shfl_xor(sk, 1); sk += __shfl_xor(sk, 2); sk += __shfl_xor(sk, 4);
              mq = fmaxf(mq, sq); mk = fmaxf(mk, sk); }
          __syncthreads();
          if (sub == 0) { wmax[c.wave * 16 + hh] = mq; wmax[c.wave * 16 + 8 + hh] = mk; }
          __syncthreads();
          if (c.tid < 16) { float v = wmax[c.tid];
#pragma unroll
              for (int w = 1; w < NWAVES; ++w) v = fmaxf(v, wmax[w * 16 + c.tid]);
              const int b = (8 * (r0 - 8 * c.wave)) / (8 * SEQ);
              gu32* dst = (gu32*)(c.ws + WS_CTL) + ((c.tid < 8) ? CW_QN : CW_KN) + layer * 64 + b * 8 + (c.tid & 7);
              __hip_atomic_fetch_max(dst, __float_as_uint(v), RLX_AGENT); }
      } }
    __syncthreads();
    LAS double* wsum = (LAS double*)(c.lds);
    for (int task = c.bid; task < NBATCH * 8; task += c.G) {
        const int b = task >> 3, h = task & 7; const float* LF = WSP(float, WS_LF) + (size_t)b * SEQ * 8 + h;
        double v[8]; double s = 0.0;
#pragma unroll
        for (int j = 0; j < 8; ++j) { s += (double)LF[(size_t)(8 * c.tid + j) * 8]; v[j] = s; }
        double inc = s;
#pragma unroll
        for (int o = 1; o < 64; o <<= 1) { const double n = __shfl_up(inc, o); if (c.lane >= o) inc += n; }
        __syncthreads();
        if (c.lane == 63) wsum[c.wave] = inc;
        __syncthreads();
        double base = inc - s;
        for (int w = 0; w < c.wave; ++w) base += wsum[w];
        bf16* KA = WSP(bf16, WS_KA) + (size_t)(FR + b * SEQ) * PKA + h * 80 + 64;
#pragma unroll
        for (int j = 0; j < 8; ++j) { const float bias = (float)(-(base + v[j]) * 1.4426950408889634); bf16 bh, bm, bl; split3(bias, bh, bm, bl);
            WSP(float, WS_CUMB)[(size_t)task * SEQ + 8 * c.tid + j] = bias;
            u32x4 w0 = {(unsigned)bh | ((unsigned)bm << 16), (unsigned)bl | 0x3F800000u, 0x3F803F80u, 0u}, w1 = {0u, 0u, 0u, 0u};   bf16* kp = KA + (size_t)(8 * c.tid + j) * PKA; *(u32x4*)kp = w0; *(u32x4*)(kp + 8) = w1; }
    }
}
__device__ __forceinline__ void final_norm(const Ctx& c) {
    const int gw = c.bid * NWAVES + c.wave, NGW = c.G * NWAVES;
    for (int m = gw; m < M; m += NGW) {
        f32x4* xr = (f32x4*)(c.out + (size_t)m * DM) + c.lane; f32x4 v[4]; float s = 0.f;
#pragma unroll
        for (int j = 0; j < 4; ++j) { v[j] = xr[64 * j]; s += (v[j][0] * v[j][0] + v[j][1] * v[j][1]) + (v[j][2] * v[j][2] + v[j][3] * v[j][3]); }
        const float rstd = 1.f / sqrtf(wave_sum(s) * (1.f / DM) + EPS);
#pragma unroll
        for (int j = 0; j < 4; ++j) { const f32x4 g = ((const f32x4*)c.final_g + c.lane)[64 * j]; xr[64 * j] = v[j] * rstd * g; }
    }
}

#define XB_TMO      128
#define XB_XCNT(j)  (256  + 64 * (j))
#define XB_XSUB(j)  (1280 + 64 * (j))
#define XB_XGEN(j)  (2304 + 64 * (j))
#define XB_TOP      3328
#define XB_TOPGEN   3392
#define XCD_BAR_WORDS 3456
#define XB_SPIN_CAP (1u << 18)
__device__ __forceinline__ unsigned xb_ld(unsigned* p)              { return __hip_atomic_load(p, __ATOMIC_RELAXED, __HIP_MEMORY_SCOPE_AGENT); }
__device__ __forceinline__ unsigned xb_add(unsigned* p, unsigned v) { return __hip_atomic_fetch_add(p, v, __ATOMIC_RELAXED, __HIP_MEMORY_SCOPE_AGENT); }
__device__ __forceinline__ unsigned xb_xcc_id() { return (unsigned)__builtin_amdgcn_s_getreg((3 << 11) | 20) & 0xFu; }
#define XB_SPIN(cond, bar) do { unsigned _sp = 0; while (cond) { __builtin_amdgcn_s_sleep(1); \
    if ((++_sp & 255u) == 0u) { if (xb_ld(&(bar)[XB_TMO])) break; if (_sp > XB_SPIN_CAP) { atomicAdd(&(bar)[XB_TMO], 1u); break; } } } } while (0)
struct XcdBarrier { unsigned* bar; unsigned x; volatile LAS unsigned* st; };
__device__ __forceinline__ XcdBarrier xcd_barrier_post(unsigned* bar, volatile LAS unsigned* st) {
    XcdBarrier b; b.bar = bar; b.x = xb_xcc_id(); b.st = st;
    if (threadIdx.x == 0) (void)xb_add(&bar[XB_XCNT(b.x)], 1u);
    return b;
}
__device__ __forceinline__ void xcd_barrier_complete(unsigned* bar, unsigned x, unsigned& nloc, unsigned& nx) {
    const unsigned G = gridDim.x * gridDim.y * gridDim.z;
    unsigned sum, cnt, mine, sp = 0u;
    for (;;) {
        sum = 0u; cnt = 0u; mine = 0u;
#pragma unroll
        for (unsigned j = 0; j < 16; ++j) { const unsigned cc = xb_ld(&bar[XB_XCNT(j)]); sum += cc; cnt += (cc > 0u) ? 1u : 0u; mine = (j == x) ? cc : mine; }
        if (sum == G) break;
        __builtin_amdgcn_s_sleep(1);
        if ((++sp & 255u) == 0u) { if (xb_ld(&bar[XB_TMO])) break; if (sp > XB_SPIN_CAP) { atomicAdd(&bar[XB_TMO], 1u); break; } }
    }
    nloc = mine > 0u ? mine : 1u; nx = cnt > 0u ? cnt : 1u;
}
__device__ __forceinline__ void xcd_barrier(const XcdBarrier& b) {
    asm volatile("s_waitcnt vmcnt(0)" ::: "memory");
    __syncthreads();
    if (threadIdx.x == 0) {
        unsigned* bar = b.bar;
        __builtin_amdgcn_s_waitcnt(0);
        unsigned nloc = b.st[0], nx = b.st[1];
        if (nloc == 0u) { xcd_barrier_complete(bar, b.x, nloc, nx); b.st[0] = nloc; b.st[1] = nx; }
        const unsigned old = xb_add(&bar[XB_XSUB(b.x)], 1u);
        const unsigned gen = old / nloc;
        if (old + 1u == (gen + 1u) * nloc) {
            __builtin_amdgcn_fence(__ATOMIC_RELEASE, "agent");
            asm volatile("s_waitcnt vmcnt(0)" ::: "memory");
            const unsigned og = xb_add(&bar[XB_TOP], 1u);
            const unsigned tg = og / nx;
            if (og + 1u == (tg + 1u) * nx) xb_add(&bar[XB_TOPGEN], 1u);
            else XB_SPIN(xb_ld(&bar[XB_TOPGEN]) == tg, bar);
            __builtin_amdgcn_fence(__ATOMIC_ACQUIRE, "agent");
            xb_add(&bar[XB_XGEN(b.x)], 1u);
            asm volatile("s_waitcnt vmcnt(0)" ::: "memory");
        } else {
            XB_SPIN(xb_ld(&bar[XB_XGEN(b.x)]) == gen, bar);
            __builtin_amdgcn_fence(__ATOMIC_ACQUIRE, "agent");
            asm volatile("s_waitcnt vmcnt(0)" ::: "memory");
        }
    }
    __syncthreads();
}

constexpr int NSLOTS = 18;
constexpr int CW_BAR = 4096;

struct Args { const float* in[13]; float* out; unsigned char* ws; int ph_lo, ph_hi, pad0, pad1; };
#define CAS __attribute__((address_space(4)))
__device__ __forceinline__ Ctx make_ctx() {
    const CAS char* kp = (const CAS char*)__builtin_amdgcn_kernarg_segment_ptr();
    asm volatile("" : "+s"(kp));
    const CAS Args* a = (const CAS Args*)kp;
    Ctx c;
    c.x = a->in[0]; c.meta = a->in[1]; c.norm_g = a->in[2]; c.w_in = a->in[3]; c.b_f = a->in[4]; c.g_cq = a->in[5]; c.g_ckv = a->in[6];
    c.w_uq = a->in[7]; c.w_ukv = a->in[8]; c.sinks = a->in[9]; c.w_branch = a->in[10]; c.w_out = a->in[11]; c.final_g = a->in[12];
    c.out = a->out; c.ws = a->ws;
    extern __shared__ __attribute__((aligned(16))) unsigned char lds_raw[];
    c.lds = (LAS unsigned char*)lds_raw;
    c.tid = threadIdx.x; c.lane = c.tid & 63; c.wave = __builtin_amdgcn_readfirstlane(c.tid >> 6); c.G = gridDim.x; c.bid = blockIdx.x;
    return c;
}

template <int SLOT>
__device__ __forceinline__ void run_slot() {
    const Ctx c = make_ctx();
    constexpr int slot = SLOT;
    constexpr int layer = (slot >= 9) ? 1 : 0;
    constexpr int ls = (slot >= 9) ? slot - 8 : slot;
        if constexpr (slot == 0) slot0(c);
        else if constexpr (slot == 17) final_norm(c);
        else if constexpr (ls == 1) {
            zero_fronts(c);
            norm_main(c, layer == 0 ? c.x : c.out);
            meta_blocks(c, AfPlain{WSP(bf16, WS_HNM), DM}, wl(c, layer, WL_EARLY), DM, NE / 16, WSP(float, WS_RAWE), NE, 0);
        } else if constexpr (ls == 2) {
            post_early(c, layer);
            ProbSimple P{WSP(bf16, WS_HN), wl(c, layer, WL_EARLY), DM};
            gemm_run<1>(c, P, EpiEarly{c, layer}, 64, NE / 256, 0);
        } else if constexpr (ls == 3) {
            { const AfPlain af{WSP(bf16, WS_CM), 640}; meta_blocks(c, af, wl(c, layer, WL_UQ), 384, NUQ / 16, WSP(float, WS_RAWU), NUQ + NUKV, 0);
              const AfPlain af2{WSP(bf16, WS_CM) + 384, 640}; meta_blocks(c, af2, wl(c, layer, WL_UKV), 256, NUKV / 16, WSP(float, WS_RAWU), NUQ + NUKV, NUQ); }
            if (c.bid == 0) post_early_reduce(c, layer);
            if (layer == 0) { convert_weights(c, 1); __syncthreads(); }
            stats_cumsum(c, layer);
        } else if constexpr (ls == 4) {
            post_up(c);
            { ProbSimple P{WSP(bf16, WS_CQ), wl(c, layer, WL_UQ), 384}; gemm_run<1>(c, P, EpiUq{c}, 64, NUQ / 256, 0); }
            { ProbSimple P{WSP(bf16, WS_CKV), wl(c, layer, WL_UKV), 256}; gemm_run<1>(c, P, EpiUkv{c}, 64, NUKV / 256, 0); }
        } else if constexpr (ls == 5) {
            if (layer == 0) {
#ifndef NO_ATTNM
                if (c.bid == 0) attn_meta(c);
#endif
 meta_blocks(c, AfPlain{WSP(bf16, WS_HNM), DM}, wl(c, 0, WL_LATE), DM, NL / 16, WSP(float, WS_RAWL), NL, 0); }
#ifdef NAIVE_ATTN
            attn_main_naive(c, layer);
#else
            attn_main_mfma(c, layer);
#endif
        } else if constexpr (ls == 6) {
#ifndef NO_S67
            if (layer == 0) { for (int n = 0; n < 3; ++n) { const AfBranch af{WSP(bf16, WS_YM), WSP(float, WS_RAWL), n}; meta_blocks(c, af, wl(c, 0, WL_BR) + (size_t)n * DM * 512, 512, DM / 16, WSP(float, WS_RAWB) + (size_t)n * 16 * 1024, 1024, 0); } }
#endif
            { ProbSimple P{WSP(bf16, WS_HN), wl(c, layer, WL_LATE), DM}; gemm_run<1>(c, P, EpiLateZ{c}, 64, 6, 0); }
            { ProbSimple P{WSP(bf16, WS_HN), wl(c, layer, WL_LATE), DM}; gemm_run<1>(c, P, EpiLateG{c}, 64, 12, 6); }
        } else if constexpr (ls == 7) {
            if (layer == 0) { const AfMerged af{WSP(float, WS_RAWL), WSP(float, WS_RAWB)}; meta_blocks(c, af, wl(c, 0, WL_OUT), DM, DM / 16, WSP(float, WS_RAWO), DM, 0); }
            { ProbBranch P{WSP(bf16, WS_QA), WSP(bf16, WS_YB), WSP(bf16, WS_QC), wl(c, layer, WL_BR), 512}; gemm_run<3>(c, P, EpiBranch{c}, 64, 4, 0); }
        } else if constexpr (ls == 8) {
            if (layer == 0 && c.bid == 0) post_resid(c);
            ProbSimple P{WSP(bf16, WS_HN), wl(c, layer, WL_OUT), DM};
            gemm_run<1>(c, P, EpiOut{layer == 0 ? c.x : c.out, c.out}, 64, DM / 256, 0);
        }
}

__global__ void __launch_bounds__(NTHREADS, 2) skel_fwd(Args args) {
    const Ctx c = make_ctx();
    volatile LAS unsigned* MISC = (volatile LAS unsigned*)(c.lds + MISC_OFF);
    for (int u = c.tid; u < (LDS_BYTES - 131072) / 4; u += NTHREADS) ((LAS unsigned*)(c.lds + 131072))[u] = 0u;
    __syncthreads();
    XcdBarrier bar; bar.bar = (unsigned*)(c.ws + WS_CTL) + CW_BAR; bar.x = 0; bar.st = nullptr;
    const int lo = args.ph_lo, hi = args.ph_hi;
    if (hi - lo > 1) bar = xcd_barrier_post((unsigned*)(c.ws + WS_CTL) + CW_BAR, MISC + 8);

#ifndef SLOT_ON
#define SLOT_ON(k) true
#endif
#ifndef SLOT_REPS
#define SLOT_REPS(k) 1
#endif
#define RUN_SLOT(k) if (SLOT_ON(k) && lo <= (k) && (k) < hi) { _Pragma("nounroll") for (int rep_ = 0; rep_ < SLOT_REPS(k); ++rep_) { run_slot<k>(); if ((k) + 1 < hi) xcd_barrier(bar); } }
    RUN_SLOT(0) RUN_SLOT(1) RUN_SLOT(2) RUN_SLOT(3) RUN_SLOT(4) RUN_SLOT(5) RUN_SLOT(6) RUN_SLOT(7) RUN_SLOT(8)
    RUN_SLOT(9) RUN_SLOT(10) RUN_SLOT(11) RUN_SLOT(12) RUN_SLOT(13) RUN_SLOT(14) RUN_SLOT(15) RUN_SLOT(16) RUN_SLOT(17)
#undef RUN_SLOT
}

extern "C" void kernel_launch(void* const* d_in, const int* in_sizes, int n_in, void* d_out, int out_size, void* d_ws, size_t ws_size, hipStream_t stream) {
    static int grid = 0;
    if (grid == 0) {
        if (n_in != 13 || out_size != M * DM || ws_size < WS_END) { fprintf(stderr, "kernel_launch: unexpected shapes (n_in %d out %d ws %zu need %zu)\n", n_in, out_size, ws_size, (size_t)WS_END); grid = -1; return; }
        int dev = 0, cus = 0, per_cu = 0;
        if (hipGetDevice(&dev) != hipSuccess || hipDeviceGetAttribute(&cus, hipDeviceAttributeMultiprocessorCount, dev) != hipSuccess) { grid = -1; return; }
        if (hipFuncSetAttribute((const void*)skel_fwd, hipFuncAttributeMaxDynamicSharedMemorySize, LDS_BYTES) != hipSuccess) { fprintf(stderr, "kernel_launch: hipFuncSetAttribute failed\n"); grid = -1; return; }
        if (hipOccupancyMaxActiveBlocksPerMultiprocessor(&per_cu, (const void*)skel_fwd, NTHREADS, LDS_BYTES) != hipSuccess || per_cu < 1) fprintf(stderr, "kernel_launch: occupancy query says %d\n", per_cu);
        (void)hipGetLastError();
        grid = cus;
    }
    if (grid < 0) return;
    (void)hipMemsetAsync((char*)d_ws + WS_CTL, 0, CTL_BYTES, stream);
    Args a{};
    for (int i = 0; i < 13; ++i) a.in[i] = (const float*)d_in[i];
    a.out = (float*)d_out; a.ws = (unsigned char*)d_ws;
#if MK_SINGLE
    a.ph_lo = 0; a.ph_hi = NSLOTS;
    hipLaunchKernelGGL(skel_fwd, dim3(grid), dim3(NTHREADS), LDS_BYTES, stream, a);
#else
#ifndef HOST_REPS
#define HOST_REPS(s) 1
#endif
    for (int s = 0; s < NSLOTS; ++s) for (int r = 0; r < HOST_REPS(s); ++r) { a.ph_lo = s; a.ph_hi = s + 1; hipLaunchKernelGGL(skel_fwd, dim3(grid), dim3(NTHREADS), LDS_BYTES, stream, a); }
#endif
}
```
